# Optimizing an MI355X kernel written in HIP

```python
import math
import jax, jax.numpy as jnp
from jax import lax
import numpy as np

D_MODEL = 1024
BATCH = 8
SEQ = 2048
DEPTH = 2

CTX_LEN = 256
GRID_W = 64
CHUNK = 64
NORM_EPS = 1e-6
GDN_HEADS = 4
GDN_DK = 128
GDN_DV = 128
GDN_QKV = 3 * GDN_HEADS * GDN_DK
GLA_HEADS = 4
GLA_DK = 64
GLA_DV = 128
GLA_RANK = 16
GLA_NORMALIZER = 16.0
D_FF = 2816
SPLITS = (GDN_HEADS * GDN_DK, GDN_HEADS * GDN_DK, GDN_HEADS * GDN_DV, GDN_HEADS * GDN_DV,
          2 * GDN_HEADS, 2 * GDN_HEADS,
          GLA_HEADS * GLA_DK, GLA_HEADS * GLA_DK, GLA_HEADS * GLA_DV, GLA_HEADS * GLA_DV, 2 * GLA_RANK)
D_IN_PROJ = sum(SPLITS)
MIX_WIDTH = GDN_HEADS * GDN_DV + GLA_HEADS * GLA_DV

kernel_name = "hybrid_gdn_gla_prefix_dit"


def _rms_norm(x, gain):
    xf = x.astype(jnp.float32)
    y = xf * lax.rsqrt(jnp.mean(xf * xf, axis=-1, keepdims=True) + NORM_EPS)
    return (y * gain).astype(x.dtype)


def _modulate(h, shift, scale):
    return h * (1.0 + scale) + shift


def _heads(t, n_heads):
    b, l, cdim = t.shape
    return t.reshape(b, l, n_heads, cdim // n_heads).transpose(0, 2, 1, 3)


def _merge_heads(t):
    b, h, l, d = t.shape
    return t.transpose(0, 2, 1, 3).reshape(b, l, h * d)


def _l2norm(t):
    return t * lax.rsqrt(jnp.sum(t * t, axis=-1, keepdims=True) + 1e-6)


def _flip(t):
    return jnp.flip(t, axis=2)


def _conv1d_centred(x, w):
    l = x.shape[1]
    xp = jnp.pad(x, ((0, 0), (1, 1), (0, 0)))
    return xp[:, :l] * w[0] + xp[:, 1:l + 1] * w[1] + xp[:, 2:] * w[2]


def _conv_grid_3x3(x, w, b):
    bsz, l, cdim = x.shape
    rows = l // GRID_W
    img = x.reshape(bsz, rows, GRID_W, cdim)
    out = lax.conv_general_dilated(img, w[:, :, None, :], window_strides=(1, 1), padding="SAME",
                                   dimension_numbers=("NHWC", "HWIO", "NHWC"), feature_group_count=cdim)
    return out.reshape(bsz, l, cdim) + b


def _to_chunks(t):
    b, h, l = t.shape[:3]
    t = t.reshape(b, h, l // CHUNK, CHUNK, *t.shape[3:])
    return jnp.moveaxis(t, 2, 0)


def _from_chunks(t):
    t = jnp.moveaxis(t, 0, 2)
    b, h, n, cs, d = t.shape
    return t.reshape(b, h, n * cs, d)


def _gdn_scan(q, k, v, g, beta, s0):
    q, k, v, g, beta = map(_to_chunks, (q, k, v, g, beta))
    dv = v.shape[-1]
    gc = jnp.cumsum(g, axis=-1)
    incl = jnp.tril(jnp.ones((CHUNK, CHUNK), dtype=bool))
    strict = jnp.tril(jnp.ones((CHUNK, CHUNK), dtype=bool), -1)
    diff = gc[..., :, None] - gc[..., None, :]
    decay = jnp.where(incl, jnp.exp(jnp.where(incl, diff, 0.0)), 0.0)
    kb = k * beta[..., None]
    lower = jnp.where(strict, jnp.einsum("nbhcd,nbhsd->nbhcs", kb, k) * decay, 0.0)
    rhs = jnp.concatenate([v * beta[..., None], kb * jnp.exp(gc)[..., None]], axis=-1)
    sol = lax.linalg.triangular_solve(jnp.eye(CHUNK, dtype=lower.dtype) + lower, rhs,
                                      left_side=True, lower=True, unit_diagonal=True)
    u, w = sol[..., :dv], sol[..., dv:]
    attn = jnp.einsum("nbhcd,nbhsd->nbhcs", q, k) * decay

    def step(S, xs):
        q_c, k_c, u_c, w_c, a_c, g_c = xs
        v_new = u_c - jnp.einsum("bhcd,bhde->bhce", w_c, S)
        o = (jnp.einsum("bhcd,bhde->bhce", q_c * jnp.exp(g_c)[..., None], S)
             + jnp.einsum("bhcs,bhse->bhce", a_c, v_new))
        g_last = g_c[..., -1:]
        S = S * jnp.exp(g_last)[..., None] + jnp.einsum(
            "bhcd,bhce->bhde", k_c * jnp.exp(g_last - g_c)[..., None], v_new)
        return S, o

    s_final, o = lax.scan(step, s0, (q, k, u, w, attn, gc))
    return _from_chunks(o), s_final


def _gla_scan(q, k, v, gk, s0):
    q, k, v, gk = map(_to_chunks, (q, k, v, gk))
    gc = jnp.cumsum(gk, axis=-2)
    incl = jnp.tril(jnp.ones((CHUNK, CHUNK), dtype=bool))[:, :, None]

    def step(S, xs):
        q_c, k_c, v_c, g_c = xs
        o_inter = jnp.einsum("bhcd,bhde->bhce", q_c * jnp.exp(g_c), S)
        diff = g_c[..., :, None, :] - g_c[..., None, :, :]
        dec = jnp.where(incl, jnp.exp(jnp.where(incl, diff, 0.0)), 0.0)
        attn = jnp.einsum("bhcd,bhsd,bhcsd->bhcs", q_c, k_c, dec)
        o = o_inter + jnp.einsum("bhcs,bhse->bhce", attn, v_c)
        g_last = g_c[..., -1:, :]
        S = S * jnp.exp(g_last)[..., 0, :, None] + jnp.einsum(
            "bhcd,bhce->bhde", k_c * jnp.exp(g_last - g_c), v_c)
        return S, o

    s_final, o = lax.scan(step, s0, (q, k, v, gc))
    return _from_chunks(o), s_final


def _bidirectional(scan_fn, lat_f, lat_b, ctx_f, ctx_b, s0):
    o_cf, s_cf = scan_fn(*ctx_f, s0)
    o_cb, s_cb = scan_fn(*[_flip(t) for t in ctx_b], s0)
    o_lf, _ = scan_fn(*lat_f, s_cf)
    o_lb, _ = scan_fn(*[_flip(t) for t in lat_b], s_cb)
    return o_lf + _flip(o_lb), o_cf + _flip(o_cb)


def _gdn_prepare(q, k, v, a, b, conv_w, a_log, dt_bias):
    qkv = jax.nn.silu(_conv1d_centred(jnp.concatenate([q, k, v], axis=-1), conv_w))
    q, k, v = jnp.split(qkv, 3, axis=-1)
    q = _l2norm(_heads(q, GDN_HEADS)) * (GDN_DK ** -0.5)
    k = _l2norm(_heads(k, GDN_HEADS))
    v = _heads(v, GDN_HEADS)
    bsz, l = a.shape[:2]
    a = a.reshape(bsz, l, 2, GDN_HEADS)
    g = -jnp.exp(a_log) * jax.nn.softplus(a + dt_bias)
    beta = jax.nn.sigmoid(b.reshape(bsz, l, 2, GDN_HEADS))
    return q, k, v, g.transpose(2, 0, 3, 1), beta.transpose(2, 0, 3, 1)


def _gla_prepare(q, k, v, lr, w_gk, b_gk):
    q = _heads(q, GLA_HEADS) * (GLA_DK ** -0.5)
    k = _heads(k, GLA_HEADS)
    v = _heads(v, GLA_HEADS)
    bsz, l = lr.shape[:2]
    lr = lr.reshape(bsz, l, 2, GLA_RANK)
    gk = jax.nn.log_sigmoid(jnp.einsum("blzr,zrc->zblc", lr, w_gk) + b_gk[:, None, None, :]) / GLA_NORMALIZER
    return q, k, v, _heads(gk[0], GLA_HEADS), _heads(gk[1], GLA_HEADS)


def _hybrid_mixer(h_lat, h_ctx, w_in, gdn_conv, gdn_a_log, gdn_dt_bias, gdn_norm,
                  gla_w_gk, gla_b_gk, gla_norm, w_out, with_ctx_out):
    idx = np.cumsum(SPLITS)[:-1].tolist()
    p_lat = jnp.split((h_lat @ w_in).astype(jnp.float32), idx, axis=-1)
    p_ctx = jnp.split((h_ctx @ w_in).astype(jnp.float32), idx, axis=-1)
    bsz = h_lat.shape[0]

    ql, kl, vl, gl, bl = _gdn_prepare(p_lat[0], p_lat[1], p_lat[2], p_lat[4], p_lat[5], gdn_conv, gdn_a_log, gdn_dt_bias)
    qc, kc, vc, gcx, bc = _gdn_prepare(p_ctx[0], p_ctx[1], p_ctx[2], p_ctx[4], p_ctx[5], gdn_conv, gdn_a_log, gdn_dt_bias)
    s0_a = jnp.zeros((bsz, GDN_HEADS, GDN_DK, GDN_DV), jnp.float32)
    o_a_lat, o_a_ctx = _bidirectional(
        _gdn_scan,
        (ql, kl, vl, gl[0], bl[0]), (ql, kl, vl, gl[1], bl[1]),
        (qc, kc, vc, gcx[0], bc[0]), (qc, kc, vc, gcx[1], bc[1]), s0_a)

    lq, lk, lv, lgf, lgb = _gla_prepare(p_lat[6], p_lat[7], p_lat[8], p_lat[10], gla_w_gk, gla_b_gk)
    cq, ck, cv, cgf, cgb = _gla_prepare(p_ctx[6], p_ctx[7], p_ctx[8], p_ctx[10], gla_w_gk, gla_b_gk)
    s0_b = jnp.zeros((bsz, GLA_HEADS, GLA_DK, GLA_DV), jnp.float32)
    o_b_lat, o_b_ctx = _bidirectional(
        _gla_scan,
        (lq, lk, lv, lgf), (lq, lk, lv, lgb),
        (cq, ck, cv, cgf), (cq, ck, cv, cgb), s0_b)

    def merge(o_a, z, o_b, gate, dtype):
        y_a = _merge_heads(_rms_norm(o_a, gdn_norm)) * jax.nn.silu(z)
        y_b = _merge_heads(_rms_norm(o_b, gla_norm)) * jax.nn.silu(gate)
        return (jnp.concatenate([y_a, y_b], axis=-1).astype(w_out.dtype) @ w_out).astype(dtype)

    y_lat = merge(o_a_lat, p_lat[3], o_b_lat, p_lat[9], h_lat.dtype)
    y_ctx = merge(o_a_ctx, p_ctx[3], o_b_ctx, p_ctx[9], h_ctx.dtype) if with_ctx_out else None
    return y_lat, y_ctx


def _conv_ffn(h, w_up, conv_w, conv_b, w_down, on_grid):
    u = h @ w_up
    u = _conv_grid_3x3(u, conv_w, conv_b) if on_grid else _conv1d_centred(u, conv_w[1]) + conv_b
    a, v = jnp.split(u, 2, axis=-1)
    return (jax.nn.silu(a) * v) @ w_down


def setup_inputs(seed: int = 0) -> dict:
    key = jax.random.key(seed)
    ks = jax.random.split(key, 24)
    n = jax.random.normal
    d = D_MODEL
    dt = jnp.exp(jax.random.uniform(ks[9], (DEPTH, 2, GDN_HEADS), minval=math.log(1e-3), maxval=math.log(0.1)))
    return {
        "x": n(ks[0], (BATCH, SEQ, d), jnp.float32),
        "c": n(ks[1], (BATCH, d), jnp.float32),
        "ctx": n(ks[2], (BATCH, CTX_LEN, d), jnp.float32),
        "c_ctx": n(ks[3], (d,), jnp.float32),
        "w_mod": n(ks[4], (DEPTH, d, 6 * d), jnp.float32) * d ** -0.5,
        "b_mod": n(ks[5], (DEPTH, 6 * d), jnp.float32) * 0.01,
        "norm1": 1.0 + 0.02 * n(ks[6], (DEPTH, d), jnp.float32),
        "w_in": n(ks[7], (DEPTH, d, D_IN_PROJ), jnp.float32) * d ** -0.5,
        "gdn_conv": n(ks[8], (DEPTH, 3, GDN_QKV), jnp.float32) * 3 ** -0.5,
        "gdn_a_log": jnp.log(jax.random.uniform(ks[10], (DEPTH, 2, GDN_HEADS), minval=1.0, maxval=16.0)),
        "gdn_dt_bias": dt + jnp.log(-jnp.expm1(-dt)),
        "gdn_norm": 1.0 + 0.02 * n(ks[11], (DEPTH, GDN_DV), jnp.float32),
        "gla_w_gk": n(ks[12], (DEPTH, 2, GLA_RANK, GLA_HEADS * GLA_DK), jnp.float32) * GLA_RANK ** -0.5,
        "gla_b_gk": 0.1 * n(ks[13], (DEPTH, 2, GLA_HEADS * GLA_DK), jnp.float32),
        "gla_norm": 1.0 + 0.02 * n(ks[14], (DEPTH, GLA_DV), jnp.float32),
        "w_out": n(ks[15], (DEPTH, MIX_WIDTH, d), jnp.float32) * MIX_WIDTH ** -0.5,
        "norm2": 1.0 + 0.02 * n(ks[16], (DEPTH, d), jnp.float32),
        "w_up": n(ks[17], (DEPTH, d, 2 * D_FF), jnp.float32) * d ** -0.5,
        "ffn_conv": n(ks[18], (DEPTH, 3, 3, 2 * D_FF), jnp.float32) / 3.0,
        "ffn_conv_b": 0.01 * n(ks[19], (DEPTH, 2 * D_FF), jnp.float32),
        "w_down": n(ks[20], (DEPTH, D_FF, d), jnp.float32) * D_FF ** -0.5,
        "final_norm": 1.0 + 0.02 * n(ks[21], (d,), jnp.float32),
    }


def reference(x, c, ctx, c_ctx, w_mod, b_mod, norm1, w_in, gdn_conv, gdn_a_log, gdn_dt_bias, gdn_norm,
              gla_w_gk, gla_b_gk, gla_norm, w_out, norm2, w_up, ffn_conv, ffn_conv_b, w_down, final_norm):
    sc_lat = jax.nn.silu(c)[:, None, :]
    sc_ctx = jax.nn.silu(c_ctx)
    for i in range(DEPTH):
        last = i == DEPTH - 1
        m_lat = jnp.split(sc_lat @ w_mod[i] + b_mod[i], 6, axis=-1)
        m_ctx = jnp.split(sc_ctx @ w_mod[i] + b_mod[i], 6, axis=-1)
        h_lat = _modulate(_rms_norm(x, norm1[i]), m_lat[0], m_lat[1])
        h_ctx = _modulate(_rms_norm(ctx, norm1[i]), m_ctx[0], m_ctx[1])
        y_lat, y_ctx = _hybrid_mixer(h_lat, h_ctx, w_in[i], gdn_conv[i], gdn_a_log[i], gdn_dt_bias[i], gdn_norm[i],
                                     gla_w_gk[i], gla_b_gk[i], gla_norm[i], w_out[i], not last)
        x = x + m_lat[2] * y_lat
        h_lat = _modulate(_rms_norm(x, norm2[i]), m_lat[3], m_lat[4])
        x = x + m_lat[5] * _conv_ffn(h_lat, w_up[i], ffn_conv[i], ffn_conv_b[i], w_down[i], True)
        if not last:
            ctx = ctx + m_ctx[2] * y_ctx
            h_ctx = _modulate(_rms_norm(ctx, norm2[i]), m_ctx[3], m_ctx[4])
            ctx = ctx + m_ctx[5] * _conv_ffn(h_ctx, w_up[i], ffn_conv[i], ffn_conv_b[i], w_down[i], False)
    return _rms_norm(x, final_norm)
```

```cpp
#include <hip/hip_runtime.h>
#include <math.h>

#define D 1024
#define NB 8
#define LL 2048
#define LC 256
#define DIN 3632
#define FF 2816
#define TB (LC + LL)

__device__ __forceinline__ float silu_f(float x) { return x / (1.f + expf(-x)); }
__device__ __forceinline__ float softplus_f(float x) { return fmaxf(x, 0.f) + log1pf(expf(-fabsf(x))); }
__device__ __forceinline__ float sigmoid_f(float x) { return 1.f / (1.f + expf(-x)); }

__global__ void k_mod(const float* c, const float* c_ctx, const float* w_mod, const float* b_mod, float* mod) {
    int n = blockIdx.x * 256 + threadIdx.x, s = blockIdx.y;
    const float* cv = s < 8 ? c + s * D : c_ctx;
    __shared__ float sc[D];
    for (int k = threadIdx.x; k < D; k += 256) sc[k] = silu_f(cv[k]);
    __syncthreads();
    float acc = 0.f;
    for (int k = 0; k < D; ++k) acc += sc[k] * w_mod[(size_t)k * 6144 + n];
    mod[s * 6144 + n] = acc + b_mod[n];
}

__global__ void k_norm(const float* X, const float* CX, int b, const float* gain, const float* mod, int shift_idx, float* H) {
    int r = blockIdx.x, t = threadIdx.x;
    const float* src = r < LC ? CX + ((size_t)b * LC + r) * D : X + ((size_t)b * LL + (r - LC)) * D;
    int s = r < LC ? 8 : b;
    float v[4]; float ss = 0.f;
    for (int j = 0; j < 4; ++j) { v[j] = src[t + 256 * j]; ss += v[j] * v[j]; }
    __shared__ float red[256];
    red[t] = ss; __syncthreads();
    for (int o = 128; o > 0; o >>= 1) { if (t < o) red[t] += red[t + o]; __syncthreads(); }
    float rstd = rsqrtf(red[0] / D + 1e-6f);
    const float* sh = mod + s * 6144 + shift_idx * D; const float* scl = sh + D;
    for (int j = 0; j < 4; ++j) { int cc = t + 256 * j; H[(size_t)r * D + cc] = v[j] * rstd * gain[cc] * (1.f + scl[cc]) + sh[cc]; }
}

__global__ void __launch_bounds__(256) k_gemm(const float* A, const float* B, float* C, int M, int N, int K) {
    __shared__ float As[16][64 + 1];
    __shared__ float Bs[16][64 + 1];
    int tx = threadIdx.x & 15, ty = threadIdx.x >> 4;
    int m0 = blockIdx.y * 64, n0 = blockIdx.x * 64;
    float acc[4][4] = {};
    for (int k0 = 0; k0 < K; k0 += 16) {
        for (int i = threadIdx.x; i < 64 * 16; i += 256) {
            int m = i >> 4, k = i & 15; As[k][m] = A[(size_t)(m0 + m) * K + k0 + k];
            int kk = i >> 6, n = i & 63; Bs[kk][n] = (n0 + n < N) ? B[(size_t)(k0 + kk) * N + n0 + n] : 0.f;
        }
        __syncthreads();
#pragma unroll
        for (int k = 0; k < 16; ++k) {
            float a[4], bb[4];
#pragma unroll
            for (int i = 0; i < 4; ++i) { a[i] = As[k][ty * 4 + i]; bb[i] = Bs[k][tx * 4 + i]; }
#pragma unroll
            for (int i = 0; i < 4; ++i)
#pragma unroll
                for (int j = 0; j < 4; ++j) acc[i][j] += a[i] * bb[j];
        }
        __syncthreads();
    }
    for (int i = 0; i < 4; ++i)
        for (int j = 0; j < 4; ++j) { int n = n0 + tx * 4 + j; if (n < N) C[(size_t)(m0 + ty * 4 + i) * N + n] = acc[i][j]; }
}

__global__ void k_gdn_prep(const float* P, const float* convw, const float* a_log, const float* dt_bias, float* QKVn, float* gb) {
    int r = blockIdx.x, j = threadIdx.x;
    int seg0 = r < LC ? 0 : LC, seg1 = r < LC ? LC : TB;
    float val[3];
    for (int p = 0; p < 3; ++p) {
        int cc = j + 512 * p;
        float x0 = (r - 1 >= seg0) ? P[(size_t)(r - 1) * DIN + cc] : 0.f;
        float x1 = P[(size_t)r * DIN + cc];
        float x2 = (r + 1 < seg1) ? P[(size_t)(r + 1) * DIN + cc] : 0.f;
        val[p] = silu_f(x0 * convw[cc] + x1 * convw[1536 + cc] + x2 * convw[3072 + cc]);
    }
    __shared__ float red[2][512];
    red[0][j] = val[0] * val[0]; red[1][j] = val[1] * val[1];
    __syncthreads();
    for (int o = 64; o > 0; o >>= 1) { if ((j & 127) < o) { red[0][j] += red[0][j + o]; red[1][j] += red[1][j + o]; } __syncthreads(); }
    int hb = j & ~127;
    float qn = rsqrtf(red[0][hb] + 1e-6f) * 0.08838834764831845f;
    float kn = rsqrtf(red[1][hb] + 1e-6f);
    QKVn[(size_t)r * 1536 + j] = val[0] * qn;
    QKVn[(size_t)r * 1536 + 512 + j] = val[1] * kn;
    QKVn[(size_t)r * 1536 + 1024 + j] = val[2];
    if (j < 8) {
        float a = P[(size_t)r * DIN + 2048 + j], bv = P[(size_t)r * DIN + 2056 + j];
        gb[(size_t)(0 * 8 + j) * TB + r] = -expf(a_log[j]) * softplus_f(a + dt_bias[j]);
        gb[(size_t)(1 * 8 + j) * TB + r] = sigmoid_f(bv);
    }
}

__global__ void __launch_bounds__(128) k_gdn_scan(const float* QKVn, const float* gb, float* Og) {
    int h = blockIdx.x, dir = blockIdx.y, e = threadIdx.x;
    __shared__ float sq[128], sk[128];
    float S[128];
#pragma unroll
    for (int d = 0; d < 128; ++d) S[d] = 0.f;
    const float* g = gb + (size_t)(0 * 8 + dir * 4 + h) * TB;
    const float* beta = gb + (size_t)(1 * 8 + dir * 4 + h) * TB;
    for (int seg = 0; seg < 2; ++seg) {
        int start = seg ? LC : 0, len = seg ? LL : LC;
        for (int jj = 0; jj < len; ++jj) {
            int r = start + (dir ? len - 1 - jj : jj);
            __syncthreads();
            sq[e] = QKVn[(size_t)r * 1536 + h * 128 + e];
            sk[e] = QKVn[(size_t)r * 1536 + 512 + h * 128 + e];
            __syncthreads();
            float v = QKVn[(size_t)r * 1536 + 1024 + h * 128 + e];
            float a = expf(g[r]), bt = beta[r];
            float kS = 0.f;
#pragma unroll
            for (int d = 0; d < 128; ++d) kS += sk[d] * S[d];
            float o = 0.f;
#pragma unroll
            for (int d = 0; d < 128; ++d) { S[d] = a * (S[d] - bt * sk[d] * kS) + bt * sk[d] * v; o += sq[d] * S[d]; }
            Og[((size_t)dir * TB + r) * 512 + h * 128 + e] = o;
        }
    }
}

__global__ void k_gla_prep(const float* P, const float* w_gk, const float* b_gk, float* gk) {
    int r = blockIdx.x, c = threadIdx.x;
    for (int dir = 0; dir < 2; ++dir) {
        float acc = b_gk[dir * 256 + c];
        for (int q = 0; q < 16; ++q) acc += P[(size_t)r * DIN + 3600 + dir * 16 + q] * w_gk[(dir * 16 + q) * 256 + c];
        gk[((size_t)dir * TB + r) * 256 + c] = -softplus_f(-acc) * (1.f / 16.f);
    }
}

__global__ void __launch_bounds__(128) k_gla_scan(const float* P, const float* gk, float* Ol) {
    int h = blockIdx.x, dir = blockIdx.y, e = threadIdx.x;
    __shared__ float sq[64], sk[64], sg[64];
    float S[64];
#pragma unroll
    for (int d = 0; d < 64; ++d) S[d] = 0.f;
    for (int seg = 0; seg < 2; ++seg) {
        int start = seg ? LC : 0, len = seg ? LL : LC;
        for (int jj = 0; jj < len; ++jj) {
            int r = start + (dir ? len - 1 - jj : jj);
            __syncthreads();
            if (e < 64) {
                sq[e] = P[(size_t)r * DIN + 2064 + h * 64 + e] * 0.125f;
                sk[e] = P[(size_t)r * DIN + 2320 + h * 64 + e];
                sg[e] = expf(gk[((size_t)dir * TB + r) * 256 + h * 64 + e]);
            }
            __syncthreads();
            float v = P[(size_t)r * DIN + 2576 + h * 128 + e];
            float o = 0.f;
#pragma unroll
            for (int d = 0; d < 64; ++d) { S[d] = sg[d] * S[d] + sk[d] * v; o += sq[d] * S[d]; }
            Ol[((size_t)dir * TB + r) * 512 + h * 128 + e] = o;
        }
    }
}

__global__ void __launch_bounds__(1024) k_merge(const float* P, const float* Og, const float* Ol, const float* gdn_norm, const float* gla_norm, float* Y) {
    int r = blockIdx.x, t = threadIdx.x, hs = t >> 7, e = t & 127;
    float o, gate, gn;
    if (hs < 4) {
        o = Og[(size_t)r * 512 + hs * 128 + e] + Og[((size_t)TB + r) * 512 + hs * 128 + e];
        gate = P[(size_t)r * DIN + 1536 + hs * 128 + e]; gn = gdn_norm[e];
    } else {
        o = Ol[(size_t)r * 512 + (hs - 4) * 128 + e] + Ol[((size_t)TB + r) * 512 + (hs - 4) * 128 + e];
        gate = P[(size_t)r * DIN + 3088 + (hs - 4) * 128 + e]; gn = gla_norm[e];
    }
    __shared__ float red[1024];
    red[t] = o * o; __syncthreads();
    for (int s = 64; s > 0; s >>= 1) { if (e < s) red[t] += red[t + s]; __syncthreads(); }
    float rstd = rsqrtf(red[hs * 128] / 128.f + 1e-6f);
    Y[(size_t)r * D + t] = o * rstd * gn * silu_f(gate);
}

__global__ void k_resid(float* X, float* CX, int b, const float* mod, int gate_idx, const float* T) {
    int r = blockIdx.x, t = threadIdx.x;
    float* dst = r < LC ? CX + ((size_t)b * LC + r) * D : X + ((size_t)b * LL + (r - LC)) * D;
    int s = r < LC ? 8 : b;
    const float* gt = mod + s * 6144 + gate_idx * D;
    for (int j = 0; j < 4; ++j) { int cc = t + 256 * j; dst[cc] += gt[cc] * T[(size_t)r * D + cc]; }
}

__global__ void k_convgate(const float* U, const float* cw, const float* cb, float* G) {
    int r = blockIdx.x;
    for (int f = threadIdx.x; f < FF; f += 256) {
        float acc[2];
        for (int p = 0; p < 2; ++p) {
            int ch = f + p * FF; float a = cb[ch];
            if (r < LC) {
                for (int dx = -1; dx <= 1; ++dx) { int rr = r + dx; if (rr >= 0 && rr < LC) a += U[(size_t)rr * 5632 + ch] * cw[(1 * 3 + (dx + 1)) * 5632 + ch]; }
            } else {
                int pos = r - LC, gy = pos >> 6, gx = pos & 63;
                for (int dy = -1; dy <= 1; ++dy) for (int dx = -1; dx <= 1; ++dx) {
                    int yy = gy + dy, xx = gx + dx;
                    if (yy >= 0 && yy < 32 && xx >= 0 && xx < 64) a += U[(size_t)(LC + yy * 64 + xx) * 5632 + ch] * cw[((dy + 1) * 3 + (dx + 1)) * 5632 + ch];
                }
            }
            acc[p] = a;
        }
        G[(size_t)r * FF + f] = silu_f(acc[0]) * acc[1];
    }
}

__global__ void k_final(float* X, const float* gain) {
    int r = blockIdx.x, t = threadIdx.x;
    float* src = X + (size_t)r * D;
    float v[4]; float ss = 0.f;
    for (int j = 0; j < 4; ++j) { v[j] = src[t + 256 * j]; ss += v[j] * v[j]; }
    __shared__ float red[256];
    red[t] = ss; __syncthreads();
    for (int o = 128; o > 0; o >>= 1) { if (t < o) red[t] += red[t + o]; __syncthreads(); }
    float rstd = rsqrtf(red[0] / D + 1e-6f);
    for (int j = 0; j < 4; ++j) { int cc = t + 256 * j; src[cc] = v[j] * rstd * gain[cc]; }
}

extern "C" void kernel_launch(void* const* d_in, const int* in_sizes, int n_in,
                              void* d_out, int out_size, void* d_ws, size_t ws_size,
                              hipStream_t stream) {
    const float* x = (const float*)d_in[0]; const float* c = (const float*)d_in[1]; const float* ctx = (const float*)d_in[2];
    const float* c_ctx = (const float*)d_in[3]; const float* w_mod = (const float*)d_in[4]; const float* b_mod = (const float*)d_in[5];
    const float* norm1 = (const float*)d_in[6]; const float* w_in = (const float*)d_in[7]; const float* gdn_conv = (const float*)d_in[8];
    const float* a_log = (const float*)d_in[9]; const float* dt_bias = (const float*)d_in[10]; const float* gdn_norm = (const float*)d_in[11];
    const float* w_gk = (const float*)d_in[12]; const float* b_gk = (const float*)d_in[13]; const float* gla_norm = (const float*)d_in[14];
    const float* w_out = (const float*)d_in[15]; const float* norm2 = (const float*)d_in[16]; const float* w_up = (const float*)d_in[17];
    const float* ffn_conv = (const float*)d_in[18]; const float* ffn_conv_b = (const float*)d_in[19]; const float* w_down = (const float*)d_in[20];
    const float* final_norm = (const float*)d_in[21];
    float* X = (float*)d_out;
    float* w = (float*)d_ws;
    float* mod = w; w += 9 * 6144;
    float* CX = w; w += (size_t)NB * LC * D;
    float* H = w; w += (size_t)TB * D;
    float* P = w; w += (size_t)TB * DIN;
    float* QKVn = w; w += (size_t)TB * 1536;
    float* gb = w; w += (size_t)16 * TB;
    float* Og = w; w += (size_t)2 * TB * 512;
    float* gk = w; w += (size_t)2 * TB * 256;
    float* Ol = w; w += (size_t)2 * TB * 512;
    float* Y = w; w += (size_t)TB * D;
    float* T = w; w += (size_t)TB * D;
    float* U = w; w += (size_t)TB * 5632;
    float* G = w; w += (size_t)TB * FF;

    hipMemcpyAsync(X, x, (size_t)NB * LL * D * 4, hipMemcpyDeviceToDevice, stream);
    hipMemcpyAsync(CX, ctx, (size_t)NB * LC * D * 4, hipMemcpyDeviceToDevice, stream);
    for (int i = 0; i < 2; ++i) {
        k_mod<<<dim3(6144 / 256, 9), 256, 0, stream>>>(c, c_ctx, w_mod + (size_t)i * D * 6144, b_mod + i * 6144, mod);
        for (int b = 0; b < NB; ++b) {
            k_norm<<<TB, 256, 0, stream>>>(X, CX, b, norm1 + i * D, mod, 0, H);
            k_gemm<<<dim3((DIN + 63) / 64, TB / 64), 256, 0, stream>>>(H, w_in + (size_t)i * D * DIN, P, TB, DIN, D);
            k_gdn_prep<<<TB, 512, 0, stream>>>(P, gdn_conv + i * 3 * 1536, a_log + i * 8, dt_bias + i * 8, QKVn, gb);
            k_gdn_scan<<<dim3(4, 2), 128, 0, stream>>>(QKVn, gb, Og);
            k_gla_prep<<<TB, 256, 0, stream>>>(P, w_gk + i * 2 * 16 * 256, b_gk + i * 2 * 256, gk);
            k_gla_scan<<<dim3(4, 2), 128, 0, stream>>>(P, gk, Ol);
            k_merge<<<TB, 1024, 0, stream>>>(P, Og, Ol, gdn_norm + i * 128, gla_norm + i * 128, Y);
            k_gemm<<<dim3(D / 64, TB / 64), 256, 0, stream>>>(Y, w_out + (size_t)i * D * D, T, TB, D, D);
            k_resid<<<TB, 256, 0, stream>>>(X, CX, b, mod, 2, T);
            k_norm<<<TB, 256, 0, stream>>>(X, CX, b, norm2 + i * D, mod, 3, H);
            k_gemm<<<dim3(5632 / 64, TB / 64), 256, 0, stream>>>(H, w_up + (size_t)i * D * 5632, U, TB, 5632, D);
            k_convgate<<<TB, 256, 0, stream>>>(U, ffn_conv + (size_t)i * 9 * 5632, ffn_conv_b + i * 5632, G);
            k_gemm<<<dim3(D / 64, TB / 64), 256, 0, stream>>>(G, w_down + (size_t)i * FF * D, T, TB, D, FF);
            k_resid<<<TB, 256, 0, stream>>>(X, CX, b, mod, 5, T);
        }
    }
    k_final<<<NB * LL, 256, 0, stream>>>(X, final_norm);
}
```

```cpp
#include <hip/hip_runtime.h>
#include <cstdio>
#include <cstdint>
#include <math.h>

#define GAS __attribute__((address_space(1)))
#define LAS __attribute__((address_space(3)))
typedef unsigned short bf16;
typedef unsigned v4u __attribute__((ext_vector_type(4)));
typedef unsigned v2u __attribute__((ext_vector_type(2)));
typedef float f32x4 __attribute__((ext_vector_type(4)));
typedef float f32x16 __attribute__((ext_vector_type(16)));
typedef short bf16x8 __attribute__((ext_vector_type(8)));
typedef short s16x4 __attribute__((ext_vector_type(4)));
typedef __bf16 bf16x2_t __attribute__((ext_vector_type(2)));
typedef float f32x2_t __attribute__((ext_vector_type(2)));
typedef GAS unsigned gu32;

constexpr int DM = 1024, NBATCH = 8, LSEQ = 2048, LCTX = 256, DEPTH = 2;
constexpr int MLAT = NBATCH * LSEQ;
constexpr int MALL = MLAT + NBATCH * LCTX;
constexpr int NCHUNK = MALL / 64;
constexpr int DINP = 3632, NMAIN = 3584, NSMALL = 48;
constexpr int DFF = 2816, FCB = 1280, FCA = 1536;
constexpr float NEPS = 1e-6f;

constexpr size_t MiB = 1u << 20;
constexpr size_t WS_CTL = 0, CTL_ZERO_BYTES = 1 * MiB;
constexpr int CW_BAR = 4096;
constexpr size_t WS_RSA = 256 * 1024;
constexpr size_t WS_MOD = 1 * MiB;
constexpr size_t WS_RS1 = 1 * MiB + 512 * 1024;
constexpr size_t WS_SW = 2 * MiB;
constexpr size_t SW_LAYER = (size_t)9 * (NMAIN + NSMALL + 2 * DFF);
constexpr size_t WS_GDEC = 3 * MiB;
constexpr size_t WS_LDEC = 4 * MiB + 512 * 1024;
constexpr size_t WS_SM = 5 * MiB + 256 * 1024;
constexpr size_t WS_HALO = 9 * MiB;
constexpr size_t WS_WSM = 11 * MiB;
constexpr size_t WS_W2 = 12 * MiB, WS_W1 = 38 * MiB;
constexpr size_t W_IN = 0, W_OUT = 7 * MiB, W_UP = 9 * MiB, W_DB = 20 * MiB, W_DA = 20 * MiB + (size_t)1024 * FCB * 2;
constexpr size_t WS_CXR = 64 * MiB;
static_assert(W_DA + (size_t)1024 * FCA * 2 <= 26 * MiB, "weights");
static_assert(WS_SM + (size_t)MALL * 48 * 4 <= WS_HALO && WS_HALO + (size_t)NCHUNK * 2 * 1536 * 2 <= WS_WSM, "ws small map");
static_assert(WS_SW + 2 * SW_LAYER * 4 <= WS_GDEC && WS_RSA + (size_t)4 * MALL * 4 <= CTL_ZERO_BYTES, "ws map");

struct LayerBufs {
    long XG, GQ, GK, GV, LV, ZA, ZB, LQ, LK, GTA, LOP0, LOP1, Y, XG2, UB, GB, UA, GA, XGN;
};
#define DO_(x) (-(long)((x) * MiB) - 1)
__host__ __device__ constexpr LayerBufs layer_bufs(int l) {
    return l == 0 ? LayerBufs{ 72 * (long)MiB, 108 * (long)MiB, 126 * (long)MiB, 144 * (long)MiB, 162 * (long)MiB, DO_(0), DO_(18), DO_(36), DO_(45),
                               180 * (long)MiB, 72 * (long)MiB, 216 * (long)MiB, 108 * (long)MiB, 72 * (long)MiB, 108 * (long)MiB, 198 * (long)MiB, 126 * (long)MiB, 72 * (long)MiB, 220 * (long)MiB }
                  : LayerBufs{ 220 * (long)MiB, 38 * (long)MiB, 56 * (long)MiB, 74 * (long)MiB, 92 * (long)MiB, 110 * (long)MiB, 128 * (long)MiB, 146 * (long)MiB, 155 * (long)MiB,
                               164 * (long)MiB, 200 * (long)MiB, 227 * (long)MiB, 38 * (long)MiB, 74 * (long)MiB, 110 * (long)MiB, 190 * (long)MiB, 110 * (long)MiB, 206 * (long)MiB, 0 };
}

#define LDS_WAIT() asm volatile("s_waitcnt lgkmcnt(0)" ::: "memory")
#define VM_WAIT() asm volatile("s_waitcnt vmcnt(0)" ::: "memory")
__device__ __forceinline__ unsigned pk2(float lo, float hi) { f32x2_t v = {lo, hi}; bf16x2_t b = __builtin_convertvector(v, bf16x2_t); return __builtin_bit_cast(unsigned, b); }
__device__ __forceinline__ float bflo(unsigned u) { return __uint_as_float(u << 16); }
__device__ __forceinline__ float bfhi(unsigned u) { return __uint_as_float(u & 0xffff0000u); }
__device__ __forceinline__ float bf2f(bf16 u) { return __uint_as_float((unsigned)u << 16); }
__device__ __forceinline__ float silu_f(float x) { return x / (1.f + __expf(-x)); }
__device__ __forceinline__ float softplus_f(float x) { return fmaxf(x, 0.f) + log1pf(__expf(-fabsf(x))); }
__device__ __forceinline__ float sigmoid_f(float x) { return 1.f / (1.f + __expf(-x)); }
__device__ __forceinline__ float wave_sum(float v) {
#pragma unroll
    for (int o = 1; o < 64; o <<= 1) v += __shfl_xor(v, o);
    return v;
}
__device__ __forceinline__ int row_s(int m) { return m < MLAT ? (m >> 11) : 8; }
__host__ __device__ __forceinline__ unsigned char* bufp(unsigned char* ws, float* out, long off) { return off >= 0 ? ws + off : (unsigned char*)out + (-off - 1); }
namespace pg8 {
#define PG8_LAS __attribute__((address_space(3)))
typedef unsigned short bf16_t;
typedef short bf16x8 __attribute__((ext_vector_type(8)));
typedef float f32x4 __attribute__((ext_vector_type(4)));
typedef unsigned u32x4 __attribute__((ext_vector_type(4)));
constexpr int BM = 256, BK = 64, HALF = 128, HTB = HALF * BK * 2  , STAGE_BYTES = 8 * HTB, NXCD = 8, WGM = 8;

__host__ __device__ __forceinline__ int lds_byte(int r, int c) { const int st = (r >> 4) * 2 + (c >> 5), rr = r & 15, cc = c & 31, ob = rr * 64 + cc * 2; return st * 1024 + (ob ^ (((ob >> 9) & 1) << 5)); }
__host__ __device__ __forceinline__ void stage_rc(int b, int& R, int& C) { const int st = b / 1024, sb = b % 1024, swz = sb ^ (((sb >> 9) & 1) << 5); R = (st >> 1) * 16 + swz / 64; C = (st & 1) * 32 + (swz % 64) / 2; }
__host__ __device__ __forceinline__ int perm32(int rho) { const int n = rho >> 4, i = rho & 15; return 8 * (i >> 2) + 4 * n + (i & 3); }

struct Unit { int pm, pn; };
struct Gemm { const bf16_t* A; const bf16_t* Bt; int M, N, K; };

struct StaticOrder {
    int nM, nN, nwg, G, c;
    __host__ __device__ void init(int M, int N, int G_, int c_) { nM = M / BM; nN = N / BM; nwg = nM * nN; G = G_; c = c_; }
    __host__ __device__ bool next(int i, Unit& u) const {
        const long L = (long)i * G + c; if (L >= nwg) return false;
        int wgid = (int)L; { const int q = nwg / NXCD, r = nwg % NXCD, xcd = wgid % NXCD, off = wgid / NXCD; wgid = (xcd < r ? xcd * (q + 1) : r * (q + 1) + (xcd - r) * q) + off; }
        const int nig = WGM * nN, gid = wgid / nig, fm = gid * WGM, gsz = (nM - fm) < WGM ? (nM - fm) : WGM;
        u.pm = fm + ((wgid % nig) % gsz); u.pn = (wgid % nig) / gsz; return true;
    }
    __device__ __forceinline__ void a_ready(const Unit&) const {}
    __device__ __forceinline__ void done(const Unit&) const {}
};
__device__ __forceinline__ unsigned pk2e(float lo, float hi) { f32x2_t v = {lo, hi}; bf16x2_t b = __builtin_convertvector(v, bf16x2_t); return __builtin_bit_cast(unsigned, b); }

struct EpiInProj {
    static constexpr bool PERM = true, AFTER_DRAIN = false;
    unsigned char* ws; float* out; int l;
    __device__ __forceinline__ void operator()(const f32x4 (&acc)[2][2][4][2], const Unit& u, int wr, int wc, int fr, int fq) const {
        const LayerBufs B = layer_bufs(l);
        const float* rowss = l == 0 ? (const float*)(ws + WS_RS1) : (const float*)(ws + WS_RSA) + MALL;
        const float* sW = (const float*)(ws + WS_SW) + (size_t)l * SW_LAYER;
        const int pn = u.pn, s = u.pm < 64 ? (u.pm >> 3) : 8;
        long boff; int ld, cb;
        if (pn < 8) { const int t = pn >> 1; boff = t == 0 ? B.GQ : (t == 1 ? B.GK : (t == 2 ? B.GV : B.ZA)); ld = 512; cb = (pn & 1) * 256; }
        else if (pn == 8) { boff = B.LQ; ld = 256; cb = 0; }
        else if (pn == 9) { boff = B.LK; ld = 256; cb = 0; }
        else { boff = pn < 12 ? B.LV : B.ZB; ld = 512; cb = (pn & 1) * 256; }
        bf16_t* base = (bf16_t*)bufp(ws, out, boff);
        bf16_t* HALO = (bf16_t*)(ws + WS_HALO);
        const int row0 = u.pm * BM + wr * 64 + fr, colw = wc * 32 + 8 * fq;
        const float* swp = sW + (size_t)s * 3584 + pn * BM + colw;
        f32x4 bv[2][2];
#pragma unroll
        for (int bj = 0; bj < 2; ++bj)
#pragma unroll
            for (int n = 0; n < 2; ++n) bv[bj][n] = *(const f32x4*)(swp + bj * HALF + 4 * n);
#pragma unroll
        for (int ai = 0; ai < 2; ++ai)
#pragma unroll
            for (int m = 0; m < 4; ++m) {
                const int row = row0 + ai * HALF + m * 16;
                const float rstd = rsqrtf(rowss[row] * (1.0f / 1024.0f) + 1e-6f);
                bf16_t* rowp = base + (size_t)row * ld + cb + colw;
                const bool halo = (pn < 6) && ((m == 0 && fr == 0) || (m == 3 && fr == 15));
                bf16_t* hp = HALO + ((size_t)(row >> 6) * 2 + (m == 3 ? 1 : 0)) * 1536 + (pn >> 1) * 512 + cb + colw;
#pragma unroll
                for (int bj = 0; bj < 2; ++bj) {
                    const f32x4 v0 = acc[ai][bj][m][0] * rstd + bv[bj][0], v1 = acc[ai][bj][m][1] * rstd + bv[bj][1];
                    u32x4 w; w.x = pk2e(v0[0], v0[1]); w.y = pk2e(v0[2], v0[3]); w.z = pk2e(v1[0], v1[1]); w.w = pk2e(v1[2], v1[3]);
                    *(u32x4*)(rowp + bj * HALF) = w;
                    if (halo) *(u32x4*)(hp + bj * HALF) = w;
                }
            }
    }
};

struct EpiResid {
    static constexpr bool PERM = true, AFTER_DRAIN = false;
    const float* rin_lat; const float* rin_ctx; float* rout_lat; float* rout_ctx;
    const float* gate;
    const float* gn;
    const float* scl;
    bf16_t* XGo; float* rowss;
    __device__ __forceinline__ void operator()(const f32x4 (&acc)[2][2][4][2], const Unit& u, int wr, int wc, int fr, int fq) const {
        const int s = u.pm < 64 ? (u.pm >> 3) : 8;
        const bool isctx = u.pm >= 64, do_xg = XGo != nullptr, do_ss = rowss != nullptr;
        const float* rin = isctx ? rin_ctx - (size_t)16384 * 1024 : rin_lat;
        float* rout = isctx ? rout_ctx - (size_t)16384 * 1024 : rout_lat;
        const int row0 = u.pm * BM + wr * 64 + fr, col0 = u.pn * BM + wc * 32 + 8 * fq;
        f32x4 gv[2][2], nv[2][2];
#pragma unroll
        for (int bj = 0; bj < 2; ++bj)
#pragma unroll
            for (int n = 0; n < 2; ++n) {
                gv[bj][n] = *(const f32x4*)(gate + (size_t)s * 6144 + col0 + bj * HALF + 4 * n);
                if (do_xg) { const f32x4 g = *(const f32x4*)(gn + col0 + bj * HALF + 4 * n), sc = *(const f32x4*)(scl + (size_t)s * 6144 + col0 + bj * HALF + 4 * n); nv[bj][n] = g * (sc + 1.0f); }
                else nv[bj][n] = (f32x4){0.f, 0.f, 0.f, 0.f};
            }
#pragma unroll
        for (int ai = 0; ai < 2; ++ai)
#pragma unroll
            for (int m = 0; m < 4; ++m) {
                const int row = row0 + ai * HALF + m * 16;
                const float* rp = rin + (size_t)row * 1024 + col0; float* op = rout + (size_t)row * 1024 + col0;
                float ss = 0.f;
#pragma unroll
                for (int bj = 0; bj < 2; ++bj) {
                    const f32x4 x0 = *(const f32x4*)(rp + bj * HALF) + gv[bj][0] * acc[ai][bj][m][0];
                    const f32x4 x1 = *(const f32x4*)(rp + bj * HALF + 4) + gv[bj][1] * acc[ai][bj][m][1];
                    *(f32x4*)(op + bj * HALF) = x0; *(f32x4*)(op + bj * HALF + 4) = x1;
                    ss += (x0[0] * x0[0] + x0[1] * x0[1]) + (x0[2] * x0[2] + x0[3] * x0[3]) + (x1[0] * x1[0] + x1[1] * x1[1]) + (x1[2] * x1[2] + x1[3] * x1[3]);
                    if (do_xg) {
                        const f32x4 y0 = x0 * nv[bj][0], y1 = x1 * nv[bj][1];
                        u32x4 w; w.x = pk2e(y0[0], y0[1]); w.y = pk2e(y0[2], y0[3]); w.z = pk2e(y1[0], y1[1]); w.w = pk2e(y1[2], y1[3]);
                        *(u32x4*)(XGo + (size_t)row * 1024 + col0 + bj * HALF) = w;
                    }
                }
                if (do_ss) { ss += __shfl_xor(ss, 16); ss += __shfl_xor(ss, 32); if (fq == 0) atomicAdd(rowss + row, ss); }
            }
    }
};

struct EpiUp {
    static constexpr bool PERM = true, AFTER_DRAIN = false;
    const float* rowss; const float* sW;
    bf16_t* U; int ldu;
    __device__ __forceinline__ void operator()(const f32x4 (&acc)[2][2][4][2], const Unit& u, int wr, int wc, int fr, int fq) const {
        const int s = u.pm < 64 ? (u.pm >> 3) : 8;
        const int row0 = u.pm * BM + wr * 64 + fr, col0 = u.pn * BM + wc * 32 + 8 * fq;
        const float* swp = sW + (size_t)s * 5632 + col0;
        f32x4 bv[2][2];
#pragma unroll
        for (int bj = 0; bj < 2; ++bj)
#pragma unroll
            for (int n = 0; n < 2; ++n) bv[bj][n] = *(const f32x4*)(swp + bj * HALF + 4 * n);
#pragma unroll
        for (int ai = 0; ai < 2; ++ai)
#pragma unroll
            for (int m = 0; m < 4; ++m) {
                const int row = row0 + ai * HALF + m * 16;
                const float rstd = rsqrtf(rowss[row] * (1.0f / 1024.0f) + 1e-6f);
                bf16_t* rowp = U + (size_t)row * ldu + col0;
#pragma unroll
                for (int bj = 0; bj < 2; ++bj) {
                    const f32x4 v0 = acc[ai][bj][m][0] * rstd + bv[bj][0], v1 = acc[ai][bj][m][1] * rstd + bv[bj][1];
                    u32x4 w; w.x = pk2e(v0[0], v0[1]); w.y = pk2e(v0[2], v0[3]); w.z = pk2e(v1[0], v1[1]); w.w = pk2e(v1[2], v1[3]);
                    *(u32x4*)(rowp + bj * HALF) = w;
                }
            }
    }
};
template <class Epi, class Sched, bool ALIGN_EPI = false, bool SP2 = false>
__device__ __forceinline__ void gemm_phase(PG8_LAS unsigned char* lds, const Gemm g, const Sched& S, const Epi& E) {
    int tid_o = threadIdx.x; asm volatile("" : "+v"(tid_o));
    const int tid = tid_o, wid = __builtin_amdgcn_readfirstlane(tid >> 6), lane = tid & 63, wr = wid >> 2, wc = wid & 3, fr = lane & 15, fq = lane >> 4;
    const int K = g.K, nt = K / BK;
    unsigned voffA[2], voffB[2];
#pragma unroll
    for (int i = 0; i < 2; ++i) { int R, C; stage_rc(tid * 16 + i * 8192, R, C); const int Rb = Epi::PERM ? ((R & ~31) + perm32(R & 31)) : R;
        voffA[i] = (unsigned)(R * K + C) * 2u; voffB[i] = (unsigned)(Rb * K + C) * 2u; }
    const size_t kstep = (size_t)(BK * 2);
    const size_t hstep = (size_t)HALF * K * 2;
    const size_t tstep = 2 * hstep;
    const unsigned ldsw = (unsigned)wid * 1024u;
    const int aoff = lds_byte(wr * 64 + fr, fq * 8), boff = lds_byte(wc * 32 + fr, fq * 8);
#define PG8_SA(b, h) (((b) * 2 + (h)) * HTB)
#define PG8_SB(b, h) ((4 + (b) * 2 + (h)) * HTB)
#define PG8_STAGE(bufoff, gbase, voff) do { _Pragma("unroll") for (int _i = 0; _i < 2; ++_i) \
        __builtin_amdgcn_global_load_lds((const unsigned*)((const char*)(gbase) + (voff)[_i]), (PG8_LAS unsigned*)(lds + (bufoff) + ldsw + _i * 8192), 16, 0, 0); } while (0)
#define PG8_LDA(dst, b, h) do { _Pragma("unroll") for (int m = 0; m < 4; ++m) _Pragma("unroll") for (int k = 0; k < 2; ++k) dst[m][k] = *(const PG8_LAS bf16x8*)(lds + PG8_SA(b, h) + aoff + m * 2048 + k * 1024); } while (0)
#define PG8_LDB(dst, b, h) do { _Pragma("unroll") for (int n = 0; n < 2; ++n) _Pragma("unroll") for (int k = 0; k < 2; ++k) dst[n][k] = *(const PG8_LAS bf16x8*)(lds + PG8_SB(b, h) + boff + n * 2048 + k * 1024); } while (0)
#define PG8_MMA(ai, bj, At, Bt) do { __builtin_amdgcn_s_setprio(1); _Pragma("unroll") for (int m = 0; m < 4; ++m) _Pragma("unroll") for (int n = 0; n < 2; ++n) _Pragma("unroll") for (int k = 0; k < 2; ++k) \
        acc[ai][bj][m][n] = __builtin_amdgcn_mfma_f32_16x16x32_bf16(Bt[n][k], At[m][k], acc[ai][bj][m][n], 0, 0, 0); __builtin_amdgcn_s_setprio(0); } while (0)
#define PG8_WAIT_V(n) asm volatile("s_waitcnt vmcnt(" #n ")" ::: "memory")
#define PG8_WAIT_L(n) asm volatile("s_waitcnt lgkmcnt(" #n ")" ::: "memory")
#define PG8_BAR __builtin_amdgcn_s_barrier()
#define PG8_SCHED __builtin_amdgcn_sched_barrier(0)
    Unit cur, nxt; int ui = 0;
    if (!S.next(0, cur)) return;
    f32x4 acc[2][2][4][2];
#pragma unroll
    for (int a = 0; a < 2; ++a)
#pragma unroll
        for (int b = 0; b < 2; ++b)
#pragma unroll
            for (int m = 0; m < 4; ++m)
#pragma unroll
                for (int n = 0; n < 2; ++n) acc[a][b][m][n] = (f32x4){0.f, 0.f, 0.f, 0.f};
    bf16x8 At[4][2], B0[2][2], B1[2][2];
    const char* cA = (const char*)g.A + (size_t)cur.pm * tstep; const char* cB = (const char*)g.Bt + (size_t)cur.pn * tstep;
    S.a_ready(cur);
    if constexpr (SP2) {
        PG8_STAGE(PG8_SB(0, 0), cB, voffB); PG8_STAGE(PG8_SB(0, 1), cB + hstep, voffB); PG8_STAGE(PG8_SA(0, 0), cA, voffA); PG8_STAGE(PG8_SA(0, 1), cA + hstep, voffA);
        if (wr == 1) PG8_BAR;
        PG8_WAIT_V(2); PG8_BAR;
        PG8_STAGE(PG8_SB(1, 0), cB + kstep, voffB); PG8_STAGE(PG8_SA(1, 0), cA + kstep, voffA); PG8_STAGE(PG8_SB(1, 1), cB + hstep + kstep, voffB);
        PG8_WAIT_V(6); PG8_BAR;
    } else {
        PG8_STAGE(PG8_SB(0, 0), cB, voffB); PG8_STAGE(PG8_SA(0, 0), cA, voffA); PG8_STAGE(PG8_SB(0, 1), cB + hstep, voffB); PG8_STAGE(PG8_SA(0, 1), cA + hstep, voffA);
        if (wr == 1) PG8_BAR;
        PG8_WAIT_V(4); PG8_BAR;
        PG8_STAGE(PG8_SB(1, 0), cB + kstep, voffB); PG8_STAGE(PG8_SA(1, 0), cA + kstep, voffA); PG8_STAGE(PG8_SB(1, 1), cB + hstep + kstep, voffB);
        PG8_WAIT_V(6); PG8_BAR;
    }
    for (;;) {
        const bool has_next = S.next(ui + 1, nxt);
        const char* nA = has_next ? (const char*)g.A + (size_t)nxt.pm * tstep : cA; const char* nB = has_next ? (const char*)g.Bt + (size_t)nxt.pn * tstep : cB;
        for (int t = 0; t < nt; t += 2) {
            const bool last = (t == nt - 2);
            const char* a1 = cA + (size_t)(t + 1) * kstep;
            const char* a2 = last ? nA : cA + (size_t)(t + 2) * kstep; const char* b2 = last ? nB : cB + (size_t)(t + 2) * kstep;
            const char* a3 = a2 + kstep; const char* b3 = b2 + kstep;
            if (last && has_next) S.a_ready(nxt);
            if constexpr (SP2) {
            PG8_LDB(B0, 0, 0); PG8_LDB(B1, 0, 1); PG8_SCHED; PG8_LDA(At, 0, 0); PG8_STAGE(PG8_SA(1, 1), a1 + hstep, voffA);
            PG8_WAIT_V(8); PG8_WAIT_L(0); PG8_BAR; PG8_MMA(0, 0, At, B0); PG8_MMA(0, 1, At, B1); PG8_BAR; PG8_SCHED;
            PG8_LDA(At, 0, 1); PG8_STAGE(PG8_SB(0, 0), b2, voffB); PG8_STAGE(PG8_SB(0, 1), b2 + hstep, voffB); PG8_STAGE(PG8_SA(0, 0), a2, voffA);
            PG8_WAIT_V(8); PG8_WAIT_L(0); PG8_BAR; PG8_MMA(1, 0, At, B0); PG8_MMA(1, 1, At, B1); PG8_BAR; PG8_SCHED;
            PG8_LDB(B0, 1, 0); PG8_LDB(B1, 1, 1); PG8_SCHED; PG8_LDA(At, 1, 0); PG8_STAGE(PG8_SA(0, 1), a2 + hstep, voffA);
            PG8_WAIT_V(8); PG8_WAIT_L(0); PG8_BAR; PG8_MMA(0, 0, At, B0); PG8_MMA(0, 1, At, B1); PG8_BAR; PG8_SCHED;
            PG8_LDA(At, 1, 1); PG8_STAGE(PG8_SB(1, 0), b3, voffB); PG8_STAGE(PG8_SB(1, 1), b3 + hstep, voffB); PG8_STAGE(PG8_SA(1, 0), a3, voffA);
            PG8_WAIT_V(8); PG8_WAIT_L(0); PG8_BAR; PG8_MMA(1, 0, At, B0); PG8_MMA(1, 1, At, B1); PG8_BAR; PG8_SCHED;
            } else {
            PG8_LDB(B0, 0, 0); PG8_SCHED; PG8_LDA(At, 0, 0); PG8_STAGE(PG8_SA(1, 1), a1 + hstep, voffA);
            PG8_WAIT_L(8); PG8_BAR; PG8_WAIT_L(0); PG8_MMA(0, 0, At, B0); PG8_BAR; PG8_SCHED;
            PG8_LDB(B1, 0, 1); PG8_STAGE(PG8_SB(0, 0), b2, voffB);
            PG8_BAR; PG8_WAIT_L(0); PG8_MMA(0, 1, At, B1); PG8_BAR;
            PG8_LDA(At, 0, 1); PG8_STAGE(PG8_SA(0, 0), a2, voffA);
            PG8_BAR; PG8_WAIT_L(0); PG8_MMA(1, 0, At, B0); PG8_BAR; PG8_SCHED;
            PG8_STAGE(PG8_SB(0, 1), b2 + hstep, voffB);
            PG8_WAIT_V(6); PG8_BAR; PG8_MMA(1, 1, At, B1); PG8_BAR;
            PG8_LDB(B0, 1, 0); PG8_SCHED; PG8_LDA(At, 1, 0); PG8_STAGE(PG8_SA(0, 1), a2 + hstep, voffA);
            PG8_WAIT_L(8); PG8_BAR; PG8_WAIT_L(0); PG8_MMA(0, 0, At, B0); PG8_BAR; PG8_SCHED;
            PG8_LDB(B1, 1, 1); PG8_STAGE(PG8_SB(1, 0), b3, voffB);
            PG8_BAR; PG8_WAIT_L(0); PG8_MMA(0, 1, At, B1); PG8_BAR;
            PG8_LDA(At, 1, 1); PG8_STAGE(PG8_SA(1, 0), a3, voffA);
            PG8_BAR; PG8_WAIT_L(0); PG8_MMA(1, 0, At, B0); PG8_BAR; PG8_SCHED;
            PG8_STAGE(PG8_SB(1, 1), b3 + hstep, voffB);
            PG8_WAIT_V(6); PG8_BAR; PG8_MMA(1, 1, At, B1); PG8_BAR;
            }
        }
        if constexpr (ALIGN_EPI) { if (wr == 0) PG8_BAR; }
        if constexpr (!Epi::AFTER_DRAIN) { E(acc, cur, wr, wc, fr, fq); S.done(cur); }
        if (!has_next) break;
#pragma unroll
        for (int a = 0; a < 2; ++a)
#pragma unroll
            for (int b = 0; b < 2; ++b)
#pragma unroll
                for (int m = 0; m < 4; ++m)
#pragma unroll
                    for (int n = 0; n < 2; ++n) acc[a][b][m][n] = (f32x4){0.f, 0.f, 0.f, 0.f};
        cur = nxt; cA = nA; cB = nB; ++ui;
        if constexpr (ALIGN_EPI) { if (wr == 1) PG8_BAR; }
    }
    PG8_WAIT_V(0);
    if constexpr (!ALIGN_EPI) { if (wr == 0) PG8_BAR; }
    PG8_BAR;
    if constexpr (Epi::AFTER_DRAIN) { E.fused(acc, cur, wr, wc, fr, fq, lds, wid, lane); S.done(cur); }
#undef PG8_SA
#undef PG8_SB
#undef PG8_STAGE
#undef PG8_LDA
#undef PG8_LDB
#undef PG8_MMA
#undef PG8_WAIT_V
#undef PG8_WAIT_L
#undef PG8_BAR
#undef PG8_SCHED
}
}
#define XB_TMO      128
#define XB_XCNT(j)  (256  + 64 * (j))
#define XB_XSUB(j)  (1280 + 64 * (j))
#define XB_XGEN(j)  (2304 + 64 * (j))
#define XB_TOP      3328
#define XB_TOPGEN   3392
#define XCD_BAR_WORDS 3456
#define XB_SPIN_CAP (1u << 18)

__device__ __forceinline__ unsigned xb_ld(unsigned* p)              { return __hip_atomic_load(p, __ATOMIC_RELAXED, __HIP_MEMORY_SCOPE_AGENT); }
__device__ __forceinline__ unsigned xb_add(unsigned* p, unsigned v) { return __hip_atomic_fetch_add(p, v, __ATOMIC_RELAXED, __HIP_MEMORY_SCOPE_AGENT); }
__device__ __forceinline__ unsigned xb_xcc_id() { return (unsigned)__builtin_amdgcn_s_getreg((3 << 11) | 20) & 0xFu; }
#define XB_SPIN(cond, bar) do { unsigned _sp = 0; while (cond) { __builtin_amdgcn_s_sleep(1); \
    if ((++_sp & 255u) == 0u) { if (xb_ld(&(bar)[XB_TMO])) break; if (_sp > XB_SPIN_CAP) { atomicAdd(&(bar)[XB_TMO], 1u); break; } } } } while (0)

struct XcdBarrier {
    unsigned* bar; unsigned x;
    volatile LAS unsigned* st;
};

__device__ __forceinline__ XcdBarrier xcd_barrier_post(unsigned* bar, volatile LAS unsigned* st) {
    XcdBarrier b; b.bar = bar; b.x = xb_xcc_id(); b.st = st;
    if (threadIdx.x == 0) (void)xb_add(&bar[XB_XCNT(b.x)], 1u);
    return b;
}
__device__ __forceinline__ void xcd_barrier_complete(unsigned* bar, unsigned x, unsigned& nloc, unsigned& nx) {
    const unsigned G = gridDim.x * gridDim.y * gridDim.z;
    unsigned sum, cnt, mine, sp = 0u;
    for (;;) {
        sum = 0u; cnt = 0u; mine = 0u;
#pragma unroll
        for (unsigned j = 0; j < 16; ++j) { const unsigned c = xb_ld(&bar[XB_XCNT(j)]); sum += c; cnt += (c > 0u) ? 1u : 0u; mine = (j == x) ? c : mine; }
        if (sum == G) break;
        __builtin_amdgcn_s_sleep(1);
        if ((++sp & 255u) == 0u) { if (xb_ld(&bar[XB_TMO])) break; if (sp > XB_SPIN_CAP) { atomicAdd(&bar[XB_TMO], 1u); break; } }
    }
    nloc = mine > 0u ? mine : 1u; nx = cnt > 0u ? cnt : 1u;
}

__device__ __forceinline__ void xcd_barrier(const XcdBarrier& b) {
    asm volatile("s_waitcnt vmcnt(0)" ::: "memory");
    __syncthreads();
    if (threadIdx.x == 0) {
        unsigned* bar = b.bar;
        __builtin_amdgcn_s_waitcnt(0);
        unsigned nloc = b.st[0], nx = b.st[1];
        if (nloc == 0u) { xcd_barrier_complete(bar, b.x, nloc, nx); b.st[0] = nloc; b.st[1] = nx; }
        const unsigned old = xb_add(&bar[XB_XSUB(b.x)], 1u);
        const unsigned gen = old / nloc;
        if (old + 1u == (gen + 1u) * nloc) {
            __builtin_amdgcn_fence(__ATOMIC_RELEASE, "agent");
            asm volatile("s_waitcnt vmcnt(0)" ::: "memory");
            const unsigned og = xb_add(&bar[XB_TOP], 1u);
            const unsigned tg = og / nx;
            if (og + 1u == (tg + 1u) * nx) xb_add(&bar[XB_TOPGEN], 1u);
            else XB_SPIN(xb_ld(&bar[XB_TOPGEN]) == tg, bar);
            __builtin_amdgcn_fence(__ATOMIC_ACQUIRE, "agent");
            xb_add(&bar[XB_XGEN(b.x)], 1u);
            asm volatile("s_waitcnt vmcnt(0)" ::: "memory");
        } else {
            XB_SPIN(xb_ld(&bar[XB_XGEN(b.x)]) == gen, bar);
            __builtin_amdgcn_fence(__ATOMIC_ACQUIRE, "agent");
            asm volatile("s_waitcnt vmcnt(0)" ::: "memory");
        }
    }
    __syncthreads();
}
constexpr int NWAVES = 8;
constexpr int RING_BYTES = 131072, LDSCTL_OFF = 131072 + 8192, LDS_BYTES = 147456;
struct Args {
    const float* in[22]; float* out; unsigned char* ws; int ph_lo, ph_hi; int use_bar, pad;
};
enum { I_X = 0, I_C, I_CTX, I_CCTX, I_WMOD, I_BMOD, I_NORM1, I_WIN, I_GCONV, I_ALOG, I_DTB, I_GNORM, I_WGK, I_BGK, I_LNORM, I_WOUT, I_NORM2, I_WUP, I_FCONV, I_FCB, I_WDOWN, I_FNORM };


__device__ __forceinline__ void tr_item(const float* src, int ldsrc, int k0, int c0, int ncols, bf16* dst, int lddst, int r0, int kd0, LAS float* scr, int lane) {
    const int cl = lane & 31;
#pragma unroll 8
    for (int i = 0; i < 32; ++i) { const int kk = 2 * i + (lane >> 5); scr[kk * 33 + cl] = cl < ncols ? src[(size_t)(k0 + kk) * ldsrc + c0 + cl] : 0.f; }
    LDS_WAIT(); asm volatile("" ::: "memory");
    const int c = lane & 7;
#pragma unroll
    for (int j = 0; j < 4; ++j) { const int n = (lane >> 3) + 8 * j; const LAS float* s = scr + (8 * c) * 33 + n;
        v4u o; o.x = pk2(s[0 * 33], s[1 * 33]); o.y = pk2(s[2 * 33], s[3 * 33]); o.z = pk2(s[4 * 33], s[5 * 33]); o.w = pk2(s[6 * 33], s[7 * 33]);
        if (n < ncols) *(GAS v4u*)(dst + (size_t)(r0 + n) * lddst + kd0 + 8 * c) = o; }
    LDS_WAIT(); asm volatile("" ::: "memory");
}

__device__ __forceinline__ void phase_p0a(const Args& a, LAS unsigned char* lds, int vcu, int G, int tid, int wave, int lane) {
    unsigned char* ws = a.ws;
    {
        LAS float* sc = (LAS float*)lds;
        LAS float* red = (LAS float*)(lds + 36864);
        bool have = false;
        for (int it = vcu; it < 192; it += G) {
            if (!have) {
                for (int i = tid; i < 9 * 1024; i += 512) { const int s = i >> 10, k = i & 1023; const float v = s < 8 ? a.in[I_C][s * 1024 + k] : a.in[I_CCTX][k]; sc[i] = silu_f(v); }
                __syncthreads(); have = true;
            }
            const int l = it / 96, n0 = (it % 96) * 64;
            const float* W = a.in[I_WMOD] + (size_t)l * 1024 * 6144;
            const int c4 = tid & 15, ks = tid >> 4;
            f32x4 acc[9];
#pragma unroll
            for (int s = 0; s < 9; ++s) acc[s] = (f32x4){0.f, 0.f, 0.f, 0.f};
            for (int j = 0; j < 32; ++j) {
                const int k = ks + 32 * j;
                const f32x4 w = *(const f32x4*)(W + (size_t)k * 6144 + n0 + 4 * c4);
#pragma unroll
                for (int s = 0; s < 9; ++s) acc[s] += w * sc[s * 1024 + k];
            }
#pragma unroll
            for (int s = 0; s < 9; ++s) *(LAS f32x4*)(red + (ks * 9 + s) * 64 + 4 * c4) = acc[s];
            __syncthreads();
            for (int o = tid; o < 576; o += 512) {
                const int s = o >> 6, c = o & 63; float v = 0.f;
                for (int q = 0; q < 32; ++q) v += red[(q * 9 + s) * 64 + c];
                ((float*)(ws + WS_MOD))[((size_t)l * 9 + s) * 6144 + n0 + c] = v + a.in[I_BMOD][l * 6144 + n0 + c];
            }
            __syncthreads();
        }
        __syncthreads();
    }
    {
        LAS float* scr = (LAS float*)(lds + wave * 16384);
        const int gw = vcu * NWAVES + wave, NGW = G * NWAVES;
        constexpr int I_IN = 16 * 112, I_SM = 16 * 2, I_O = 16 * 32, I_U = 16 * 176, I_D = 44 * 32, PER_L = I_IN + I_SM + I_O + I_U + I_D;
        for (int it = gw; it < 2 * PER_L; it += NGW) {
            const int l = it / PER_L; int r = it % PER_L;
            unsigned char* wl = ws + (l == 0 ? WS_W1 : WS_W2);
            if (r < I_IN) { const int kb = r / 112, nb = r % 112, n0 = nb * 32; const int c0 = n0 < 2048 ? n0 : n0 + 16;
                tr_item(a.in[I_WIN] + (size_t)l * 1024 * DINP, DINP, kb * 64, c0, 32, (bf16*)(wl + W_IN), 1024, n0, kb * 64, scr, lane); continue; } r -= I_IN;
            if (r < I_SM) { const int kb = r / 2, part = r % 2;
                tr_item(a.in[I_WIN] + (size_t)l * 1024 * DINP, DINP, kb * 64, part == 0 ? 2048 : 3600, part == 0 ? 16 : 32, (bf16*)(ws + WS_WSM) + (size_t)l * 48 * 1024, 1024, part == 0 ? 0 : 16, kb * 64, scr, lane); continue; } r -= I_SM;
            if (r < I_O) { const int kb = r / 32, nb = r % 32;
                tr_item(a.in[I_WOUT] + (size_t)l * 1024 * 1024, 1024, kb * 64, nb * 32, 32, (bf16*)(wl + W_OUT), 1024, nb * 32, kb * 64, scr, lane); continue; } r -= I_O;
            if (r < I_U) { const int kb = r / 176, nb = r % 176, r0 = nb * 32;
                const int c0 = r0 < 1280 ? r0 : (r0 < 2560 ? 2816 + (r0 - 1280) : (r0 < 4096 ? 1280 + (r0 - 2560) : 2816 + 1280 + (r0 - 4096)));
                tr_item(a.in[I_WUP] + (size_t)l * 1024 * 5632, 5632, kb * 64, c0, 32, (bf16*)(wl + W_UP), 1024, r0, kb * 64, scr, lane); continue; } r -= I_U;
            { const int kb = r / 32, nb = r % 32, k0 = kb * 64;
              if (k0 < FCB) tr_item(a.in[I_WDOWN] + (size_t)l * DFF * 1024, 1024, k0, nb * 32, 32, (bf16*)(wl + W_DB), FCB, nb * 32, k0, scr, lane);
              else          tr_item(a.in[I_WDOWN] + (size_t)l * DFF * 1024, 1024, k0, nb * 32, 32, (bf16*)(wl + W_DA), FCA, nb * 32, k0 - FCB, scr, lane); }
        }
    }
}

__device__ __forceinline__ void xg_rows(const float* xlat, const float* xctx, const float* gain, const float* scl  , bf16* XG, float* rowss, int gw, int NGW, int lane, int mrows) {
    for (int m = gw; m < mrows; m += NGW) {
        const float* src = m < MLAT ? xlat + (size_t)m * 1024 : xctx + (size_t)(m - MLAT) * 1024;
        const int s = row_s(m);
        float ss = 0.f;
#pragma unroll
        for (int j = 0; j < 4; ++j) {
            const int c = 4 * lane + 256 * j;
            const f32x4 v = *(const f32x4*)(src + c), g = *(const f32x4*)(gain + c), sc = *(const f32x4*)(scl + (size_t)s * 6144 + c);
            ss += (v[0] * v[0] + v[1] * v[1]) + (v[2] * v[2] + v[3] * v[3]);
            const f32x4 y = v * g * (sc + 1.0f);
            v2u o; o.x = pk2(y[0], y[1]); o.y = pk2(y[2], y[3]);
            *(GAS v2u*)(XG + (size_t)m * 1024 + c) = o;
        }
        ss = wave_sum(ss);
        if (lane == 0) rowss[m] = ss;
    }
}

__device__ __forceinline__ void phase_p0b(const Args& a, LAS unsigned char* lds, int vcu, int G, int tid, int wave, int lane) {
    unsigned char* ws = a.ws;
    const int gw = vcu * NWAVES + wave, NGW = G * NWAVES;
    const float* MOD = (const float*)(ws + WS_MOD);
    constexpr LayerBufs B0 = layer_bufs(0);
    xg_rows(a.in[I_X], a.in[I_CTX], a.in[I_NORM1], MOD + 1 * 1024, (bf16*)bufp(ws, a.out, B0.XG), (float*)(ws + WS_RS1), gw, NGW, lane, MALL);
    LAS float* sh = (LAS float*)lds;
    for (int combo = 0; combo < 4; ++combo) {
        const int l = combo >> 1, which = combo & 1;
        __syncthreads();
        for (int i = tid; i < 9 * 1024; i += 512) sh[i] = MOD[((size_t)l * 9 + (i >> 10)) * 6144 + (which ? 3 : 0) * 1024 + (i & 1023)];
        __syncthreads();
        const int nrows = which ? 5632 : (NMAIN + NSMALL);
        float* SWl = (float*)(ws + WS_SW) + (size_t)l * SW_LAYER;
        unsigned char* wl = ws + (l == 0 ? WS_W1 : WS_W2);
        for (int n = gw; n < nrows; n += NGW) {
            const bf16* wrow; float* dst; int ldd;
            if (which) { wrow = (const bf16*)(wl + W_UP) + (size_t)n * 1024; dst = SWl + 9 * (NMAIN + NSMALL) + n; ldd = 5632; }
            else if (n < NMAIN) { wrow = (const bf16*)(wl + W_IN) + (size_t)n * 1024; dst = SWl + n; ldd = NMAIN; }
            else { wrow = (const bf16*)(ws + WS_WSM) + ((size_t)l * 48 + (n - NMAIN)) * 1024; dst = SWl + 9 * NMAIN + (n - NMAIN); ldd = NSMALL; }
            const v4u w0 = *(const GAS v4u*)(wrow + 8 * lane), w1 = *(const GAS v4u*)(wrow + 512 + 8 * lane);
            float wf[16] = { bflo(w0.x), bfhi(w0.x), bflo(w0.y), bfhi(w0.y), bflo(w0.z), bfhi(w0.z), bflo(w0.w), bfhi(w0.w),
                             bflo(w1.x), bfhi(w1.x), bflo(w1.y), bfhi(w1.y), bflo(w1.z), bfhi(w1.z), bflo(w1.w), bfhi(w1.w) };
#pragma unroll
            for (int s = 0; s < 9; ++s) {
                float acc = 0.f;
#pragma unroll
                for (int j = 0; j < 8; ++j) acc += wf[j] * sh[s * 1024 + 8 * lane + j] + wf[8 + j] * sh[s * 1024 + 512 + 8 * lane + j];
                acc = wave_sum(acc);
                if (lane == 0) dst[(size_t)s * ldd] = acc;
            }
        }
    }
    __syncthreads();
}

__device__ __forceinline__ void skinny_rows(const bf16* XG, const bf16* Wsm  , const float* rowss, const float* sWsm  , float* SM, int gw, int NGW, int lane) {
    const int r = lane & 15, g = lane >> 4;
    for (int t = gw; t < MALL / 16; t += NGW) {
        const int m0 = t * 16;
        f32x4 acc[3];
#pragma unroll
        for (int n = 0; n < 3; ++n) acc[n] = (f32x4){0.f, 0.f, 0.f, 0.f};
        const bf16* ap = XG + (size_t)(m0 + r) * 1024 + 8 * g;
        const bf16* bp = Wsm + (size_t)r * 1024 + 8 * g;
#pragma unroll 4
        for (int ks = 0; ks < 32; ++ks) {
            const bf16x8 af = *(const GAS bf16x8*)(ap + 32 * ks);
#pragma unroll
            for (int n = 0; n < 3; ++n) { const bf16x8 bf = *(const GAS bf16x8*)(bp + (size_t)n * 16 * 1024 + 32 * ks); acc[n] = __builtin_amdgcn_mfma_f32_16x16x32_bf16(af, bf, acc[n], 0, 0, 0); }
        }
#pragma unroll
        for (int j = 0; j < 4; ++j) {
            const int m = m0 + 4 * g + j; const int s = row_s(m);
            const float rstd = rsqrtf(rowss[m] * (1.0f / 1024.0f) + NEPS);
#pragma unroll
            for (int n = 0; n < 3; ++n) SM[(size_t)m * 48 + 16 * n + r] = acc[n][j] * rstd + sWsm[s * 48 + 16 * n + r];
        }
    }
}
#define MFMA32(a, b, c) __builtin_amdgcn_mfma_f32_32x32x16_bf16((a), (b), (c), 0, 0, 0)
__device__ __forceinline__ int crow(int reg, int h) { return (reg & 3) + 8 * (reg >> 2) + 4 * h; }
__device__ __forceinline__ bf16x8 pack_step(const f32x16& x, int s) {
    v4u p; p.x = pk2(x[8 * s], x[8 * s + 1]); p.y = pk2(x[8 * s + 2], x[8 * s + 3]); p.z = pk2(x[8 * s + 4], x[8 * s + 5]); p.w = pk2(x[8 * s + 6], x[8 * s + 7]);
    return __builtin_bit_cast(bf16x8, p);
}
__device__ __forceinline__ bf16x8 frag_perm(const LAS unsigned char* img, int stride, int row, int col16, int h) {
    const LAS unsigned char* p = img + row * stride + (col16 + 4 * h) * 2;
    const s16x4 lo = *(const LAS s16x4*)p, hi = *(const LAS s16x4*)(p + 16);
    return __builtin_shufflevector(lo, hi, 0, 1, 2, 3, 4, 5, 6, 7);
}
__device__ __forceinline__ bf16x8 frag_nat(const LAS unsigned char* img, int stride, int row, int col16, int h) {
    const LAS unsigned char* p = img + row * stride + (col16 + 8 * h) * 2;
    const s16x4 lo = *(const LAS s16x4*)p, hi = *(const LAS s16x4*)(p + 8);
    return __builtin_shufflevector(lo, hi, 0, 1, 2, 3, 4, 5, 6, 7);
}
__device__ __forceinline__ void unpack8(const v4u w, float* f) {
    f[0] = bflo(w.x); f[1] = bfhi(w.x); f[2] = bflo(w.y); f[3] = bfhi(w.y); f[4] = bflo(w.z); f[5] = bfhi(w.z); f[6] = bflo(w.w); f[7] = bfhi(w.w);
}
__device__ __forceinline__ int chunk_first(int cid) { return cid < 256 ? ((cid & 31) == 0) : ((cid & 3) == 0); }
__device__ __forceinline__ int chunk_last(int cid) { return cid < 256 ? ((cid & 31) == 31) : ((cid & 3) == 3); }

constexpr int GP_Q = 0, GP_K = 17408, GP_RAW = 34816, GP_KK = 34816, GP_QK = 51456, GP_LP = 68096, GP_GATE = 100864, GP_ST = 272;
__device__ __forceinline__ void gdn_prep_unit(const Args& a, LAS unsigned char* lds, int l, int cid, int h, int tid_in, int wave_in, int lane_in) {
    int tid = tid_in; asm volatile("" : "+v"(tid));
    const int lane = tid & 63, wave = __builtin_amdgcn_readfirstlane(tid >> 6);
    unsigned char* ws = a.ws; const LayerBufs B = layer_bufs(l);
    bf16* GQ = (bf16*)bufp(ws, a.out, B.GQ); bf16* GK = (bf16*)bufp(ws, a.out, B.GK); bf16* GV = (bf16*)bufp(ws, a.out, B.GV);
    const bf16* HALO = (const bf16*)(ws + WS_HALO);
    const int m0 = cid * 64;
    LAS unsigned char* raw_s = lds + GP_RAW;
    {
        const int first = chunk_first(cid), last = chunk_last(cid);
#pragma unroll 1
        for (int p = tid; p < 3 * 66 * 16; p += 512) {
            const int t = p / (66 * 16), rem = p % (66 * 16), rr = rem >> 4, cg = rem & 15;
            const bf16* base = t == 0 ? GQ : (t == 1 ? GK : GV);
            v4u v = (v4u){0u, 0u, 0u, 0u};
            if (rr == 0) { if (!first) v = *(const GAS v4u*)(HALO + ((size_t)(cid - 1) * 2 + 1) * 1536 + t * 512 + h * 128 + 8 * cg); }
            else if (rr == 65) { if (!last) v = *(const GAS v4u*)(HALO + ((size_t)(cid + 1) * 2 + 0) * 1536 + t * 512 + h * 128 + 8 * cg); }
            else v = *(const GAS v4u*)(base + (size_t)(m0 + rr - 1) * 512 + h * 128 + 8 * cg);
            *(LAS v4u*)(raw_s + ((t * 66 + rr) * 128 + 8 * cg) * 2) = v;
        }
    }
    __syncthreads();
    {
        const float* cw = a.in[I_GCONV] + (size_t)l * 3 * 1536;
        const int grp = tid >> 4, cg = tid & 15;
#pragma unroll 1
        for (int j = 0; j < 6; ++j) {
            const int id = grp + 32 * j, t = id >> 6, r = id & 63;
            float x0[8], x1[8], x2[8], y[8];
            unpack8(*(const LAS v4u*)(raw_s + ((t * 66 + r) * 128 + 8 * cg) * 2), x0);
            unpack8(*(const LAS v4u*)(raw_s + ((t * 66 + r + 1) * 128 + 8 * cg) * 2), x1);
            unpack8(*(const LAS v4u*)(raw_s + ((t * 66 + r + 2) * 128 + 8 * cg) * 2), x2);
            const float* w0 = cw + t * 512 + h * 128 + 8 * cg;
            float ss = 0.f;
#pragma unroll
            for (int e = 0; e < 8; ++e) { const float c = x0[e] * w0[e] + x1[e] * w0[1536 + e] + x2[e] * w0[3072 + e]; y[e] = silu_f(c); ss += y[e] * y[e]; }
            ss += __shfl_xor(ss, 1); ss += __shfl_xor(ss, 2); ss += __shfl_xor(ss, 4); ss += __shfl_xor(ss, 8);
            float sc = 1.f;
            if (t == 0) sc = rsqrtf(ss + 1e-6f) * 0.08838834764831845f; else if (t == 1) sc = rsqrtf(ss + 1e-6f);
            v4u o; o.x = pk2(y[0] * sc, y[1] * sc); o.y = pk2(y[2] * sc, y[3] * sc); o.z = pk2(y[4] * sc, y[5] * sc); o.w = pk2(y[6] * sc, y[7] * sc);
            bf16* base = t == 0 ? GQ : (t == 1 ? GK : GV);
            *(GAS v4u*)(base + (size_t)(m0 + r) * 512 + h * 128 + 8 * cg) = o;
            if (t < 2) *(LAS v4u*)(lds + (t == 0 ? GP_Q : GP_K) + r * GP_ST + 16 * cg) = o;
        }
    }
    LAS float* gt = (LAS float*)(lds + GP_GATE);
    if (tid < 128) {
        const int dir = tid >> 6, i = tid & 63;
        const float* sm = (const float*)(ws + WS_SM) + (size_t)(m0 + i) * 48;
        const float av = sm[dir * 4 + h], bv = sm[8 + dir * 4 + h];
        gt[dir * 64 + i] = -__expf(a.in[I_ALOG][l * 8 + dir * 4 + h]) * softplus_f(av + a.in[I_DTB][l * 8 + dir * 4 + h]);
        gt[128 + dir * 64 + i] = sigmoid_f(bv);
    }
    __syncthreads();
    if (tid < 2) {
        const int dir = tid; float c = 0.f;
        if (dir == 0) { for (int i = 0; i < 64; ++i) { c += gt[i]; gt[256 + i] = c; } }
        else { for (int i = 63; i >= 0; --i) { c += gt[64 + i]; gt[256 + 64 + i] = c; } }
        gt[384 + dir] = c;
    }
    {
        const int which = wave >> 2, ti = (wave >> 1) & 1, tj = wave & 1, r = lane & 31, hh = lane >> 5;
        f32x16 acc; for (int i = 0; i < 16; ++i) acc[i] = 0.f;
        const LAS unsigned char* Ai = lds + (which ? GP_Q : GP_K); const LAS unsigned char* Bi = lds + GP_K;
#pragma unroll
        for (int s = 0; s < 8; ++s) acc = MFMA32(frag_nat(Ai, GP_ST, 32 * ti + r, 16 * s, hh), frag_nat(Bi, GP_ST, 32 * tj + r, 16 * s, hh), acc);
        LAS float* dst = (LAS float*)(lds + (which ? GP_QK : GP_KK));
#pragma unroll
        for (int i = 0; i < 16; ++i) dst[(32 * ti + crow(i, hh)) * 65 + 32 * tj + r] = acc[i];
    }
    __syncthreads();
    {
        const LAS float* KK = (const LAS float*)(lds + GP_KK); const LAS float* QK = (const LAS float*)(lds + GP_QK);
        bf16* GTA = (bf16*)bufp(ws, a.out, B.GTA);
#pragma unroll 1
        for (int p = tid; p < 2 * 4096; p += 512) {
            const int dir = p >> 12, ip = (p >> 6) & 63, jp = p & 63;
            const int i = dir ? 63 - ip : ip, j = dir ? 63 - jp : jp;
            const float gi = gt[256 + dir * 64 + i], gj = gt[256 + dir * 64 + j];
            float lv = 0.f;
            if (jp < ip) lv = gt[128 + dir * 64 + i] * KK[i * 65 + j] * __expf(gi - gj);
            ((LAS float*)(lds + GP_LP))[dir * 4096 + ip * 64 + jp] = lv;
            const int i2 = ip, j2 = jp;
            const bool keep = dir ? (j2 >= i2) : (j2 <= i2);
            const float av = keep ? QK[i2 * 65 + j2] * __expf(gt[256 + dir * 64 + i2] - gt[256 + dir * 64 + j2]) : 0.f;
            GTA[(((size_t)dir * NCHUNK + cid) * 4 + h) * 8192 + i2 * 128 + 64 + j2] = (bf16)(pk2(av, 0.f) & 0xffffu);
        }
        if (tid < 128) {
            const int dir = tid >> 6, i = tid & 63;
            float* E = (float*)(ws + WS_GDEC);
            const float gc = gt[256 + dir * 64 + i], gl = gt[384 + dir];
            E[(((size_t)dir * NCHUNK + cid) * 4 + h) * 64 + i] = __expf(gc);
            E[(size_t)2 * NCHUNK * 4 * 64 + (((size_t)dir * NCHUNK + cid) * 4 + h) * 64 + i] = __expf(gl - gc);
            if (i == 0) E[(size_t)4 * NCHUNK * 4 * 64 + ((size_t)dir * NCHUNK + cid) * 4 + h] = __expf(gl);
        }
    }
    __syncthreads();
    if (wave < 2) {
        const int dir = wave;
        const LAS float* Lp = (const LAS float*)(lds + GP_LP) + dir * 4096;
        float t[64];
#pragma unroll
        for (int i = 0; i < 64; ++i) {
            float a0 = (lane == i) ? 1.f : 0.f, a1 = 0.f;
#pragma unroll
            for (int j = 0; j + 1 < i; j += 2) { a0 -= Lp[i * 64 + j] * t[j]; a1 -= Lp[i * 64 + j + 1] * t[j + 1]; }
            if (i & 1) a0 -= Lp[i * 64 + i - 1] * t[i - 1];
            t[i] = a0 + a1;
        }
        const int jo = dir ? 63 - lane : lane;
        const float bj = gt[128 + dir * 64 + jo];
        bf16* GTA = (bf16*)bufp(ws, a.out, B.GTA) + (((size_t)dir * NCHUNK + cid) * 4 + h) * 8192;
#pragma unroll
        for (int ip = 0; ip < 64; ++ip) { const int io = dir ? 63 - ip : ip; GTA[io * 128 + jo] = (bf16)(pk2(t[ip] * bj, 0.f) & 0xffffu); }
    }
    __syncthreads();
}

constexpr int LP_GK = 0, LP_QG = 32768, LP_KI = 51200, LP_LR = 69632, LP_W = 77824, LP_B = 86016, LP_GL = 86528, LP_ST = 144;
__device__ __forceinline__ void gla_prep_unit(const Args& a, LAS unsigned char* lds, int l, int cid, int h, int tid_in, int wave_in, int lane_in) {
    int tid = tid_in; asm volatile("" : "+v"(tid));
    const int lane = tid & 63, wave = __builtin_amdgcn_readfirstlane(tid >> 6);
    unsigned char* ws = a.ws; const LayerBufs B = layer_bufs(l);
    const int m0 = cid * 64;
    LAS float* gk = (LAS float*)(lds + LP_GK); LAS float* lr = (LAS float*)(lds + LP_LR); LAS float* Wv = (LAS float*)(lds + LP_W); LAS float* bs = (LAS float*)(lds + LP_B); LAS float* gl = (LAS float*)(lds + LP_GL);
#pragma unroll 1
    for (int p = tid; p < 64 * 32; p += 512) lr[p] = ((const float*)(ws + WS_SM))[(size_t)(m0 + (p >> 5)) * 48 + 16 + (p & 31)];
#pragma unroll 1
    for (int p = tid; p < 2 * 16 * 64; p += 512) { const int dir = p >> 10, rk = (p >> 6) & 15, c = p & 63; Wv[p] = a.in[I_WGK][(((size_t)l * 2 + dir) * 16 + rk) * 256 + h * 64 + c]; }
    if (tid < 128) bs[tid] = a.in[I_BGK][((size_t)l * 2 + (tid >> 6)) * 256 + h * 64 + (tid & 63)];
    __syncthreads();
#pragma unroll 1
    for (int p = tid; p < 2 * 64 * 64; p += 512) {
        const int dir = p >> 12, i = (p >> 6) & 63, c = p & 63;
        float acc = bs[dir * 64 + c];
#pragma unroll
        for (int rk = 0; rk < 16; ++rk) acc += lr[i * 32 + dir * 16 + rk] * Wv[(dir * 16 + rk) * 64 + c];
        gk[p] = -softplus_f(-acc) * (1.0f / 16.0f);
    }
    __syncthreads();
    if (tid < 128) {
        const int dir = tid >> 6, c = tid & 63; float s = 0.f;
        if (dir == 0) { for (int i = 0; i < 64; ++i) { s += gk[i * 64 + c]; gk[i * 64 + c] = s; } }
        else { for (int i = 63; i >= 0; --i) { s += gk[4096 + i * 64 + c]; gk[4096 + i * 64 + c] = s; } }
        gl[dir * 64 + c] = s;
        ((float*)(ws + WS_LDEC))[(((size_t)dir * NCHUNK + cid) * 4 + h) * 64 + c] = __expf(s);
    }
    __syncthreads();
    {
        const bf16* LQ = (const bf16*)bufp(ws, a.out, B.LQ); const bf16* LK = (const bf16*)bufp(ws, a.out, B.LK);
#pragma unroll 1
        for (int p = tid; p < 2 * 64 * 64; p += 512) {
            const int dir = p >> 12, i = (p >> 6) & 63, c = p & 63;
            const float gc = gk[p], q = bf2f(LQ[(size_t)(m0 + i) * 256 + h * 64 + c]), k = bf2f(LK[(size_t)(m0 + i) * 256 + h * 64 + c]);
            const unsigned qg = pk2(q * 0.125f * __expf(gc), 0.f) & 0xffffu, ki = pk2(k * __expf(-gc), 0.f) & 0xffffu, kd = pk2(k * __expf(gl[dir * 64 + c] - gc), 0.f) & 0xffffu;
            *(LAS bf16*)(lds + LP_QG + dir * 9216 + i * LP_ST + 2 * c) = (bf16)qg;
            *(LAS bf16*)(lds + LP_KI + dir * 9216 + i * LP_ST + 2 * c) = (bf16)ki;
            bf16* blk = (bf16*)bufp(ws, a.out, dir ? B.LOP1 : B.LOP0) + ((size_t)cid * 4 + h) * 12288;
            blk[i * 64 + c] = (bf16)qg;
            blk[4096 + c * 64 + i] = (bf16)kd;
        }
    }
    __syncthreads();
    {
        const int dir = wave >> 2, ti = (wave >> 1) & 1, tj = wave & 1, r = lane & 31, hh = lane >> 5;
        f32x16 acc; for (int i = 0; i < 16; ++i) acc[i] = 0.f;
        const LAS unsigned char* Ai = lds + LP_QG + dir * 9216; const LAS unsigned char* Bi = lds + LP_KI + dir * 9216;
#pragma unroll
        for (int s = 0; s < 4; ++s) acc = MFMA32(frag_nat(Ai, LP_ST, 32 * ti + r, 16 * s, hh), frag_nat(Bi, LP_ST, 32 * tj + r, 16 * s, hh), acc);
        bf16* blk = (bf16*)bufp(ws, a.out, dir ? B.LOP1 : B.LOP0) + ((size_t)cid * 4 + h) * 12288 + 8192;
#pragma unroll
        for (int i = 0; i < 16; ++i) {
            const int io = 32 * ti + crow(i, hh), jo = 32 * tj + r;
            const bool keep = dir ? (jo >= io) : (jo <= io);
            blk[io * 64 + jo] = (bf16)(pk2(keep ? acc[i] : 0.f, 0.f) & 0xffffu);
        }
    }
    __syncthreads();
}

__device__ __forceinline__ void phase_prep(const Args& a, LAS unsigned char* lds, int l, int vcu, int G, int tid, int wave, int lane) {
    for (int it = vcu; it < 2 * NCHUNK * 4; it += G) {
        if (it < NCHUNK * 4) gdn_prep_unit(a, lds, l, it >> 2, it & 3, tid, wave, lane);
        else gla_prep_unit(a, lds, l, (it - NCHUNK * 4) >> 2, it & 3, tid, wave, lane);
    }
}

__device__ __forceinline__ int chain_cid(int b, int dir, int step) {
    if (step < 4) return 256 + 4 * b + (dir ? 3 - step : step);
    const int n = step - 4; return 32 * b + (dir ? 31 - n : n);
}
constexpr int GS_K = 0, GS_Q = 16896, GS_KT = 33792, GS_VT = 51200, GS_TB = 68608, GS_AT = 77312, GS_E1 = 86016, GS_E2 = 86272, GS_E3 = 86528;
__device__ __forceinline__ void gdn_scan_chain(const Args& a, LAS unsigned char* lds, int l, int b, int h, int dir, int tid_in, int wave_in, int lane_in) {
    int tid = tid_in; asm volatile("" : "+v"(tid));
    const int lane = tid & 63, wave = __builtin_amdgcn_readfirstlane(tid >> 6);
    unsigned char* ws = a.ws; const LayerBufs B = layer_bufs(l);
    const bf16* GQ = (const bf16*)bufp(ws, a.out, B.GQ); const bf16* GK = (const bf16*)bufp(ws, a.out, B.GK); const bf16* GV = (const bf16*)bufp(ws, a.out, B.GV);
    bf16* GTA = (bf16*)bufp(ws, a.out, B.GTA);
    const float* E = (const float*)(ws + WS_GDEC);
    const bool loader = wave >= 4;
    const int lt = tid - 256, li = lt & 63, lc = lt >> 6;
    const int r = lane & 31, hh = lane >> 5, w = wave;
    v4u rq[4], rk[4], rv[4], rt[4]; float re1 = 0.f, re2 = 0.f, re3 = 0.f;
    auto issue_loads = [&](int cid) {
        const size_t m = (size_t)cid * 64 + li;
        const bf16* ta = GTA + (((size_t)dir * NCHUNK + cid) * 4 + h) * 8192 + li * 128;
#pragma unroll
        for (int q = 0; q < 4; ++q) {
            const int cg = lc + 4 * q;
            rq[q] = *(const GAS v4u*)(GQ + m * 512 + h * 128 + 8 * cg);
            rk[q] = *(const GAS v4u*)(GK + m * 512 + h * 128 + 8 * cg);
            rv[q] = *(const GAS v4u*)(GV + m * 512 + h * 128 + 8 * cg);
            rt[q] = *(const GAS v4u*)(ta + 8 * cg);
        }
        if (lc == 0) { const size_t eo = (((size_t)dir * NCHUNK + cid) * 4 + h) * 64 + li; re1 = E[eo]; re2 = E[(size_t)2 * NCHUNK * 4 * 64 + eo];
                       re3 = E[(size_t)4 * NCHUNK * 4 * 64 + ((size_t)dir * NCHUNK + cid) * 4 + h]; }
    };
    auto write_lds = [&]() {
#pragma unroll
        for (int q = 0; q < 4; ++q) {
            const int cg = lc + 4 * q;
            *(LAS v2u*)(lds + GS_Q + li * 264 + 16 * cg) = (v2u){rq[q].x, rq[q].y}; *(LAS v2u*)(lds + GS_Q + li * 264 + 16 * cg + 8) = (v2u){rq[q].z, rq[q].w};
            *(LAS v2u*)(lds + GS_K + li * 264 + 16 * cg) = (v2u){rk[q].x, rk[q].y}; *(LAS v2u*)(lds + GS_K + li * 264 + 16 * cg + 8) = (v2u){rk[q].z, rk[q].w};
            const unsigned kw[4] = {rk[q].x, rk[q].y, rk[q].z, rk[q].w}, vw[4] = {rv[q].x, rv[q].y, rv[q].z, rv[q].w};
#pragma unroll
            for (int e = 0; e < 4; ++e) {
                *(LAS bf16*)(lds + GS_KT + (8 * cg + 2 * e) * 136 + 2 * li) = (bf16)(kw[e] & 0xffffu); *(LAS bf16*)(lds + GS_KT + (8 * cg + 2 * e + 1) * 136 + 2 * li) = (bf16)(kw[e] >> 16);
                *(LAS bf16*)(lds + GS_VT + (8 * cg + 2 * e) * 136 + 2 * li) = (bf16)(vw[e] & 0xffffu); *(LAS bf16*)(lds + GS_VT + (8 * cg + 2 * e + 1) * 136 + 2 * li) = (bf16)(vw[e] >> 16);
            }
            LAS unsigned char* tdst = lds + (cg < 8 ? GS_TB + li * 136 + 16 * cg : GS_AT + li * 136 + 16 * (cg - 8));
            *(LAS v2u*)tdst = (v2u){rt[q].x, rt[q].y}; *(LAS v2u*)(tdst + 8) = (v2u){rt[q].z, rt[q].w};
        }
        if (lc == 0) { ((LAS float*)(lds + GS_E1))[li] = re1; ((LAS float*)(lds + GS_E2))[li] = re2; if (li == 0) ((LAS float*)(lds + GS_E3))[0] = re3; }
    };

    __syncthreads();
    if (loader) {
        issue_loads(chain_cid(b, dir, 0)); write_lds();
        __syncthreads();
#pragma unroll 1
        for (int step = 0; step < 36; ++step) {
            if (step + 1 < 36) issue_loads(chain_cid(b, dir, step + 1));
            __syncthreads();
            if (step + 1 < 36) write_lds();
            __syncthreads();
        }
    } else {
        f32x16 S[4];
#pragma unroll
        for (int mt = 0; mt < 4; ++mt) for (int i = 0; i < 16; ++i) S[mt][i] = 0.f;
        __syncthreads();
#pragma unroll 1
        for (int step = 0; step < 36; ++step) {
            const int cid = chain_cid(b, dir, step);
            const LAS float* e1s = (const LAS float*)(lds + GS_E1); const LAS float* e2s = (const LAS float*)(lds + GS_E2);
            const float e3 = ((const LAS float*)(lds + GS_E3))[0];
            f32x16 Z[2], Q[2];
#pragma unroll
            for (int it = 0; it < 2; ++it) for (int i = 0; i < 16; ++i) { Z[it][i] = 0.f; Q[it][i] = 0.f; }
#pragma unroll
            for (int mt = 0; mt < 4; ++mt)
#pragma unroll
                for (int s = 0; s < 2; ++s) {
                    const bf16x8 sb = pack_step(S[mt], s);
#pragma unroll
                    for (int it = 0; it < 2; ++it) {
                        Z[it] = MFMA32(frag_perm(lds + GS_K, 264, 32 * it + r, 32 * mt + 16 * s, hh), sb, Z[it]);
                        Q[it] = MFMA32(frag_perm(lds + GS_Q, 264, 32 * it + r, 32 * mt + 16 * s, hh), sb, Q[it]);
                    }
                }
#pragma unroll
            for (int it = 0; it < 2; ++it)
#pragma unroll
                for (int g = 0; g < 4; ++g) {
                    const f32x4 ev = *(const LAS f32x4*)(e1s + 32 * it + 8 * g + 4 * hh);
                    const v2u vv = *(const LAS v2u*)(lds + GS_VT + (32 * w + r) * 136 + 2 * (32 * it + 8 * g + 4 * hh));
                    Z[it][4 * g] = bflo(vv.x) - ev[0] * Z[it][4 * g]; Z[it][4 * g + 1] = bfhi(vv.x) - ev[1] * Z[it][4 * g + 1];
                    Z[it][4 * g + 2] = bflo(vv.y) - ev[2] * Z[it][4 * g + 2]; Z[it][4 * g + 3] = bfhi(vv.y) - ev[3] * Z[it][4 * g + 3];
                    Q[it][4 * g] *= ev[0]; Q[it][4 * g + 1] *= ev[1]; Q[it][4 * g + 2] *= ev[2]; Q[it][4 * g + 3] *= ev[3];
                }
            f32x16 Vn[2];
#pragma unroll
            for (int it = 0; it < 2; ++it) for (int i = 0; i < 16; ++i) Vn[it][i] = 0.f;
#pragma unroll
            for (int kt = 0; kt < 2; ++kt)
#pragma unroll
                for (int s = 0; s < 2; ++s) {
                    const bf16x8 rb = pack_step(Z[kt], s);
#pragma unroll
                    for (int it = 0; it < 2; ++it) Vn[it] = MFMA32(frag_perm(lds + GS_TB, 136, 32 * it + r, 32 * kt + 16 * s, hh), rb, Vn[it]);
                }
#pragma unroll
            for (int kt = 0; kt < 2; ++kt)
#pragma unroll
                for (int s = 0; s < 2; ++s) {
                    const bf16x8 vb = pack_step(Vn[kt], s);
#pragma unroll
                    for (int it = 0; it < 2; ++it) Q[it] = MFMA32(frag_perm(lds + GS_AT, 136, 32 * it + r, 32 * kt + 16 * s, hh), vb, Q[it]);
                }
            {
                bf16* ob = GTA + (((size_t)dir * NCHUNK + cid) * 4 + h) * 8192 + 32 * w + r;
#pragma unroll
                for (int it = 0; it < 2; ++it)
#pragma unroll
                    for (int i = 0; i < 16; ++i) ob[(32 * it + crow(i, hh)) * 128] = (bf16)(pk2(Q[it][i], 0.f) & 0xffffu);
            }
#pragma unroll
            for (int it = 0; it < 2; ++it)
#pragma unroll
                for (int g = 0; g < 4; ++g) {
                    const f32x4 ev = *(const LAS f32x4*)(e2s + 32 * it + 8 * g + 4 * hh);
                    Vn[it][4 * g] *= ev[0]; Vn[it][4 * g + 1] *= ev[1]; Vn[it][4 * g + 2] *= ev[2]; Vn[it][4 * g + 3] *= ev[3];
                }
#pragma unroll
            for (int mt = 0; mt < 4; ++mt) for (int i = 0; i < 16; ++i) S[mt][i] *= e3;
#pragma unroll
            for (int kt = 0; kt < 2; ++kt)
#pragma unroll
                for (int s = 0; s < 2; ++s) {
                    const bf16x8 vb = pack_step(Vn[kt], s);
#pragma unroll
                    for (int mt = 0; mt < 4; ++mt) S[mt] = MFMA32(frag_perm(lds + GS_KT, 136, 32 * mt + r, 32 * kt + 16 * s, hh), vb, S[mt]);
                }
            __syncthreads();
            __syncthreads();
        }
    }
}

constexpr int LS_QG = 0, LS_KD = 8704, LS_AT = 17408, LS_VT = 26112, LS_E3 = 43520;
__device__ __forceinline__ void gla_scan_chain(const Args& a, LAS unsigned char* lds, int l, int b, int h, int dir, int tid_in, int wave_in, int lane_in) {
    int tid = tid_in; asm volatile("" : "+v"(tid));
    const int lane = tid & 63, wave = __builtin_amdgcn_readfirstlane(tid >> 6);
    unsigned char* ws = a.ws; const LayerBufs B = layer_bufs(l);
    bf16* LOP = (bf16*)bufp(ws, a.out, dir ? B.LOP1 : B.LOP0);
    const bf16* LV = (const bf16*)bufp(ws, a.out, B.LV);
    const float* E = (const float*)(ws + WS_LDEC);
    const bool loader = wave >= 4;
    const int lt = tid - 256, li = lt & 63, lc = lt >> 6;
    const int r = lane & 31, hh = lane >> 5, w = wave;
    v4u ro[6], rv[4]; float re3 = 0.f;
    auto issue_loads = [&](int cid) {
        const bf16* blk = LOP + ((size_t)cid * 4 + h) * 12288;
#pragma unroll
        for (int q = 0; q < 6; ++q) { const int pc = lc + 4 * q, mat = pc >> 3, cg = pc & 7; ro[q] = *(const GAS v4u*)(blk + mat * 4096 + li * 64 + 8 * cg); }
#pragma unroll
        for (int q = 0; q < 4; ++q) { const int cg = lc + 4 * q; rv[q] = *(const GAS v4u*)(LV + ((size_t)cid * 64 + li) * 512 + h * 128 + 8 * cg); }
        if (lc == 0) re3 = E[(((size_t)dir * NCHUNK + cid) * 4 + h) * 64 + li];
    };
    auto write_lds = [&]() {
#pragma unroll
        for (int q = 0; q < 6; ++q) { const int pc = lc + 4 * q, mat = pc >> 3, cg = pc & 7;
            LAS unsigned char* d = lds + mat * 8704 + li * 136 + 16 * cg; *(LAS v2u*)d = (v2u){ro[q].x, ro[q].y}; *(LAS v2u*)(d + 8) = (v2u){ro[q].z, ro[q].w}; }
#pragma unroll
        for (int q = 0; q < 4; ++q) { const int cg = lc + 4 * q; const unsigned vw[4] = {rv[q].x, rv[q].y, rv[q].z, rv[q].w};
#pragma unroll
            for (int e = 0; e < 4; ++e) { *(LAS bf16*)(lds + LS_VT + (8 * cg + 2 * e) * 136 + 2 * li) = (bf16)(vw[e] & 0xffffu); *(LAS bf16*)(lds + LS_VT + (8 * cg + 2 * e + 1) * 136 + 2 * li) = (bf16)(vw[e] >> 16); } }
        if (lc == 0) ((LAS float*)(lds + LS_E3))[li] = re3;
    };
    __syncthreads();
    if (loader) {
        issue_loads(chain_cid(b, dir, 0)); write_lds();
        __syncthreads();
#pragma unroll 1
        for (int step = 0; step < 36; ++step) {
            if (step + 1 < 36) issue_loads(chain_cid(b, dir, step + 1));
            __syncthreads();
            if (step + 1 < 36) write_lds();
            __syncthreads();
        }
    } else {
        f32x16 S[2];
#pragma unroll
        for (int mt = 0; mt < 2; ++mt) for (int i = 0; i < 16; ++i) S[mt][i] = 0.f;
        __syncthreads();
#pragma unroll 1
        for (int step = 0; step < 36; ++step) {
            const int cid = chain_cid(b, dir, step);
            const LAS float* e3s = (const LAS float*)(lds + LS_E3);
            f32x16 O[2];
#pragma unroll
            for (int it = 0; it < 2; ++it) for (int i = 0; i < 16; ++i) O[it][i] = 0.f;
#pragma unroll
            for (int mt = 0; mt < 2; ++mt)
#pragma unroll
                for (int s = 0; s < 2; ++s) {
                    const bf16x8 sb = pack_step(S[mt], s);
#pragma unroll
                    for (int it = 0; it < 2; ++it) O[it] = MFMA32(frag_perm(lds + LS_QG, 136, 32 * it + r, 32 * mt + 16 * s, hh), sb, O[it]);
                }
#pragma unroll
            for (int mt = 0; mt < 2; ++mt)
#pragma unroll
                for (int g = 0; g < 4; ++g) {
                    const f32x4 ev = *(const LAS f32x4*)(e3s + 32 * mt + 8 * g + 4 * hh);
                    S[mt][4 * g] *= ev[0]; S[mt][4 * g + 1] *= ev[1]; S[mt][4 * g + 2] *= ev[2]; S[mt][4 * g + 3] *= ev[3];
                }
#pragma unroll
            for (int kt = 0; kt < 2; ++kt)
#pragma unroll
                for (int s = 0; s < 2; ++s) {
                    const bf16x8 vb = frag_nat(lds + LS_VT, 136, 32 * w + r, 32 * kt + 16 * s, hh);
#pragma unroll
                    for (int it = 0; it < 2; ++it) O[it] = MFMA32(frag_nat(lds + LS_AT, 136, 32 * it + r, 32 * kt + 16 * s, hh), vb, O[it]);
#pragma unroll
                    for (int mt = 0; mt < 2; ++mt) S[mt] = MFMA32(frag_nat(lds + LS_KD, 136, 32 * mt + r, 32 * kt + 16 * s, hh), vb, S[mt]);
                }
            bf16* ob = LOP + ((size_t)cid * 4 + h) * 12288 + 32 * w + r;
#pragma unroll
            for (int it = 0; it < 2; ++it)
#pragma unroll
                for (int i = 0; i < 16; ++i) ob[(32 * it + crow(i, hh)) * 128] = (bf16)(pk2(O[it][i], 0.f) & 0xffffu);
            __syncthreads();
            __syncthreads();
        }
    }
}

__device__ __forceinline__ void phase_scan(const Args& a, LAS unsigned char* lds, int l, int vcu, int G, int tid, int wave, int lane) {
    for (int ch = vcu; ch < 128; ch += G) {
        const int dir = ch & 1, h = (ch >> 1) & 3, b = (ch >> 3) & 7;
        if (ch < 64) gdn_scan_chain(a, lds, l, b, h, dir, tid, wave, lane);
        else gla_scan_chain(a, lds, l, b, h, dir, tid, wave, lane);
    }
}

__device__ __forceinline__ void phase_merge(const Args& a, int l, int gw, int NGW, int lane) {
    unsigned char* ws = a.ws; const LayerBufs B = layer_bufs(l);
    const bf16* GTA = (const bf16*)bufp(ws, a.out, B.GTA); const bf16* L0 = (const bf16*)bufp(ws, a.out, B.LOP0); const bf16* L1 = (const bf16*)bufp(ws, a.out, B.LOP1);
    const bf16* ZA = (const bf16*)bufp(ws, a.out, B.ZA); const bf16* ZB = (const bf16*)bufp(ws, a.out, B.ZB);
    bf16* Y = (bf16*)bufp(ws, a.out, B.Y);
    const int mrows = l == DEPTH - 1 ? MLAT : MALL;
    const int grp = lane >> 4, cg = lane & 15;
    for (int it = gw * 4 + grp; it < mrows * 8; it += NGW * 4) {
        const int m = it >> 3, hs = it & 7, cid = m >> 6, i = m & 63;
        const bf16 *o0, *o1, *zp; const float* gn;
        if (hs < 4) { o0 = GTA + (((size_t)0 * NCHUNK + cid) * 4 + hs) * 8192 + i * 128; o1 = GTA + (((size_t)1 * NCHUNK + cid) * 4 + hs) * 8192 + i * 128; zp = ZA + (size_t)m * 512 + hs * 128; gn = a.in[I_GNORM] + l * 128; }
        else { const int h2 = hs - 4; o0 = L0 + ((size_t)cid * 4 + h2) * 12288 + i * 128; o1 = L1 + ((size_t)cid * 4 + h2) * 12288 + i * 128; zp = ZB + (size_t)m * 512 + h2 * 128; gn = a.in[I_LNORM] + l * 128; }
        float f0[8], f1[8], z[8];
        unpack8(*(const GAS v4u*)(o0 + 8 * cg), f0); unpack8(*(const GAS v4u*)(o1 + 8 * cg), f1); unpack8(*(const GAS v4u*)(zp + 8 * cg), z);
        float ss = 0.f;
#pragma unroll
        for (int e = 0; e < 8; ++e) { f0[e] += f1[e]; ss += f0[e] * f0[e]; }
        ss += __shfl_xor(ss, 1); ss += __shfl_xor(ss, 2); ss += __shfl_xor(ss, 4); ss += __shfl_xor(ss, 8);
        const float rstd = rsqrtf(ss * (1.0f / 128.0f) + NEPS);
        float y[8];
#pragma unroll
        for (int e = 0; e < 8; ++e) y[e] = f0[e] * rstd * gn[8 * cg + e] * silu_f(z[e]);
        v4u o; o.x = pk2(y[0], y[1]); o.y = pk2(y[2], y[3]); o.z = pk2(y[4], y[5]); o.w = pk2(y[6], y[7]);
        *(GAS v4u*)(Y + (size_t)m * 1024 + hs * 128 + 8 * cg) = o;
    }
}
constexpr int CV_W = 0  , CV_B = 2304  , CV_T = 2560;
__device__ __forceinline__ void conv_unit(const Args& a, LAS unsigned char* lds, int l, const bf16* U, bf16* Gd, int Fc, int f0, int unit, int nslab, int tid_in) {
    int tid = tid_in; asm volatile("" : "+v"(tid));
    const int slab = unit % nslab, rest = unit / nslab;
    const bool isctx = rest >= 32;
    const int b = isctx ? rest - 32 : rest >> 2, gy0 = isctx ? 0 : (rest & 3) * 8;
    const int W = isctx ? 256 : 64, NR = isctx ? 1 : 8, HR = isctx ? 0 : 1, TR = NR + 2 * HR, TW = W + 2;
    const int mbase = isctx ? MLAT + b * 256 : b * 2048;
    const int fl = slab * 32;
    LAS float* wsm = (LAS float*)(lds + CV_W); LAS float* bsm = (LAS float*)(lds + CV_B); LAS unsigned char* tile = lds + CV_T;
    __syncthreads();
    for (int p = tid; p < 9 * 64; p += 512) { const int tap = p >> 6, av = (p >> 5) & 1, c = p & 31; wsm[p] = a.in[I_FCONV][((size_t)l * 9 + tap) * 5632 + av * DFF + f0 + fl + c]; }
    if (tid < 64) bsm[tid] = a.in[I_FCB][(size_t)l * 5632 + (tid >> 5) * DFF + f0 + fl + (tid & 31)];
    const int ncell = TR * TW;
#pragma unroll 1
    for (int p = tid; p < ncell * 8; p += 512) {
        const int cell = p >> 3, pc = p & 7, tr = cell / TW, tc = cell % TW;
        const int gy = gy0 - HR + tr, gx = tc - 1;
        v4u v = (v4u){0u, 0u, 0u, 0u};
        if (gx >= 0 && gx < W && gy >= 0 && gy < (isctx ? 1 : 32)) {
            const size_t m = (size_t)mbase + gy * W + gx;
            v = *(const GAS v4u*)(U + m * (2 * Fc) + (pc >> 2) * Fc + fl + 8 * (pc & 3));
        }
        *(LAS v4u*)(tile + cell * 128 + 16 * pc) = v;
    }
    __syncthreads();
#pragma unroll 1
    for (int it = tid; it < NR * W * 4; it += 512) {
        const int cg = it & 3, tok = it >> 2, ry = tok / W, gx = tok % W;
        float sa[8], sv[8];
#pragma unroll
        for (int e = 0; e < 8; ++e) { sa[e] = bsm[8 * cg + e]; sv[e] = bsm[32 + 8 * cg + e]; }
#pragma unroll
        for (int dy = -1; dy <= 1; ++dy) {
            if (isctx && dy != 0) continue;
#pragma unroll
            for (int dx = -1; dx <= 1; ++dx) {
                const int tap = (dy + 1) * 3 + dx + 1;
                const LAS unsigned char* cp = tile + ((ry + HR + dy) * TW + gx + 1 + dx) * 128 + 16 * cg;
                float xa[8], xv[8];
                unpack8(*(const LAS v4u*)cp, xa); unpack8(*(const LAS v4u*)(cp + 64), xv);
                const LAS float* wp = wsm + tap * 64 + 8 * cg;
#pragma unroll
                for (int e = 0; e < 8; ++e) { sa[e] += xa[e] * wp[e]; sv[e] += xv[e] * wp[32 + e]; }
            }
        }
        float y[8];
#pragma unroll
        for (int e = 0; e < 8; ++e) y[e] = silu_f(sa[e]) * sv[e];
        v4u o; o.x = pk2(y[0], y[1]); o.y = pk2(y[2], y[3]); o.z = pk2(y[4], y[5]); o.w = pk2(y[6], y[7]);
        const size_t m = (size_t)mbase + (gy0 + ry) * W + gx;
        *(GAS v4u*)(Gd + m * Fc + fl + 8 * cg) = o;
    }
}
__device__ __forceinline__ void phase_conv(const Args& a, LAS unsigned char* lds, int l, int chunkA, int vcu, int G, int tid) {
    unsigned char* ws = a.ws; const LayerBufs B = layer_bufs(l);
    const int Fc = chunkA ? FCA : FCB, f0 = chunkA ? FCB : 0, nslab = Fc / 32;
    const bf16* U = (const bf16*)bufp(ws, a.out, chunkA ? B.UA : B.UB); bf16* Gd = (bf16*)bufp(ws, a.out, chunkA ? B.GA : B.GB);
    const int nunits = (l == DEPTH - 1 ? 32 : 40) * nslab;
    for (int u = vcu; u < nunits; u += G) conv_unit(a, lds, l, U, Gd, Fc, f0, u, nslab, tid);
    __syncthreads();
}
__device__ __forceinline__ void phase_final(const Args& a, int gw, int NGW, int lane) {
    const float* rs = (const float*)(a.ws + WS_RSA) + (size_t)3 * MALL; const float* fn = a.in[I_FNORM];
    for (int m = gw; m < MLAT; m += NGW) {
        const float rstd = rsqrtf(rs[m] * (1.0f / 1024.0f) + NEPS);
        float* row = a.out + (size_t)m * 1024;
#pragma unroll
        for (int j = 0; j < 4; ++j) { const int c = 4 * lane + 256 * j; const f32x4 v = *(const f32x4*)(row + c), g = *(const f32x4*)(fn + c); *(f32x4*)(row + c) = v * rstd * g; }
    }
}
constexpr int PH_P0A = 0, PH_P0B = 1, PH_L0 = 2, PH_PER_LAYER = 11, PH_FINAL = PH_L0 + 2 * PH_PER_LAYER, PH_COUNT = PH_FINAL + 1;
enum { K_INPROJ = 0, K_PREP, K_SCAN, K_MERGE, K_OUTPROJ, K_UPB, K_CONVB, K_DOWNB, K_UPA, K_CONVA, K_DOWNA };

__global__ void __launch_bounds__(NWAVES * 64, 2) mk_fwd(Args a) {
    extern __shared__ __attribute__((aligned(16))) unsigned char lds_raw[];
    LAS unsigned char* lds = (LAS unsigned char*)lds_raw;
    const int G = gridDim.x; const int bx = blockIdx.x;
    const int vcu = (G % 8 == 0) ? (bx % 8) * (G / 8) + bx / 8 : bx;
    const int NGW = G * NWAVES;
    unsigned char* ws = a.ws;
    for (int u = threadIdx.x; u < (LDS_BYTES - LDSCTL_OFF) / 4; u += NWAVES * 64) ((LAS unsigned*)(lds + LDSCTL_OFF))[u] = 0u;
    __syncthreads();
    XcdBarrier bar; bar.bar = (unsigned*)(ws + WS_CTL) + CW_BAR; bar.x = 0; bar.st = nullptr;
    if (a.use_bar) bar = xcd_barrier_post((unsigned*)(ws + WS_CTL) + CW_BAR, (volatile LAS unsigned*)(lds + LDSCTL_OFF) + 8);
    const float* MOD = (const float*)(ws + WS_MOD);
    float* RSA = (float*)(ws + WS_RSA);

    for (int ph = a.ph_lo; ph < a.ph_hi; ++ph) {
        int tid_o = threadIdx.x; asm volatile("" : "+v"(tid_o));
        const int tid = tid_o, lane = tid & 63, wave = __builtin_amdgcn_readfirstlane(tid >> 6);
        const int gw = vcu * NWAVES + wave;
        if (ph == PH_P0A) phase_p0a(a, lds, vcu, G, tid, wave, lane);
        else if (ph == PH_P0B) phase_p0b(a, lds, vcu, G, tid, wave, lane);
        else if (ph < PH_FINAL) {
            const int l = (ph - PH_L0) / PH_PER_LAYER, k = (ph - PH_L0) % PH_PER_LAYER;
            const LayerBufs B = layer_bufs(l);
            unsigned char* wl = ws + (l == 0 ? WS_W1 : WS_W2);
            const float* MODl = MOD + (size_t)l * 9 * 6144;
            const float* SWl = (const float*)(ws + WS_SW) + (size_t)l * SW_LAYER;
            const float* rs_n1 = l == 0 ? (const float*)(ws + WS_RS1) : RSA + (size_t)1 * MALL;
            if (k == K_INPROJ) {
                const bf16* XG = (const bf16*)bufp(ws, a.out, B.XG);
                skinny_rows(XG, (const bf16*)(ws + WS_WSM) + (size_t)l * 48 * 1024, rs_n1, SWl + 9 * NMAIN, (float*)(ws + WS_SM), gw, NGW, lane);
                pg8::Gemm g{XG, (const bf16*)(wl + W_IN), MALL, NMAIN, 1024}; pg8::StaticOrder S; S.init(MALL, NMAIN, G, bx);
                pg8::EpiInProj E{ws, a.out, l};
                pg8::gemm_phase<pg8::EpiInProj, pg8::StaticOrder, true, true>(lds, g, S, E);
            }
            else if (k == K_PREP) phase_prep(a, lds, l, vcu, G, tid, wave, lane);
            else if (k == K_SCAN) phase_scan(a, lds, l, vcu, G, tid, wave, lane);
            else if (k == K_MERGE) phase_merge(a, l, gw, NGW, lane);
            else if (k == K_OUTPROJ || k == K_DOWNB || k == K_DOWNA) {
                const int M = l == DEPTH - 1 ? MLAT : MALL;
                const bool last = l == DEPTH - 1;
                float* res_lat = a.out; float* res_ctx = (float*)(ws + WS_CXR);
                pg8::EpiResid E;
                E.rin_lat = (k == K_OUTPROJ && l == 0) ? a.in[I_X] : res_lat; E.rin_ctx = (k == K_OUTPROJ && l == 0) ? a.in[I_CTX] : res_ctx;
                E.rout_lat = res_lat; E.rout_ctx = res_ctx;
                E.gate = MODl + (k == K_OUTPROJ ? 2 : 5) * 1024; E.gn = nullptr; E.scl = nullptr; E.XGo = nullptr; E.rowss = nullptr;
                pg8::Gemm g;
                if (k == K_OUTPROJ) { g = pg8::Gemm{(const bf16*)bufp(ws, a.out, B.Y), (const bf16*)(wl + W_OUT), M, 1024, 1024};
                    E.gn = a.in[I_NORM2] + l * 1024; E.scl = MODl + 4 * 1024; E.XGo = (bf16*)bufp(ws, a.out, B.XG2); E.rowss = RSA + (size_t)(l == 0 ? 0 : 2) * MALL; }
                else if (k == K_DOWNB) g = pg8::Gemm{(const bf16*)bufp(ws, a.out, B.GB), (const bf16*)(wl + W_DB), M, 1024, FCB};
                else { g = pg8::Gemm{(const bf16*)bufp(ws, a.out, B.GA), (const bf16*)(wl + W_DA), M, 1024, FCA};
                    if (!last) { E.gn = a.in[I_NORM1] + 1024; E.scl = MOD + (size_t)9 * 6144 + 1 * 1024; E.XGo = (bf16*)bufp(ws, a.out, B.XGN); E.rowss = RSA + (size_t)1 * MALL; }
                    else E.rowss = RSA + (size_t)3 * MALL; }
                pg8::StaticOrder S; S.init(M, 1024, G, bx);
                pg8::gemm_phase<pg8::EpiResid, pg8::StaticOrder, true, true>(lds, g, S, E);
            }
            else if (k == K_UPB || k == K_UPA) {
                const int M = l == DEPTH - 1 ? MLAT : MALL;
                const int roff = k == K_UPA ? 2 * FCB : 0, N = k == K_UPA ? 2 * FCA : 2 * FCB;
                pg8::Gemm g{(const bf16*)bufp(ws, a.out, B.XG2), (const bf16*)(wl + W_UP) + (size_t)roff * 1024, M, N, 1024};
                pg8::EpiUp E{RSA + (size_t)(l == 0 ? 0 : 2) * MALL, SWl + 9 * (NMAIN + NSMALL) + roff, (bf16*)bufp(ws, a.out, k == K_UPA ? B.UA : B.UB), N};
                pg8::StaticOrder S; S.init(M, N, G, bx);
                pg8::gemm_phase<pg8::EpiUp, pg8::StaticOrder, true, true>(lds, g, S, E);
            }
            else if (k == K_CONVB || k == K_CONVA) phase_conv(a, lds, l, k == K_CONVA, vcu, G, tid);
        }
        else phase_final(a, gw, NGW, lane);
        if (ph + 1 < a.ph_hi && a.use_bar) xcd_barrier(bar);
    }
}
static int g_grid = 0;
static int mk_setup() {
    if (g_grid) return g_grid;
    int dev = 0, cus = 0;
    if (hipGetDevice(&dev) != hipSuccess || hipDeviceGetAttribute(&cus, hipDeviceAttributeMultiprocessorCount, dev) != hipSuccess) { g_grid = -1; return -1; }
    if (hipFuncSetAttribute((const void*)mk_fwd, hipFuncAttributeMaxDynamicSharedMemorySize, LDS_BYTES) != hipSuccess) { fprintf(stderr, "hipFuncSetAttribute failed\n"); g_grid = -1; return -1; }
    (void)hipGetLastError();
    g_grid = cus;
    return g_grid;
}
static void mk_launch(const Args& base, int lo, int hi, int use_bar, hipStream_t stream) {
    Args a = base; a.ph_lo = lo; a.ph_hi = hi; a.use_bar = use_bar; a.pad = 0;
    hipLaunchKernelGGL(mk_fwd, dim3(g_grid), dim3(NWAVES * 64), LDS_BYTES, stream, a);
}

extern "C" void kernel_launch(void* const* d_in, const int* in_sizes, int n_in, void* d_out, int out_size, void* d_ws, size_t ws_size, hipStream_t stream) {
    if (mk_setup() < 0) return;
    unsigned char* ws = (unsigned char*)d_ws;
    (void)hipMemsetAsync(ws + WS_CTL, 0, CTL_ZERO_BYTES, stream);
    Args a{};
    for (int i = 0; i < 22; ++i) a.in[i] = (const float*)d_in[i];
    a.out = (float*)d_out; a.ws = ws;
#ifndef MK_N_LAUNCHES
#define MK_N_LAUNCHES 1
#endif
    if (MK_N_LAUNCHES == 1) mk_launch(a, 0, PH_COUNT, 1, stream);
    else for (int ph = 0; ph < PH_COUNT; ++ph) mk_launch(a, ph, ph + 1, 0, stream);
}
```

```cpp
#include <hip/hip_runtime.h>
#include <cstdio>
#include <cstdint>
#include <math.h>

#define GAS __attribute__((address_space(1)))
#define LAS __attribute__((address_space(3)))
typedef unsigned short bf16;
typedef unsigned v4u __attribute__((ext_vector_type(4)));
typedef unsigned v2u __attribute__((ext_vector_type(2)));
typedef float f32x4 __attribute__((ext_vector_type(4)));
typedef float f32x16 __attribute__((ext_vector_type(16)));
typedef short bf16x8 __attribute__((ext_vector_type(8)));
typedef short s16x4 __attribute__((ext_vector_type(4)));
typedef __bf16 bf16x2_t __attribute__((ext_vector_type(2)));
typedef float f32x2_t __attribute__((ext_vector_type(2)));
typedef GAS unsigned gu32;

constexpr int DM = 1024, NBATCH = 8, LSEQ = 2048, LCTX = 256, DEPTH = 2;
constexpr int MLAT = NBATCH * LSEQ;
constexpr int MALL = MLAT + NBATCH * LCTX;
constexpr int NCHUNK = MALL / 64;
constexpr int DINP = 3632, NMAIN = 3584, NSMALL = 48;
constexpr int DFF = 2816, FCB = 1280, FCA = 1536;
constexpr float NEPS = 1e-6f;

constexpr size_t MiB = 1u << 20;
constexpr size_t WS_CTL = 0, CTL_ZERO_BYTES = 1 * MiB;
constexpr int CW_BAR = 4096;
constexpr size_t WS_RSA = 256 * 1024;
constexpr size_t WS_MOD = 1 * MiB;
constexpr size_t WS_RS1 = 1 * MiB + 512 * 1024;
constexpr size_t WS_SW = 2 * MiB;
constexpr size_t SW_LAYER = (size_t)9 * (NMAIN + NSMALL + 2 * DFF);
constexpr size_t WS_GDEC = 3 * MiB;
constexpr size_t WS_LDEC = 4 * MiB + 512 * 1024;
constexpr size_t WS_SM = 5 * MiB + 256 * 1024;
constexpr size_t WS_HALO = 9 * MiB;
constexpr size_t WS_WSM = 11 * MiB;
constexpr size_t WS_W2 = 12 * MiB, WS_W1 = 38 * MiB;
constexpr size_t W_IN = 0, W_OUT = 7 * MiB, W_UP = 9 * MiB, W_DB = 20 * MiB, W_DA = 20 * MiB + (size_t)1024 * FCB * 2;
constexpr size_t WS_CXR = 64 * MiB;
static_assert(W_DA + (size_t)1024 * FCA * 2 <= 26 * MiB, "weights");
static_assert(WS_SM + (size_t)MALL * 48 * 4 <= WS_HALO && WS_HALO + (size_t)NCHUNK * 2 * 1536 * 2 <= WS_WSM, "ws small map");
static_assert(WS_SW + 2 * SW_LAYER * 4 <= WS_GDEC && WS_RSA + (size_t)4 * MALL * 4 <= CTL_ZERO_BYTES, "ws map");

struct LayerBufs {
    long XG, GQ, GK, GV, LV, ZA, ZB, LQ, LK, GTA, LOP0, LOP1, Y, XG2, UB, GB, UA, GA, XGN;
};
#define DO_(x) (-(long)((x) * MiB) - 1)
__host__ __device__ constexpr LayerBufs layer_bufs(int l) {
    return l == 0 ? LayerBufs{ 72 * (long)MiB, 108 * (long)MiB, 126 * (long)MiB, 144 * (long)MiB, 162 * (long)MiB, DO_(0), DO_(18), DO_(36), DO_(45),
                               180 * (long)MiB, 72 * (long)MiB, 216 * (long)MiB, 108 * (long)MiB, 72 * (long)MiB, 108 * (long)MiB, 198 * (long)MiB, 126 * (long)MiB, 72 * (long)MiB, 220 * (long)MiB }
                  : LayerBufs{ 220 * (long)MiB, 38 * (long)MiB, 56 * (long)MiB, 74 * (long)MiB, 92 * (long)MiB, 110 * (long)MiB, 128 * (long)MiB, 146 * (long)MiB, 155 * (long)MiB,
                               164 * (long)MiB, 200 * (long)MiB, 227 * (long)MiB, 38 * (long)MiB, 74 * (long)MiB, 110 * (long)MiB, 190 * (long)MiB, 110 * (long)MiB, 206 * (long)MiB, 0 };
}

#define LDS_WAIT() asm volatile("s_waitcnt lgkmcnt(0)" ::: "memory")
#define VM_WAIT() asm volatile("s_waitcnt vmcnt(0)" ::: "memory")
__device__ __forceinline__ unsigned pk2(float lo, float hi) { f32x2_t v = {lo, hi}; bf16x2_t b = __builtin_convertvector(v, bf16x2_t); return __builtin_bit_cast(unsigned, b); }
__device__ __forceinline__ float bflo(unsigned u) { return __uint_as_float(u << 16); }
__device__ __forceinline__ float bfhi(unsigned u) { return __uint_as_float(u & 0xffff0000u); }
__device__ __forceinline__ float bf2f(bf16 u) { return __uint_as_float((unsigned)u << 16); }
__device__ __forceinline__ float silu_f(float x) { return x / (1.f + __expf(-x)); }
__device__ __forceinline__ float softplus_f(float x) { return fmaxf(x, 0.f) + log1pf(__expf(-fabsf(x))); }
__device__ __forceinline__ float sigmoid_f(float x) { return 1.f / (1.f + __expf(-x)); }
__device__ __forceinline__ float wave_sum(float v) {
#pragma unroll
    for (int o = 1; o < 64; o <<= 1) v += __shfl_xor(v, o);
    return v;
}
__device__ __forceinline__ int row_s(int m) { return m < MLAT ? (m >> 11) : 8; }
__host__ __device__ __forceinline__ unsigned char* bufp(unsigned char* ws, float* out, long off) { return off >= 0 ? ws + off : (unsigned char*)out + (-off - 1); }
namespace pg8 {
#define PG8_LAS __attribute__((address_space(3)))
typedef unsigned short bf16_t;
typedef short bf16x8 __attribute__((ext_vector_type(8)));
typedef float f32x4 __attribute__((ext_vector_type(4)));
typedef unsigned u32x4 __attribute__((ext_vector_type(4)));
constexpr int BM = 256, BK = 64, HALF = 128, HTB = HALF * BK * 2  , STAGE_BYTES = 8 * HTB, NXCD = 8, WGM = 8;

__host__ __device__ __forceinline__ int lds_byte(int r, int c) { const int st = (r >> 4) * 2 + (c >> 5), rr = r & 15, cc = c & 31, ob = rr * 64 + cc * 2; return st * 1024 + (ob ^ (((ob >> 9) & 1) << 5)); }
__host__ __device__ __forceinline__ void stage_rc(int b, int& R, int& C) { const int st = b / 1024, sb = b % 1024, swz = sb ^ (((sb >> 9) & 1) << 5); R = (st >> 1) * 16 + swz / 64; C = (st & 1) * 32 + (swz % 64) / 2; }
__host__ __device__ __forceinline__ int perm32(int rho) { const int n = rho >> 4, i = rho & 15; return 8 * (i >> 2) + 4 * n + (i & 3); }

struct Unit { int pm, pn; };
struct Gemm { const bf16_t* A; const bf16_t* Bt; int M, N, K; };

struct StaticOrder {
    int nM, nN, nwg, G, c;
    __host__ __device__ void init(int M, int N, int G_, int c_) { nM = M / BM; nN = N / BM; nwg = nM * nN; G = G_; c = c_; }
    __host__ __device__ bool next(int i, Unit& u) const {
        const long L = (long)i * G + c; if (L >= nwg) return false;
        int wgid = (int)L; { const int q = nwg / NXCD, r = nwg % NXCD, xcd = wgid % NXCD, off = wgid / NXCD; wgid = (xcd < r ? xcd * (q + 1) : r * (q + 1) + (xcd - r) * q) + off; }
        const int nig = WGM * nN, gid = wgid / nig, fm = gid * WGM, gsz = (nM - fm) < WGM ? (nM - fm) : WGM;
        u.pm = fm + ((wgid % nig) % gsz); u.pn = (wgid % nig) / gsz; return true;
    }
    __device__ __forceinline__ void a_ready(const Unit&) const {}
    __device__ __forceinline__ void done(const Unit&) const {}
};
__device__ __forceinline__ unsigned pk2e(float lo, float hi) { f32x2_t v = {lo, hi}; bf16x2_t b = __builtin_convertvector(v, bf16x2_t); return __builtin_bit_cast(unsigned, b); }

struct EpiInProj {
    static constexpr bool PERM = true, AFTER_DRAIN = false;
    unsigned char* ws; float* out; int l;
    __device__ __forceinline__ void operator()(const f32x4 (&acc)[2][2][4][2], const Unit& u, int wr, int wc, int fr, int fq) const {
        const LayerBufs B = layer_bufs(l);
        const float* rowss = l == 0 ? (const float*)(ws + WS_RS1) : (const float*)(ws + WS_RSA) + MALL;
        const float* sW = (const float*)(ws + WS_SW) + (size_t)l * SW_LAYER;
        const int pn = u.pn, s = u.pm < 64 ? (u.pm >> 3) : 8;
        long boff; int ld, cb;
        if (pn < 8) { const int t = pn >> 1; boff = t == 0 ? B.GQ : (t == 1 ? B.GK : (t == 2 ? B.GV : B.ZA)); ld = 512; cb = (pn & 1) * 256; }
        else if (pn == 8) { boff = B.LQ; ld = 256; cb = 0; }
        else if (pn == 9) { boff = B.LK; ld = 256; cb = 0; }
        else { boff = pn < 12 ? B.LV : B.ZB; ld = 512; cb = (pn & 1) * 256; }
        bf16_t* base = (bf16_t*)bufp(ws, out, boff);
        bf16_t* HALO = (bf16_t*)(ws + WS_HALO);
        const int row0 = u.pm * BM + wr * 64 + fr, colw = wc * 32 + 8 * fq;
        const float* swp = sW + (size_t)s * 3584 + pn * BM + colw;
        f32x4 bv[2][2];
#pragma unroll
        for (int bj = 0; bj < 2; ++bj)
#pragma unroll
            for (int n = 0; n < 2; ++n) bv[bj][n] = *(const f32x4*)(swp + bj * HALF + 4 * n);
#pragma unroll
        for (int ai = 0; ai < 2; ++ai)
#pragma unroll
            for (int m = 0; m < 4; ++m) {
                const int row = row0 + ai * HALF + m * 16;
                const float rstd = rsqrtf(rowss[row] * (1.0f / 1024.0f) + 1e-6f);
                bf16_t* rowp = base + (size_t)row * ld + cb + colw;
                const bool halo = (pn < 6) && ((m == 0 && fr == 0) || (m == 3 && fr == 15));
                bf16_t* hp = HALO + ((size_t)(row >> 6) * 2 + (m == 3 ? 1 : 0)) * 1536 + (pn >> 1) * 512 + cb + colw;
#pragma unroll
                for (int bj = 0; bj < 2; ++bj) {
                    const f32x4 v0 = acc[ai][bj][m][0] * rstd + bv[bj][0], v1 = acc[ai][bj][m][1] * rstd + bv[bj][1];
                    u32x4 w; w.x = pk2e(v0[0], v0[1]); w.y = pk2e(v0[2], v0[3]); w.z = pk2e(v1[0], v1[1]); w.w = pk2e(v1[2], v1[3]);
                    *(u32x4*)(rowp + bj * HALF) = w;
                    if (halo) *(u32x4*)(hp + bj * HALF) = w;
                }
            }
    }
};

struct EpiResid {
    static constexpr bool PERM = true, AFTER_DRAIN = false;
    const float* rin_lat; const float* rin_ctx; float* rout_lat; float* rout_ctx;
    const float* gate;
    const float* gn;
    const float* scl;
    bf16_t* XGo; float* rowss;
    __device__ __forceinline__ void operator()(const f32x4 (&acc)[2][2][4][2], const Unit& u, int wr, int wc, int fr, int fq) const {
        const int s = u.pm < 64 ? (u.pm >> 3) : 8;
        const bool isctx = u.pm >= 64, do_xg = XGo != nullptr, do_ss = rowss != nullptr;
        const float* rin = isctx ? rin_ctx - (size_t)16384 * 1024 : rin_lat;
        float* rout = isctx ? rout_ctx - (size_t)16384 * 1024 : rout_lat;
        const int row0 = u.pm * BM + wr * 64 + fr, col0 = u.pn * BM + wc * 32 + 8 * fq;
        f32x4 gv[2][2], nv[2][2];
#pragma unroll
        for (int bj = 0; bj < 2; ++bj)
#pragma unroll
            for (int n = 0; n < 2; ++n) {
                gv[bj][n] = *(const f32x4*)(gate + (size_t)s * 6144 + col0 + bj * HALF + 4 * n);
                if (do_xg) { const f32x4 g = *(const f32x4*)(gn + col0 + bj * HALF + 4 * n), sc = *(const f32x4*)(scl + (size_t)s * 6144 + col0 + bj * HALF + 4 * n); nv[bj][n] = g * (sc + 1.0f); }
                else nv[bj][n] = (f32x4){0.f, 0.f, 0.f, 0.f};
            }
#pragma unroll
        for (int ai = 0; ai < 2; ++ai)
#pragma unroll
            for (int m = 0; m < 4; ++m) {
                const int row = row0 + ai * HALF + m * 16;
                const float* rp = rin + (size_t)row * 1024 + col0; float* op = rout + (size_t)row * 1024 + col0;
                float ss = 0.f;
#pragma unroll
                for (int bj = 0; bj < 2; ++bj) {
                    const f32x4 x0 = *(const f32x4*)(rp + bj * HALF) + gv[bj][0] * acc[ai][bj][m][0];
                    const f32x4 x1 = *(const f32x4*)(rp + bj * HALF + 4) + gv[bj][1] * acc[ai][bj][m][1];
                    *(f32x4*)(op + bj * HALF) = x0; *(f32x4*)(op + bj * HALF + 4) = x1;
                    ss += (x0[0] * x0[0] + x0[1] * x0[1]) + (x0[2] * x0[2] + x0[3] * x0[3]) + (x1[0] * x1[0] + x1[1] * x1[1]) + (x1[2] * x1[2] + x1[3] * x1[3]);
                    if (do_xg) {
                        const f32x4 y0 = x0 * nv[bj][0], y1 = x1 * nv[bj][1];
                        u32x4 w; w.x = pk2e(y0[0], y0[1]); w.y = pk2e(y0[2], y0[3]); w.z = pk2e(y1[0], y1[1]); w.w = pk2e(y1[2], y1[3]);
                        *(u32x4*)(XGo + (size_t)row * 1024 + col0 + bj * HALF) = w;
                    }
                }
                if (do_ss) { ss += __shfl_xor(ss, 16); ss += __shfl_xor(ss, 32); if (fq == 0) atomicAdd(rowss + row, ss); }
            }
    }
};

struct EpiUp {
    static constexpr bool PERM = true, AFTER_DRAIN = false;
    const float* rowss; const float* sW;
    bf16_t* U; int ldu;
    __device__ __forceinline__ void operator()(const f32x4 (&acc)[2][2][4][2], const Unit& u, int wr, int wc, int fr, int fq) const {
        const int s = u.pm < 64 ? (u.pm >> 3) : 8;
        const int row0 = u.pm * BM + wr * 64 + fr, col0 = u.pn * BM + wc * 32 + 8 * fq;
        const float* swp = sW + (size_t)s * 5632 + col0;
        f32x4 bv[2][2];
#pragma unroll
        for (int bj = 0; bj < 2; ++bj)
#pragma unroll
            for (int n = 0; n < 2; ++n) bv[bj][n] = *(const f32x4*)(swp + bj * HALF + 4 * n);
#pragma unroll
        for (int ai = 0; ai < 2; ++ai)
#pragma unroll
            for (int m = 0; m < 4; ++m) {
                const int row = row0 + ai * HALF + m * 16;
                const float rstd = rsqrtf(rowss[row] * (1.0f / 1024.0f) + 1e-6f);
                bf16_t* rowp = U + (size_t)row * ldu + col0;
#pragma unroll
                for (int bj = 0; bj < 2; ++bj) {
                    const f32x4 v0 = acc[ai][bj][m][0] * rstd + bv[bj][0], v1 = acc[ai][bj][m][1] * rstd + bv[bj][1];
                    u32x4 w; w.x = pk2e(v0[0], v0[1]); w.y = pk2e(v0[2], v0[3]); w.z = pk2e(v1[0], v1[1]); w.w = pk2e(v1[2], v1[3]);
                    *(u32x4*)(rowp + bj * HALF) = w;
                }
            }
    }
};
template <class Epi, class Sched, bool ALIGN_EPI = false, bool SP2 = false>
__device__ __forceinline__ void gemm_phase(PG8_LAS unsigned char* lds, const Gemm g, const Sched& S, const Epi& E) {
    int tid_o = threadIdx.x; asm volatile("" : "+v"(tid_o));
    const int tid = tid_o, wid = __builtin_amdgcn_readfirstlane(tid >> 6), lane = tid & 63, wr = wid >> 2, wc = wid & 3, fr = lane & 15, fq = lane >> 4;
    const int K = g.K, nt = K / BK;
    unsigned voffA[2], voffB[2];
#pragma unroll
    for (int i = 0; i < 2; ++i) { int R, C; stage_rc(tid * 16 + i * 8192, R, C); const int Rb = Epi::PERM ? ((R & ~31) + perm32(R & 31)) : R;
        voffA[i] = (unsigned)(R * K + C) * 2u; voffB[i] = (unsigned)(Rb * K + C) * 2u; }
    const size_t kstep = (size_t)(BK * 2);
    const size_t hstep = (size_t)HALF * K * 2;
    const size_t tstep = 2 * hstep;
    const unsigned ldsw = (unsigned)wid * 1024u;
    const int aoff = lds_byte(wr * 64 + fr, fq * 8), boff = lds_byte(wc * 32 + fr, fq * 8);
#define PG8_SA(b, h) (((b) * 2 + (h)) * HTB)
#define PG8_SB(b, h) ((4 + (b) * 2 + (h)) * HTB)
#define PG8_STAGE(bufoff, gbase, voff) do { _Pragma("unroll") for (int _i = 0; _i < 2; ++_i) \
        __builtin_amdgcn_global_load_lds((const unsigned*)((const char*)(gbase) + (voff)[_i]), (PG8_LAS unsigned*)(lds + (bufoff) + ldsw + _i * 8192), 16, 0, 0); } while (0)
#define PG8_LDA(dst, b, h) do { _Pragma("unroll") for (int m = 0; m < 4; ++m) _Pragma("unroll") for (int k = 0; k < 2; ++k) dst[m][k] = *(const PG8_LAS bf16x8*)(lds + PG8_SA(b, h) + aoff + m * 2048 + k * 1024); } while (0)
#define PG8_LDB(dst, b, h) do { _Pragma("unroll") for (int n = 0; n < 2; ++n) _Pragma("unroll") for (int k = 0; k < 2; ++k) dst[n][k] = *(const PG8_LAS bf16x8*)(lds + PG8_SB(b, h) + boff + n * 2048 + k * 1024); } while (0)
#define PG8_MMA(ai, bj, At, Bt) do { __builtin_amdgcn_s_setprio(1); _Pragma("unroll") for (int m = 0; m < 4; ++m) _Pragma("unroll") for (int n = 0; n < 2; ++n) _Pragma("unroll") for (int k = 0; k < 2; ++k) \
        acc[ai][bj][m][n] = __builtin_amdgcn_mfma_f32_16x16x32_bf16(Bt[n][k], At[m][k], acc[ai][bj][m][n], 0, 0, 0); __builtin_amdgcn_s_setprio(0); } while (0)
#define PG8_WAIT_V(n) asm volatile("s_waitcnt vmcnt(" #n ")" ::: "memory")
#define PG8_WAIT_L(n) asm volatile("s_waitcnt lgkmcnt(" #n ")" ::: "memory")
#define PG8_BAR __builtin_amdgcn_s_barrier()
#define PG8_SCHED __builtin_amdgcn_sched_barrier(0)
    Unit cur, nxt; int ui = 0;
    if (!S.next(0, cur)) return;
    f32x4 acc[2][2][4][2];
#pragma unroll
    for (int a = 0; a < 2; ++a)
#pragma unroll
        for (int b = 0; b < 2; ++b)
#pragma unroll
            for (int m = 0; m < 4; ++m)
#pragma unroll
                for (int n = 0; n < 2; ++n) acc[a][b][m][n] = (f32x4){0.f, 0.f, 0.f, 0.f};
    bf16x8 At[4][2], B0[2][2], B1[2][2];
    const char* cA = (const char*)g.A + (size_t)cur.pm * tstep; const char* cB = (const char*)g.Bt + (size_t)cur.pn * tstep;
    S.a_ready(cur);
    if constexpr (SP2) {
        PG8_STAGE(PG8_SB(0, 0), cB, voffB); PG8_STAGE(PG8_SB(0, 1), cB + hstep, voffB); PG8_STAGE(PG8_SA(0, 0), cA, voffA); PG8_STAGE(PG8_SA(0, 1), cA + hstep, voffA);
        if (wr == 1) PG8_BAR;
        PG8_WAIT_V(2); PG8_BAR;
        PG8_STAGE(PG8_SB(1, 0), cB + kstep, voffB); PG8_STAGE(PG8_SA(1, 0), cA + kstep, voffA); PG8_STAGE(PG8_SB(1, 1), cB + hstep + kstep, voffB);
        PG8_WAIT_V(6); PG8_BAR;
    } else {
        PG8_STAGE(PG8_SB(0, 0), cB, voffB); PG8_STAGE(PG8_SA(0, 0), cA, voffA); PG8_STAGE(PG8_SB(0, 1), cB + hstep, voffB); PG8_STAGE(PG8_SA(0, 1), cA + hstep, voffA);
        if (wr == 1) PG8_BAR;
        PG8_WAIT_V(4); PG8_BAR;
        PG8_STAGE(PG8_SB(1, 0), cB + kstep, voffB); PG8_STAGE(PG8_SA(1, 0), cA + kstep, voffA); PG8_STAGE(PG8_SB(1, 1), cB + hstep + kstep, voffB);
        PG8_WAIT_V(6); PG8_BAR;
    }
    for (;;) {
        const bool has_next = S.next(ui + 1, nxt);
        const char* nA = has_next ? (const char*)g.A + (size_t)nxt.pm * tstep : cA; const char* nB = has_next ? (const char*)g.Bt + (size_t)nxt.pn * tstep : cB;
        for (int t = 0; t < nt; t += 2) {
            const bool last = (t == nt - 2);
            const char* a1 = cA + (size_t)(t + 1) * kstep;
            const char* a2 = last ? nA : cA + (size_t)(t + 2) * kstep; const char* b2 = last ? nB : cB + (size_t)(t + 2) * kstep;
            const char* a3 = a2 + kstep; const char* b3 = b2 + kstep;
            if (last && has_next) S.a_ready(nxt);
            if constexpr (SP2) {
            PG8_LDB(B0, 0, 0); PG8_LDB(B1, 0, 1); PG8_SCHED; PG8_LDA(At, 0, 0); PG8_STAGE(PG8_SA(1, 1), a1 + hstep, voffA);
            PG8_WAIT_V(8); PG8_WAIT_L(0); PG8_BAR; PG8_MMA(0, 0, At, B0); PG8_MMA(0, 1, At, B1); PG8_BAR; PG8_SCHED;
            PG8_LDA(At, 0, 1); PG8_STAGE(PG8_SB(0, 0), b2, voffB); PG8_STAGE(PG8_SB(0, 1), b2 + hstep, voffB); PG8_STAGE(PG8_SA(0, 0), a2, voffA);
            PG8_WAIT_V(8); PG8_WAIT_L(0); PG8_BAR; PG8_MMA(1, 0, At, B0); PG8_MMA(1, 1, At, B1); PG8_BAR; PG8_SCHED;
            PG8_LDB(B0, 1, 0); PG8_LDB(B1, 1, 1); PG8_SCHED; PG8_LDA(At, 1, 0); PG8_STAGE(PG8_SA(0, 1), a2 + hstep, voffA);
            PG8_WAIT_V(8); PG8_WAIT_L(0); PG8_BAR; PG8_MMA(0, 0, At, B0); PG8_MMA(0, 1, At, B1); PG8_BAR; PG8_SCHED;
            PG8_LDA(At, 1, 1); PG8_STAGE(PG8_SB(1, 0), b3, voffB); PG8_STAGE(PG8_SB(1, 1), b3 + hstep, voffB); PG8_STAGE(PG8_SA(1, 0), a3, voffA);
            PG8_WAIT_V(8); PG8_WAIT_L(0); PG8_BAR; PG8_MMA(1, 0, At, B0); PG8_MMA(1, 1, At, B1); PG8_BAR; PG8_SCHED;
            } else {
            PG8_LDB(B0, 0, 0); PG8_SCHED; PG8_LDA(At, 0, 0); PG8_STAGE(PG8_SA(1, 1), a1 + hstep, voffA);
            PG8_WAIT_L(8); PG8_BAR; PG8_WAIT_L(0); PG8_MMA(0, 0, At, B0); PG8_BAR; PG8_SCHED;
            PG8_LDB(B1, 0, 1); PG8_STAGE(PG8_SB(0, 0), b2, voffB);
            PG8_BAR; PG8_WAIT_L(0); PG8_MMA(0, 1, At, B1); PG8_BAR;
            PG8_LDA(At, 0, 1); PG8_STAGE(PG8_SA(0, 0), a2, voffA);
            PG8_BAR; PG8_WAIT_L(0); PG8_MMA(1, 0, At, B0); PG8_BAR; PG8_SCHED;
            PG8_STAGE(PG8_SB(0, 1), b2 + hstep, voffB);
            PG8_WAIT_V(6); PG8_BAR; PG8_MMA(1, 1, At, B1); PG8_BAR;
            PG8_LDB(B0, 1, 0); PG8_SCHED; PG8_LDA(At, 1, 0); PG8_STAGE(PG8_SA(0, 1), a2 + hstep, voffA);
            PG8_WAIT_L(8); PG8_BAR; PG8_WAIT_L(0); PG8_MMA(0, 0, At, B0); PG8_BAR; PG8_SCHED;
            PG8_LDB(B1, 1, 1); PG8_STAGE(PG8_SB(1, 0), b3, voffB);
            PG8_BAR; PG8_WAIT_L(0); PG8_MMA(0, 1, At, B1); PG8_BAR;
            PG8_LDA(At, 1, 1); PG8_STAGE(PG8_SA(1, 0), a3, voffA);
            PG8_BAR; PG8_WAIT_L(0); PG8_MMA(1, 0, At, B0); PG8_BAR; PG8_SCHED;
            PG8_STAGE(PG8_SB(1, 1), b3 + hstep, voffB);
            PG8_WAIT_V(6); PG8_BAR; PG8_MMA(1, 1, At, B1); PG8_BAR;
            }
        }
        if constexpr (ALIGN_EPI) { if (wr == 0) PG8_BAR; }
        if constexpr (!Epi::AFTER_DRAIN) { E(acc, cur, wr, wc, fr, fq); S.done(cur); }
        if (!has_next) break;
#pragma unroll
        for (int a = 0; a < 2; ++a)
#pragma unroll
            for (int b = 0; b < 2; ++b)
#pragma unroll
                for (int m = 0; m < 4; ++m)
#pragma unroll
                    for (int n = 0; n < 2; ++n) acc[a][b][m][n] = (f32x4){0.f, 0.f, 0.f, 0.f};
        cur = nxt; cA = nA; cB = nB; ++ui;
        if constexpr (ALIGN_EPI) { if (wr == 1) PG8_BAR; }
    }
    PG8_WAIT_V(0);
    if constexpr (!ALIGN_EPI) { if (wr == 0) PG8_BAR; }
    PG8_BAR;
    if constexpr (Epi::AFTER_DRAIN) { E.fused(acc, cur, wr, wc, fr, fq, lds, wid, lane); S.done(cur); }
#undef PG8_SA
#undef PG8_SB
#undef PG8_STAGE
#undef PG8_LDA
#undef PG8_LDB
#undef PG8_MMA
#undef PG8_WAIT_V
#undef PG8_WAIT_L
#undef PG8_BAR
#undef PG8_SCHED
}
}
#define XB_TMO      128
#define XB_XCNT(j)  (256  + 64 * (j))
#define XB_XSUB(j)  (1280 + 64 * (j))
#define XB_XGEN(j)  (2304 + 64 * (j))
#define XB_TOP      3328
#define XB_TOPGEN   3392
#define XCD_BAR_WORDS 3456
#define XB_SPIN_CAP (1u << 18)

__device__ __forceinline__ unsigned xb_ld(unsigned* p)              { return __hip_atomic_load(p, __ATOMIC_RELAXED, __HIP_MEMORY_SCOPE_AGENT); }
__device__ __forceinline__ unsigned xb_add(unsigned* p, unsigned v) { return __hip_atomic_fetch_add(p, v, __ATOMIC_RELAXED, __HIP_MEMORY_SCOPE_AGENT); }
__device__ __forceinline__ unsigned xb_xcc_id() { return (unsigned)__builtin_amdgcn_s_getreg((3 << 11) | 20) & 0xFu; }
#define XB_SPIN(cond, bar) do { unsigned _sp = 0; while (cond) { __builtin_amdgcn_s_sleep(1); \
    if ((++_sp & 255u) == 0u) { if (xb_ld(&(bar)[XB_TMO])) break; if (_sp > XB_SPIN_CAP) { atomicAdd(&(bar)[XB_TMO], 1u); break; } } } } while (0)

struct XcdBarrier {
    unsigned* bar; unsigned x;
    volatile LAS unsigned* st;
};

__device__ __forceinline__ XcdBarrier xcd_barrier_post(unsigned* bar, volatile LAS unsigned* st) {
    XcdBarrier b; b.bar = bar; b.x = xb_xcc_id(); b.st = st;
    if (threadIdx.x == 0) (void)xb_add(&bar[XB_XCNT(b.x)], 1u);
    return b;
}
__device__ __forceinline__ void xcd_barrier_complete(unsigned* bar, unsigned x, unsigned& nloc, unsigned& nx) {
    const unsigned G = gridDim.x * gridDim.y * gridDim.z;
    unsigned sum, cnt, mine, sp = 0u;
    for (;;) {
        sum = 0u; cnt = 0u; mine = 0u;
#pragma unroll
        for (unsigned j = 0; j < 16; ++j) { const unsigned c = xb_ld(&bar[XB_XCNT(j)]); sum += c; cnt += (c > 0u) ? 1u : 0u; mine = (j == x) ? c : mine; }
        if (sum == G) break;
        __builtin_amdgcn_s_sleep(1);
        if ((++sp & 255u) == 0u) { if (xb_ld(&bar[XB_TMO])) break; if (sp > XB_SPIN_CAP) { atomicAdd(&bar[XB_TMO], 1u); break; } }
    }
    nloc = mine > 0u ? mine : 1u; nx = cnt > 0u ? cnt : 1u;
}

__device__ __forceinline__ void xcd_barrier(const XcdBarrier& b) {
    asm volatile("s_waitcnt vmcnt(0)" ::: "memory");
    __syncthreads();
    if (threadIdx.x == 0) {
        unsigned* bar = b.bar;
        __builtin_amdgcn_s_waitcnt(0);
        unsigned nloc = b.st[0], nx = b.st[1];
        if (nloc == 0u) { xcd_barrier_complete(bar, b.x, nloc, nx); b.st[0] = nloc; b.st[1] = nx; }
        const unsigned old = xb_add(&bar[XB_XSUB(b.x)], 1u);
        const unsigned gen = old / nloc;
        if (old + 1u == (gen + 1u) * nloc) {
            __builtin_amdgcn_fence(__ATOMIC_RELEASE, "agent");
            asm volatile("s_waitcnt vmcnt(0)" ::: "memory");
            const unsigned og = xb_add(&bar[XB_TOP], 1u);
            const unsigned tg = og / nx;
            if (og + 1u == (tg + 1u) * nx) xb_add(&bar[XB_TOPGEN], 1u);
            else XB_SPIN(xb_ld(&bar[XB_TOPGEN]) == tg, bar);
            __builtin_amdgcn_fence(__ATOMIC_ACQUIRE, "agent");
            xb_add(&bar[XB_XGEN(b.x)], 1u);
            asm volatile("s_waitcnt vmcnt(0)" ::: "memory");
        } else {
            XB_SPIN(xb_ld(&bar[XB_XGEN(b.x)]) == gen, bar);
            __builtin_amdgcn_fence(__ATOMIC_ACQUIRE, "agent");
            asm volatile("s_waitcnt vmcnt(0)" ::: "memory");
        }
    }
    __syncthreads();
}
constexpr int NWAVES = 8;
constexpr int RING_BYTES = 131072, LDSCTL_OFF = 155648, LDS_BYTES = 163840;
struct Args {
    const float* in[22]; float* out; unsigned char* ws; int ph_lo, ph_hi; int use_bar, pad;
};
enum { I_X = 0, I_C, I_CTX, I_CCTX, I_WMOD, I_BMOD, I_NORM1, I_WIN, I_GCONV, I_ALOG, I_DTB, I_GNORM, I_WGK, I_BGK, I_LNORM, I_WOUT, I_NORM2, I_WUP, I_FCONV, I_FCB, I_WDOWN, I_FNORM };


__device__ __forceinline__ void tr_item(const float* src, int ldsrc, int k0, int c0, int ncols, bf16* dst, int lddst, int r0, int kd0, LAS float* scr, int lane) {
    const int cl = lane & 31;
#pragma unroll 8
    for (int i = 0; i < 32; ++i) { const int kk = 2 * i + (lane >> 5); scr[kk * 33 + cl] = cl < ncols ? src[(size_t)(k0 + kk) * ldsrc + c0 + cl] : 0.f; }
    LDS_WAIT(); asm volatile("" ::: "memory");
    const int c = lane & 7;
#pragma unroll
    for (int j = 0; j < 4; ++j) { const int n = (lane >> 3) + 8 * j; const LAS float* s = scr + (8 * c) * 33 + n;
        v4u o; o.x = pk2(s[0 * 33], s[1 * 33]); o.y = pk2(s[2 * 33], s[3 * 33]); o.z = pk2(s[4 * 33], s[5 * 33]); o.w = pk2(s[6 * 33], s[7 * 33]);
        if (n < ncols) *(GAS v4u*)(dst + (size_t)(r0 + n) * lddst + kd0 + 8 * c) = o; }
    LDS_WAIT(); asm volatile("" ::: "memory");
}

__device__ __forceinline__ void phase_p0a(const Args& a, LAS unsigned char* lds, int vcu, int G, int tid, int wave, int lane) {
    unsigned char* ws = a.ws;
    {
        LAS float* sc = (LAS float*)lds;
        LAS float* red = (LAS float*)(lds + 36864);
        bool have = false;
        for (int it = vcu; it < 192; it += G) {
            if (!have) {
                for (int i = tid; i < 9 * 1024; i += 512) { const int s = i >> 10, k = i & 1023; const float v = s < 8 ? a.in[I_C][s * 1024 + k] : a.in[I_CCTX][k]; sc[i] = silu_f(v); }
                __syncthreads(); have = true;
            }
            const int l = it / 96, n0 = (it % 96) * 64;
            const float* W = a.in[I_WMOD] + (size_t)l * 1024 * 6144;
            const int c4 = tid & 15, ks = tid >> 4;
            f32x4 acc[9];
#pragma unroll
            for (int s = 0; s < 9; ++s) acc[s] = (f32x4){0.f, 0.f, 0.f, 0.f};
            for (int j = 0; j < 32; ++j) {
                const int k = ks + 32 * j;
                const f32x4 w = *(const f32x4*)(W + (size_t)k * 6144 + n0 + 4 * c4);
#pragma unroll
                for (int s = 0; s < 9; ++s) acc[s] += w * sc[s * 1024 + k];
            }
#pragma unroll
            for (int s = 0; s < 9; ++s) *(LAS f32x4*)(red + (ks * 9 + s) * 64 + 4 * c4) = acc[s];
            __syncthreads();
            for (int o = tid; o < 576; o += 512) {
                const int s = o >> 6, c = o & 63; float v = 0.f;
                for (int q = 0; q < 32; ++q) v += red[(q * 9 + s) * 64 + c];
                ((float*)(ws + WS_MOD))[((size_t)l * 9 + s) * 6144 + n0 + c] = v + a.in[I_BMOD][l * 6144 + n0 + c];
            }
            __syncthreads();
        }
        __syncthreads();
    }
    {
        LAS float* scr = (LAS float*)(lds + wave * 16384);
        const int gw = vcu * NWAVES + wave, NGW = G * NWAVES;
        constexpr int I_IN = 16 * 112, I_SM = 16 * 2, I_O = 16 * 32, I_U = 16 * 176, I_D = 44 * 32, PER_L = I_IN + I_SM + I_O + I_U + I_D;
        for (int it = gw; it < 2 * PER_L; it += NGW) {
            const int l = it / PER_L; int r = it % PER_L;
            unsigned char* wl = ws + (l == 0 ? WS_W1 : WS_W2);
            if (r < I_IN) { const int kb = r / 112, nb = r % 112, n0 = nb * 32; const int c0 = n0 < 2048 ? n0 : n0 + 16;
                tr_item(a.in[I_WIN] + (size_t)l * 1024 * DINP, DINP, kb * 64, c0, 32, (bf16*)(wl + W_IN), 1024, n0, kb * 64, scr, lane); continue; } r -= I_IN;
            if (r < I_SM) { const int kb = r / 2, part = r % 2;
                tr_item(a.in[I_WIN] + (size_t)l * 1024 * DINP, DINP, kb * 64, part == 0 ? 2048 : 3600, part == 0 ? 16 : 32, (bf16*)(ws + WS_WSM) + (size_t)l * 48 * 1024, 1024, part == 0 ? 0 : 16, kb * 64, scr, lane); continue; } r -= I_SM;
            if (r < I_O) { const int kb = r / 32, nb = r % 32;
                tr_item(a.in[I_WOUT] + (size_t)l * 1024 * 1024, 1024, kb * 64, nb * 32, 32, (bf16*)(wl + W_OUT), 1024, nb * 32, kb * 64, scr, lane); continue; } r -= I_O;
            if (r < I_U) { const int kb = r / 176, nb = r % 176, r0 = nb * 32;
                const int c0 = r0 < 1280 ? r0 : (r0 < 2560 ? 2816 + (r0 - 1280) : (r0 < 4096 ? 1280 + (r0 - 2560) : 2816 + 1280 + (r0 - 4096)));
                tr_item(a.in[I_WUP] + (size_t)l * 1024 * 5632, 5632, kb * 64, c0, 32, (bf16*)(wl + W_UP), 1024, r0, kb * 64, scr, lane); continue; } r -= I_U;
            { const int kb = r / 32, nb = r % 32, k0 = kb * 64;
              if (k0 < FCB) tr_item(a.in[I_WDOWN] + (size_t)l * DFF * 1024, 1024, k0, nb * 32, 32, (bf16*)(wl + W_DB), FCB, nb * 32, k0, scr, lane);
              else          tr_item(a.in[I_WDOWN] + (size_t)l * DFF * 1024, 1024, k0, nb * 32, 32, (bf16*)(wl + W_DA), FCA, nb * 32, k0 - FCB, scr, lane); }
        }
    }
}

__device__ __forceinline__ void xg_rows(const float* xlat, const float* xctx, const float* gain, const float* scl  , bf16* XG, float* rowss, int gw, int NGW, int lane, int mrows) {
    f32x4 g[4];
#pragma unroll
    for (int j = 0; j < 4; ++j) g[j] = *(const f32x4*)(gain + 4 * lane + 256 * j);
#pragma unroll 1
    for (int m0 = gw; m0 < mrows; m0 += 4 * NGW) {
        f32x4 v[4][4];
#pragma unroll
        for (int u = 0; u < 4; ++u) { const int m = m0 + u * NGW; if (m < mrows) { const float* src = m < MLAT ? xlat + (size_t)m * 1024 : xctx + (size_t)(m - MLAT) * 1024;
#pragma unroll
            for (int j = 0; j < 4; ++j) v[u][j] = *(const f32x4*)(src + 4 * lane + 256 * j); } }
#pragma unroll
        for (int u = 0; u < 4; ++u) { const int m = m0 + u * NGW; if (m < mrows) {
            const int s = row_s(m); float ss = 0.f;
#pragma unroll
            for (int j = 0; j < 4; ++j) {
                const int c = 4 * lane + 256 * j; const f32x4 x = v[u][j], sc = *(const f32x4*)(scl + (size_t)s * 6144 + c);
                ss += (x[0] * x[0] + x[1] * x[1]) + (x[2] * x[2] + x[3] * x[3]);
                const f32x4 y = x * g[j] * (sc + 1.0f);
                v2u o; o.x = pk2(y[0], y[1]); o.y = pk2(y[2], y[3]);
                *(GAS v2u*)(XG + (size_t)m * 1024 + c) = o;
            }
            ss = wave_sum(ss);
            if (lane == 0) rowss[m] = ss; } }
    }
}

__device__ __forceinline__ void phase_p0b(const Args& a, LAS unsigned char* lds, int vcu, int G, int tid, int wave, int lane) {
    unsigned char* ws = a.ws;
    const int gw = vcu * NWAVES + wave, NGW = G * NWAVES;
    const float* MOD = (const float*)(ws + WS_MOD);
    constexpr LayerBufs B0 = layer_bufs(0);
    xg_rows(a.in[I_X], a.in[I_CTX], a.in[I_NORM1], MOD + 1 * 1024, (bf16*)bufp(ws, a.out, B0.XG), (float*)(ws + WS_RS1), gw, NGW, lane, MALL);
    LAS float* sh = (LAS float*)lds;
    for (int combo = 0; combo < 4; ++combo) {
        const int l = combo >> 1, which = combo & 1;
        __syncthreads();
        for (int i = tid; i < 9 * 1024; i += 512) sh[i] = MOD[((size_t)l * 9 + (i >> 10)) * 6144 + (which ? 3 : 0) * 1024 + (i & 1023)];
        __syncthreads();
        const int nrows = which ? 5632 : (NMAIN + NSMALL);
        float* SWl = (float*)(ws + WS_SW) + (size_t)l * SW_LAYER;
        unsigned char* wl = ws + (l == 0 ? WS_W1 : WS_W2);
        for (int n = gw; n < nrows; n += NGW) {
            const bf16* wrow; float* dst; int ldd;
            if (which) { wrow = (const bf16*)(wl + W_UP) + (size_t)n * 1024; dst = SWl + 9 * (NMAIN + NSMALL) + n; ldd = 5632; }
            else if (n < NMAIN) { wrow = (const bf16*)(wl + W_IN) + (size_t)n * 1024; dst = SWl + n; ldd = NMAIN; }
            else { wrow = (const bf16*)(ws + WS_WSM) + ((size_t)l * 48 + (n - NMAIN)) * 1024; dst = SWl + 9 * NMAIN + (n - NMAIN); ldd = NSMALL; }
            const v4u w0 = *(const GAS v4u*)(wrow + 8 * lane), w1 = *(const GAS v4u*)(wrow + 512 + 8 * lane);
            float wf[16] = { bflo(w0.x), bfhi(w0.x), bflo(w0.y), bfhi(w0.y), bflo(w0.z), bfhi(w0.z), bflo(w0.w), bfhi(w0.w),
                             bflo(w1.x), bfhi(w1.x), bflo(w1.y), bfhi(w1.y), bflo(w1.z), bfhi(w1.z), bflo(w1.w), bfhi(w1.w) };
#pragma unroll
            for (int s = 0; s < 9; ++s) {
                float acc = 0.f;
#pragma unroll
                for (int j = 0; j < 8; ++j) acc += wf[j] * sh[s * 1024 + 8 * lane + j] + wf[8 + j] * sh[s * 1024 + 512 + 8 * lane + j];
                acc = wave_sum(acc);
                if (lane == 0) dst[(size_t)s * ldd] = acc;
            }
        }
    }
    __syncthreads();
}

__device__ __forceinline__ void skinny_rows(const bf16* XG, const bf16* Wsm  , const float* rowss, const float* sWsm  , float* SM, int gw, int NGW, int lane) {
    const int r = lane & 15, g = lane >> 4;
    for (int t = gw; t < MALL / 16; t += NGW) {
        const int m0 = t * 16;
        f32x4 acc[3];
#pragma unroll
        for (int n = 0; n < 3; ++n) acc[n] = (f32x4){0.f, 0.f, 0.f, 0.f};
        const bf16* ap = XG + (size_t)(m0 + r) * 1024 + 8 * g;
        const bf16* bp = Wsm + (size_t)r * 1024 + 8 * g;
#pragma unroll 4
        for (int ks = 0; ks < 32; ++ks) {
            const bf16x8 af = *(const GAS bf16x8*)(ap + 32 * ks);
#pragma unroll
            for (int n = 0; n < 3; ++n) { const bf16x8 bf = *(const GAS bf16x8*)(bp + (size_t)n * 16 * 1024 + 32 * ks); acc[n] = __builtin_amdgcn_mfma_f32_16x16x32_bf16(af, bf, acc[n], 0, 0, 0); }
        }
#pragma unroll
        for (int j = 0; j < 4; ++j) {
            const int m = m0 + 4 * g + j; const int s = row_s(m);
            const float rstd = rsqrtf(rowss[m] * (1.0f / 1024.0f) + NEPS);
#pragma unroll
            for (int n = 0; n < 3; ++n) SM[(size_t)m * 48 + 16 * n + r] = acc[n][j] * rstd + sWsm[s * 48 + 16 * n + r];
        }
    }
}
#define MFMA32(a, b, c) __builtin_amdgcn_mfma_f32_32x32x16_bf16((a), (b), (c), 0, 0, 0)
__device__ __forceinline__ int crow(int reg, int h) { return (reg & 3) + 8 * (reg >> 2) + 4 * h; }
__device__ __forceinline__ bf16x8 pack_step(const f32x16& x, int s) {
    v4u p; p.x = pk2(x[8 * s], x[8 * s + 1]); p.y = pk2(x[8 * s + 2], x[8 * s + 3]); p.z = pk2(x[8 * s + 4], x[8 * s + 5]); p.w = pk2(x[8 * s + 6], x[8 * s + 7]);
    return __builtin_bit_cast(bf16x8, p);
}
__device__ __forceinline__ bf16x8 frag_perm(const LAS unsigned char* img, int stride, int row, int col16, int h) {
    const LAS unsigned char* p = img + row * stride + (col16 + 4 * h) * 2;
    const s16x4 lo = *(const LAS s16x4*)p, hi = *(const LAS s16x4*)(p + 16);
    return __builtin_shufflevector(lo, hi, 0, 1, 2, 3, 4, 5, 6, 7);
}
__device__ __forceinline__ bf16x8 frag_nat(const LAS unsigned char* img, int stride, int row, int col16, int h) {
    const LAS unsigned char* p = img + row * stride + (col16 + 8 * h) * 2;
    const s16x4 lo = *(const LAS s16x4*)p, hi = *(const LAS s16x4*)(p + 8);
    return __builtin_shufflevector(lo, hi, 0, 1, 2, 3, 4, 5, 6, 7);
}
__device__ __forceinline__ void unpack8(const v4u w, float* f) {
    f[0] = bflo(w.x); f[1] = bfhi(w.x); f[2] = bflo(w.y); f[3] = bfhi(w.y); f[4] = bflo(w.z); f[5] = bfhi(w.z); f[6] = bflo(w.w); f[7] = bfhi(w.w);
}
__device__ __forceinline__ int chunk_first(int cid) { return cid < 256 ? ((cid & 31) == 0) : ((cid & 3) == 0); }
__device__ __forceinline__ int chunk_last(int cid) { return cid < 256 ? ((cid & 31) == 31) : ((cid & 3) == 3); }

constexpr int GP_Q = 0, GP_K = 16896, GP_RAW = 33792, GP_KK = 33792, GP_QK = 50432, GP_LP = 67584, GP_LPSZ = 8448, GP_GATE = 135168, GP_GSZ = 1536, GP_ST = 264;
__host__ __device__ constexpr int tri_off(int i) { return i == 0 ? 0 : (8 * ((i + 3) / 4) * (((i + 3) / 4) - 1) + 4 * ((i + 3) / 4) * ((i - 1) & 3)); }
__device__ __forceinline__ void gdn_prep_front(const Args& a, LAS unsigned char* lds, int l, int cid, int h, int slot, int tid_in) {
    int tid = tid_in; asm volatile("" : "+v"(tid));
    const int lane = tid & 63, wave = __builtin_amdgcn_readfirstlane(tid >> 6);
    unsigned char* ws = a.ws; const LayerBufs B = layer_bufs(l);
    bf16* GQ = (bf16*)bufp(ws, a.out, B.GQ); bf16* GK = (bf16*)bufp(ws, a.out, B.GK); bf16* GV = (bf16*)bufp(ws, a.out, B.GV);
    const bf16* HALO = (const bf16*)(ws + WS_HALO);
    const int m0 = cid * 64;
    const int first = chunk_first(cid), last = chunk_last(cid);
    LAS unsigned char* raw_s = lds + GP_RAW;
    LAS float* gt = (LAS float*)(lds + GP_GATE + slot * GP_GSZ);
    const int grp = tid >> 4, cg = tid & 15;
    {
        v4u rr[5];
#pragma unroll
        for (int j = 0; j < 5; ++j) {
            const int p = tid + 512 * j; rr[j] = (v4u){0u, 0u, 0u, 0u};
            if (p < 2 * 66 * 16) {
                const int t = p / (66 * 16), rem = p % (66 * 16), r = rem >> 4, c = rem & 15;
                const bf16* base = t == 0 ? GQ : GK;
                if (r == 0) { if (!first) rr[j] = *(const GAS v4u*)(HALO + ((size_t)(cid - 1) * 2 + 1) * 1536 + t * 512 + h * 128 + 8 * c); }
                else if (r == 65) { if (!last) rr[j] = *(const GAS v4u*)(HALO + ((size_t)(cid + 1) * 2 + 0) * 1536 + t * 512 + h * 128 + 8 * c); }
                else rr[j] = *(const GAS v4u*)(base + (size_t)(m0 + r - 1) * 512 + h * 128 + 8 * c);
            }
        }
#pragma unroll
        for (int j = 0; j < 5; ++j) { const int p = tid + 512 * j; if (p < 2 * 66 * 16) *(LAS v4u*)(raw_s + p * 16) = rr[j]; }
    }
    v4u vraw[2][3];
#pragma unroll
    for (int j = 0; j < 2; ++j) {
        const int r = grp + 32 * j;
#pragma unroll
        for (int d = 0; d < 3; ++d) {
            const int rr2 = r - 1 + d; vraw[j][d] = (v4u){0u, 0u, 0u, 0u};
            if (rr2 < 0) { if (!first) vraw[j][d] = *(const GAS v4u*)(HALO + ((size_t)(cid - 1) * 2 + 1) * 1536 + 1024 + h * 128 + 8 * cg); }
            else if (rr2 > 63) { if (!last) vraw[j][d] = *(const GAS v4u*)(HALO + ((size_t)(cid + 1) * 2 + 0) * 1536 + 1024 + h * 128 + 8 * cg); }
            else vraw[j][d] = *(const GAS v4u*)(GV + (size_t)(m0 + rr2) * 512 + h * 128 + 8 * cg);
        }
    }
    float gval = 0.f, bval = 0.f;
    if (tid < 128) {
        const int dir = tid >> 6, i = tid & 63;
        const float* sm = (const float*)(ws + WS_SM) + (size_t)(m0 + i) * 48;
        const float av = sm[dir * 4 + h], bv = sm[8 + dir * 4 + h];
        gval = -__expf(a.in[I_ALOG][l * 8 + dir * 4 + h]) * softplus_f(av + a.in[I_DTB][l * 8 + dir * 4 + h]);
        bval = sigmoid_f(bv);
        float c = gval;
        if (dir == 0) {
#pragma unroll
            for (int o = 1; o < 64; o <<= 1) { const float u = __shfl_up(c, o); if (i >= o) c += u; }
        } else {
#pragma unroll
            for (int o = 1; o < 64; o <<= 1) { const float u = __shfl_down(c, o); if (i + o < 64) c += u; }
        }
        gt[dir * 64 + i] = gval; gt[128 + dir * 64 + i] = bval; gt[256 + dir * 64 + i] = c;
    }
    __syncthreads();
    {
        const float* cw = a.in[I_GCONV] + (size_t)l * 3 * 1536;
#pragma unroll 1
        for (int t = 0; t < 3; ++t)
#pragma unroll
        for (int jj = 0; jj < 2; ++jj) {
            const int r = grp + 32 * jj;
            float x0[8], x1[8], x2[8], y[8];
            if (t < 2) {
                unpack8(*(const LAS v4u*)(raw_s + ((t * 66 + r) * 128 + 8 * cg) * 2), x0);
                unpack8(*(const LAS v4u*)(raw_s + ((t * 66 + r + 1) * 128 + 8 * cg) * 2), x1);
                unpack8(*(const LAS v4u*)(raw_s + ((t * 66 + r + 2) * 128 + 8 * cg) * 2), x2);
            } else { unpack8(vraw[jj][0], x0); unpack8(vraw[jj][1], x1); unpack8(vraw[jj][2], x2); }
            const float* w0 = cw + t * 512 + h * 128 + 8 * cg;
            float ss = 0.f;
#pragma unroll
            for (int e = 0; e < 8; ++e) { const float c = x0[e] * w0[e] + x1[e] * w0[1536 + e] + x2[e] * w0[3072 + e]; y[e] = silu_f(c); ss += y[e] * y[e]; }
            ss += __shfl_xor(ss, 1); ss += __shfl_xor(ss, 2); ss += __shfl_xor(ss, 4); ss += __shfl_xor(ss, 8);
            float sc = 1.f;
            if (t == 0) sc = rsqrtf(ss + 1e-6f) * 0.08838834764831845f; else if (t == 1) sc = rsqrtf(ss + 1e-6f);
            v4u o; o.x = pk2(y[0] * sc, y[1] * sc); o.y = pk2(y[2] * sc, y[3] * sc); o.z = pk2(y[4] * sc, y[5] * sc); o.w = pk2(y[6] * sc, y[7] * sc);
            bf16* base = t == 0 ? GQ : (t == 1 ? GK : GV);
            *(GAS v4u*)(base + (size_t)(m0 + r) * 512 + h * 128 + 8 * cg) = o;
            if (t < 2) { LAS unsigned char* d = lds + (t == 0 ? GP_Q : GP_K) + r * GP_ST + 16 * cg; *(LAS v2u*)d = (v2u){o.x, o.y}; *(LAS v2u*)(d + 8) = (v2u){o.z, o.w}; }
        }
    }
    __syncthreads();
    {
        const int which = wave >> 2, ti = (wave >> 1) & 1, tj = wave & 1, r = lane & 31, hh = lane >> 5;
        f32x16 acc; for (int i = 0; i < 16; ++i) acc[i] = 0.f;
        const LAS unsigned char* Ai = lds + (which ? GP_Q : GP_K); const LAS unsigned char* Bi = lds + GP_K;
#pragma unroll
        for (int s2 = 0; s2 < 8; ++s2) acc = MFMA32(frag_nat(Ai, GP_ST, 32 * ti + r, 16 * s2, hh), frag_nat(Bi, GP_ST, 32 * tj + r, 16 * s2, hh), acc);
        LAS float* dst = (LAS float*)(lds + (which ? GP_QK : GP_KK));
#pragma unroll
        for (int i = 0; i < 16; ++i) dst[(32 * ti + crow(i, hh)) * 65 + 32 * tj + r] = acc[i];
    }
    __syncthreads();
    {
        const LAS float* KK = (const LAS float*)(lds + GP_KK); const LAS float* QK = (const LAS float*)(lds + GP_QK);
        bf16* GTA = (bf16*)bufp(ws, a.out, B.GTA);
#pragma unroll 4
        for (int it = 0; it < 16; ++it) {
            const int p = tid + 512 * it;
            const int dir = p >> 12, ip = (p >> 6) & 63, jp = p & 63;
            const int i = dir ? 63 - ip : ip, j = dir ? 63 - jp : jp;
            if (jp < ip) {
                const float lv = gt[128 + dir * 64 + i] * KK[i * 65 + j] * __expf(gt[256 + dir * 64 + i] - gt[256 + dir * 64 + j]);
                const int q = (ip + 3) >> 2, off = 8 * q * (q - 1) + 4 * q * ((ip - 1) & 3);
                ((LAS float*)(lds + GP_LP + (slot * 2 + dir) * GP_LPSZ))[off + jp] = lv;
            }
            const bool keep = dir ? (jp >= ip) : (jp <= ip);
            const float av = keep ? QK[ip * 65 + jp] * __expf(gt[256 + dir * 64 + ip] - gt[256 + dir * 64 + jp]) : 0.f;
            GTA[(((size_t)dir * NCHUNK + cid) * 4 + h) * 8192 + ip * 128 + 64 + jp] = (bf16)(pk2(av, 0.f) & 0xffffu);
        }
        if (tid < 128) {
            const int dir = tid >> 6, i = tid & 63;
            float* E = (float*)(ws + WS_GDEC);
            const float gc = gt[256 + dir * 64 + i], gl = gt[256 + dir * 64 + (dir ? 0 : 63)];
            E[(((size_t)dir * NCHUNK + cid) * 4 + h) * 64 + i] = __expf(gc);
            E[(size_t)2 * NCHUNK * 4 * 64 + (((size_t)dir * NCHUNK + cid) * 4 + h) * 64 + i] = __expf(gl - gc);
            if (i == 0) E[(size_t)4 * NCHUNK * 4 * 64 + ((size_t)dir * NCHUNK + cid) * 4 + h] = __expf(gl);
        }
    }
    __syncthreads();
}
__device__ __forceinline__ void gdn_prep_invert(const Args& a, LAS unsigned char* lds, int l, int cid, int h, int slot, int dir, int lane_in) {
    int lane = lane_in; asm volatile("" : "+v"(lane));
    const LAS float* Lp = (const LAS float*)(lds + GP_LP + (slot * 2 + dir) * GP_LPSZ);
    const LAS float* gt = (const LAS float*)(lds + GP_GATE + slot * GP_GSZ);
    const int jo = dir ? 63 - lane : lane;
    const float bj = gt[128 + dir * 64 + jo];
    const LayerBufs B = layer_bufs(l);
    bf16* gp = (bf16*)bufp(a.ws, a.out, B.GTA) + (((size_t)dir * NCHUNK + cid) * 4 + h) * 8192 + jo + (dir ? 63 * 128 : 0);
    const int rstep = dir ? -128 : 128;
    float t[64];
    f32x4 bA[16];
#pragma unroll
    for (int i = 0; i < 64; ++i) {
#pragma unroll
        for (int q = 0; q < (i + 3) / 4; ++q) bA[q] = *(const LAS f32x4*)(Lp + tri_off(i) + 4 * q);
        float a0 = (lane == i) ? 1.f : 0.f, a1 = 0.f, a2 = 0.f, a3 = 0.f;
#pragma unroll
        for (int q = 0; q < (i + 3) / 4; ++q) {
            a0 -= bA[q][0] * t[4 * q];
            if (4 * q + 1 < i) a1 -= bA[q][1] * t[4 * q + 1];
            if (4 * q + 2 < i) a2 -= bA[q][2] * t[4 * q + 2];
            if (4 * q + 3 < i) a3 -= bA[q][3] * t[4 * q + 3];
        }
        t[i] = (a0 + a1) + (a2 + a3);
        *gp = (bf16)(pk2(t[i] * bj, 0.f) & 0xffffu); gp += rstep;
        asm volatile("" ::: "memory");
    }
}

constexpr int LP_GK = 0, LP_QG = 33280, LP_KI = 51712, LP_LR = 70144, LP_W = 78336, LP_B = 86528, LP_GL = 87040, LP_QR = 87552, LP_KR = 95744, LP_ST = 144;
__device__ __forceinline__ void gla_prep_unit(const Args& a, LAS unsigned char* lds, int l, int cid, int h, int tid_in) {
    int tid = tid_in; asm volatile("" : "+v"(tid));
    const int lane = tid & 63, wave = __builtin_amdgcn_readfirstlane(tid >> 6);
    unsigned char* ws = a.ws; const LayerBufs B = layer_bufs(l);
    const int m0 = cid * 64;
    LAS float* gk = (LAS float*)(lds + LP_GK); LAS float* lr = (LAS float*)(lds + LP_LR); LAS float* Wv = (LAS float*)(lds + LP_W); LAS float* bs = (LAS float*)(lds + LP_B); LAS float* gl = (LAS float*)(lds + LP_GL);
    {
        float lrv[4], wv[4]; v4u qk;
#pragma unroll
        for (int j = 0; j < 4; ++j) { const int p = tid + 512 * j; lrv[j] = ((const float*)(ws + WS_SM))[(size_t)(m0 + (p >> 5)) * 48 + 16 + (p & 31)]; }
#pragma unroll
        for (int j = 0; j < 4; ++j) { const int p = tid + 512 * j; const int dir = p >> 10, rk = (p >> 6) & 15, c = p & 63; wv[j] = a.in[I_WGK][(((size_t)l * 2 + dir) * 16 + rk) * 256 + h * 64 + c]; }
        { const int t = tid >> 8, p = tid & 255, i = p >> 2, c8 = p & 3;
          (void)c8; (void)i; (void)t; }
        const bf16* LQ = (const bf16*)bufp(ws, a.out, B.LQ); const bf16* LK = (const bf16*)bufp(ws, a.out, B.LK);
        const int i = tid >> 3, c8 = tid & 7;
        const v4u qv = *(const GAS v4u*)(LQ + (size_t)(m0 + i) * 256 + h * 64 + 8 * c8), kv = *(const GAS v4u*)(LK + (size_t)(m0 + i) * 256 + h * 64 + 8 * c8);
        float bsv = 0.f; if (tid < 128) bsv = a.in[I_BGK][((size_t)l * 2 + (tid >> 6)) * 256 + h * 64 + (tid & 63)];
#pragma unroll
        for (int j = 0; j < 4; ++j) { lr[tid + 512 * j] = lrv[j]; Wv[tid + 512 * j] = wv[j]; }
        *(LAS v4u*)(lds + LP_QR + i * 128 + 16 * c8) = qv; *(LAS v4u*)(lds + LP_KR + i * 128 + 16 * c8) = kv;
        if (tid < 128) bs[tid] = bsv;
        (void)qk;
    }
    __syncthreads();
#pragma unroll 4
    for (int it = 0; it < 16; ++it) {
        const int p = tid + 512 * it;
        const int dir = p >> 12, i = (p >> 6) & 63, c = p & 63;
        float acc = bs[dir * 64 + c];
#pragma unroll
        for (int rk = 0; rk < 16; ++rk) acc += lr[i * 32 + dir * 16 + rk] * Wv[(dir * 16 + rk) * 64 + c];
        gk[(dir * 64 + i) * 65 + c] = -softplus_f(-acc) * (1.0f / 16.0f);
    }
    __syncthreads();
    if (tid < 128) {
        const int dir = tid >> 6, c = tid & 63;
        float v[64];
#pragma unroll
        for (int i = 0; i < 64; ++i) v[i] = gk[(dir * 64 + i) * 65 + c];
        float s = 0.f;
        if (dir == 0) {
#pragma unroll
            for (int i = 0; i < 64; ++i) { s += v[i]; v[i] = s; }
        } else {
#pragma unroll
            for (int i = 63; i >= 0; --i) { s += v[i]; v[i] = s; }
        }
#pragma unroll
        for (int i = 0; i < 64; ++i) gk[(dir * 64 + i) * 65 + c] = v[i];
        gl[dir * 64 + c] = s;
        ((float*)(ws + WS_LDEC))[(((size_t)dir * NCHUNK + cid) * 4 + h) * 64 + c] = __expf(s);
    }
    __syncthreads();
    {
#pragma unroll
        for (int it = 0; it < 2; ++it) {
            const int p = tid + 512 * it, dir = p >> 9, i = (p >> 3) & 63, c8 = p & 7;
            float q[8], k[8];
            unpack8(*(const LAS v4u*)(lds + LP_QR + i * 128 + 16 * c8), q); unpack8(*(const LAS v4u*)(lds + LP_KR + i * 128 + 16 * c8), k);
            float qg[8], ki[8];
#pragma unroll
            for (int e = 0; e < 8; ++e) { const float gc = gk[(dir * 64 + i) * 65 + 8 * c8 + e]; qg[e] = q[e] * 0.125f * __expf(gc); ki[e] = k[e] * __expf(-gc); }
            v4u oq, ok; oq.x = pk2(qg[0], qg[1]); oq.y = pk2(qg[2], qg[3]); oq.z = pk2(qg[4], qg[5]); oq.w = pk2(qg[6], qg[7]);
            ok.x = pk2(ki[0], ki[1]); ok.y = pk2(ki[2], ki[3]); ok.z = pk2(ki[4], ki[5]); ok.w = pk2(ki[6], ki[7]);
            *(LAS v4u*)(lds + LP_QG + dir * 9216 + i * LP_ST + 16 * c8) = oq; *(LAS v4u*)(lds + LP_KI + dir * 9216 + i * LP_ST + 16 * c8) = ok;
            bf16* blk = (bf16*)bufp(ws, a.out, dir ? B.LOP1 : B.LOP0) + ((size_t)cid * 4 + h) * 12288;
            *(GAS v4u*)(blk + i * 64 + 8 * c8) = oq;
        }
#pragma unroll
        for (int it = 0; it < 2; ++it) {
            const int p = tid + 512 * it, dir = p >> 9, c = (p >> 3) & 63, ig = p & 7;
            const float glc = gl[dir * 64 + c];
            float kd[8];
#pragma unroll
            for (int e = 0; e < 8; ++e) { const int i = 8 * ig + e; kd[e] = bf2f(*(const LAS bf16*)(lds + LP_KR + i * 128 + 2 * c)) * __expf(glc - gk[(dir * 64 + i) * 65 + c]); }
            v4u o; o.x = pk2(kd[0], kd[1]); o.y = pk2(kd[2], kd[3]); o.z = pk2(kd[4], kd[5]); o.w = pk2(kd[6], kd[7]);
            bf16* blk = (bf16*)bufp(ws, a.out, dir ? B.LOP1 : B.LOP0) + ((size_t)cid * 4 + h) * 12288;
            *(GAS v4u*)(blk + 4096 + c * 64 + 8 * ig) = o;
        }
    }
    __syncthreads();
    {
        const int dir = wave >> 2, ti = (wave >> 1) & 1, tj = wave & 1, r = lane & 31, hh = lane >> 5;
        f32x16 acc; for (int i = 0; i < 16; ++i) acc[i] = 0.f;
        const LAS unsigned char* Ai = lds + LP_QG + dir * 9216; const LAS unsigned char* Bi = lds + LP_KI + dir * 9216;
#pragma unroll
        for (int s2 = 0; s2 < 4; ++s2) acc = MFMA32(frag_nat(Ai, LP_ST, 32 * ti + r, 16 * s2, hh), frag_nat(Bi, LP_ST, 32 * tj + r, 16 * s2, hh), acc);
        bf16* blk = (bf16*)bufp(ws, a.out, dir ? B.LOP1 : B.LOP0) + ((size_t)cid * 4 + h) * 12288 + 8192;
#pragma unroll
        for (int i = 0; i < 16; ++i) {
            const int io = 32 * ti + crow(i, hh), jo = 32 * tj + r;
            const bool keep = dir ? (jo >= io) : (jo <= io);
            blk[io * 64 + jo] = (bf16)(pk2(keep ? acc[i] : 0.f, 0.f) & 0xffffu);
        }
    }
    __syncthreads();
}

__device__ __forceinline__ void phase_prep(const Args& a, LAS unsigned char* lds, int l, int vcu, int G, int tid, int wave, int lane) {
    if (!(a.pad & 1))
    for (int j0 = 0; vcu + G * j0 < NCHUNK * 4; j0 += 4) {
        int nb = 0;
        for (int j = 0; j < 4; ++j) { const int it = vcu + G * (j0 + j); if (it < NCHUNK * 4) { gdn_prep_front(a, lds, l, it >> 2, it & 3, j, tid); nb = j + 1; } }
        const int slot = wave >> 1, dir = wave & 1;
        if (slot < nb && !(a.pad & 4)) { const int it = vcu + G * (j0 + slot); const int nrep = (a.pad & 8) ? 2 : 1;
#pragma unroll 1
            for (int rep = 0; rep < nrep; ++rep) gdn_prep_invert(a, lds, l, it >> 2, it & 3, slot, dir, lane); }
        __syncthreads();
    }
    if (!(a.pad & 2))
    for (int it = vcu; it < NCHUNK * 4; it += G) gla_prep_unit(a, lds, l, it >> 2, it & 3, tid);
}

__device__ __forceinline__ int chain_cid(int b, int dir, int step) {
    if (step < 4) return 256 + 4 * b + (dir ? 3 - step : step);
    const int n = step - 4; return 32 * b + (dir ? 31 - n : n);
}
constexpr int GS_K = 0, GS_Q = 16896, GS_KT = 33792, GS_VT = 51200, GS_TB = 68608, GS_AT = 77312, GS_E1 = 86016, GS_E2 = 86272, GS_E3 = 86528;
__device__ __forceinline__ void gdn_scan_chain(const Args& a, LAS unsigned char* lds, int l, int b, int h, int dir, int tid_in, int wave_in, int lane_in) {
    int tid = tid_in; asm volatile("" : "+v"(tid));
    const int lane = tid & 63, wave = __builtin_amdgcn_readfirstlane(tid >> 6);
    unsigned char* ws = a.ws; const LayerBufs B = layer_bufs(l);
    const bf16* GQ = (const bf16*)bufp(ws, a.out, B.GQ); const bf16* GK = (const bf16*)bufp(ws, a.out, B.GK); const bf16* GV = (const bf16*)bufp(ws, a.out, B.GV);
    bf16* GTA = (bf16*)bufp(ws, a.out, B.GTA);
    const float* E = (const float*)(ws + WS_GDEC);
    const bool loader = wave >= 4;
    const int lt = tid - 256, li = lt & 63, lc = lt >> 6;
    const int r = lane & 31, hh = lane >> 5, w = wave;
    v4u rq[4], rk[4], rv[4], rt[4]; float re1 = 0.f, re2 = 0.f, re3 = 0.f;
    auto issue_loads = [&](int cid) {
        const size_t m = (size_t)cid * 64 + li;
        const bf16* ta = GTA + (((size_t)dir * NCHUNK + cid) * 4 + h) * 8192 + li * 128;
#pragma unroll
        for (int q = 0; q < 4; ++q) {
            const int cg = lc + 4 * q;
            rq[q] = *(const GAS v4u*)(GQ + m * 512 + h * 128 + 8 * cg);
            rk[q] = *(const GAS v4u*)(GK + m * 512 + h * 128 + 8 * cg);
            rv[q] = *(const GAS v4u*)(GV + m * 512 + h * 128 + 8 * cg);
            rt[q] = *(const GAS v4u*)(ta + 8 * cg);
        }
        if (lc == 0) { const size_t eo = (((size_t)dir * NCHUNK + cid) * 4 + h) * 64 + li; re1 = E[eo]; re2 = E[(size_t)2 * NCHUNK * 4 * 64 + eo];
                       re3 = E[(size_t)4 * NCHUNK * 4 * 64 + ((size_t)dir * NCHUNK + cid) * 4 + h]; }
    };
    auto write_lds = [&]() {
#pragma unroll
        for (int q = 0; q < 4; ++q) {
            const int cg = lc + 4 * q;
            *(LAS v2u*)(lds + GS_Q + li * 264 + 16 * cg) = (v2u){rq[q].x, rq[q].y}; *(LAS v2u*)(lds + GS_Q + li * 264 + 16 * cg + 8) = (v2u){rq[q].z, rq[q].w};
            *(LAS v2u*)(lds + GS_K + li * 264 + 16 * cg) = (v2u){rk[q].x, rk[q].y}; *(LAS v2u*)(lds + GS_K + li * 264 + 16 * cg + 8) = (v2u){rk[q].z, rk[q].w};
            const unsigned kw[4] = {rk[q].x, rk[q].y, rk[q].z, rk[q].w}, vw[4] = {rv[q].x, rv[q].y, rv[q].z, rv[q].w};
#pragma unroll
            for (int e = 0; e < 4; ++e) {
                *(LAS bf16*)(lds + GS_KT + (8 * cg + 2 * e) * 136 + 2 * li) = (bf16)(kw[e] & 0xffffu); *(LAS bf16*)(lds + GS_KT + (8 * cg + 2 * e + 1) * 136 + 2 * li) = (bf16)(kw[e] >> 16);
                *(LAS bf16*)(lds + GS_VT + (8 * cg + 2 * e) * 136 + 2 * li) = (bf16)(vw[e] & 0xffffu); *(LAS bf16*)(lds + GS_VT + (8 * cg + 2 * e + 1) * 136 + 2 * li) = (bf16)(vw[e] >> 16);
            }
            LAS unsigned char* tdst = lds + (cg < 8 ? GS_TB + li * 136 + 16 * cg : GS_AT + li * 136 + 16 * (cg - 8));
            *(LAS v2u*)tdst = (v2u){rt[q].x, rt[q].y}; *(LAS v2u*)(tdst + 8) = (v2u){rt[q].z, rt[q].w};
        }
        if (lc == 0) { ((LAS float*)(lds + GS_E1))[li] = re1; ((LAS float*)(lds + GS_E2))[li] = re2; if (li == 0) ((LAS float*)(lds + GS_E3))[0] = re3; }
    };

    __syncthreads();
    if (loader) {
        issue_loads(chain_cid(b, dir, 0)); write_lds();
        __syncthreads();
#pragma unroll 1
        for (int step = 0; step < 36; ++step) {
            if (step + 1 < 36) issue_loads(chain_cid(b, dir, step + 1));
            __syncthreads();
            if (step + 1 < 36) write_lds();
            __syncthreads();
        }
    } else {
        f32x16 S[4];
#pragma unroll
        for (int mt = 0; mt < 4; ++mt) for (int i = 0; i < 16; ++i) S[mt][i] = 0.f;
        __syncthreads();
#pragma unroll 1
        for (int step = 0; step < 36; ++step) {
            const int cid = chain_cid(b, dir, step);
            const LAS float* e1s = (const LAS float*)(lds + GS_E1); const LAS float* e2s = (const LAS float*)(lds + GS_E2);
            const float e3 = ((const LAS float*)(lds + GS_E3))[0];
            f32x16 Z[2], Q[2];
#pragma unroll
            for (int it = 0; it < 2; ++it) for (int i = 0; i < 16; ++i) { Z[it][i] = 0.f; Q[it][i] = 0.f; }
#pragma unroll
            for (int mt = 0; mt < 4; ++mt)
#pragma unroll
                for (int s = 0; s < 2; ++s) {
                    const bf16x8 sb = pack_step(S[mt], s);
#pragma unroll
                    for (int it = 0; it < 2; ++it) {
                        Z[it] = MFMA32(frag_perm(lds + GS_K, 264, 32 * it + r, 32 * mt + 16 * s, hh), sb, Z[it]);
                        Q[it] = MFMA32(frag_perm(lds + GS_Q, 264, 32 * it + r, 32 * mt + 16 * s, hh), sb, Q[it]);
                    }
                }
#pragma unroll
            for (int it = 0; it < 2; ++it)
#pragma unroll
                for (int g = 0; g < 4; ++g) {
                    const f32x4 ev = *(const LAS f32x4*)(e1s + 32 * it + 8 * g + 4 * hh);
                    const v2u vv = *(const LAS v2u*)(lds + GS_VT + (32 * w + r) * 136 + 2 * (32 * it + 8 * g + 4 * hh));
                    Z[it][4 * g] = bflo(vv.x) - ev[0] * Z[it][4 * g]; Z[it][4 * g + 1] = bfhi(vv.x) - ev[1] * Z[it][4 * g + 1];
                    Z[it][4 * g + 2] = bflo(vv.y) - ev[2] * Z[it][4 * g + 2]; Z[it][4 * g + 3] = bfhi(vv.y) - ev[3] * Z[it][4 * g + 3];
                    Q[it][4 * g] *= ev[0]; Q[it][4 * g + 1] *= ev[1]; Q[it][4 * g + 2] *= ev[2]; Q[it][4 * g + 3] *= ev[3];
                }
            f32x16 Vn[2];
#pragma unroll
            for (int it = 0; it < 2; ++it) for (int i = 0; i < 16; ++i) Vn[it][i] = 0.f;
#pragma unroll
            for (int kt = 0; kt < 2; ++kt)
#pragma unroll
                for (int s = 0; s < 2; ++s) {
                    const bf16x8 rb = pack_step(Z[kt], s);
#pragma unroll
                    for (int it = 0; it < 2; ++it) Vn[it] = MFMA32(frag_perm(lds + GS_TB, 136, 32 * it + r, 32 * kt + 16 * s, hh), rb, Vn[it]);
                }
#pragma unroll
            for (int kt = 0; kt < 2; ++kt)
#pragma unroll
                for (int s = 0; s < 2; ++s) {
                    const bf16x8 vb = pack_step(Vn[kt], s);
#pragma unroll
                    for (int it = 0; it < 2; ++it) Q[it] = MFMA32(frag_perm(lds + GS_AT, 136, 32 * it + r, 32 * kt + 16 * s, hh), vb, Q[it]);
                }
            {
                bf16* ob = GTA + (((size_t)dir * NCHUNK + cid) * 4 + h) * 8192 + 32 * w + r;
#pragma unroll
                for (int it = 0; it < 2; ++it)
#pragma unroll
                    for (int i = 0; i < 16; ++i) ob[(32 * it + crow(i, hh)) * 128] = (bf16)(pk2(Q[it][i], 0.f) & 0xffffu);
            }
#pragma unroll
            for (int it = 0; it < 2; ++it)
#pragma unroll
                for (int g = 0; g < 4; ++g) {
                    const f32x4 ev = *(const LAS f32x4*)(e2s + 32 * it + 8 * g + 4 * hh);
                    Vn[it][4 * g] *= ev[0]; Vn[it][4 * g + 1] *= ev[1]; Vn[it][4 * g + 2] *= ev[2]; Vn[it][4 * g + 3] *= ev[3];
                }
#pragma unroll
            for (int mt = 0; mt < 4; ++mt) for (int i = 0; i < 16; ++i) S[mt][i] *= e3;
#pragma unroll
            for (int kt = 0; kt < 2; ++kt)
#pragma unroll
                for (int s = 0; s < 2; ++s) {
                    const bf16x8 vb = pack_step(Vn[kt], s);
#pragma unroll
                    for (int mt = 0; mt < 4; ++mt) S[mt] = MFMA32(frag_perm(lds + GS_KT, 136, 32 * mt + r, 32 * kt + 16 * s, hh), vb, S[mt]);
                }
            __syncthreads();
            __syncthreads();
        }
    }
}

constexpr int LS_QG = 0, LS_KD = 8704, LS_AT = 17408, LS_VT = 26112, LS_E3 = 43520;
__device__ __forceinline__ void gla_scan_chain(const Args& a, LAS unsigned char* lds, int l, int b, int h, int dir, int tid_in, int wave_in, int lane_in) {
    int tid = tid_in; asm volatile("" : "+v"(tid));
    const int lane = tid & 63, wave = __builtin_amdgcn_readfirstlane(tid >> 6);
    unsigned char* ws = a.ws; const LayerBufs B = layer_bufs(l);
    bf16* LOP = (bf16*)bufp(ws, a.out, dir ? B.LOP1 : B.LOP0);
    const bf16* LV = (const bf16*)bufp(ws, a.out, B.LV);
    const float* E = (const float*)(ws + WS_LDEC);
    const bool loader = wave >= 4;
    const int lt = tid - 256, li = lt & 63, lc = lt >> 6;
    const int r = lane & 31, hh = lane >> 5, w = wave;
    v4u ro[6], rv[4]; float re3 = 0.f;
    auto issue_loads = [&](int cid) {
        const bf16* blk = LOP + ((size_t)cid * 4 + h) * 12288;
#pragma unroll
        for (int q = 0; q < 6; ++q) { const int pc = lc + 4 * q, mat = pc >> 3, cg = pc & 7; ro[q] = *(const GAS v4u*)(blk + mat * 4096 + li * 64 + 8 * cg); }
#pragma unroll
        for (int q = 0; q < 4; ++q) { const int cg = lc + 4 * q; rv[q] = *(const GAS v4u*)(LV + ((size_t)cid * 64 + li) * 512 + h * 128 + 8 * cg); }
        if (lc == 0) re3 = E[(((size_t)dir * NCHUNK + cid) * 4 + h) * 64 + li];
    };
    auto write_lds = [&]() {
#pragma unroll
        for (int q = 0; q < 6; ++q) { const int pc = lc + 4 * q, mat = pc >> 3, cg = pc & 7;
            LAS unsigned char* d = lds + mat * 8704 + li * 136 + 16 * cg; *(LAS v2u*)d = (v2u){ro[q].x, ro[q].y}; *(LAS v2u*)(d + 8) = (v2u){ro[q].z, ro[q].w}; }
#pragma unroll
        for (int q = 0; q < 4; ++q) { const int cg = lc + 4 * q; const unsigned vw[4] = {rv[q].x, rv[q].y, rv[q].z, rv[q].w};
#pragma unroll
            for (int e = 0; e < 4; ++e) { *(LAS bf16*)(lds + LS_VT + (8 * cg + 2 * e) * 136 + 2 * li) = (bf16)(vw[e] & 0xffffu); *(LAS bf16*)(lds + LS_VT + (8 * cg + 2 * e + 1) * 136 + 2 * li) = (bf16)(vw[e] >> 16); } }
        if (lc == 0) ((LAS float*)(lds + LS_E3))[li] = re3;
    };
    __syncthreads();
    if (loader) {
        issue_loads(chain_cid(b, dir, 0)); write_lds();
        __syncthreads();
#pragma unroll 1
        for (int step = 0; step < 36; ++step) {
            if (step + 1 < 36) issue_loads(chain_cid(b, dir, step + 1));
            __syncthreads();
            if (step + 1 < 36) write_lds();
            __syncthreads();
        }
    } else {
        f32x16 S[2];
#pragma unroll
        for (int mt = 0; mt < 2; ++mt) for (int i = 0; i < 16; ++i) S[mt][i] = 0.f;
        __syncthreads();
#pragma unroll 1
        for (int step = 0; step < 36; ++step) {
            const int cid = chain_cid(b, dir, step);
            const LAS float* e3s = (const LAS float*)(lds + LS_E3);
            f32x16 O[2];
#pragma unroll
            for (int it = 0; it < 2; ++it) for (int i = 0; i < 16; ++i) O[it][i] = 0.f;
#pragma unroll
            for (int mt = 0; mt < 2; ++mt)
#pragma unroll
                for (int s = 0; s < 2; ++s) {
                    const bf16x8 sb = pack_step(S[mt], s);
#pragma unroll
                    for (int it = 0; it < 2; ++it) O[it] = MFMA32(frag_perm(lds + LS_QG, 136, 32 * it + r, 32 * mt + 16 * s, hh), sb, O[it]);
                }
#pragma unroll
            for (int mt = 0; mt < 2; ++mt)
#pragma unroll
                for (int g = 0; g < 4; ++g) {
                    const f32x4 ev = *(const LAS f32x4*)(e3s + 32 * mt + 8 * g + 4 * hh);
                    S[mt][4 * g] *= ev[0]; S[mt][4 * g + 1] *= ev[1]; S[mt][4 * g + 2] *= ev[2]; S[mt][4 * g + 3] *= ev[3];
                }
#pragma unroll
            for (int kt = 0; kt < 2; ++kt)
#pragma unroll
                for (int s = 0; s < 2; ++s) {
                    const bf16x8 vb = frag_nat(lds + LS_VT, 136, 32 * w + r, 32 * kt + 16 * s, hh);
#pragma unroll
                    for (int it = 0; it < 2; ++it) O[it] = MFMA32(frag_nat(lds + LS_AT, 136, 32 * it + r, 32 * kt + 16 * s, hh), vb, O[it]);
#pragma unroll
                    for (int mt = 0; mt < 2; ++mt) S[mt] = MFMA32(frag_nat(lds + LS_KD, 136, 32 * mt + r, 32 * kt + 16 * s, hh), vb, S[mt]);
                }
            bf16* ob = LOP + ((size_t)cid * 4 + h) * 12288 + 32 * w + r;
#pragma unroll
            for (int it = 0; it < 2; ++it)
#pragma unroll
                for (int i = 0; i < 16; ++i) ob[(32 * it + crow(i, hh)) * 128] = (bf16)(pk2(O[it][i], 0.f) & 0xffffu);
            __syncthreads();
            __syncthreads();
        }
    }
}

__device__ __forceinline__ void phase_scan(const Args& a, LAS unsigned char* lds, int l, int vcu, int G, int tid, int wave, int lane) {
    for (int ch = vcu; ch < 128; ch += G) {
        const int dir = ch & 1, h = (ch >> 1) & 3, b = (ch >> 3) & 7;
        if (ch < 64) gdn_scan_chain(a, lds, l, b, h, dir, tid, wave, lane);
        else gla_scan_chain(a, lds, l, b, h, dir, tid, wave, lane);
    }
}

__device__ __forceinline__ void phase_merge(const Args& a, int l, int gw, int NGW, int lane) {
    unsigned char* ws = a.ws; const LayerBufs B = layer_bufs(l);
    const bf16* GTA = (const bf16*)bufp(ws, a.out, B.GTA); const bf16* L0 = (const bf16*)bufp(ws, a.out, B.LOP0); const bf16* L1 = (const bf16*)bufp(ws, a.out, B.LOP1);
    const bf16* ZA = (const bf16*)bufp(ws, a.out, B.ZA); const bf16* ZB = (const bf16*)bufp(ws, a.out, B.ZB);
    bf16* Y = (bf16*)bufp(ws, a.out, B.Y);
    const int mrows = l == DEPTH - 1 ? MLAT : MALL;
    const int grp = lane >> 4, cg = lane & 15;
    const float* gnA = a.in[I_GNORM] + l * 128; const float* gnB = a.in[I_LNORM] + l * 128;
    float gA[8], gB[8];
#pragma unroll
    for (int e = 0; e < 8; ++e) { gA[e] = gnA[8 * cg + e]; gB[e] = gnB[8 * cg + e]; }
    constexpr int UN = 4;
#pragma unroll 1
    for (int it0 = gw * 4 + grp; it0 < mrows * 8; it0 += NGW * 4 * UN) {
        v4u r0[UN], r1[UN], rz[UN];
#pragma unroll
        for (int u = 0; u < UN; ++u) {
            const int it = it0 + u * NGW * 4;
            r0[u] = (v4u){0u, 0u, 0u, 0u}; r1[u] = r0[u]; rz[u] = r0[u];
            if (it < mrows * 8) {
                const int m = it >> 3, hs = it & 7, cid = m >> 6, i = m & 63;
                const bf16 *o0, *o1, *zp;
                if (hs < 4) { o0 = GTA + (((size_t)0 * NCHUNK + cid) * 4 + hs) * 8192 + i * 128; o1 = GTA + (((size_t)1 * NCHUNK + cid) * 4 + hs) * 8192 + i * 128; zp = ZA + (size_t)m * 512 + hs * 128; }
                else { const int h2 = hs - 4; o0 = L0 + ((size_t)cid * 4 + h2) * 12288 + i * 128; o1 = L1 + ((size_t)cid * 4 + h2) * 12288 + i * 128; zp = ZB + (size_t)m * 512 + h2 * 128; }
                r0[u] = *(const GAS v4u*)(o0 + 8 * cg); r1[u] = *(const GAS v4u*)(o1 + 8 * cg); rz[u] = *(const GAS v4u*)(zp + 8 * cg);
            }
        }
#pragma unroll
        for (int u = 0; u < UN; ++u) {
            const int it = it0 + u * NGW * 4;
            if (it < mrows * 8) {
                const int m = it >> 3, hs = it & 7;
                float f0[8], f1[8], z[8];
                unpack8(r0[u], f0); unpack8(r1[u], f1); unpack8(rz[u], z);
                float ss = 0.f;
#pragma unroll
                for (int e = 0; e < 8; ++e) { f0[e] += f1[e]; ss += f0[e] * f0[e]; }
                ss += __shfl_xor(ss, 1); ss += __shfl_xor(ss, 2); ss += __shfl_xor(ss, 4); ss += __shfl_xor(ss, 8);
                const float rstd = rsqrtf(ss * (1.0f / 128.0f) + NEPS);
                float y[8];
#pragma unroll
                for (int e = 0; e < 8; ++e) y[e] = f0[e] * rstd * (hs < 4 ? gA[e] : gB[e]) * silu_f(z[e]);
                v4u o; o.x = pk2(y[0], y[1]); o.y = pk2(y[2], y[3]); o.z = pk2(y[4], y[5]); o.w = pk2(y[6], y[7]);
                *(GAS v4u*)(Y + (size_t)m * 1024 + hs * 128 + 8 * cg) = o;
            }
        }
    }
}
constexpr int CV_W = 0  , CV_B = 2304  , CV_T = 2560;
__device__ __forceinline__ void conv_unit(const Args& a, LAS unsigned char* lds, int l, const bf16* U, bf16* Gd, int Fc, int f0, int unit, int nslab, int tid_in) {
    int tid = tid_in; asm volatile("" : "+v"(tid));
    const int slab = unit % nslab, rest = unit / nslab;
    const bool isctx = rest >= 32;
    const int b = isctx ? rest - 32 : rest >> 2, gy0 = isctx ? 0 : (rest & 3) * 8;
    const int W = isctx ? 256 : 64, NR = isctx ? 1 : 8, HR = isctx ? 0 : 1, TR = NR + 2 * HR, TW = W + 2;
    const int mbase = isctx ? MLAT + b * 256 : b * 2048;
    const int fl = slab * 32;
    LAS float* wsm = (LAS float*)(lds + CV_W); LAS float* bsm = (LAS float*)(lds + CV_B); LAS unsigned char* tile = lds + CV_T;
    __syncthreads();
    for (int p = tid; p < 9 * 64; p += 512) { const int tap = p >> 6, av = (p >> 5) & 1, c = p & 31; wsm[p] = a.in[I_FCONV][((size_t)l * 9 + tap) * 5632 + av * DFF + f0 + fl + c]; }
    if (tid < 64) bsm[tid] = a.in[I_FCB][(size_t)l * 5632 + (tid >> 5) * DFF + f0 + fl + (tid & 31)];
    const int ncell = TR * TW;
    {
        v4u rr[11];
#pragma unroll
        for (int j = 0; j < 11; ++j) {
            const int p = tid + 512 * j; rr[j] = (v4u){0u, 0u, 0u, 0u};
            if (p < ncell * 8) {
                const int cell = p >> 3, pc = p & 7, tr = cell / TW, tc = cell - tr * TW;
                const int gy = gy0 - HR + tr, gx = tc - 1;
                if (gx >= 0 && gx < W && gy >= 0 && gy < (isctx ? 1 : 32)) {
                    const size_t m = (size_t)mbase + gy * W + gx;
                    rr[j] = *(const GAS v4u*)(U + m * (2 * Fc) + (pc >> 2) * Fc + fl + 8 * (pc & 3));
                }
            }
        }
#pragma unroll
        for (int j = 0; j < 11; ++j) { const int p = tid + 512 * j; if (p < ncell * 8) *(LAS v4u*)(tile + p * 16) = rr[j]; }
    }
    __syncthreads();
#pragma unroll 1
    for (int it = tid; it < NR * W * 4; it += 512) {
        const int cg = it & 3, tok = it >> 2, ry = tok / W, gx = tok % W;
        float sa[8], sv[8];
#pragma unroll
        for (int e = 0; e < 8; ++e) { sa[e] = bsm[8 * cg + e]; sv[e] = bsm[32 + 8 * cg + e]; }
#pragma unroll
        for (int dy = -1; dy <= 1; ++dy) {
            if (isctx && dy != 0) continue;
#pragma unroll
            for (int dx = -1; dx <= 1; ++dx) {
                const int tap = (dy + 1) * 3 + dx + 1;
                const LAS unsigned char* cp = tile + ((ry + HR + dy) * TW + gx + 1 + dx) * 128 + 16 * cg;
                float xa[8], xv[8];
                unpack8(*(const LAS v4u*)cp, xa); unpack8(*(const LAS v4u*)(cp + 64), xv);
                const LAS float* wp = wsm + tap * 64 + 8 * cg;
#pragma unroll
                for (int e = 0; e < 8; ++e) { sa[e] += xa[e] * wp[e]; sv[e] += xv[e] * wp[32 + e]; }
            }
        }
        float y[8];
#pragma unroll
        for (int e = 0; e < 8; ++e) y[e] = silu_f(sa[e]) * sv[e];
        v4u o; o.x = pk2(y[0], y[1]); o.y = pk2(y[2], y[3]); o.z = pk2(y[4], y[5]); o.w = pk2(y[6], y[7]);
        const size_t m = (size_t)mbase + (gy0 + ry) * W + gx;
        *(GAS v4u*)(Gd + m * Fc + fl + 8 * cg) = o;
    }
}
__device__ __forceinline__ void phase_conv(const Args& a, LAS unsigned char* lds, int l, int chunkA, int vcu, int G, int tid) {
    unsigned char* ws = a.ws; const LayerBufs B = layer_bufs(l);
    const int Fc = chunkA ? FCA : FCB, f0 = chunkA ? FCB : 0, nslab = Fc / 32;
    const bf16* U = (const bf16*)bufp(ws, a.out, chunkA ? B.UA : B.UB); bf16* Gd = (bf16*)bufp(ws, a.out, chunkA ? B.GA : B.GB);
    const int nunits = (l == DEPTH - 1 ? 32 : 40) * nslab;
    for (int u = vcu; u < nunits; u += G) conv_unit(a, lds, l, U, Gd, Fc, f0, u, nslab, tid);
    __syncthreads();
}
__device__ __forceinline__ void phase_final(const Args& a, int gw, int NGW, int lane) {
    const float* rs = (const float*)(a.ws + WS_RSA) + (size_t)3 * MALL; const float* fn = a.in[I_FNORM];
    f32x4 g[4];
#pragma unroll
    for (int j = 0; j < 4; ++j) g[j] = *(const f32x4*)(fn + 4 * lane + 256 * j);
#pragma unroll 1
    for (int m0 = gw; m0 < MLAT; m0 += 4 * NGW) {
        f32x4 v[4][4]; float rstd[4];
#pragma unroll
        for (int u = 0; u < 4; ++u) { const int m = m0 + u * NGW; if (m < MLAT) { rstd[u] = rs[m];
#pragma unroll
            for (int j = 0; j < 4; ++j) v[u][j] = *(const f32x4*)(a.out + (size_t)m * 1024 + 4 * lane + 256 * j); } }
#pragma unroll
        for (int u = 0; u < 4; ++u) { const int m = m0 + u * NGW; if (m < MLAT) { const float r = rsqrtf(rstd[u] * (1.0f / 1024.0f) + NEPS);
#pragma unroll
            for (int j = 0; j < 4; ++j) *(f32x4*)(a.out + (size_t)m * 1024 + 4 * lane + 256 * j) = v[u][j] * r * g[j]; } }
    }
}
constexpr int PH_P0A = 0, PH_P0B = 1, PH_L0 = 2, PH_PER_LAYER = 11, PH_FINAL = PH_L0 + 2 * PH_PER_LAYER, PH_COUNT = PH_FINAL + 1;
enum { K_INPROJ = 0, K_PREP, K_SCAN, K_MERGE, K_OUTPROJ, K_UPB, K_CONVB, K_DOWNB, K_UPA, K_CONVA, K_DOWNA };

__global__ void __launch_bounds__(NWAVES * 64, 2) mk_fwd(Args a) {
    extern __shared__ __attribute__((aligned(16))) unsigned char lds_raw[];
    LAS unsigned char* lds = (LAS unsigned char*)lds_raw;
    const int G = gridDim.x; const int bx = blockIdx.x;
    const int vcu = (G % 8 == 0) ? (bx % 8) * (G / 8) + bx / 8 : bx;
    const int NGW = G * NWAVES;
    unsigned char* ws = a.ws;
    for (int u = threadIdx.x; u < (LDS_BYTES - LDSCTL_OFF) / 4; u += NWAVES * 64) ((LAS unsigned*)(lds + LDSCTL_OFF))[u] = 0u;
    __syncthreads();
    XcdBarrier bar; bar.bar = (unsigned*)(ws + WS_CTL) + CW_BAR; bar.x = 0; bar.st = nullptr;
    if (a.use_bar) bar = xcd_barrier_post((unsigned*)(ws + WS_CTL) + CW_BAR, (volatile LAS unsigned*)(lds + LDSCTL_OFF) + 8);
    const float* MOD = (const float*)(ws + WS_MOD);
    float* RSA = (float*)(ws + WS_RSA);

    for (int ph = a.ph_lo; ph < a.ph_hi; ++ph) {
        int tid_o = threadIdx.x; asm volatile("" : "+v"(tid_o));
        const int tid = tid_o, lane = tid & 63, wave = __builtin_amdgcn_readfirstlane(tid >> 6);
        const int gw = vcu * NWAVES + wave;
        if (ph == PH_P0A) phase_p0a(a, lds, vcu, G, tid, wave, lane);
        else if (ph == PH_P0B) phase_p0b(a, lds, vcu, G, tid, wave, lane);
        else if (ph < PH_FINAL) {
            const int l = (ph - PH_L0) / PH_PER_LAYER, k = (ph - PH_L0) % PH_PER_LAYER;
            const LayerBufs B = layer_bufs(l);
            unsigned char* wl = ws + (l == 0 ? WS_W1 : WS_W2);
            const float* MODl = MOD + (size_t)l * 9 * 6144;
            const float* SWl = (const float*)(ws + WS_SW) + (size_t)l * SW_LAYER;
            const float* rs_n1 = l == 0 ? (const float*)(ws + WS_RS1) : RSA + (size_t)1 * MALL;
            if (k == K_INPROJ) {
                const bf16* XG = (const bf16*)bufp(ws, a.out, B.XG);
                skinny_rows(XG, (const bf16*)(ws + WS_WSM) + (size_t)l * 48 * 1024, rs_n1, SWl + 9 * NMAIN, (float*)(ws + WS_SM), gw, NGW, lane);
                pg8::Gemm g{XG, (const bf16*)(wl + W_IN), MALL, NMAIN, 1024}; pg8::StaticOrder S; S.init(MALL, NMAIN, G, bx);
                pg8::EpiInProj E{ws, a.out, l};
                pg8::gemm_phase<pg8::EpiInProj, pg8::StaticOrder, true, true>(lds, g, S, E);
            }
            else if (k == K_PREP) phase_prep(a, lds, l, vcu, G, tid, wave, lane);
            else if (k == K_SCAN) phase_scan(a, lds, l, vcu, G, tid, wave, lane);
            else if (k == K_MERGE) phase_merge(a, l, gw, NGW, lane);
            else if (k == K_OUTPROJ || k == K_DOWNB || k == K_DOWNA) {
                const int M = l == DEPTH - 1 ? MLAT : MALL;
                const bool last = l == DEPTH - 1;
                float* res_lat = a.out; float* res_ctx = (float*)(ws + WS_CXR);
                pg8::EpiResid E;
                E.rin_lat = (k == K_OUTPROJ && l == 0) ? a.in[I_X] : res_lat; E.rin_ctx = (k == K_OUTPROJ && l == 0) ? a.in[I_CTX] : res_ctx;
                E.rout_lat = res_lat; E.rout_ctx = res_ctx;
                E.gate = MODl + (k == K_OUTPROJ ? 2 : 5) * 1024; E.gn = nullptr; E.scl = nullptr; E.XGo = nullptr; E.rowss = nullptr;
                pg8::Gemm g;
                if (k == K_OUTPROJ) { g = pg8::Gemm{(const bf16*)bufp(ws, a.out, B.Y), (const bf16*)(wl + W_OUT), M, 1024, 1024};
                    E.gn = a.in[I_NORM2] + l * 1024; E.scl = MODl + 4 * 1024; E.XGo = (bf16*)bufp(ws, a.out, B.XG2); E.rowss = RSA + (size_t)(l == 0 ? 0 : 2) * MALL; }
                else if (k == K_DOWNB) g = pg8::Gemm{(const bf16*)bufp(ws, a.out, B.GB), (const bf16*)(wl + W_DB), M, 1024, FCB};
                else { g = pg8::Gemm{(const bf16*)bufp(ws, a.out, B.GA), (const bf16*)(wl + W_DA), M, 1024, FCA};
                    if (!last) { E.gn = a.in[I_NORM1] + 1024; E.scl = MOD + (size_t)9 * 6144 + 1 * 1024; E.XGo = (bf16*)bufp(ws, a.out, B.XGN); E.rowss = RSA + (size_t)1 * MALL; }
                    else E.rowss = RSA + (size_t)3 * MALL; }
                pg8::StaticOrder S; S.init(M, 1024, G, bx);
                pg8::gemm_phase<pg8::EpiResid, pg8::StaticOrder, true, true>(lds, g, S, E);
            }
            else if (k == K_UPB || k == K_UPA) {
                const int M = l == DEPTH - 1 ? MLAT : MALL;
                const int roff = k == K_UPA ? 2 * FCB : 0, N = k == K_UPA ? 2 * FCA : 2 * FCB;
                pg8::Gemm g{(const bf16*)bufp(ws, a.out, B.XG2), (const bf16*)(wl + W_UP) + (size_t)roff * 1024, M, N, 1024};
                pg8::EpiUp E{RSA + (size_t)(l == 0 ? 0 : 2) * MALL, SWl + 9 * (NMAIN + NSMALL) + roff, (bf16*)bufp(ws, a.out, k == K_UPA ? B.UA : B.UB), N};
                pg8::StaticOrder S; S.init(M, N, G, bx);
                pg8::gemm_phase<pg8::EpiUp, pg8::StaticOrder, true, true>(lds, g, S, E);
            }
            else if (k == K_CONVB || k == K_CONVA) phase_conv(a, lds, l, k == K_CONVA, vcu, G, tid);
        }
        else phase_final(a, gw, NGW, lane);
        if (ph + 1 < a.ph_hi && a.use_bar) xcd_barrier(bar);
    }
}
static int g_grid = 0;
static int mk_setup() {
    if (g_grid) return g_grid;
    int dev = 0, cus = 0;
    if (hipGetDevice(&dev) != hipSuccess || hipDeviceGetAttribute(&cus, hipDeviceAttributeMultiprocessorCount, dev) != hipSuccess) { g_grid = -1; return -1; }
    if (hipFuncSetAttribute((const void*)mk_fwd, hipFuncAttributeMaxDynamicSharedMemorySize, LDS_BYTES) != hipSuccess) { fprintf(stderr, "hipFuncSetAttribute failed\n"); g_grid = -1; return -1; }
    (void)hipGetLastError();
    g_grid = cus;
    return g_grid;
}
static void mk_launch(const Args& base, int lo, int hi, int use_bar, hipStream_t stream) {
    Args a = base; a.ph_lo = lo; a.ph_hi = hi; a.use_bar = use_bar;
    hipLaunchKernelGGL(mk_fwd, dim3(g_grid), dim3(NWAVES * 64), LDS_BYTES, stream, a);
}

extern "C" void kernel_launch(void* const* d_in, const int* in_sizes, int n_in, void* d_out, int out_size, void* d_ws, size_t ws_size, hipStream_t stream) {
    if (mk_setup() < 0) return;
    unsigned char* ws = (unsigned char*)d_ws;
    (void)hipMemsetAsync(ws + WS_CTL, 0, CTL_ZERO_BYTES, stream);
    Args a{};
    for (int i = 0; i < 22; ++i) a.in[i] = (const float*)d_in[i];
    a.out = (float*)d_out; a.ws = ws;
#ifndef MK_N_LAUNCHES
#define MK_N_LAUNCHES 1
#endif
    if (MK_N_LAUNCHES == 1) mk_launch(a, 0, PH_COUNT, 1, stream);
    else for (int ph = 0; ph < PH_COUNT; ++ph) mk_launch(a, ph, ph + 1, 0, stream);
#ifdef MK_PROBE_LIST
    {
        Args p = a; p.out = (float*)(ws + 64 * MiB);
#ifdef MK_PROBE_PMODE
        p.pad = MK_PROBE_PMODE;
#endif
        const int lst[] = { MK_PROBE_LIST };
        for (int r = 0; r < MK_PROBE_REPS; ++r) for (unsigned i = 0; i < sizeof(lst) / sizeof(lst[0]); ++i) mk_launch(p, lst[i], lst[i] + 1, 0, stream);
    }
#endif
}
```

```cpp
#include <hip/hip_runtime.h>
#include <cstdio>
#include <cstdint>
#include <math.h>

#define GAS __attribute__((address_space(1)))
#define LAS __attribute__((address_space(3)))
typedef unsigned short bf16;
typedef unsigned v4u __attribute__((ext_vector_type(4)));
typedef unsigned v2u __attribute__((ext_vector_type(2)));
typedef float f32x4 __attribute__((ext_vector_type(4)));
typedef float f32x16 __attribute__((ext_vector_type(16)));
typedef short bf16x8 __attribute__((ext_vector_type(8)));
typedef short s16x4 __attribute__((ext_vector_type(4)));
typedef __bf16 bf16x2_t __attribute__((ext_vector_type(2)));
typedef float f32x2_t __attribute__((ext_vector_type(2)));
typedef GAS unsigned gu32;

constexpr int DM = 1024, NBATCH = 8, LSEQ = 2048, LCTX = 256, DEPTH = 2;
constexpr int MLAT = NBATCH * LSEQ;
constexpr int MALL = MLAT + NBATCH * LCTX;
constexpr int NCHUNK = MALL / 64;
constexpr int DINP = 3632, NMAIN = 3584, NSMALL = 48;
constexpr int DFF = 2816, FCB = 1280, FCA = 1536;
constexpr float NEPS = 1e-6f;

constexpr size_t MiB = 1u << 20;
constexpr size_t WS_CTL = 0, CTL_ZERO_BYTES = 1 * MiB;
constexpr int CW_BAR = 4096;
constexpr size_t WS_RSA = 256 * 1024;
constexpr size_t WS_MOD = 1 * MiB;
constexpr size_t WS_RS1 = 1 * MiB + 512 * 1024;
constexpr size_t WS_SW = 2 * MiB;
constexpr size_t SW_LAYER = (size_t)9 * (NMAIN + NSMALL + 2 * DFF);
constexpr size_t WS_GDEC = 3 * MiB;
constexpr size_t WS_LDEC = 4 * MiB + 512 * 1024;
constexpr size_t WS_SM = 5 * MiB + 256 * 1024;
constexpr size_t WS_HALO = 9 * MiB;
constexpr size_t WS_WSM = 11 * MiB;
constexpr size_t WS_W2 = 12 * MiB, WS_W1 = 38 * MiB;
constexpr size_t W_IN = 0, W_OUT = 7 * MiB, W_UP = 9 * MiB, W_DB = 20 * MiB, W_DA = 20 * MiB + (size_t)1024 * FCB * 2;
constexpr size_t WS_CXR = 64 * MiB;
static_assert(W_DA + (size_t)1024 * FCA * 2 <= 26 * MiB, "weights");
static_assert(WS_SM + (size_t)MALL * 48 * 4 <= WS_HALO && WS_HALO + (size_t)NCHUNK * 2 * 1536 * 2 <= WS_WSM, "ws small map");
static_assert(WS_SW + 2 * SW_LAYER * 4 <= WS_GDEC && WS_RSA + (size_t)4 * MALL * 4 <= CTL_ZERO_BYTES, "ws map");

struct LayerBufs {
    long XG, GQ, GK, GV, LV, ZA, ZB, LQ, LK, GTA, LOP0, LOP1, Y, XG2, UB, GB, UA, GA, XGN;
};
#define DO_(x) (-(long)((x) * MiB) - 1)
__host__ __device__ constexpr LayerBufs layer_bufs(int l) {
    return l == 0 ? LayerBufs{ 72 * (long)MiB, 108 * (long)MiB, 126 * (long)MiB, 144 * (long)MiB, 162 * (long)MiB, DO_(0), DO_(18), DO_(36), DO_(45),
                               180 * (long)MiB, 72 * (long)MiB, 216 * (long)MiB, 108 * (long)MiB, 72 * (long)MiB, 108 * (long)MiB, 198 * (long)MiB, 126 * (long)MiB, 72 * (long)MiB, 220 * (long)MiB }
                  : LayerBufs{ 220 * (long)MiB, 38 * (long)MiB, 56 * (long)MiB, 74 * (long)MiB, 92 * (long)MiB, 110 * (long)MiB, 128 * (long)MiB, 146 * (long)MiB, 155 * (long)MiB,
                               164 * (long)MiB, 200 * (long)MiB, 227 * (long)MiB, 38 * (long)MiB, 74 * (long)MiB, 110 * (long)MiB, 190 * (long)MiB, 110 * (long)MiB, 206 * (long)MiB, 0 };
}

#define LDS_WAIT() asm volatile("s_waitcnt lgkmcnt(0)" ::: "memory")
#define VM_WAIT() asm volatile("s_waitcnt vmcnt(0)" ::: "memory")
__device__ __forceinline__ unsigned pk2(float lo, float hi) { f32x2_t v = {lo, hi}; bf16x2_t b = __builtin_convertvector(v, bf16x2_t); return __builtin_bit_cast(unsigned, b); }
__device__ __forceinline__ float bflo(unsigned u) { return __uint_as_float(u << 16); }
__device__ __forceinline__ float bfhi(unsigned u) { return __uint_as_float(u & 0xffff0000u); }
__device__ __forceinline__ float bf2f(bf16 u) { return __uint_as_float((unsigned)u << 16); }
__device__ __forceinline__ float silu_f(float x) { return x / (1.f + __expf(-x)); }
__device__ __forceinline__ float softplus_f(float x) { return fmaxf(x, 0.f) + log1pf(__expf(-fabsf(x))); }
__device__ __forceinline__ float sigmoid_f(float x) { return 1.f / (1.f + __expf(-x)); }
__device__ __forceinline__ float wave_sum(float v) {
#pragma unroll
    for (int o = 1; o < 64; o <<= 1) v += __shfl_xor(v, o);
    return v;
}
__device__ __forceinline__ int row_s(int m) { return m < MLAT ? (m >> 11) : 8; }
__host__ __device__ __forceinline__ unsigned char* bufp(unsigned char* ws, float* out, long off) { return off >= 0 ? ws + off : (unsigned char*)out + (-off - 1); }
namespace pg8 {
#define PG8_LAS __attribute__((address_space(3)))
typedef unsigned short bf16_t;
typedef short bf16x8 __attribute__((ext_vector_type(8)));
typedef float f32x4 __attribute__((ext_vector_type(4)));
typedef unsigned u32x4 __attribute__((ext_vector_type(4)));
constexpr int BM = 256, BK = 64, HALF = 128, HTB = HALF * BK * 2  , STAGE_BYTES = 8 * HTB, NXCD = 8, WGM = 8;

__host__ __device__ __forceinline__ int lds_byte(int r, int c) { const int st = (r >> 4) * 2 + (c >> 5), rr = r & 15, cc = c & 31, ob = rr * 64 + cc * 2; return st * 1024 + (ob ^ (((ob >> 9) & 1) << 5)); }
__host__ __device__ __forceinline__ void stage_rc(int b, int& R, int& C) { const int st = b / 1024, sb = b % 1024, swz = sb ^ (((sb >> 9) & 1) << 5); R = (st >> 1) * 16 + swz / 64; C = (st & 1) * 32 + (swz % 64) / 2; }
__host__ __device__ __forceinline__ int perm32(int rho) { const int n = rho >> 4, i = rho & 15; return 8 * (i >> 2) + 4 * n + (i & 3); }

struct Unit { int pm, pn; };
struct Gemm { const bf16_t* A; const bf16_t* Bt; int M, N, K; };

struct StaticOrder {
    int nM, nN, nwg, G, c;
    __host__ __device__ void init(int M, int N, int G_, int c_) { nM = M / BM; nN = N / BM; nwg = nM * nN; G = G_; c = c_; }
    __host__ __device__ bool next(int i, Unit& u) const {
        const long L = (long)i * G + c; if (L >= nwg) return false;
        int wgid = (int)L; { const int q = nwg / NXCD, r = nwg % NXCD, xcd = wgid % NXCD, off = wgid / NXCD; wgid = (xcd < r ? xcd * (q + 1) : r * (q + 1) + (xcd - r) * q) + off; }
        const int nig = WGM * nN, gid = wgid / nig, fm = gid * WGM, gsz = (nM - fm) < WGM ? (nM - fm) : WGM;
        u.pm = fm + ((wgid % nig) % gsz); u.pn = (wgid % nig) / gsz; return true;
    }
    __device__ __forceinline__ void a_ready(const Unit&) const {}
    __device__ __forceinline__ void done(const Unit&) const {}
};
__device__ __forceinline__ unsigned pk2e(float lo, float hi) { f32x2_t v = {lo, hi}; bf16x2_t b = __builtin_convertvector(v, bf16x2_t); return __builtin_bit_cast(unsigned, b); }

struct EpiInProj {
    static constexpr bool PERM = true, AFTER_DRAIN = false;
    unsigned char* ws; float* out; int l;
    __device__ __forceinline__ void operator()(const f32x4 (&acc)[2][2][4][2], const Unit& u, int wr, int wc, int fr, int fq) const {
        const LayerBufs B = layer_bufs(l);
        const float* rowss = l == 0 ? (const float*)(ws + WS_RS1) : (const float*)(ws + WS_RSA) + MALL;
        const float* sW = (const float*)(ws + WS_SW) + (size_t)l * SW_LAYER;
        const int pn = u.pn, s = u.pm < 64 ? (u.pm >> 3) : 8;
        long boff; int ld, cb;
        if (pn < 8) { const int t = pn >> 1; boff = t == 0 ? B.GQ : (t == 1 ? B.GK : (t == 2 ? B.GV : B.ZA)); ld = 512; cb = (pn & 1) * 256; }
        else if (pn == 8) { boff = B.LQ; ld = 256; cb = 0; }
        else if (pn == 9) { boff = B.LK; ld = 256; cb = 0; }
        else { boff = pn < 12 ? B.LV : B.ZB; ld = 512; cb = (pn & 1) * 256; }
        bf16_t* base = (bf16_t*)bufp(ws, out, boff);
        bf16_t* HALO = (bf16_t*)(ws + WS_HALO);
        const int row0 = u.pm * BM + wr * 64 + fr, colw = wc * 32 + 8 * fq;
        const float* swp = sW + (size_t)s * 3584 + pn * BM + colw;
        f32x4 bv[2][2];
#pragma unroll
        for (int bj = 0; bj < 2; ++bj)
#pragma unroll
            for (int n = 0; n < 2; ++n) bv[bj][n] = *(const f32x4*)(swp + bj * HALF + 4 * n);
        float rs8[8];
#pragma unroll
        for (int q = 0; q < 8; ++q) rs8[q] = rowss[row0 + (q >> 2) * HALF + (q & 3) * 16];
#pragma unroll
        for (int ai = 0; ai < 2; ++ai)
#pragma unroll
            for (int m = 0; m < 4; ++m) {
                const int row = row0 + ai * HALF + m * 16;
                const float rstd = rsqrtf(rs8[ai * 4 + m] * (1.0f / 1024.0f) + 1e-6f);
                bf16_t* rowp = base + (size_t)row * ld + cb + colw;
                const bool halo = (pn < 6) && ((m == 0 && fr == 0) || (m == 3 && fr == 15));
                bf16_t* hp = HALO + ((size_t)(row >> 6) * 2 + (m == 3 ? 1 : 0)) * 1536 + (pn >> 1) * 512 + cb + colw;
#pragma unroll
                for (int bj = 0; bj < 2; ++bj) {
                    const f32x4 v0 = acc[ai][bj][m][0] * rstd + bv[bj][0], v1 = acc[ai][bj][m][1] * rstd + bv[bj][1];
                    u32x4 w; w.x = pk2e(v0[0], v0[1]); w.y = pk2e(v0[2], v0[3]); w.z = pk2e(v1[0], v1[1]); w.w = pk2e(v1[2], v1[3]);
                    *(u32x4*)(rowp + bj * HALF) = w;
                    if (halo) *(u32x4*)(hp + bj * HALF) = w;
                }
            }
    }
};

struct EpiResid {
    static constexpr bool PERM = true, AFTER_DRAIN = false;
    const float* rin_lat; const float* rin_ctx; float* rout_lat; float* rout_ctx;
    const float* gate;
    const float* gn;
    const float* scl;
    bf16_t* XGo; float* rowss;
    __device__ __forceinline__ void operator()(const f32x4 (&acc)[2][2][4][2], const Unit& u, int wr, int wc, int fr, int fq) const {
        const int s = u.pm < 64 ? (u.pm >> 3) : 8;
        const bool isctx = u.pm >= 64, do_xg = XGo != nullptr, do_ss = rowss != nullptr;
        const float* rin = isctx ? rin_ctx - (size_t)16384 * 1024 : rin_lat;
        float* rout = isctx ? rout_ctx - (size_t)16384 * 1024 : rout_lat;
        const int row0 = u.pm * BM + wr * 64 + fr, col0 = u.pn * BM + wc * 32 + 8 * fq;
        f32x4 gv[2][2], nv[2][2];
#pragma unroll
        for (int bj = 0; bj < 2; ++bj)
#pragma unroll
            for (int n = 0; n < 2; ++n) {
                gv[bj][n] = *(const f32x4*)(gate + (size_t)s * 6144 + col0 + bj * HALF + 4 * n);
                if (do_xg) { const f32x4 g = *(const f32x4*)(gn + col0 + bj * HALF + 4 * n), sc = *(const f32x4*)(scl + (size_t)s * 6144 + col0 + bj * HALF + 4 * n); nv[bj][n] = g * (sc + 1.0f); }
                else nv[bj][n] = (f32x4){0.f, 0.f, 0.f, 0.f};
            }
#pragma unroll
        for (int am = 0; am < 4; ++am) {
            const int ai = am >> 1, mb = (am & 1) * 2;
            f32x4 rv[2][2][2];
#pragma unroll
            for (int mm = 0; mm < 2; ++mm) { const float* rp = rin + (size_t)(row0 + ai * HALF + (mb + mm) * 16) * 1024 + col0;
#pragma unroll
                for (int bj = 0; bj < 2; ++bj) { rv[mm][bj][0] = *(const f32x4*)(rp + bj * HALF); rv[mm][bj][1] = *(const f32x4*)(rp + bj * HALF + 4); } }
#pragma unroll
            for (int mm = 0; mm < 2; ++mm) {
                const int m = mb + mm;
                const int row = row0 + ai * HALF + m * 16;
                float* op = rout + (size_t)row * 1024 + col0;
                float ss = 0.f;
#pragma unroll
                for (int bj = 0; bj < 2; ++bj) {
                    const f32x4 x0 = rv[mm][bj][0] + gv[bj][0] * acc[ai][bj][m][0];
                    const f32x4 x1 = rv[mm][bj][1] + gv[bj][1] * acc[ai][bj][m][1];
                    *(f32x4*)(op + bj * HALF) = x0; *(f32x4*)(op + bj * HALF + 4) = x1;
                    ss += (x0[0] * x0[0] + x0[1] * x0[1]) + (x0[2] * x0[2] + x0[3] * x0[3]) + (x1[0] * x1[0] + x1[1] * x1[1]) + (x1[2] * x1[2] + x1[3] * x1[3]);
                    if (do_xg) {
                        const f32x4 y0 = x0 * nv[bj][0], y1 = x1 * nv[bj][1];
                        u32x4 w; w.x = pk2e(y0[0], y0[1]); w.y = pk2e(y0[2], y0[3]); w.z = pk2e(y1[0], y1[1]); w.w = pk2e(y1[2], y1[3]);
                        *(u32x4*)(XGo + (size_t)row * 1024 + col0 + bj * HALF) = w;
                    }
                }
                if (do_ss) { ss += __shfl_xor(ss, 16); ss += __shfl_xor(ss, 32); if (fq == 0) atomicAdd(rowss + row, ss); }
            }
        }
    }
};

struct EpiUp {
    static constexpr bool PERM = true, AFTER_DRAIN = false;
    const float* rowss; const float* sW;
    bf16_t* U; int ldu;
    __device__ __forceinline__ void operator()(const f32x4 (&acc)[2][2][4][2], const Unit& u, int wr, int wc, int fr, int fq) const {
        const int s = u.pm < 64 ? (u.pm >> 3) : 8;
        const int row0 = u.pm * BM + wr * 64 + fr, col0 = u.pn * BM + wc * 32 + 8 * fq;
        const float* swp = sW + (size_t)s * 5632 + col0;
        f32x4 bv[2][2];
#pragma unroll
        for (int bj = 0; bj < 2; ++bj)
#pragma unroll
            for (int n = 0; n < 2; ++n) bv[bj][n] = *(const f32x4*)(swp + bj * HALF + 4 * n);
        float rs8[8];
#pragma unroll
        for (int q = 0; q < 8; ++q) rs8[q] = rowss[row0 + (q >> 2) * HALF + (q & 3) * 16];
#pragma unroll
        for (int ai = 0; ai < 2; ++ai)
#pragma unroll
            for (int m = 0; m < 4; ++m) {
                const int row = row0 + ai * HALF + m * 16;
                const float rstd = rsqrtf(rs8[ai * 4 + m] * (1.0f / 1024.0f) + 1e-6f);
                bf16_t* rowp = U + (size_t)row * ldu + col0;
#pragma unroll
                for (int bj = 0; bj < 2; ++bj) {
                    const f32x4 v0 = acc[ai][bj][m][0] * rstd + bv[bj][0], v1 = acc[ai][bj][m][1] * rstd + bv[bj][1];
                    u32x4 w; w.x = pk2e(v0[0], v0[1]); w.y = pk2e(v0[2], v0[3]); w.z = pk2e(v1[0], v1[1]); w.w = pk2e(v1[2], v1[3]);
                    *(u32x4*)(rowp + bj * HALF) = w;
                }
            }
    }
};
template <class Epi, class Sched, bool ALIGN_EPI = false, bool SP2 = false>
__device__ __forceinline__ void gemm_phase(PG8_LAS unsigned char* lds, const Gemm g, const Sched& S, const Epi& E) {
    int tid_o = threadIdx.x; asm volatile("" : "+v"(tid_o));
    const int tid = tid_o, wid = __builtin_amdgcn_readfirstlane(tid >> 6), lane = tid & 63, wr = wid >> 2, wc = wid & 3, fr = lane & 15, fq = lane >> 4;
    const int K = g.K, nt = K / BK;
    unsigned voffA[2], voffB[2];
#pragma unroll
    for (int i = 0; i < 2; ++i) { int R, C; stage_rc(tid * 16 + i * 8192, R, C); const int Rb = Epi::PERM ? ((R & ~31) + perm32(R & 31)) : R;
        voffA[i] = (unsigned)(R * K + C) * 2u; voffB[i] = (unsigned)(Rb * K + C) * 2u; }
    const size_t kstep = (size_t)(BK * 2);
    const size_t hstep = (size_t)HALF * K * 2;
    const size_t tstep = 2 * hstep;
    const unsigned ldsw = (unsigned)wid * 1024u;
    const int aoff = lds_byte(wr * 64 + fr, fq * 8), boff = lds_byte(wc * 32 + fr, fq * 8);
#define PG8_SA(b, h) (((b) * 2 + (h)) * HTB)
#define PG8_SB(b, h) ((4 + (b) * 2 + (h)) * HTB)
#define PG8_STAGE(bufoff, gbase, voff) do { _Pragma("unroll") for (int _i = 0; _i < 2; ++_i) \
        __builtin_amdgcn_global_load_lds((const unsigned*)((const char*)(gbase) + (voff)[_i]), (PG8_LAS unsigned*)(lds + (bufoff) + ldsw + _i * 8192), 16, 0, 0); } while (0)
#define PG8_LDA(dst, b, h) do { _Pragma("unroll") for (int m = 0; m < 4; ++m) _Pragma("unroll") for (int k = 0; k < 2; ++k) dst[m][k] = *(const PG8_LAS bf16x8*)(lds + PG8_SA(b, h) + aoff + m * 2048 + k * 1024); } while (0)
#define PG8_LDB(dst, b, h) do { _Pragma("unroll") for (int n = 0; n < 2; ++n) _Pragma("unroll") for (int k = 0; k < 2; ++k) dst[n][k] = *(const PG8_LAS bf16x8*)(lds + PG8_SB(b, h) + boff + n * 2048 + k * 1024); } while (0)
#define PG8_MMA(ai, bj, At, Bt) do { __builtin_amdgcn_s_setprio(1); _Pragma("unroll") for (int m = 0; m < 4; ++m) _Pragma("unroll") for (int n = 0; n < 2; ++n) _Pragma("unroll") for (int k = 0; k < 2; ++k) \
        acc[ai][bj][m][n] = __builtin_amdgcn_mfma_f32_16x16x32_bf16(Bt[n][k], At[m][k], acc[ai][bj][m][n], 0, 0, 0); __builtin_amdgcn_s_setprio(0); } while (0)
#define PG8_WAIT_V(n) asm volatile("s_waitcnt vmcnt(" #n ")" ::: "memory")
#define PG8_WAIT_L(n) asm volatile("s_waitcnt lgkmcnt(" #n ")" ::: "memory")
#define PG8_BAR __builtin_amdgcn_s_barrier()
#define PG8_SCHED __builtin_amdgcn_sched_barrier(0)
    Unit cur, nxt; int ui = 0;
    if (!S.next(0, cur)) return;
    f32x4 acc[2][2][4][2];
#pragma unroll
    for (int a = 0; a < 2; ++a)
#pragma unroll
        for (int b = 0; b < 2; ++b)
#pragma unroll
            for (int m = 0; m < 4; ++m)
#pragma unroll
                for (int n = 0; n < 2; ++n) acc[a][b][m][n] = (f32x4){0.f, 0.f, 0.f, 0.f};
    bf16x8 At[4][2], B0[2][2], B1[2][2];
    const char* cA = (const char*)g.A + (size_t)cur.pm * tstep; const char* cB = (const char*)g.Bt + (size_t)cur.pn * tstep;
    S.a_ready(cur);
    if constexpr (SP2) {
        PG8_STAGE(PG8_SB(0, 0), cB, voffB); PG8_STAGE(PG8_SB(0, 1), cB + hstep, voffB); PG8_STAGE(PG8_SA(0, 0), cA, voffA); PG8_STAGE(PG8_SA(0, 1), cA + hstep, voffA);
        if (wr == 1) PG8_BAR;
        PG8_WAIT_V(2); PG8_BAR;
        PG8_STAGE(PG8_SB(1, 0), cB + kstep, voffB); PG8_STAGE(PG8_SA(1, 0), cA + kstep, voffA); PG8_STAGE(PG8_SB(1, 1), cB + hstep + kstep, voffB);
        PG8_WAIT_V(6); PG8_BAR;
    } else {
        PG8_STAGE(PG8_SB(0, 0), cB, voffB); PG8_STAGE(PG8_SA(0, 0), cA, voffA); PG8_STAGE(PG8_SB(0, 1), cB + hstep, voffB); PG8_STAGE(PG8_SA(0, 1), cA + hstep, voffA);
        if (wr == 1) PG8_BAR;
        PG8_WAIT_V(4); PG8_BAR;
        PG8_STAGE(PG8_SB(1, 0), cB + kstep, voffB); PG8_STAGE(PG8_SA(1, 0), cA + kstep, voffA); PG8_STAGE(PG8_SB(1, 1), cB + hstep + kstep, voffB);
        PG8_WAIT_V(6); PG8_BAR;
    }
    for (;;) {
        const bool has_next = S.next(ui + 1, nxt);
        const char* nA = has_next ? (const char*)g.A + (size_t)nxt.pm * tstep : cA; const char* nB = has_next ? (const char*)g.Bt + (size_t)nxt.pn * tstep : cB;
        for (int t = 0; t < nt; t += 2) {
            const bool last = (t == nt - 2);
            const char* a1 = cA + (size_t)(t + 1) * kstep;
            const char* a2 = last ? nA : cA + (size_t)(t + 2) * kstep; const char* b2 = last ? nB : cB + (size_t)(t + 2) * kstep;
            const char* a3 = a2 + kstep; const char* b3 = b2 + kstep;
            if (last && has_next) S.a_ready(nxt);
            if constexpr (SP2) {
            PG8_LDB(B0, 0, 0); PG8_LDB(B1, 0, 1); PG8_SCHED; PG8_LDA(At, 0, 0); PG8_STAGE(PG8_SA(1, 1), a1 + hstep, voffA);
            PG8_WAIT_V(8); PG8_WAIT_L(0); PG8_BAR; PG8_MMA(0, 0, At, B0); PG8_MMA(0, 1, At, B1); PG8_BAR; PG8_SCHED;
            PG8_LDA(At, 0, 1); PG8_STAGE(PG8_SB(0, 0), b2, voffB); PG8_STAGE(PG8_SB(0, 1), b2 + hstep, voffB); PG8_STAGE(PG8_SA(0, 0), a2, voffA);
            PG8_WAIT_V(8); PG8_WAIT_L(0); PG8_BAR; PG8_MMA(1, 0, At, B0); PG8_MMA(1, 1, At, B1); PG8_BAR; PG8_SCHED;
            PG8_LDB(B0, 1, 0); PG8_LDB(B1, 1, 1); PG8_SCHED; PG8_LDA(At, 1, 0); PG8_STAGE(PG8_SA(0, 1), a2 + hstep, voffA);
            PG8_WAIT_V(8); PG8_WAIT_L(0); PG8_BAR; PG8_MMA(0, 0, At, B0); PG8_MMA(0, 1, At, B1); PG8_BAR; PG8_SCHED;
            PG8_LDA(At, 1, 1); PG8_STAGE(PG8_SB(1, 0), b3, voffB); PG8_STAGE(PG8_SB(1, 1), b3 + hstep, voffB); PG8_STAGE(PG8_SA(1, 0), a3, voffA);
            PG8_WAIT_V(8); PG8_WAIT_L(0); PG8_BAR; PG8_MMA(1, 0, At, B0); PG8_MMA(1, 1, At, B1); PG8_BAR; PG8_SCHED;
            } else {
            PG8_LDB(B0, 0, 0); PG8_SCHED; PG8_LDA(At, 0, 0); PG8_STAGE(PG8_SA(1, 1), a1 + hstep, voffA);
            PG8_WAIT_L(8); PG8_BAR; PG8_WAIT_L(0); PG8_MMA(0, 0, At, B0); PG8_BAR; PG8_SCHED;
            PG8_LDB(B1, 0, 1); PG8_STAGE(PG8_SB(0, 0), b2, voffB);
            PG8_BAR; PG8_WAIT_L(0); PG8_MMA(0, 1, At, B1); PG8_BAR;
            PG8_LDA(At, 0, 1); PG8_STAGE(PG8_SA(0, 0), a2, voffA);
            PG8_BAR; PG8_WAIT_L(0); PG8_MMA(1, 0, At, B0); PG8_BAR; PG8_SCHED;
            PG8_STAGE(PG8_SB(0, 1), b2 + hstep, voffB);
            PG8_WAIT_V(6); PG8_BAR; PG8_MMA(1, 1, At, B1); PG8_BAR;
            PG8_LDB(B0, 1, 0); PG8_SCHED; PG8_LDA(At, 1, 0); PG8_STAGE(PG8_SA(0, 1), a2 + hstep, voffA);
            PG8_WAIT_L(8); PG8_BAR; PG8_WAIT_L(0); PG8_MMA(0, 0, At, B0); PG8_BAR; PG8_SCHED;
            PG8_LDB(B1, 1, 1); PG8_STAGE(PG8_SB(1, 0), b3, voffB);
            PG8_BAR; PG8_WAIT_L(0); PG8_MMA(0, 1, At, B1); PG8_BAR;
            PG8_LDA(At, 1, 1); PG8_STAGE(PG8_SA(1, 0), a3, voffA);
            PG8_BAR; PG8_WAIT_L(0); PG8_MMA(1, 0, At, B0); PG8_BAR; PG8_SCHED;
            PG8_STAGE(PG8_SB(1, 1), b3 + hstep, voffB);
            PG8_WAIT_V(6); PG8_BAR; PG8_MMA(1, 1, At, B1); PG8_BAR;
            }
        }
        if constexpr (ALIGN_EPI) { if (wr == 0) PG8_BAR; }
        if constexpr (!Epi::AFTER_DRAIN) { E(acc, cur, wr, wc, fr, fq); S.done(cur); }
        if (!has_next) break;
#pragma unroll
        for (int a = 0; a < 2; ++a)
#pragma unroll
            for (int b = 0; b < 2; ++b)
#pragma unroll
                for (int m = 0; m < 4; ++m)
#pragma unroll
                    for (int n = 0; n < 2; ++n) acc[a][b][m][n] = (f32x4){0.f, 0.f, 0.f, 0.f};
        cur = nxt; cA = nA; cB = nB; ++ui;
        if constexpr (ALIGN_EPI) { if (wr == 1) PG8_BAR; }
    }
    PG8_WAIT_V(0);
    if constexpr (!ALIGN_EPI) { if (wr == 0) PG8_BAR; }
    PG8_BAR;
    if constexpr (Epi::AFTER_DRAIN) { E.fused(acc, cur, wr, wc, fr, fq, lds, wid, lane); S.done(cur); }
#undef PG8_SA
#undef PG8_SB
#undef PG8_STAGE
#undef PG8_LDA
#undef PG8_LDB
#undef PG8_MMA
#undef PG8_WAIT_V
#undef PG8_WAIT_L
#undef PG8_BAR
#undef PG8_SCHED
}
}
#define XB_TMO      128
#define XB_XCNT(j)  (256  + 64 * (j))
#define XB_XSUB(j)  (1280 + 64 * (j))
#define XB_XGEN(j)  (2304 + 64 * (j))
#define XB_TOP      3328
#define XB_TOPGEN   3392
#define XCD_BAR_WORDS 3456
#define XB_SPIN_CAP (1u << 18)

__device__ __forceinline__ unsigned xb_ld(unsigned* p)              { return __hip_atomic_load(p, __ATOMIC_RELAXED, __HIP_MEMORY_SCOPE_AGENT); }
__device__ __forceinline__ unsigned xb_add(unsigned* p, unsigned v) { return __hip_atomic_fetch_add(p, v, __ATOMIC_RELAXED, __HIP_MEMORY_SCOPE_AGENT); }
__device__ __forceinline__ unsigned xb_xcc_id() { return (unsigned)__builtin_amdgcn_s_getreg((3 << 11) | 20) & 0xFu; }
#define XB_SPIN(cond, bar) do { unsigned _sp = 0; while (cond) { __builtin_amdgcn_s_sleep(1); \
    if ((++_sp & 255u) == 0u) { if (xb_ld(&(bar)[XB_TMO])) break; if (_sp > XB_SPIN_CAP) { atomicAdd(&(bar)[XB_TMO], 1u); break; } } } } while (0)

struct XcdBarrier {
    unsigned* bar; unsigned x;
    volatile LAS unsigned* st;
};

__device__ __forceinline__ XcdBarrier xcd_barrier_post(unsigned* bar, volatile LAS unsigned* st) {
    XcdBarrier b; b.bar = bar; b.x = xb_xcc_id(); b.st = st;
    if (threadIdx.x == 0) (void)xb_add(&bar[XB_XCNT(b.x)], 1u);
    return b;
}
__device__ __forceinline__ void xcd_barrier_complete(unsigned* bar, unsigned x, unsigned& nloc, unsigned& nx) {
    const unsigned G = gridDim.x * gridDim.y * gridDim.z;
    unsigned sum, cnt, mine, sp = 0u;
    for (;;) {
        sum = 0u; cnt = 0u; mine = 0u;
#pragma unroll
        for (unsigned j = 0; j < 16; ++j) { const unsigned c = xb_ld(&bar[XB_XCNT(j)]); sum += c; cnt += (c > 0u) ? 1u : 0u; mine = (j == x) ? c : mine; }
        if (sum == G) break;
        __builtin_amdgcn_s_sleep(1);
        if ((++sp & 255u) == 0u) { if (xb_ld(&bar[XB_TMO])) break; if (sp > XB_SPIN_CAP) { atomicAdd(&bar[XB_TMO], 1u); break; } }
    }
    nloc = mine > 0u ? mine : 1u; nx = cnt > 0u ? cnt : 1u;
}

__device__ __forceinline__ void xcd_barrier(const XcdBarrier& b) {
    asm volatile("s_waitcnt vmcnt(0)" ::: "memory");
    __syncthreads();
    if (threadIdx.x == 0) {
        unsigned* bar = b.bar;
        __builtin_amdgcn_s_waitcnt(0);
        unsigned nloc = b.st[0], nx = b.st[1];
        if (nloc == 0u) { xcd_barrier_complete(bar, b.x, nloc, nx); b.st[0] = nloc; b.st[1] = nx; }
        const unsigned old = xb_add(&bar[XB_XSUB(b.x)], 1u);
        const unsigned gen = old / nloc;
        if (old + 1u == (gen + 1u) * nloc) {
            __builtin_amdgcn_fence(__ATOMIC_RELEASE, "agent");
            asm volatile("s_waitcnt vmcnt(0)" ::: "memory");
            const unsigned og = xb_add(&bar[XB_TOP], 1u);
            const unsigned tg = og / nx;
            if (og + 1u == (tg + 1u) * nx) xb_add(&bar[XB_TOPGEN], 1u);
            else XB_SPIN(xb_ld(&bar[XB_TOPGEN]) == tg, bar);
            __builtin_amdgcn_fence(__ATOMIC_ACQUIRE, "agent");
            xb_add(&bar[XB_XGEN(b.x)], 1u);
            asm volatile("s_waitcnt vmcnt(0)" ::: "memory");
        } else {
            XB_SPIN(xb_ld(&bar[XB_XGEN(b.x)]) == gen, bar);
            __builtin_amdgcn_fence(__ATOMIC_ACQUIRE, "agent");
            asm volatile("s_waitcnt vmcnt(0)" ::: "memory");
        }
    }
    __syncthreads();
}
constexpr int NWAVES = 8;
constexpr int RING_BYTES = 131072, LDSCTL_OFF = 155648, LDS_BYTES = 163840;
struct Args {
    const float* in[22]; float* out; unsigned char* ws; int ph_lo, ph_hi; int use_bar, pad;
};
enum { I_X = 0, I_C, I_CTX, I_CCTX, I_WMOD, I_BMOD, I_NORM1, I_WIN, I_GCONV, I_ALOG, I_DTB, I_GNORM, I_WGK, I_BGK, I_LNORM, I_WOUT, I_NORM2, I_WUP, I_FCONV, I_FCB, I_WDOWN, I_FNORM };


__device__ __forceinline__ void tr_item(const float* src, int ldsrc, int k0, int c0, int ncols, bf16* dst, int lddst, int r0, int kd0, LAS float* scr, int lane) {
    const int cl = lane & 31;
#pragma unroll 8
    for (int i = 0; i < 32; ++i) { const int kk = 2 * i + (lane >> 5); scr[kk * 33 + cl] = cl < ncols ? src[(size_t)(k0 + kk) * ldsrc + c0 + cl] : 0.f; }
    LDS_WAIT(); asm volatile("" ::: "memory");
    const int c = lane & 7;
#pragma unroll
    for (int j = 0; j < 4; ++j) { const int n = (lane >> 3) + 8 * j; const LAS float* s = scr + (8 * c) * 33 + n;
        v4u o; o.x = pk2(s[0 * 33], s[1 * 33]); o.y = pk2(s[2 * 33], s[3 * 33]); o.z = pk2(s[4 * 33], s[5 * 33]); o.w = pk2(s[6 * 33], s[7 * 33]);
        if (n < ncols) *(GAS v4u*)(dst + (size_t)(r0 + n) * lddst + kd0 + 8 * c) = o; }
    LDS_WAIT(); asm volatile("" ::: "memory");
}

__device__ __forceinline__ void phase_p0a(const Args& a, LAS unsigned char* lds, int vcu, int G, int tid, int wave, int lane) {
    unsigned char* ws = a.ws;
    {
        LAS float* sc = (LAS float*)lds;
        LAS float* red = (LAS float*)(lds + 36864);
        bool have = false;
        for (int it = vcu; it < 192; it += G) {
            if (!have) {
                for (int i = tid; i < 9 * 1024; i += 512) { const int s = i >> 10, k = i & 1023; const float v = s < 8 ? a.in[I_C][s * 1024 + k] : a.in[I_CCTX][k]; sc[i] = silu_f(v); }
                __syncthreads(); have = true;
            }
            const int l = it / 96, n0 = (it % 96) * 64;
            const float* W = a.in[I_WMOD] + (size_t)l * 1024 * 6144;
            const int c4 = tid & 15, ks = tid >> 4;
            f32x4 acc[9];
#pragma unroll
            for (int s = 0; s < 9; ++s) acc[s] = (f32x4){0.f, 0.f, 0.f, 0.f};
            for (int j = 0; j < 32; ++j) {
                const int k = ks + 32 * j;
                const f32x4 w = *(const f32x4*)(W + (size_t)k * 6144 + n0 + 4 * c4);
#pragma unroll
                for (int s = 0; s < 9; ++s) acc[s] += w * sc[s * 1024 + k];
            }
#pragma unroll
            for (int s = 0; s < 9; ++s) *(LAS f32x4*)(red + (ks * 9 + s) * 64 + 4 * c4) = acc[s];
            __syncthreads();
            for (int o = tid; o < 576; o += 512) {
                const int s = o >> 6, c = o & 63; float v = 0.f;
                for (int q = 0; q < 32; ++q) v += red[(q * 9 + s) * 64 + c];
                ((float*)(ws + WS_MOD))[((size_t)l * 9 + s) * 6144 + n0 + c] = v + a.in[I_BMOD][l * 6144 + n0 + c];
            }
            __syncthreads();
        }
        __syncthreads();
    }
    {
        LAS float* scr = (LAS float*)(lds + wave * 16384);
        const int gw = vcu * NWAVES + wave, NGW = G * NWAVES;
        constexpr int I_IN = 16 * 112, I_SM = 16 * 2, I_O = 16 * 32, I_U = 16 * 176, I_D = 44 * 32, PER_L = I_IN + I_SM + I_O + I_U + I_D;
        for (int it = gw; it < 2 * PER_L; it += NGW) {
            const int l = it / PER_L; int r = it % PER_L;
            unsigned char* wl = ws + (l == 0 ? WS_W1 : WS_W2);
            if (r < I_IN) { const int kb = r / 112, nb = r % 112, n0 = nb * 32; const int c0 = n0 < 2048 ? n0 : n0 + 16;
                tr_item(a.in[I_WIN] + (size_t)l * 1024 * DINP, DINP, kb * 64, c0, 32, (bf16*)(wl + W_IN), 1024, n0, kb * 64, scr, lane); continue; } r -= I_IN;
            if (r < I_SM) { const int kb = r / 2, part = r % 2;
                tr_item(a.in[I_WIN] + (size_t)l * 1024 * DINP, DINP, kb * 64, part == 0 ? 2048 : 3600, part == 0 ? 16 : 32, (bf16*)(ws + WS_WSM) + (size_t)l * 48 * 1024, 1024, part == 0 ? 0 : 16, kb * 64, scr, lane); continue; } r -= I_SM;
            if (r < I_O) { const int kb = r / 32, nb = r % 32;
                tr_item(a.in[I_WOUT] + (size_t)l * 1024 * 1024, 1024, kb * 64, nb * 32, 32, (bf16*)(wl + W_OUT), 1024, nb * 32, kb * 64, scr, lane); continue; } r -= I_O;
            if (r < I_U) { const int kb = r / 176, nb = r % 176, r0 = nb * 32;
                const int c0 = r0 < 1280 ? r0 : (r0 < 2560 ? 2816 + (r0 - 1280) : (r0 < 4096 ? 1280 + (r0 - 2560) : 2816 + 1280 + (r0 - 4096)));
                tr_item(a.in[I_WUP] + (size_t)l * 1024 * 5632, 5632, kb * 64, c0, 32, (bf16*)(wl + W_UP), 1024, r0, kb * 64, scr, lane); continue; } r -= I_U;
            { const int kb = r / 32, nb = r % 32, k0 = kb * 64;
              if (k0 < FCB) tr_item(a.in[I_WDOWN] + (size_t)l * DFF * 1024, 1024, k0, nb * 32, 32, (bf16*)(wl + W_DB), FCB, nb * 32, k0, scr, lane);
              else          tr_item(a.in[I_WDOWN] + (size_t)l * DFF * 1024, 1024, k0, nb * 32, 32, (bf16*)(wl + W_DA), FCA, nb * 32, k0 - FCB, scr, lane); }
        }
    }
}

__device__ __forceinline__ void xg_rows(const float* xlat, const float* xctx, const float* gain, const float* scl  , bf16* XG, float* rowss, int gw, int NGW, int lane, int mrows) {
    f32x4 g[4];
#pragma unroll
    for (int j = 0; j < 4; ++j) g[j] = *(const f32x4*)(gain + 4 * lane + 256 * j);
#pragma unroll 1
    for (int m0 = gw; m0 < mrows; m0 += 4 * NGW) {
        f32x4 v[4][4];
#pragma unroll
        for (int u = 0; u < 4; ++u) { const int m = m0 + u * NGW; if (m < mrows) { const float* src = m < MLAT ? xlat + (size_t)m * 1024 : xctx + (size_t)(m - MLAT) * 1024;
#pragma unroll
            for (int j = 0; j < 4; ++j) v[u][j] = *(const f32x4*)(src + 4 * lane + 256 * j); } }
#pragma unroll
        for (int u = 0; u < 4; ++u) { const int m = m0 + u * NGW; if (m < mrows) {
            const int s = row_s(m); float ss = 0.f;
#pragma unroll
            for (int j = 0; j < 4; ++j) {
                const int c = 4 * lane + 256 * j; const f32x4 x = v[u][j], sc = *(const f32x4*)(scl + (size_t)s * 6144 + c);
                ss += (x[0] * x[0] + x[1] * x[1]) + (x[2] * x[2] + x[3] * x[3]);
                const f32x4 y = x * g[j] * (sc + 1.0f);
                v2u o; o.x = pk2(y[0], y[1]); o.y = pk2(y[2], y[3]);
                *(GAS v2u*)(XG + (size_t)m * 1024 + c) = o;
            }
            ss = wave_sum(ss);
            if (lane == 0) rowss[m] = ss; } }
    }
}

__device__ __forceinline__ void phase_p0b(const Args& a, LAS unsigned char* lds, int vcu, int G, int tid, int wave, int lane) {
    unsigned char* ws = a.ws;
    const int gw = vcu * NWAVES + wave, NGW = G * NWAVES;
    const float* MOD = (const float*)(ws + WS_MOD);
    constexpr LayerBufs B0 = layer_bufs(0);
    xg_rows(a.in[I_X], a.in[I_CTX], a.in[I_NORM1], MOD + 1 * 1024, (bf16*)bufp(ws, a.out, B0.XG), (float*)(ws + WS_RS1), gw, NGW, lane, MALL);
    LAS float* sh = (LAS float*)lds;
    for (int combo = 0; combo < 4; ++combo) {
        const int l = combo >> 1, which = combo & 1;
        __syncthreads();
        for (int i = tid; i < 9 * 1024; i += 512) sh[i] = MOD[((size_t)l * 9 + (i >> 10)) * 6144 + (which ? 3 : 0) * 1024 + (i & 1023)];
        __syncthreads();
        const int nrows = which ? 5632 : (NMAIN + NSMALL);
        float* SWl = (float*)(ws + WS_SW) + (size_t)l * SW_LAYER;
        unsigned char* wl = ws + (l == 0 ? WS_W1 : WS_W2);
        for (int n = gw; n < nrows; n += NGW) {
            const bf16* wrow; float* dst; int ldd;
            if (which) { wrow = (const bf16*)(wl + W_UP) + (size_t)n * 1024; dst = SWl + 9 * (NMAIN + NSMALL) + n; ldd = 5632; }
            else if (n < NMAIN) { wrow = (const bf16*)(wl + W_IN) + (size_t)n * 1024; dst = SWl + n; ldd = NMAIN; }
            else { wrow = (const bf16*)(ws + WS_WSM) + ((size_t)l * 48 + (n - NMAIN)) * 1024; dst = SWl + 9 * NMAIN + (n - NMAIN); ldd = NSMALL; }
            const v4u w0 = *(const GAS v4u*)(wrow + 8 * lane), w1 = *(const GAS v4u*)(wrow + 512 + 8 * lane);
            float wf[16] = { bflo(w0.x), bfhi(w0.x), bflo(w0.y), bfhi(w0.y), bflo(w0.z), bfhi(w0.z), bflo(w0.w), bfhi(w0.w),
                             bflo(w1.x), bfhi(w1.x), bflo(w1.y), bfhi(w1.y), bflo(w1.z), bfhi(w1.z), bflo(w1.w), bfhi(w1.w) };
#pragma unroll
            for (int s = 0; s < 9; ++s) {
                float acc = 0.f;
#pragma unroll
                for (int j = 0; j < 8; ++j) acc += wf[j] * sh[s * 1024 + 8 * lane + j] + wf[8 + j] * sh[s * 1024 + 512 + 8 * lane + j];
                acc = wave_sum(acc);
                if (lane == 0) dst[(size_t)s * ldd] = acc;
            }
        }
    }
    __syncthreads();
}

__device__ __forceinline__ void skinny_rows(const bf16* XG, const bf16* Wsm  , const float* rowss, const float* sWsm  , float* SM, int gw, int NGW, int lane) {
    const int r = lane & 15, g = lane >> 4;
    for (int t = gw; t < MALL / 16; t += NGW) {
        const int m0 = t * 16;
        f32x4 acc[3];
#pragma unroll
        for (int n = 0; n < 3; ++n) acc[n] = (f32x4){0.f, 0.f, 0.f, 0.f};
        const bf16* ap = XG + (size_t)(m0 + r) * 1024 + 8 * g;
        const bf16* bp = Wsm + (size_t)r * 1024 + 8 * g;
        float rs4[4], sw[4][3];
#pragma unroll
        for (int j = 0; j < 4; ++j) { const int m = m0 + 4 * g + j; rs4[j] = rowss[m]; const int s = row_s(m);
#pragma unroll
            for (int n = 0; n < 3; ++n) sw[j][n] = sWsm[s * 48 + 16 * n + r]; }
#pragma unroll 1
        for (int k0 = 0; k0 < 32; k0 += 4) {
            bf16x8 af[4], bfr[4][3];
#pragma unroll
            for (int kk = 0; kk < 4; ++kk) { af[kk] = *(const GAS bf16x8*)(ap + 32 * (k0 + kk));
#pragma unroll
                for (int n = 0; n < 3; ++n) bfr[kk][n] = *(const GAS bf16x8*)(bp + (size_t)n * 16 * 1024 + 32 * (k0 + kk)); }
#pragma unroll
            for (int kk = 0; kk < 4; ++kk)
#pragma unroll
                for (int n = 0; n < 3; ++n) acc[n] = __builtin_amdgcn_mfma_f32_16x16x32_bf16(af[kk], bfr[kk][n], acc[n], 0, 0, 0);
        }
#pragma unroll
        for (int j = 0; j < 4; ++j) {
            const int m = m0 + 4 * g + j;
            const float rstd = rsqrtf(rs4[j] * (1.0f / 1024.0f) + NEPS);
#pragma unroll
            for (int n = 0; n < 3; ++n) SM[(size_t)m * 48 + 16 * n + r] = acc[n][j] * rstd + sw[j][n];
        }
    }
}
#define MFMA32(a, b, c) __builtin_amdgcn_mfma_f32_32x32x16_bf16((a), (b), (c), 0, 0, 0)
__device__ __forceinline__ int crow(int reg, int h) { return (reg & 3) + 8 * (reg >> 2) + 4 * h; }
__device__ __forceinline__ bf16x8 pack_step(const f32x16& x, int s) {
    v4u p; p.x = pk2(x[8 * s], x[8 * s + 1]); p.y = pk2(x[8 * s + 2], x[8 * s + 3]); p.z = pk2(x[8 * s + 4], x[8 * s + 5]); p.w = pk2(x[8 * s + 6], x[8 * s + 7]);
    return __builtin_bit_cast(bf16x8, p);
}
__device__ __forceinline__ bf16x8 frag_perm(const LAS unsigned char* img, int stride, int row, int col16, int h) {
    const LAS unsigned char* p = img + row * stride + (col16 + 4 * h) * 2;
    const s16x4 lo = *(const LAS s16x4*)p, hi = *(const LAS s16x4*)(p + 16);
    return __builtin_shufflevector(lo, hi, 0, 1, 2, 3, 4, 5, 6, 7);
}
__device__ __forceinline__ bf16x8 frag_nat(const LAS unsigned char* img, int stride, int row, int col16, int h) {
    const LAS unsigned char* p = img + row * stride + (col16 + 8 * h) * 2;
    const s16x4 lo = *(const LAS s16x4*)p, hi = *(const LAS s16x4*)(p + 8);
    return __builtin_shufflevector(lo, hi, 0, 1, 2, 3, 4, 5, 6, 7);
}
__device__ __forceinline__ void unpack8(const v4u w, float* f) {
    f[0] = bflo(w.x); f[1] = bfhi(w.x); f[2] = bflo(w.y); f[3] = bfhi(w.y); f[4] = bflo(w.z); f[5] = bfhi(w.z); f[6] = bflo(w.w); f[7] = bfhi(w.w);
}
__device__ __forceinline__ int chunk_first(int cid) { return cid < 256 ? ((cid & 31) == 0) : ((cid & 3) == 0); }
__device__ __forceinline__ int chunk_last(int cid) { return cid < 256 ? ((cid & 31) == 31) : ((cid & 3) == 3); }

constexpr int GP_Q = 0, GP_K = 16896, GP_RAW = 33792, GP_KK = 33792, GP_QK = 50432, GP_LP = 67584, GP_LPSZ = 8448, GP_GATE = 135168, GP_GSZ = 1536, GP_ST = 264;
__host__ __device__ constexpr int tri_off(int i) { return i == 0 ? 0 : (8 * ((i + 3) / 4) * (((i + 3) / 4) - 1) + 4 * ((i + 3) / 4) * ((i - 1) & 3)); }
__device__ __forceinline__ void gdn_prep_front(const Args& a, LAS unsigned char* lds, int l, int cid, int h, int slot, int tid_in) {
    int tid = tid_in; asm volatile("" : "+v"(tid));
    const int lane = tid & 63, wave = __builtin_amdgcn_readfirstlane(tid >> 6);
    unsigned char* ws = a.ws; const LayerBufs B = layer_bufs(l);
    bf16* GQ = (bf16*)bufp(ws, a.out, B.GQ); bf16* GK = (bf16*)bufp(ws, a.out, B.GK); bf16* GV = (bf16*)bufp(ws, a.out, B.GV);
    const bf16* HALO = (const bf16*)(ws + WS_HALO);
    const int m0 = cid * 64;
    const int first = chunk_first(cid), last = chunk_last(cid);
    LAS unsigned char* raw_s = lds + GP_RAW;
    LAS float* gt = (LAS float*)(lds + GP_GATE + slot * GP_GSZ);
    const int grp = tid >> 4, cg = tid & 15;
    {
        v4u rr[5];
#pragma unroll
        for (int j = 0; j < 5; ++j) {
            const int p = tid + 512 * j; rr[j] = (v4u){0u, 0u, 0u, 0u};
            if (p < 2 * 66 * 16) {
                const int t = p / (66 * 16), rem = p % (66 * 16), r = rem >> 4, c = rem & 15;
                const bf16* base = t == 0 ? GQ : GK;
                if (r == 0) { if (!first) rr[j] = *(const GAS v4u*)(HALO + ((size_t)(cid - 1) * 2 + 1) * 1536 + t * 512 + h * 128 + 8 * c); }
                else if (r == 65) { if (!last) rr[j] = *(const GAS v4u*)(HALO + ((size_t)(cid + 1) * 2 + 0) * 1536 + t * 512 + h * 128 + 8 * c); }
                else rr[j] = *(const GAS v4u*)(base + (size_t)(m0 + r - 1) * 512 + h * 128 + 8 * c);
            }
        }
#pragma unroll
        for (int j = 0; j < 5; ++j) { const int p = tid + 512 * j; if (p < 2 * 66 * 16) *(LAS v4u*)(raw_s + p * 16) = rr[j]; }
    }
    v4u vraw[2][3];
#pragma unroll
    for (int j = 0; j < 2; ++j) {
        const int r = grp + 32 * j;
#pragma unroll
        for (int d = 0; d < 3; ++d) {
            const int rr2 = r - 1 + d; vraw[j][d] = (v4u){0u, 0u, 0u, 0u};
            if (rr2 < 0) { if (!first) vraw[j][d] = *(const GAS v4u*)(HALO + ((size_t)(cid - 1) * 2 + 1) * 1536 + 1024 + h * 128 + 8 * cg); }
            else if (rr2 > 63) { if (!last) vraw[j][d] = *(const GAS v4u*)(HALO + ((size_t)(cid + 1) * 2 + 0) * 1536 + 1024 + h * 128 + 8 * cg); }
            else vraw[j][d] = *(const GAS v4u*)(GV + (size_t)(m0 + rr2) * 512 + h * 128 + 8 * cg);
        }
    }
    float gval = 0.f, bval = 0.f;
    if (tid < 128) {
        const int dir = tid >> 6, i = tid & 63;
        const float* sm = (const float*)(ws + WS_SM) + (size_t)(m0 + i) * 48;
        const float av = sm[dir * 4 + h], bv = sm[8 + dir * 4 + h];
        gval = -__expf(a.in[I_ALOG][l * 8 + dir * 4 + h]) * softplus_f(av + a.in[I_DTB][l * 8 + dir * 4 + h]);
        bval = sigmoid_f(bv);
        float c = gval;
        if (dir == 0) {
#pragma unroll
            for (int o = 1; o < 64; o <<= 1) { const float u = __shfl_up(c, o); if (i >= o) c += u; }
        } else {
#pragma unroll
            for (int o = 1; o < 64; o <<= 1) { const float u = __shfl_down(c, o); if (i + o < 64) c += u; }
        }
        gt[dir * 64 + i] = gval; gt[128 + dir * 64 + i] = bval; gt[256 + dir * 64 + i] = c;
    }
    __syncthreads();
    {
        const float* cw = a.in[I_GCONV] + (size_t)l * 3 * 1536;
#pragma unroll 1
        for (int t = 0; t < 3; ++t)
#pragma unroll
        for (int jj = 0; jj < 2; ++jj) {
            const int r = grp + 32 * jj;
            float x0[8], x1[8], x2[8], y[8];
            if (t < 2) {
                unpack8(*(const LAS v4u*)(raw_s + ((t * 66 + r) * 128 + 8 * cg) * 2), x0);
                unpack8(*(const LAS v4u*)(raw_s + ((t * 66 + r + 1) * 128 + 8 * cg) * 2), x1);
                unpack8(*(const LAS v4u*)(raw_s + ((t * 66 + r + 2) * 128 + 8 * cg) * 2), x2);
            } else { unpack8(vraw[jj][0], x0); unpack8(vraw[jj][1], x1); unpack8(vraw[jj][2], x2); }
            const float* w0 = cw + t * 512 + h * 128 + 8 * cg;
            float ss = 0.f;
#pragma unroll
            for (int e = 0; e < 8; ++e) { const float c = x0[e] * w0[e] + x1[e] * w0[1536 + e] + x2[e] * w0[3072 + e]; y[e] = silu_f(c); ss += y[e] * y[e]; }
            ss += __shfl_xor(ss, 1); ss += __shfl_xor(ss, 2); ss += __shfl_xor(ss, 4); ss += __shfl_xor(ss, 8);
            float sc = 1.f;
            if (t == 0) sc = rsqrtf(ss + 1e-6f) * 0.08838834764831845f; else if (t == 1) sc = rsqrtf(ss + 1e-6f);
            v4u o; o.x = pk2(y[0] * sc, y[1] * sc); o.y = pk2(y[2] * sc, y[3] * sc); o.z = pk2(y[4] * sc, y[5] * sc); o.w = pk2(y[6] * sc, y[7] * sc);
            bf16* base = t == 0 ? GQ : (t == 1 ? GK : GV);
            *(GAS v4u*)(base + (size_t)(m0 + r) * 512 + h * 128 + 8 * cg) = o;
            if (t < 2) { LAS unsigned char* d = lds + (t == 0 ? GP_Q : GP_K) + r * GP_ST + 16 * cg; *(LAS v2u*)d = (v2u){o.x, o.y}; *(LAS v2u*)(d + 8) = (v2u){o.z, o.w}; }
        }
    }
    __syncthreads();
    {
        const int which = wave >> 2, ti = (wave >> 1) & 1, tj = wave & 1, r = lane & 31, hh = lane >> 5;
        f32x16 acc; for (int i = 0; i < 16; ++i) acc[i] = 0.f;
        const LAS unsigned char* Ai = lds + (which ? GP_Q : GP_K); const LAS unsigned char* Bi = lds + GP_K;
#pragma unroll
        for (int s2 = 0; s2 < 8; ++s2) acc = MFMA32(frag_nat(Ai, GP_ST, 32 * ti + r, 16 * s2, hh), frag_nat(Bi, GP_ST, 32 * tj + r, 16 * s2, hh), acc);
        LAS float* dst = (LAS float*)(lds + (which ? GP_QK : GP_KK));
#pragma unroll
        for (int i = 0; i < 16; ++i) dst[(32 * ti + crow(i, hh)) * 65 + 32 * tj + r] = acc[i];
    }
    __syncthreads();
    {
        const LAS float* KK = (const LAS float*)(lds + GP_KK); const LAS float* QK = (const LAS float*)(lds + GP_QK);
        bf16* GTA = (bf16*)bufp(ws, a.out, B.GTA);
#pragma unroll 4
        for (int it = 0; it < 16; ++it) {
            const int p = tid + 512 * it;
            const int dir = p >> 12, ip = (p >> 6) & 63, jp = p & 63;
            const int i = dir ? 63 - ip : ip, j = dir ? 63 - jp : jp;
            if (jp < ip) {
                const float lv = gt[128 + dir * 64 + i] * KK[i * 65 + j] * __expf(gt[256 + dir * 64 + i] - gt[256 + dir * 64 + j]);
                const int q = (ip + 3) >> 2, off = 8 * q * (q - 1) + 4 * q * ((ip - 1) & 3);
                ((LAS float*)(lds + GP_LP + (slot * 2 + dir) * GP_LPSZ))[off + jp] = lv;
            }
            const bool keep = dir ? (jp >= ip) : (jp <= ip);
            const float av = keep ? QK[ip * 65 + jp] * __expf(gt[256 + dir * 64 + ip] - gt[256 + dir * 64 + jp]) : 0.f;
            GTA[(((size_t)dir * NCHUNK + cid) * 4 + h) * 8192 + ip * 128 + 64 + jp] = (bf16)(pk2(av, 0.f) & 0xffffu);
        }
        if (tid < 128) {
            const int dir = tid >> 6, i = tid & 63;
            float* E = (float*)(ws + WS_GDEC);
            const float gc = gt[256 + dir * 64 + i], gl = gt[256 + dir * 64 + (dir ? 0 : 63)];
            E[(((size_t)dir * NCHUNK + cid) * 4 + h) * 64 + i] = __expf(gc);
            E[(size_t)2 * NCHUNK * 4 * 64 + (((size_t)dir * NCHUNK + cid) * 4 + h) * 64 + i] = __expf(gl - gc);
            if (i == 0) E[(size_t)4 * NCHUNK * 4 * 64 + ((size_t)dir * NCHUNK + cid) * 4 + h] = __expf(gl);
        }
    }
    __syncthreads();
}
__device__ __forceinline__ void gdn_prep_invert(const Args& a, LAS unsigned char* lds, int l, int cid, int h, int slot, int dir, int lane_in) {
    int lane = lane_in; asm volatile("" : "+v"(lane));
    const LAS float* Lp = (const LAS float*)(lds + GP_LP + (slot * 2 + dir) * GP_LPSZ);
    const LAS float* gt = (const LAS float*)(lds + GP_GATE + slot * GP_GSZ);
    const int jo = dir ? 63 - lane : lane;
    const float bj = gt[128 + dir * 64 + jo];
    const LayerBufs B = layer_bufs(l);
    bf16* gp = (bf16*)bufp(a.ws, a.out, B.GTA) + (((size_t)dir * NCHUNK + cid) * 4 + h) * 8192 + jo + (dir ? 63 * 128 : 0);
    const int rstep = dir ? -128 : 128;
    float t[64];
    f32x4 bA[16];
#pragma unroll
    for (int i = 0; i < 64; ++i) {
#pragma unroll
        for (int q = 0; q < (i + 3) / 4; ++q) bA[q] = *(const LAS f32x4*)(Lp + tri_off(i) + 4 * q);
        float a0 = (lane == i) ? 1.f : 0.f, a1 = 0.f, a2 = 0.f, a3 = 0.f;
#pragma unroll
        for (int q = 0; q < (i + 3) / 4; ++q) {
            a0 -= bA[q][0] * t[4 * q];
            if (4 * q + 1 < i) a1 -= bA[q][1] * t[4 * q + 1];
            if (4 * q + 2 < i) a2 -= bA[q][2] * t[4 * q + 2];
            if (4 * q + 3 < i) a3 -= bA[q][3] * t[4 * q + 3];
        }
        t[i] = (a0 + a1) + (a2 + a3);
        *gp = (bf16)(pk2(t[i] * bj, 0.f) & 0xffffu); gp += rstep;
        asm volatile("" ::: "memory");
    }
}

constexpr int LP_GK = 0, LP_QG = 33280, LP_KI = 51712, LP_LR = 70144, LP_W = 78336, LP_B = 86528, LP_GL = 87040, LP_QR = 87552, LP_KR = 95744, LP_ST = 144;
__device__ __forceinline__ void gla_prep_unit(const Args& a, LAS unsigned char* lds, int l, int cid, int h, int tid_in) {
    int tid = tid_in; asm volatile("" : "+v"(tid));
    const int lane = tid & 63, wave = __builtin_amdgcn_readfirstlane(tid >> 6);
    unsigned char* ws = a.ws; const LayerBufs B = layer_bufs(l);
    const int m0 = cid * 64;
    LAS float* gk = (LAS float*)(lds + LP_GK); LAS float* lr = (LAS float*)(lds + LP_LR); LAS float* Wv = (LAS float*)(lds + LP_W); LAS float* bs = (LAS float*)(lds + LP_B); LAS float* gl = (LAS float*)(lds + LP_GL);
    {
        float lrv[4], wv[4]; v4u qk;
#pragma unroll
        for (int j = 0; j < 4; ++j) { const int p = tid + 512 * j; lrv[j] = ((const float*)(ws + WS_SM))[(size_t)(m0 + (p >> 5)) * 48 + 16 + (p & 31)]; }
#pragma unroll
        for (int j = 0; j < 4; ++j) { const int p = tid + 512 * j; const int dir = p >> 10, rk = (p >> 6) & 15, c = p & 63; wv[j] = a.in[I_WGK][(((size_t)l * 2 + dir) * 16 + rk) * 256 + h * 64 + c]; }
        { const int t = tid >> 8, p = tid & 255, i = p >> 2, c8 = p & 3;
          (void)c8; (void)i; (void)t; }
        const bf16* LQ = (const bf16*)bufp(ws, a.out, B.LQ); const bf16* LK = (const bf16*)bufp(ws, a.out, B.LK);
        const int i = tid >> 3, c8 = tid & 7;
        const v4u qv = *(const GAS v4u*)(LQ + (size_t)(m0 + i) * 256 + h * 64 + 8 * c8), kv = *(const GAS v4u*)(LK + (size_t)(m0 + i) * 256 + h * 64 + 8 * c8);
        float bsv = 0.f; if (tid < 128) bsv = a.in[I_BGK][((size_t)l * 2 + (tid >> 6)) * 256 + h * 64 + (tid & 63)];
#pragma unroll
        for (int j = 0; j < 4; ++j) { lr[tid + 512 * j] = lrv[j]; Wv[tid + 512 * j] = wv[j]; }
        *(LAS v4u*)(lds + LP_QR + i * 128 + 16 * c8) = qv; *(LAS v4u*)(lds + LP_KR + i * 128 + 16 * c8) = kv;
        if (tid < 128) bs[tid] = bsv;
        (void)qk;
    }
    __syncthreads();
#pragma unroll 4
    for (int it = 0; it < 16; ++it) {
        const int p = tid + 512 * it;
        const int dir = p >> 12, i = (p >> 6) & 63, c = p & 63;
        float acc = bs[dir * 64 + c];
#pragma unroll
        for (int rk = 0; rk < 16; ++rk) acc += lr[i * 32 + dir * 16 + rk] * Wv[(dir * 16 + rk) * 64 + c];
        gk[(dir * 64 + i) * 65 + c] = -softplus_f(-acc) * (1.0f / 16.0f);
    }
    __syncthreads();
    if (tid < 128) {
        const int dir = tid >> 6, c = tid & 63;
        float v[64];
#pragma unroll
        for (int i = 0; i < 64; ++i) v[i] = gk[(dir * 64 + i) * 65 + c];
        float s = 0.f;
        if (dir == 0) {
#pragma unroll
            for (int i = 0; i < 64; ++i) { s += v[i]; v[i] = s; }
        } else {
#pragma unroll
            for (int i = 63; i >= 0; --i) { s += v[i]; v[i] = s; }
        }
#pragma unroll
        for (int i = 0; i < 64; ++i) gk[(dir * 64 + i) * 65 + c] = v[i];
        gl[dir * 64 + c] = s;
        ((float*)(ws + WS_LDEC))[(((size_t)dir * NCHUNK + cid) * 4 + h) * 64 + c] = __expf(s);
    }
    __syncthreads();
    {
#pragma unroll
        for (int it = 0; it < 2; ++it) {
            const int p = tid + 512 * it, dir = p >> 9, i = (p >> 3) & 63, c8 = p & 7;
            float q[8], k[8];
            unpack8(*(const LAS v4u*)(lds + LP_QR + i * 128 + 16 * c8), q); unpack8(*(const LAS v4u*)(lds + LP_KR + i * 128 + 16 * c8), k);
            float qg[8], ki[8];
#pragma unroll
            for (int e = 0; e < 8; ++e) { const float gc = gk[(dir * 64 + i) * 65 + 8 * c8 + e]; qg[e] = q[e] * 0.125f * __expf(gc); ki[e] = k[e] * __expf(-gc); }
            v4u oq, ok; oq.x = pk2(qg[0], qg[1]); oq.y = pk2(qg[2], qg[3]); oq.z = pk2(qg[4], qg[5]); oq.w = pk2(qg[6], qg[7]);
            ok.x = pk2(ki[0], ki[1]); ok.y = pk2(ki[2], ki[3]); ok.z = pk2(ki[4], ki[5]); ok.w = pk2(ki[6], ki[7]);
            *(LAS v4u*)(lds + LP_QG + dir * 9216 + i * LP_ST + 16 * c8) = oq; *(LAS v4u*)(lds + LP_KI + dir * 9216 + i * LP_ST + 16 * c8) = ok;
            bf16* blk = (bf16*)bufp(ws, a.out, dir ? B.LOP1 : B.LOP0) + ((size_t)cid * 4 + h) * 12288;
            *(GAS v4u*)(blk + i * 64 + 8 * c8) = oq;
        }
#pragma unroll
        for (int it = 0; it < 2; ++it) {
            const int p = tid + 512 * it, dir = p >> 9, c = (p >> 3) & 63, ig = p & 7;
            const float glc = gl[dir * 64 + c];
            float kd[8];
#pragma unroll
            for (int e = 0; e < 8; ++e) { const int i = 8 * ig + e; kd[e] = bf2f(*(const LAS bf16*)(lds + LP_KR + i * 128 + 2 * c)) * __expf(glc - gk[(dir * 64 + i) * 65 + c]); }
            v4u o; o.x = pk2(kd[0], kd[1]); o.y = pk2(kd[2], kd[3]); o.z = pk2(kd[4], kd[5]); o.w = pk2(kd[6], kd[7]);
            bf16* blk = (bf16*)bufp(ws, a.out, dir ? B.LOP1 : B.LOP0) + ((size_t)cid * 4 + h) * 12288;
            *(GAS v4u*)(blk + 4096 + c * 64 + 8 * ig) = o;
        }
    }
    __syncthreads();
    {
        const int dir = wave >> 2, ti = (wave >> 1) & 1, tj = wave & 1, r = lane & 31, hh = lane >> 5;
        f32x16 acc; for (int i = 0; i < 16; ++i) acc[i] = 0.f;
        const LAS unsigned char* Ai = lds + LP_QG + dir * 9216; const LAS unsigned char* Bi = lds + LP_KI + dir * 9216;
#pragma unroll
        for (int s2 = 0; s2 < 4; ++s2) acc = MFMA32(frag_nat(Ai, LP_ST, 32 * ti + r, 16 * s2, hh), frag_nat(Bi, LP_ST, 32 * tj + r, 16 * s2, hh), acc);
        bf16* blk = (bf16*)bufp(ws, a.out, dir ? B.LOP1 : B.LOP0) + ((size_t)cid * 4 + h) * 12288 + 8192;
#pragma unroll
        for (int i = 0; i < 16; ++i) {
            const int io = 32 * ti + crow(i, hh), jo = 32 * tj + r;
            const bool keep = dir ? (jo >= io) : (jo <= io);
            blk[io * 64 + jo] = (bf16)(pk2(keep ? acc[i] : 0.f, 0.f) & 0xffffu);
        }
    }
    __syncthreads();
}

__device__ __forceinline__ void phase_prep(const Args& a, LAS unsigned char* lds, int l, int vcu, int G, int tid, int wave, int lane) {
    if (!(a.pad & 1))
    for (int j0 = 0; vcu + G * j0 < NCHUNK * 4; j0 += 4) {
        int nb = 0;
        for (int j = 0; j < 4; ++j) { const int it = vcu + G * (j0 + j); if (it < NCHUNK * 4) { gdn_prep_front(a, lds, l, it >> 2, it & 3, j, tid); nb = j + 1; } }
        const int slot = wave >> 1, dir = wave & 1;
        if (slot < nb && !(a.pad & 4)) { const int it = vcu + G * (j0 + slot); const int nrep = (a.pad & 8) ? 2 : 1;
#pragma unroll 1
            for (int rep = 0; rep < nrep; ++rep) gdn_prep_invert(a, lds, l, it >> 2, it & 3, slot, dir, lane); }
        __syncthreads();
    }
    if (!(a.pad & 2))
    for (int it = vcu; it < NCHUNK * 4; it += G) gla_prep_unit(a, lds, l, it >> 2, it & 3, tid);
}

__device__ __forceinline__ int chain_cid(int b, int dir, int step) {
    if (step < 4) return 256 + 4 * b + (dir ? 3 - step : step);
    const int n = step - 4; return 32 * b + (dir ? 31 - n : n);
}
constexpr int GS_K = 0, GS_Q = 16896, GS_KT = 33792, GS_VT = 51200, GS_TB = 68608, GS_AT = 77312, GS_E1 = 86016, GS_E2 = 86272, GS_E3 = 86528;
__device__ __forceinline__ void gdn_scan_chain(const Args& a, LAS unsigned char* lds, int l, int b, int h, int dir, int tid_in, int wave_in, int lane_in) {
    int tid = tid_in; asm volatile("" : "+v"(tid));
    const int lane = tid & 63, wave = __builtin_amdgcn_readfirstlane(tid >> 6);
    unsigned char* ws = a.ws; const LayerBufs B = layer_bufs(l);
    const bf16* GQ = (const bf16*)bufp(ws, a.out, B.GQ); const bf16* GK = (const bf16*)bufp(ws, a.out, B.GK); const bf16* GV = (const bf16*)bufp(ws, a.out, B.GV);
    bf16* GTA = (bf16*)bufp(ws, a.out, B.GTA);
    const float* E = (const float*)(ws + WS_GDEC);
    const bool loader = wave >= 4;
    const int lt = tid - 256, li = lt & 63, lc = lt >> 6;
    const int r = lane & 31, hh = lane >> 5, w = wave;
    v4u rq[4], rk[4], rv[4], rt[4]; float re1 = 0.f, re2 = 0.f, re3 = 0.f;
    auto issue_loads = [&](int cid) {
        const size_t m = (size_t)cid * 64 + li;
        const bf16* ta = GTA + (((size_t)dir * NCHUNK + cid) * 4 + h) * 8192 + li * 128;
#pragma unroll
        for (int q = 0; q < 4; ++q) {
            const int cg = lc + 4 * q;
            rq[q] = *(const GAS v4u*)(GQ + m * 512 + h * 128 + 8 * cg);
            rk[q] = *(const GAS v4u*)(GK + m * 512 + h * 128 + 8 * cg);
            rv[q] = *(const GAS v4u*)(GV + m * 512 + h * 128 + 8 * cg);
            rt[q] = *(const GAS v4u*)(ta + 8 * cg);
        }
        if (lc == 0) { const size_t eo = (((size_t)dir * NCHUNK + cid) * 4 + h) * 64 + li; re1 = E[eo]; re2 = E[(size_t)2 * NCHUNK * 4 * 64 + eo];
                       re3 = E[(size_t)4 * NCHUNK * 4 * 64 + ((size_t)dir * NCHUNK + cid) * 4 + h]; }
    };
    auto write_lds = [&]() {
#pragma unroll
        for (int q = 0; q < 4; ++q) {
            const int cg = lc + 4 * q;
            *(LAS v2u*)(lds + GS_Q + li * 264 + 16 * cg) = (v2u){rq[q].x, rq[q].y}; *(LAS v2u*)(lds + GS_Q + li * 264 + 16 * cg + 8) = (v2u){rq[q].z, rq[q].w};
            *(LAS v2u*)(lds + GS_K + li * 264 + 16 * cg) = (v2u){rk[q].x, rk[q].y}; *(LAS v2u*)(lds + GS_K + li * 264 + 16 * cg + 8) = (v2u){rk[q].z, rk[q].w};
            const unsigned kw[4] = {rk[q].x, rk[q].y, rk[q].z, rk[q].w}, vw[4] = {rv[q].x, rv[q].y, rv[q].z, rv[q].w};
#pragma unroll
            for (int e = 0; e < 4; ++e) {
                *(LAS bf16*)(lds + GS_KT + (8 * cg + 2 * e) * 136 + 2 * li) = (bf16)(kw[e] & 0xffffu); *(LAS bf16*)(lds + GS_KT + (8 * cg + 2 * e + 1) * 136 + 2 * li) = (bf16)(kw[e] >> 16);
                *(LAS bf16*)(lds + GS_VT + (8 * cg + 2 * e) * 136 + 2 * li) = (bf16)(vw[e] & 0xffffu); *(LAS bf16*)(lds + GS_VT + (8 * cg + 2 * e + 1) * 136 + 2 * li) = (bf16)(vw[e] >> 16);
            }
            LAS unsigned char* tdst = lds + (cg < 8 ? GS_TB + li * 136 + 16 * cg : GS_AT + li * 136 + 16 * (cg - 8));
            *(LAS v2u*)tdst = (v2u){rt[q].x, rt[q].y}; *(LAS v2u*)(tdst + 8) = (v2u){rt[q].z, rt[q].w};
        }
        if (lc == 0) { ((LAS float*)(lds + GS_E1))[li] = re1; ((LAS float*)(lds + GS_E2))[li] = re2; if (li == 0) ((LAS float*)(lds + GS_E3))[0] = re3; }
    };

    __syncthreads();
    if (loader) {
        issue_loads(chain_cid(b, dir, 0)); write_lds();
        __syncthreads();
#pragma unroll 1
        for (int step = 0; step < 36; ++step) {
            if (step + 1 < 36) issue_loads(chain_cid(b, dir, step + 1));
            __syncthreads();
            if (step + 1 < 36) write_lds();
            __syncthreads();
        }
    } else {
        f32x16 S[4];
#pragma unroll
        for (int mt = 0; mt < 4; ++mt) for (int i = 0; i < 16; ++i) S[mt][i] = 0.f;
        __syncthreads();
#pragma unroll 1
        for (int step = 0; step < 36; ++step) {
            const int cid = chain_cid(b, dir, step);
            const LAS float* e1s = (const LAS float*)(lds + GS_E1); const LAS float* e2s = (const LAS float*)(lds + GS_E2);
            const float e3 = ((const LAS float*)(lds + GS_E3))[0];
            f32x16 Z[2], Q[2];
#pragma unroll
            for (int it = 0; it < 2; ++it) for (int i = 0; i < 16; ++i) { Z[it][i] = 0.f; Q[it][i] = 0.f; }
#pragma unroll
            for (int mt = 0; mt < 4; ++mt)
#pragma unroll
                for (int s = 0; s < 2; ++s) {
                    const bf16x8 sb = pack_step(S[mt], s);
#pragma unroll
                    for (int it = 0; it < 2; ++it) {
                        Z[it] = MFMA32(frag_perm(lds + GS_K, 264, 32 * it + r, 32 * mt + 16 * s, hh), sb, Z[it]);
                        Q[it] = MFMA32(frag_perm(lds + GS_Q, 264, 32 * it + r, 32 * mt + 16 * s, hh), sb, Q[it]);
                    }
                }
#pragma unroll
            for (int it = 0; it < 2; ++it)
#pragma unroll
                for (int g = 0; g < 4; ++g) {
                    const f32x4 ev = *(const LAS f32x4*)(e1s + 32 * it + 8 * g + 4 * hh);
                    const v2u vv = *(const LAS v2u*)(lds + GS_VT + (32 * w + r) * 136 + 2 * (32 * it + 8 * g + 4 * hh));
                    Z[it][4 * g] = bflo(vv.x) - ev[0] * Z[it][4 * g]; Z[it][4 * g + 1] = bfhi(vv.x) - ev[1] * Z[it][4 * g + 1];
                    Z[it][4 * g + 2] = bflo(vv.y) - ev[2] * Z[it][4 * g + 2]; Z[it][4 * g + 3] = bfhi(vv.y) - ev[3] * Z[it][4 * g + 3];
                    Q[it][4 * g] *= ev[0]; Q[it][4 * g + 1] *= ev[1]; Q[it][4 * g + 2] *= ev[2]; Q[it][4 * g + 3] *= ev[3];
                }
            f32x16 Vn[2];
#pragma unroll
            for (int it = 0; it < 2; ++it) for (int i = 0; i < 16; ++i) Vn[it][i] = 0.f;
#pragma unroll
            for (int kt = 0; kt < 2; ++kt)
#pragma unroll
                for (int s = 0; s < 2; ++s) {
                    const bf16x8 rb = pack_step(Z[kt], s);
#pragma unroll
                    for (int it = 0; it < 2; ++it) Vn[it] = MFMA32(frag_perm(lds + GS_TB, 136, 32 * it + r, 32 * kt + 16 * s, hh), rb, Vn[it]);
                }
#pragma unroll
            for (int kt = 0; kt < 2; ++kt)
#pragma unroll
                for (int s = 0; s < 2; ++s) {
                    const bf16x8 vb = pack_step(Vn[kt], s);
#pragma unroll
                    for (int it = 0; it < 2; ++it) Q[it] = MFMA32(frag_perm(lds + GS_AT, 136, 32 * it + r, 32 * kt + 16 * s, hh), vb, Q[it]);
                }
            {
                bf16* ob = GTA + (((size_t)dir * NCHUNK + cid) * 4 + h) * 8192 + 32 * w + r;
#pragma unroll
                for (int it = 0; it < 2; ++it)
#pragma unroll
                    for (int i = 0; i < 16; ++i) ob[(32 * it + crow(i, hh)) * 128] = (bf16)(pk2(Q[it][i], 0.f) & 0xffffu);
            }
#pragma unroll
            for (int it = 0; it < 2; ++it)
#pragma unroll
                for (int g = 0; g < 4; ++g) {
                    const f32x4 ev = *(const LAS f32x4*)(e2s + 32 * it + 8 * g + 4 * hh);
                    Vn[it][4 * g] *= ev[0]; Vn[it][4 * g + 1] *= ev[1]; Vn[it][4 * g + 2] *= ev[2]; Vn[it][4 * g + 3] *= ev[3];
                }
#pragma unroll
            for (int mt = 0; mt < 4; ++mt) for (int i = 0; i < 16; ++i) S[mt][i] *= e3;
#pragma unroll
            for (int kt = 0; kt < 2; ++kt)
#pragma unroll
                for (int s = 0; s < 2; ++s) {
                    const bf16x8 vb = pack_step(Vn[kt], s);
#pragma unroll
                    for (int mt = 0; mt < 4; ++mt) S[mt] = MFMA32(frag_perm(lds + GS_KT, 136, 32 * mt + r, 32 * kt + 16 * s, hh), vb, S[mt]);
                }
            __syncthreads();
            __syncthreads();
        }
    }
}

constexpr int LS_QG = 0, LS_KD = 8704, LS_AT = 17408, LS_VT = 26112, LS_E3 = 43520;
__device__ __forceinline__ void gla_scan_chain(const Args& a, LAS unsigned char* lds, int l, int b, int h, int dir, int tid_in, int wave_in, int lane_in) {
    int tid = tid_in; asm volatile("" : "+v"(tid));
    const int lane = tid & 63, wave = __builtin_amdgcn_readfirstlane(tid >> 6);
    unsigned char* ws = a.ws; const LayerBufs B = layer_bufs(l);
    bf16* LOP = (bf16*)bufp(ws, a.out, dir ? B.LOP1 : B.LOP0);
    const bf16* LV = (const bf16*)bufp(ws, a.out, B.LV);
    const float* E = (const float*)(ws + WS_LDEC);
    const bool loader = wave >= 4;
    const int lt = tid - 256, li = lt & 63, lc = lt >> 6;
    const int r = lane & 31, hh = lane >> 5, w = wave;
    v4u ro[6], rv[4]; float re3 = 0.f;
    auto issue_loads = [&](int cid) {
        const bf16* blk = LOP + ((size_t)cid * 4 + h) * 12288;
#pragma unroll
        for (int q = 0; q < 6; ++q) { const int pc = lc + 4 * q, mat = pc >> 3, cg = pc & 7; ro[q] = *(const GAS v4u*)(blk + mat * 4096 + li * 64 + 8 * cg); }
#pragma unroll
        for (int q = 0; q < 4; ++q) { const int cg = lc + 4 * q; rv[q] = *(const GAS v4u*)(LV + ((size_t)cid * 64 + li) * 512 + h * 128 + 8 * cg); }
        if (lc == 0) re3 = E[(((size_t)dir * NCHUNK + cid) * 4 + h) * 64 + li];
    };
    auto write_lds = [&]() {
#pragma unroll
        for (int q = 0; q < 6; ++q) { const int pc = lc + 4 * q, mat = pc >> 3, cg = pc & 7;
            LAS unsigned char* d = lds + mat * 8704 + li * 136 + 16 * cg; *(LAS v2u*)d = (v2u){ro[q].x, ro[q].y}; *(LAS v2u*)(d + 8) = (v2u){ro[q].z, ro[q].w}; }
#pragma unroll
        for (int q = 0; q < 4; ++q) { const int cg = lc + 4 * q; const unsigned vw[4] = {rv[q].x, rv[q].y, rv[q].z, rv[q].w};
#pragma unroll
            for (int e = 0; e < 4; ++e) { *(LAS bf16*)(lds + LS_VT + (8 * cg + 2 * e) * 136 + 2 * li) = (bf16)(vw[e] & 0xffffu); *(LAS bf16*)(lds + LS_VT + (8 * cg + 2 * e + 1) * 136 + 2 * li) = (bf16)(vw[e] >> 16); } }
        if (lc == 0) ((LAS float*)(lds + LS_E3))[li] = re3;
    };
    __syncthreads();
    if (loader) {
        issue_loads(chain_cid(b, dir, 0)); write_lds();
        __syncthreads();
#pragma unroll 1
        for (int step = 0; step < 36; ++step) {
            if (step + 1 < 36) issue_loads(chain_cid(b, dir, step + 1));
            __syncthreads();
            if (step + 1 < 36) write_lds();
            __syncthreads();
        }
    } else {
        f32x16 S[2];
#pragma unroll
        for (int mt = 0; mt < 2; ++mt) for (int i = 0; i < 16; ++i) S[mt][i] = 0.f;
        __syncthreads();
#pragma unroll 1
        for (int step = 0; step < 36; ++step) {
            const int cid = chain_cid(b, dir, step);
            const LAS float* e3s = (const LAS float*)(lds + LS_E3);
            f32x16 O[2];
#pragma unroll
            for (int it = 0; it < 2; ++it) for (int i = 0; i < 16; ++i) O[it][i] = 0.f;
#pragma unroll
            for (int mt = 0; mt < 2; ++mt)
#pragma unroll
                for (int s = 0; s < 2; ++s) {
                    const bf16x8 sb = pack_step(S[mt], s);
#pragma unroll
                    for (int it = 0; it < 2; ++it) O[it] = MFMA32(frag_perm(lds + LS_QG, 136, 32 * it + r, 32 * mt + 16 * s, hh), sb, O[it]);
                }
#pragma unroll
            for (int mt = 0; mt < 2; ++mt)
#pragma unroll
                for (int g = 0; g < 4; ++g) {
                    const f32x4 ev = *(const LAS f32x4*)(e3s + 32 * mt + 8 * g + 4 * hh);
                    S[mt][4 * g] *= ev[0]; S[mt][4 * g + 1] *= ev[1]; S[mt][4 * g + 2] *= ev[2]; S[mt][4 * g + 3] *= ev[3];
                }
#pragma unroll
            for (int kt = 0; kt < 2; ++kt)
#pragma unroll
                for (int s = 0; s < 2; ++s) {
                    const bf16x8 vb = frag_nat(lds + LS_VT, 136, 32 * w + r, 32 * kt + 16 * s, hh);
#pragma unroll
                    for (int it = 0; it < 2; ++it) O[it] = MFMA32(frag_nat(lds + LS_AT, 136, 32 * it + r, 32 * kt + 16 * s, hh), vb, O[it]);
#pragma unroll
                    for (int mt = 0; mt < 2; ++mt) S[mt] = MFMA32(frag_nat(lds + LS_KD, 136, 32 * mt + r, 32 * kt + 16 * s, hh), vb, S[mt]);
                }
            bf16* ob = LOP + ((size_t)cid * 4 + h) * 12288 + 32 * w + r;
#pragma unroll
            for (int it = 0; it < 2; ++it)
#pragma unroll
                for (int i = 0; i < 16; ++i) ob[(32 * it + crow(i, hh)) * 128] = (bf16)(pk2(O[it][i], 0.f) & 0xffffu);
            __syncthreads();
            __syncthreads();
        }
    }
}

__device__ __forceinline__ void phase_scan(const Args& a, LAS unsigned char* lds, int l, int vcu, int G, int tid, int wave, int lane) {
    for (int ch = vcu; ch < 128; ch += G) {
        const int dir = ch & 1, h = (ch >> 1) & 3, b = (ch >> 3) & 7;
        if (ch < 64) gdn_scan_chain(a, lds, l, b, h, dir, tid, wave, lane);
        else gla_scan_chain(a, lds, l, b, h, dir, tid, wave, lane);
    }
}

__device__ __forceinline__ void phase_merge(const Args& a, int l, int gw, int NGW, int lane) {
    unsigned char* ws = a.ws; const LayerBufs B = layer_bufs(l);
    const bf16* GTA = (const bf16*)bufp(ws, a.out, B.GTA); const bf16* L0 = (const bf16*)bufp(ws, a.out, B.LOP0); const bf16* L1 = (const bf16*)bufp(ws, a.out, B.LOP1);
    const bf16* ZA = (const bf16*)bufp(ws, a.out, B.ZA); const bf16* ZB = (const bf16*)bufp(ws, a.out, B.ZB);
    bf16* Y = (bf16*)bufp(ws, a.out, B.Y);
    const int mrows = l == DEPTH - 1 ? MLAT : MALL;
    const int grp = lane >> 4, cg = lane & 15;
    const float* gnA = a.in[I_GNORM] + l * 128; const float* gnB = a.in[I_LNORM] + l * 128;
    float gA[8], gB[8];
#pragma unroll
    for (int e = 0; e < 8; ++e) { gA[e] = gnA[8 * cg + e]; gB[e] = gnB[8 * cg + e]; }
    constexpr int UN = 4;
#pragma unroll 1
    for (int it0 = gw * 4 + grp; it0 < mrows * 8; it0 += NGW * 4 * UN) {
        v4u r0[UN], r1[UN], rz[UN];
#pragma unroll
        for (int u = 0; u < UN; ++u) {
            const int it = it0 + u * NGW * 4;
            r0[u] = (v4u){0u, 0u, 0u, 0u}; r1[u] = r0[u]; rz[u] = r0[u];
            if (it < mrows * 8) {
                const int m = it >> 3, hs = it & 7, cid = m >> 6, i = m & 63;
                const bf16 *o0, *o1, *zp;
                if (hs < 4) { o0 = GTA + (((size_t)0 * NCHUNK + cid) * 4 + hs) * 8192 + i * 128; o1 = GTA + (((size_t)1 * NCHUNK + cid) * 4 + hs) * 8192 + i * 128; zp = ZA + (size_t)m * 512 + hs * 128; }
                else { const int h2 = hs - 4; o0 = L0 + ((size_t)cid * 4 + h2) * 12288 + i * 128; o1 = L1 + ((size_t)cid * 4 + h2) * 12288 + i * 128; zp = ZB + (size_t)m * 512 + h2 * 128; }
                r0[u] = *(const GAS v4u*)(o0 + 8 * cg); r1[u] = *(const GAS v4u*)(o1 + 8 * cg); rz[u] = *(const GAS v4u*)(zp + 8 * cg);
            }
        }
#pragma unroll
        for (int u = 0; u < UN; ++u) {
            const int it = it0 + u * NGW * 4;
            if (it < mrows * 8) {
                const int m = it >> 3, hs = it & 7;
                float f0[8], f1[8], z[8];
                unpack8(r0[u], f0); unpack8(r1[u], f1); unpack8(rz[u], z);
                float ss = 0.f;
#pragma unroll
                for (int e = 0; e < 8; ++e) { f0[e] += f1[e]; ss += f0[e] * f0[e]; }
                ss += __shfl_xor(ss, 1); ss += __shfl_xor(ss, 2); ss += __shfl_xor(ss, 4); ss += __shfl_xor(ss, 8);
                const float rstd = rsqrtf(ss * (1.0f / 128.0f) + NEPS);
                float y[8];
#pragma unroll
                for (int e = 0; e < 8; ++e) y[e] = f0[e] * rstd * (hs < 4 ? gA[e] : gB[e]) * silu_f(z[e]);
                v4u o; o.x = pk2(y[0], y[1]); o.y = pk2(y[2], y[3]); o.z = pk2(y[4], y[5]); o.w = pk2(y[6], y[7]);
                *(GAS v4u*)(Y + (size_t)m * 1024 + hs * 128 + 8 * cg) = o;
            }
        }
    }
}
constexpr int CV_W = 0  , CV_B = 2304  , CV_T = 2560;
__device__ __forceinline__ void conv_unit(const Args& a, LAS unsigned char* lds, int l, const bf16* U, bf16* Gd, int Fc, int f0, int unit, int nslab, int tid_in) {
    int tid = tid_in; asm volatile("" : "+v"(tid));
    const int slab = unit % nslab, rest = unit / nslab;
    const bool isctx = rest >= 32;
    const int b = isctx ? rest - 32 : rest >> 2, gy0 = isctx ? 0 : (rest & 3) * 8;
    const int W = isctx ? 256 : 64, NR = isctx ? 1 : 8, HR = isctx ? 0 : 1, TR = NR + 2 * HR, TW = W + 2;
    const int mbase = isctx ? MLAT + b * 256 : b * 2048;
    const int fl = slab * 32;
    LAS float* wsm = (LAS float*)(lds + CV_W); LAS float* bsm = (LAS float*)(lds + CV_B); LAS unsigned char* tile = lds + CV_T;
    __syncthreads();
    for (int p = tid; p < 9 * 64; p += 512) { const int tap = p >> 6, av = (p >> 5) & 1, c = p & 31; wsm[p] = a.in[I_FCONV][((size_t)l * 9 + tap) * 5632 + av * DFF + f0 + fl + c]; }
    if (tid < 64) bsm[tid] = a.in[I_FCB][(size_t)l * 5632 + (tid >> 5) * DFF + f0 + fl + (tid & 31)];
    const int ncell = TR * TW;
    {
        v4u rr[11];
#pragma unroll
        for (int j = 0; j < 11; ++j) {
            const int p = tid + 512 * j; rr[j] = (v4u){0u, 0u, 0u, 0u};
            if (p < ncell * 8) {
                const int cell = p >> 3, pc = p & 7, tr = cell / TW, tc = cell - tr * TW;
                const int gy = gy0 - HR + tr, gx = tc - 1;
                if (gx >= 0 && gx < W && gy >= 0 && gy < (isctx ? 1 : 32)) {
                    const size_t m = (size_t)mbase + gy * W + gx;
                    rr[j] = *(const GAS v4u*)(U + m * (2 * Fc) + (pc >> 2) * Fc + fl + 8 * (pc & 3));
                }
            }
        }
#pragma unroll
        for (int j = 0; j < 11; ++j) { const int p = tid + 512 * j; if (p < ncell * 8) *(LAS v4u*)(tile + p * 16) = rr[j]; }
    }
    __syncthreads();
#pragma unroll 1
    for (int it = tid; it < NR * W * 4; it += 512) {
        const int cg = it & 3, tok = it >> 2, ry = tok / W, gx = tok % W;
        float sa[8], sv[8];
#pragma unroll
        for (int e = 0; e < 8; ++e) { sa[e] = bsm[8 * cg + e]; sv[e] = bsm[32 + 8 * cg + e]; }
#pragma unroll
        for (int dy = -1; dy <= 1; ++dy) {
            if (isctx && dy != 0) continue;
#pragma unroll
            for (int dx = -1; dx <= 1; ++dx) {
                const int tap = (dy + 1) * 3 + dx + 1;
                const LAS unsigned char* cp = tile + ((ry + HR + dy) * TW + gx + 1 + dx) * 128 + 16 * cg;
                float xa[8], xv[8];
                unpack8(*(const LAS v4u*)cp, xa); unpack8(*(const LAS v4u*)(cp + 64), xv);
                const LAS float* wp = wsm + tap * 64 + 8 * cg;
#pragma unroll
                for (int e = 0; e < 8; ++e) { sa[e] += xa[e] * wp[e]; sv[e] += xv[e] * wp[32 + e]; }
            }
        }
        float y[8];
#pragma unroll
        for (int e = 0; e < 8; ++e) y[e] = silu_f(sa[e]) * sv[e];
        v4u o; o.x = pk2(y[0], y[1]); o.y = pk2(y[2], y[3]); o.z = pk2(y[4], y[5]); o.w = pk2(y[6], y[7]);
        const size_t m = (size_t)mbase + (gy0 + ry) * W + gx;
        *(GAS v4u*)(Gd + m * Fc + fl + 8 * cg) = o;
    }
}
__device__ __forceinline__ void phase_conv(const Args& a, LAS unsigned char* lds, int l, int chunkA, int vcu, int G, int tid) {
    unsigned char* ws = a.ws; const LayerBufs B = layer_bufs(l);
    const int Fc = chunkA ? FCA : FCB, f0 = chunkA ? FCB : 0, nslab = Fc / 32;
    const bf16* U = (const bf16*)bufp(ws, a.out, chunkA ? B.UA : B.UB); bf16* Gd = (bf16*)bufp(ws, a.out, chunkA ? B.GA : B.GB);
    const int nunits = (l == DEPTH - 1 ? 32 : 40) * nslab;
    for (int u = vcu; u < nunits; u += G) conv_unit(a, lds, l, U, Gd, Fc, f0, u, nslab, tid);
    __syncthreads();
}
__device__ __forceinline__ void phase_final(const Args& a, int gw, int NGW, int lane) {
    const float* rs = (const float*)(a.ws + WS_RSA) + (size_t)3 * MALL; const float* fn = a.in[I_FNORM];
    f32x4 g[4];
#pragma unroll
    for (int j = 0; j < 4; ++j) g[j] = *(const f32x4*)(fn + 4 * lane + 256 * j);
#pragma unroll 1
    for (int m0 = gw; m0 < MLAT; m0 += 4 * NGW) {
        f32x4 v[4][4]; float rstd[4];
#pragma unroll
        for (int u = 0; u < 4; ++u) { const int m = m0 + u * NGW; if (m < MLAT) { rstd[u] = rs[m];
#pragma unroll
            for (int j = 0; j < 4; ++j) v[u][j] = *(const f32x4*)(a.out + (size_t)m * 1024 + 4 * lane + 256 * j); } }
#pragma unroll
        for (int u = 0; u < 4; ++u) { const int m = m0 + u * NGW; if (m < MLAT) { const float r = rsqrtf(rstd[u] * (1.0f / 1024.0f) + NEPS);
#pragma unroll
            for (int j = 0; j < 4; ++j) *(f32x4*)(a.out + (size_t)m * 1024 + 4 * lane + 256 * j) = v[u][j] * r * g[j]; } }
    }
}
constexpr int PH_P0A = 0, PH_P0B = 1, PH_L0 = 2, PH_PER_LAYER = 11, PH_FINAL = PH_L0 + 2 * PH_PER_LAYER, PH_COUNT = PH_FINAL + 1;
enum { K_INPROJ = 0, K_PREP, K_SCAN, K_MERGE, K_OUTPROJ, K_UPB, K_CONVB, K_DOWNB, K_UPA, K_CONVA, K_DOWNA };

__global__ void __launch_bounds__(NWAVES * 64, 2) mk_fwd(Args a) {
    extern __shared__ __attribute__((aligned(16))) unsigned char lds_raw[];
    LAS unsigned char* lds = (LAS unsigned char*)lds_raw;
    const int G = gridDim.x; const int bx = blockIdx.x;
    const int vcu = (G % 8 == 0) ? (bx % 8) * (G / 8) + bx / 8 : bx;
    const int NGW = G * NWAVES;
    unsigned char* ws = a.ws;
    for (int u = threadIdx.x; u < (LDS_BYTES - LDSCTL_OFF) / 4; u += NWAVES * 64) ((LAS unsigned*)(lds + LDSCTL_OFF))[u] = 0u;
    __syncthreads();
    XcdBarrier bar; bar.bar = (unsigned*)(ws + WS_CTL) + CW_BAR; bar.x = 0; bar.st = nullptr;
    if (a.use_bar) bar = xcd_barrier_post((unsigned*)(ws + WS_CTL) + CW_BAR, (volatile LAS unsigned*)(lds + LDSCTL_OFF) + 8);
    const float* MOD = (const float*)(ws + WS_MOD);
    float* RSA = (float*)(ws + WS_RSA);

    for (int ph = a.ph_lo; ph < a.ph_hi; ++ph) {
        int tid_o = threadIdx.x; asm volatile("" : "+v"(tid_o));
        const int tid = tid_o, lane = tid & 63, wave = __builtin_amdgcn_readfirstlane(tid >> 6);
        const int gw = vcu * NWAVES + wave;
        if (ph == PH_P0A) phase_p0a(a, lds, vcu, G, tid, wave, lane);
        else if (ph == PH_P0B) phase_p0b(a, lds, vcu, G, tid, wave, lane);
        else if (ph < PH_FINAL) {
            const int l = (ph - PH_L0) / PH_PER_LAYER, k = (ph - PH_L0) % PH_PER_LAYER;
            const LayerBufs B = layer_bufs(l);
            unsigned char* wl = ws + (l == 0 ? WS_W1 : WS_W2);
            const float* MODl = MOD + (size_t)l * 9 * 6144;
            const float* SWl = (const float*)(ws + WS_SW) + (size_t)l * SW_LAYER;
            const float* rs_n1 = l == 0 ? (const float*)(ws + WS_RS1) : RSA + (size_t)1 * MALL;
            if (k == K_INPROJ) {
                const bf16* XG = (const bf16*)bufp(ws, a.out, B.XG);
                skinny_rows(XG, (const bf16*)(ws + WS_WSM) + (size_t)l * 48 * 1024, rs_n1, SWl + 9 * NMAIN, (float*)(ws + WS_SM), gw, NGW, lane);
                pg8::Gemm g{XG, (const bf16*)(wl + W_IN), MALL, NMAIN, 1024}; pg8::StaticOrder S; S.init(MALL, NMAIN, G, bx);
                pg8::EpiInProj E{ws, a.out, l};
                pg8::gemm_phase<pg8::EpiInProj, pg8::StaticOrder, true, true>(lds, g, S, E);
            }
            else if (k == K_PREP) phase_prep(a, lds, l, vcu, G, tid, wave, lane);
            else if (k == K_SCAN) phase_scan(a, lds, l, vcu, G, tid, wave, lane);
            else if (k == K_MERGE) phase_merge(a, l, gw, NGW, lane);
            else if (k == K_OUTPROJ || k == K_DOWNB || k == K_DOWNA) {
                const int M = l == DEPTH - 1 ? MLAT : MALL;
                const bool last = l == DEPTH - 1;
                float* res_lat = a.out; float* res_ctx = (float*)(ws + WS_CXR);
                pg8::EpiResid E;
                E.rin_lat = (k == K_OUTPROJ && l == 0) ? a.in[I_X] : res_lat; E.rin_ctx = (k == K_OUTPROJ && l == 0) ? a.in[I_CTX] : res_ctx;
                E.rout_lat = res_lat; E.rout_ctx = res_ctx;
                E.gate = MODl + (k == K_OUTPROJ ? 2 : 5) * 1024; E.gn = nullptr; E.scl = nullptr; E.XGo = nullptr; E.rowss = nullptr;
                pg8::Gemm g;
                if (k == K_OUTPROJ) { g = pg8::Gemm{(const bf16*)bufp(ws, a.out, B.Y), (const bf16*)(wl + W_OUT), M, 1024, 1024};
                    E.gn = a.in[I_NORM2] + l * 1024; E.scl = MODl + 4 * 1024; E.XGo = (bf16*)bufp(ws, a.out, B.XG2); E.rowss = RSA + (size_t)(l == 0 ? 0 : 2) * MALL; }
                else if (k == K_DOWNB) g = pg8::Gemm{(const bf16*)bufp(ws, a.out, B.GB), (const bf16*)(wl + W_DB), M, 1024, FCB};
                else { g = pg8::Gemm{(const bf16*)bufp(ws, a.out, B.GA), (const bf16*)(wl + W_DA), M, 1024, FCA};
                    if (!last) { E.gn = a.in[I_NORM1] + 1024; E.scl = MOD + (size_t)9 * 6144 + 1 * 1024; E.XGo = (bf16*)bufp(ws, a.out, B.XGN); E.rowss = RSA + (size_t)1 * MALL; }
                    else E.rowss = RSA + (size_t)3 * MALL; }
                pg8::StaticOrder S; S.init(M, 1024, G, bx);
                pg8::gemm_phase<pg8::EpiResid, pg8::StaticOrder, true, true>(lds, g, S, E);
            }
            else if (k == K_UPB || k == K_UPA) {
                const int M = l == DEPTH - 1 ? MLAT : MALL;
                const int roff = k == K_UPA ? 2 * FCB : 0, N = k == K_UPA ? 2 * FCA : 2 * FCB;
                pg8::Gemm g{(const bf16*)bufp(ws, a.out, B.XG2), (const bf16*)(wl + W_UP) + (size_t)roff * 1024, M, N, 1024};
                pg8::EpiUp E{RSA + (size_t)(l == 0 ? 0 : 2) * MALL, SWl + 9 * (NMAIN + NSMALL) + roff, (bf16*)bufp(ws, a.out, k == K_UPA ? B.UA : B.UB), N};
                pg8::StaticOrder S; S.init(M, N, G, bx);
                pg8::gemm_phase<pg8::EpiUp, pg8::StaticOrder, true, true>(lds, g, S, E);
            }
            else if (k == K_CONVB || k == K_CONVA) phase_conv(a, lds, l, k == K_CONVA, vcu, G, tid);
        }
        else phase_final(a, gw, NGW, lane);
        if (ph + 1 < a.ph_hi && a.use_bar) xcd_barrier(bar);
    }
}
static int g_grid = 0;
static int mk_setup() {
    if (g_grid) return g_grid;
    int dev = 0, cus = 0;
    if (hipGetDevice(&dev) != hipSuccess || hipDeviceGetAttribute(&cus, hipDeviceAttributeMultiprocessorCount, dev) != hipSuccess) { g_grid = -1; return -1; }
    if (hipFuncSetAttribute((const void*)mk_fwd, hipFuncAttributeMaxDynamicSharedMemorySize, LDS_BYTES) != hipSuccess) { fprintf(stderr, "hipFuncSetAttribute failed\n"); g_grid = -1; return -1; }
    (void)hipGetLastError();
    g_grid = cus;
    return g_grid;
}
static void mk_launch(const Args& base, int lo, int hi, int use_bar, hipStream_t stream) {
    Args a = base; a.ph_lo = lo; a.ph_hi = hi; a.use_bar = use_bar;
    hipLaunchKernelGGL(mk_fwd, dim3(g_grid), dim3(NWAVES * 64), LDS_BYTES, stream, a);
}

extern "C" void kernel_launch(void* const* d_in, const int* in_sizes, int n_in, void* d_out, int out_size, void* d_ws, size_t ws_size, hipStream_t stream) {
    if (mk_setup() < 0) return;
    unsigned char* ws = (unsigned char*)d_ws;
    (void)hipMemsetAsync(ws + WS_CTL, 0, CTL_ZERO_BYTES, stream);
    Args a{};
    for (int i = 0; i < 22; ++i) a.in[i] = (const float*)d_in[i];
    a.out = (float*)d_out; a.ws = ws;
#ifndef MK_N_LAUNCHES
#define MK_N_LAUNCHES 1
#endif
    if (MK_N_LAUNCHES == 1) mk_launch(a, 0, PH_COUNT, 1, stream);
    else for (int ph = 0; ph < PH_COUNT; ++ph) mk_launch(a, ph, ph + 1, 0, stream);
#ifdef MK_PROBE_LIST
    {
        Args p = a; p.out = (float*)(ws + 64 * MiB);
#ifdef MK_PROBE_PMODE
        p.pad = MK_PROBE_PMODE;
#endif
        const int lst[] = { MK_PROBE_LIST };
        for (int r = 0; r < MK_PROBE_REPS; ++r) for (unsigned i = 0; i < sizeof(lst) / sizeof(lst[0]); ++i) mk_launch(p, lst[i], lst[i] + 1, 0, stream);
    }
#endif
}
```

```cpp
#include <hip/hip_runtime.h>
#include <cstdio>
#include <cstdint>
#include <math.h>

#define GAS __attribute__((address_space(1)))
#define LAS __attribute__((address_space(3)))
typedef unsigned short bf16;
typedef unsigned v4u __attribute__((ext_vector_type(4)));
typedef unsigned v2u __attribute__((ext_vector_type(2)));
typedef float f32x4 __attribute__((ext_vector_type(4)));
typedef float f32x16 __attribute__((ext_vector_type(16)));
typedef short bf16x8 __attribute__((ext_vector_type(8)));
typedef short s16x4 __attribute__((ext_vector_type(4)));
typedef __bf16 bf16x2_t __attribute__((ext_vector_type(2)));
typedef float f32x2_t __attribute__((ext_vector_type(2)));
typedef GAS unsigned gu32;

constexpr int DM = 1024, NBATCH = 8, LSEQ = 2048, LCTX = 256, DEPTH = 2;
constexpr int MLAT = NBATCH * LSEQ;
constexpr int MALL = MLAT + NBATCH * LCTX;
constexpr int NCHUNK = MALL / 64;
constexpr int DINP = 3632, NMAIN = 3584, NSMALL = 48;
constexpr int DFF = 2816, FCB = 1280, FCA = 1536;
constexpr float NEPS = 1e-6f;

constexpr size_t MiB = 1u << 20;
constexpr size_t WS_CTL = 0, CTL_ZERO_BYTES = 1 * MiB;
constexpr int CW_BAR = 4096;
constexpr size_t WS_RSA = 256 * 1024;
constexpr size_t WS_MOD = 1 * MiB;
constexpr size_t WS_RS1 = 1 * MiB + 512 * 1024;
constexpr size_t WS_SW = 2 * MiB;
constexpr size_t SW_LAYER = (size_t)9 * (NMAIN + NSMALL + 2 * DFF);
constexpr size_t WS_GDEC = 3 * MiB;
constexpr size_t WS_LDEC = 4 * MiB + 512 * 1024;
constexpr size_t WS_SM = 5 * MiB + 256 * 1024;
constexpr size_t WS_HALO = 9 * MiB;
constexpr size_t WS_WSM = 11 * MiB;
constexpr size_t WS_W2 = 12 * MiB, WS_W1 = 38 * MiB;
constexpr size_t W_IN = 0, W_OUT = 7 * MiB, W_UP = 9 * MiB, W_DB = 20 * MiB, W_DA = 20 * MiB + (size_t)1024 * FCB * 2;
constexpr size_t WS_CXR = 64 * MiB;
static_assert(W_DA + (size_t)1024 * FCA * 2 <= 26 * MiB, "weights");
static_assert(WS_SM + (size_t)MALL * 48 * 4 <= WS_HALO && WS_HALO + (size_t)NCHUNK * 2 * 1536 * 2 <= WS_WSM, "ws small map");
static_assert(WS_SW + 2 * SW_LAYER * 4 <= WS_GDEC && WS_RSA + (size_t)4 * MALL * 4 <= CTL_ZERO_BYTES, "ws map");

struct LayerBufs {
    long XG, GQ, GK, GV, LV, ZA, ZB, LQ, LK, GTA, LOP0, LOP1, Y, XG2, UB, GB, UA, GA, XGN;
};
#define DO_(x) (-(long)((x) * MiB) - 1)
__host__ __device__ constexpr LayerBufs layer_bufs(int l) {
    return l == 0 ? LayerBufs{ 72 * (long)MiB, 108 * (long)MiB, 126 * (long)MiB, 144 * (long)MiB, 162 * (long)MiB, DO_(0), DO_(18), DO_(36), DO_(45),
                               180 * (long)MiB, 72 * (long)MiB, 216 * (long)MiB, 108 * (long)MiB, 72 * (long)MiB, 108 * (long)MiB, 198 * (long)MiB, 126 * (long)MiB, 72 * (long)MiB, 220 * (long)MiB }
                  : LayerBufs{ 220 * (long)MiB, 38 * (long)MiB, 56 * (long)MiB, 74 * (long)MiB, 92 * (long)MiB, 110 * (long)MiB, 128 * (long)MiB, 146 * (long)MiB, 155 * (long)MiB,
                               164 * (long)MiB, 200 * (long)MiB, 227 * (long)MiB, 38 * (long)MiB, 74 * (long)MiB, 110 * (long)MiB, 190 * (long)MiB, 110 * (long)MiB, 206 * (long)MiB, 0 };
}

#define LDS_WAIT() asm volatile("s_waitcnt lgkmcnt(0)" ::: "memory")
#define VM_WAIT() asm volatile("s_waitcnt vmcnt(0)" ::: "memory")
__device__ __forceinline__ unsigned pk2(float lo, float hi) { f32x2_t v = {lo, hi}; bf16x2_t b = __builtin_convertvector(v, bf16x2_t); return __builtin_bit_cast(unsigned, b); }
__device__ __forceinline__ float bflo(unsigned u) { return __uint_as_float(u << 16); }
__device__ __forceinline__ float bfhi(unsigned u) { return __uint_as_float(u & 0xffff0000u); }
__device__ __forceinline__ float bf2f(bf16 u) { return __uint_as_float((unsigned)u << 16); }
__device__ __forceinline__ float silu_f(float x) { return x / (1.f + __expf(-x)); }
__device__ __forceinline__ float softplus_f(float x) { return fmaxf(x, 0.f) + log1pf(__expf(-fabsf(x))); }
__device__ __forceinline__ float sigmoid_f(float x) { return 1.f / (1.f + __expf(-x)); }
__device__ __forceinline__ float wave_sum(float v) {
#pragma unroll
    for (int o = 1; o < 64; o <<= 1) v += __shfl_xor(v, o);
    return v;
}
__device__ __forceinline__ int row_s(int m) { return m < MLAT ? (m >> 11) : 8; }
__host__ __device__ __forceinline__ unsigned char* bufp(unsigned char* ws, float* out, long off) { return off >= 0 ? ws + off : (unsigned char*)out + (-off - 1); }
namespace pg8 {
#define PG8_LAS __attribute__((address_space(3)))
typedef unsigned short bf16_t;
typedef short bf16x8 __attribute__((ext_vector_type(8)));
typedef float f32x4 __attribute__((ext_vector_type(4)));
typedef unsigned u32x4 __attribute__((ext_vector_type(4)));
constexpr int BM = 256, BK = 64, HALF = 128, HTB = HALF * BK * 2  , STAGE_BYTES = 8 * HTB, NXCD = 8, WGM = 8;

__host__ __device__ __forceinline__ int lds_byte(int r, int c) { const int st = (r >> 4) * 2 + (c >> 5), rr = r & 15, cc = c & 31, ob = rr * 64 + cc * 2; return st * 1024 + (ob ^ (((ob >> 9) & 1) << 5)); }
__host__ __device__ __forceinline__ void stage_rc(int b, int& R, int& C) { const int st = b / 1024, sb = b % 1024, swz = sb ^ (((sb >> 9) & 1) << 5); R = (st >> 1) * 16 + swz / 64; C = (st & 1) * 32 + (swz % 64) / 2; }
__host__ __device__ __forceinline__ int perm32(int rho) { const int n = rho >> 4, i = rho & 15; return 8 * (i >> 2) + 4 * n + (i & 3); }

struct Unit { int pm, pn; };
struct Gemm { const bf16_t* A; const bf16_t* Bt; int M, N, K; };

struct StaticOrder {
    int nM, nN, nwg, G, c;
    __host__ __device__ void init(int M, int N, int G_, int c_) { nM = M / BM; nN = N / BM; nwg = nM * nN; G = G_; c = c_; }
    __host__ __device__ bool next(int i, Unit& u) const {
        const long L = (long)i * G + c; if (L >= nwg) return false;
        int wgid = (int)L; { const int q = nwg / NXCD, r = nwg % NXCD, xcd = wgid % NXCD, off = wgid / NXCD; wgid = (xcd < r ? xcd * (q + 1) : r * (q + 1) + (xcd - r) * q) + off; }
        const int nig = WGM * nN, gid = wgid / nig, fm = gid * WGM, gsz = (nM - fm) < WGM ? (nM - fm) : WGM;
        u.pm = fm + ((wgid % nig) % gsz); u.pn = (wgid % nig) / gsz; return true;
    }
    __device__ __forceinline__ void a_ready(const Unit&) const {}
    __device__ __forceinline__ void done(const Unit&) const {}
};
__device__ __forceinline__ unsigned pk2e(float lo, float hi) { f32x2_t v = {lo, hi}; bf16x2_t b = __builtin_convertvector(v, bf16x2_t); return __builtin_bit_cast(unsigned, b); }

struct EpiInProj {
    static constexpr bool PERM = true, AFTER_DRAIN = false;
    unsigned char* ws; float* out; int l;
    __device__ __forceinline__ void operator()(const f32x4 (&acc)[2][2][4][2], const Unit& u, int wr, int wc, int fr, int fq) const {
        const LayerBufs B = layer_bufs(l);
        const float* rowss = l == 0 ? (const float*)(ws + WS_RS1) : (const float*)(ws + WS_RSA) + MALL;
        const float* sW = (const float*)(ws + WS_SW) + (size_t)l * SW_LAYER;
        const int pn = u.pn, s = u.pm < 64 ? (u.pm >> 3) : 8;
        long boff; int ld, cb;
        if (pn < 8) { const int t = pn >> 1; boff = t == 0 ? B.GQ : (t == 1 ? B.GK : (t == 2 ? B.GV : B.ZA)); ld = 512; cb = (pn & 1) * 256; }
        else if (pn == 8) { boff = B.LQ; ld = 256; cb = 0; }
        else if (pn == 9) { boff = B.LK; ld = 256; cb = 0; }
        else { boff = pn < 12 ? B.LV : B.ZB; ld = 512; cb = (pn & 1) * 256; }
        bf16_t* base = (bf16_t*)bufp(ws, out, boff);
        bf16_t* HALO = (bf16_t*)(ws + WS_HALO);
        const int row0 = u.pm * BM + wr * 64 + fr, colw = wc * 32 + 8 * fq;
        const float* swp = sW + (size_t)s * 3584 + pn * BM + colw;
        f32x4 bv[2][2];
#pragma unroll
        for (int bj = 0; bj < 2; ++bj)
#pragma unroll
            for (int n = 0; n < 2; ++n) bv[bj][n] = *(const f32x4*)(swp + bj * HALF + 4 * n);
        float rs8[8];
#pragma unroll
        for (int q = 0; q < 8; ++q) rs8[q] = rowss[row0 + (q >> 2) * HALF + (q & 3) * 16];
#pragma unroll
        for (int ai = 0; ai < 2; ++ai)
#pragma unroll
            for (int m = 0; m < 4; ++m) {
                const int row = row0 + ai * HALF + m * 16;
                const float rstd = rsqrtf(rs8[ai * 4 + m] * (1.0f / 1024.0f) + 1e-6f);
                bf16_t* rowp = base + (size_t)row * ld + cb + colw;
                const bool halo = (pn < 6) && ((m == 0 && fr == 0) || (m == 3 && fr == 15));
                bf16_t* hp = HALO + ((size_t)(row >> 6) * 2 + (m == 3 ? 1 : 0)) * 1536 + (pn >> 1) * 512 + cb + colw;
#pragma unroll
                for (int bj = 0; bj < 2; ++bj) {
                    const f32x4 v0 = acc[ai][bj][m][0] * rstd + bv[bj][0], v1 = acc[ai][bj][m][1] * rstd + bv[bj][1];
                    u32x4 w; w.x = pk2e(v0[0], v0[1]); w.y = pk2e(v0[2], v0[3]); w.z = pk2e(v1[0], v1[1]); w.w = pk2e(v1[2], v1[3]);
                    *(u32x4*)(rowp + bj * HALF) = w;
                    if (halo) *(u32x4*)(hp + bj * HALF) = w;
                }
            }
    }
};

struct EpiResid {
    static constexpr bool PERM = true, AFTER_DRAIN = false;
    const float* rin_lat; const float* rin_ctx; float* rout_lat; float* rout_ctx;
    const float* gate;
    const float* gn;
    const float* scl;
    bf16_t* XGo; float* rowss;
    __device__ __forceinline__ void operator()(const f32x4 (&acc)[2][2][4][2], const Unit& u, int wr, int wc, int fr, int fq) const {
        const int s = u.pm < 64 ? (u.pm >> 3) : 8;
        const bool isctx = u.pm >= 64, do_xg = XGo != nullptr, do_ss = rowss != nullptr;
        const float* rin = isctx ? rin_ctx - (size_t)16384 * 1024 : rin_lat;
        float* rout = isctx ? rout_ctx - (size_t)16384 * 1024 : rout_lat;
        const int row0 = u.pm * BM + wr * 64 + fr, col0 = u.pn * BM + wc * 32 + 8 * fq;
        f32x4 gv[2][2], nv[2][2];
#pragma unroll
        for (int bj = 0; bj < 2; ++bj)
#pragma unroll
            for (int n = 0; n < 2; ++n) {
                gv[bj][n] = *(const f32x4*)(gate + (size_t)s * 6144 + col0 + bj * HALF + 4 * n);
                if (do_xg) { const f32x4 g = *(const f32x4*)(gn + col0 + bj * HALF + 4 * n), sc = *(const f32x4*)(scl + (size_t)s * 6144 + col0 + bj * HALF + 4 * n); nv[bj][n] = g * (sc + 1.0f); }
                else nv[bj][n] = (f32x4){0.f, 0.f, 0.f, 0.f};
            }
#pragma unroll
        for (int am = 0; am < 4; ++am) {
            const int ai = am >> 1, mb = (am & 1) * 2;
            f32x4 rv[2][2][2];
#pragma unroll
            for (int mm = 0; mm < 2; ++mm) { const float* rp = rin + (size_t)(row0 + ai * HALF + (mb + mm) * 16) * 1024 + col0;
#pragma unroll
                for (int bj = 0; bj < 2; ++bj) { rv[mm][bj][0] = *(const f32x4*)(rp + bj * HALF); rv[mm][bj][1] = *(const f32x4*)(rp + bj * HALF + 4); } }
#pragma unroll
            for (int mm = 0; mm < 2; ++mm) {
                const int m = mb + mm;
                const int row = row0 + ai * HALF + m * 16;
                float* op = rout + (size_t)row * 1024 + col0;
                float ss = 0.f;
#pragma unroll
                for (int bj = 0; bj < 2; ++bj) {
                    const f32x4 x0 = rv[mm][bj][0] + gv[bj][0] * acc[ai][bj][m][0];
                    const f32x4 x1 = rv[mm][bj][1] + gv[bj][1] * acc[ai][bj][m][1];
                    *(f32x4*)(op + bj * HALF) = x0; *(f32x4*)(op + bj * HALF + 4) = x1;
                    ss += (x0[0] * x0[0] + x0[1] * x0[1]) + (x0[2] * x0[2] + x0[3] * x0[3]) + (x1[0] * x1[0] + x1[1] * x1[1]) + (x1[2] * x1[2] + x1[3] * x1[3]);
                    if (do_xg) {
                        const f32x4 y0 = x0 * nv[bj][0], y1 = x1 * nv[bj][1];
                        u32x4 w; w.x = pk2e(y0[0], y0[1]); w.y = pk2e(y0[2], y0[3]); w.z = pk2e(y1[0], y1[1]); w.w = pk2e(y1[2], y1[3]);
                        *(u32x4*)(XGo + (size_t)row * 1024 + col0 + bj * HALF) = w;
                    }
                }
                if (do_ss) { ss += __shfl_xor(ss, 16); ss += __shfl_xor(ss, 32); if (fq == 0) atomicAdd(rowss + row, ss); }
            }
        }
    }
};

struct EpiUp {
    static constexpr bool PERM = true, AFTER_DRAIN = false;
    const float* rowss; const float* sW;
    bf16_t* U; int ldu;
    __device__ __forceinline__ void operator()(const f32x4 (&acc)[2][2][4][2], const Unit& u, int wr, int wc, int fr, int fq) const {
        const int s = u.pm < 64 ? (u.pm >> 3) : 8;
        const int row0 = u.pm * BM + wr * 64 + fr, col0 = u.pn * BM + wc * 32 + 8 * fq;
        const float* swp = sW + (size_t)s * 5632 + col0;
        f32x4 bv[2][2];
#pragma unroll
        for (int bj = 0; bj < 2; ++bj)
#pragma unroll
            for (int n = 0; n < 2; ++n) bv[bj][n] = *(const f32x4*)(swp + bj * HALF + 4 * n);
        float rs8[8];
#pragma unroll
        for (int q = 0; q < 8; ++q) rs8[q] = rowss[row0 + (q >> 2) * HALF + (q & 3) * 16];
#pragma unroll
        for (int ai = 0; ai < 2; ++ai)
#pragma unroll
            for (int m = 0; m < 4; ++m) {
                const int row = row0 + ai * HALF + m * 16;
                const float rstd = rsqrtf(rs8[ai * 4 + m] * (1.0f / 1024.0f) + 1e-6f);
                bf16_t* rowp = U + (size_t)row * ldu + col0;
#pragma unroll
                for (int bj = 0; bj < 2; ++bj) {
                    const f32x4 v0 = acc[ai][bj][m][0] * rstd + bv[bj][0], v1 = acc[ai][bj][m][1] * rstd + bv[bj][1];
                    u32x4 w; w.x = pk2e(v0[0], v0[1]); w.y = pk2e(v0[2], v0[3]); w.z = pk2e(v1[0], v1[1]); w.w = pk2e(v1[2], v1[3]);
                    *(u32x4*)(rowp + bj * HALF) = w;
                }
            }
    }
};
template <class Epi, class Sched, bool ALIGN_EPI = false, bool SP2 = false>
__device__ __forceinline__ void gemm_phase(PG8_LAS unsigned char* lds, const Gemm g, const Sched& S, const Epi& E) {
    int tid_o = threadIdx.x; asm volatile("" : "+v"(tid_o));
    const int tid = tid_o, wid = __builtin_amdgcn_readfirstlane(tid >> 6), lane = tid & 63, wr = wid >> 2, wc = wid & 3, fr = lane & 15, fq = lane >> 4;
    const int K = g.K, nt = K / BK;
    unsigned voffA[2], voffB[2];
#pragma unroll
    for (int i = 0; i < 2; ++i) { int R, C; stage_rc(tid * 16 + i * 8192, R, C); const int Rb = Epi::PERM ? ((R & ~31) + perm32(R & 31)) : R;
        voffA[i] = (unsigned)(R * K + C) * 2u; voffB[i] = (unsigned)(Rb * K + C) * 2u; }
    const size_t kstep = (size_t)(BK * 2);
    const size_t hstep = (size_t)HALF * K * 2;
    const size_t tstep = 2 * hstep;
    const unsigned ldsw = (unsigned)wid * 1024u;
    const int aoff = lds_byte(wr * 64 + fr, fq * 8), boff = lds_byte(wc * 32 + fr, fq * 8);
#define PG8_SA(b, h) (((b) * 2 + (h)) * HTB)
#define PG8_SB(b, h) ((4 + (b) * 2 + (h)) * HTB)
#define PG8_STAGE(bufoff, gbase, voff) do { _Pragma("unroll") for (int _i = 0; _i < 2; ++_i) \
        __builtin_amdgcn_global_load_lds((const unsigned*)((const char*)(gbase) + (voff)[_i]), (PG8_LAS unsigned*)(lds + (bufoff) + ldsw + _i * 8192), 16, 0, 0); } while (0)
#define PG8_LDA(dst, b, h) do { _Pragma("unroll") for (int m = 0; m < 4; ++m) _Pragma("unroll") for (int k = 0; k < 2; ++k) dst[m][k] = *(const PG8_LAS bf16x8*)(lds + PG8_SA(b, h) + aoff + m * 2048 + k * 1024); } while (0)
#define PG8_LDB(dst, b, h) do { _Pragma("unroll") for (int n = 0; n < 2; ++n) _Pragma("unroll") for (int k = 0; k < 2; ++k) dst[n][k] = *(const PG8_LAS bf16x8*)(lds + PG8_SB(b, h) + boff + n * 2048 + k * 1024); } while (0)
#define PG8_MMA(ai, bj, At, Bt) do { __builtin_amdgcn_s_setprio(1); _Pragma("unroll") for (int m = 0; m < 4; ++m) _Pragma("unroll") for (int n = 0; n < 2; ++n) _Pragma("unroll") for (int k = 0; k < 2; ++k) \
        acc[ai][bj][m][n] = __builtin_amdgcn_mfma_f32_16x16x32_bf16(Bt[n][k], At[m][k], acc[ai][bj][m][n], 0, 0, 0); __builtin_amdgcn_s_setprio(0); } while (0)
#define PG8_WAIT_V(n) asm volatile("s_waitcnt vmcnt(" #n ")" ::: "memory")
#define PG8_WAIT_L(n) asm volatile("s_waitcnt lgkmcnt(" #n ")" ::: "memory")
#define PG8_BAR __builtin_amdgcn_s_barrier()
#define PG8_SCHED __builtin_amdgcn_sched_barrier(0)
    Unit cur, nxt; int ui = 0;
    if (!S.next(0, cur)) return;
    f32x4 acc[2][2][4][2];
#pragma unroll
    for (int a = 0; a < 2; ++a)
#pragma unroll
        for (int b = 0; b < 2; ++b)
#pragma unroll
            for (int m = 0; m < 4; ++m)
#pragma unroll
                for (int n = 0; n < 2; ++n) acc[a][b][m][n] = (f32x4){0.f, 0.f, 0.f, 0.f};
    bf16x8 At[4][2], B0[2][2], B1[2][2];
    const char* cA = (const char*)g.A + (size_t)cur.pm * tstep; const char* cB = (const char*)g.Bt + (size_t)cur.pn * tstep;
    S.a_ready(cur);
    if constexpr (SP2) {
        PG8_STAGE(PG8_SB(0, 0), cB, voffB); PG8_STAGE(PG8_SB(0, 1), cB + hstep, voffB); PG8_STAGE(PG8_SA(0, 0), cA, voffA); PG8_STAGE(PG8_SA(0, 1), cA + hstep, voffA);
        if (wr == 1) PG8_BAR;
        PG8_WAIT_V(2); PG8_BAR;
        PG8_STAGE(PG8_SB(1, 0), cB + kstep, voffB); PG8_STAGE(PG8_SA(1, 0), cA + kstep, voffA); PG8_STAGE(PG8_SB(1, 1), cB + hstep + kstep, voffB);
        PG8_WAIT_V(6); PG8_BAR;
    } else {
        PG8_STAGE(PG8_SB(0, 0), cB, voffB); PG8_STAGE(PG8_SA(0, 0), cA, voffA); PG8_STAGE(PG8_SB(0, 1), cB + hstep, voffB); PG8_STAGE(PG8_SA(0, 1), cA + hstep, voffA);
        if (wr == 1) PG8_BAR;
        PG8_WAIT_V(4); PG8_BAR;
        PG8_STAGE(PG8_SB(1, 0), cB + kstep, voffB); PG8_STAGE(PG8_SA(1, 0), cA + kstep, voffA); PG8_STAGE(PG8_SB(1, 1), cB + hstep + kstep, voffB);
        PG8_WAIT_V(6); PG8_BAR;
    }
    for (;;) {
        const bool has_next = S.next(ui + 1, nxt);
        const char* nA = has_next ? (const char*)g.A + (size_t)nxt.pm * tstep : cA; const char* nB = has_next ? (const char*)g.Bt + (size_t)nxt.pn * tstep : cB;
        for (int t = 0; t < nt; t += 2) {
            const bool last = (t == nt - 2);
            const char* a1 = cA + (size_t)(t + 1) * kstep;
            const char* a2 = last ? nA : cA + (size_t)(t + 2) * kstep; const char* b2 = last ? nB : cB + (size_t)(t + 2) * kstep;
            const char* a3 = a2 + kstep; const char* b3 = b2 + kstep;
            if (last && has_next) S.a_ready(nxt);
            if constexpr (SP2) {
            PG8_LDB(B0, 0, 0); PG8_LDB(B1, 0, 1); PG8_SCHED; PG8_LDA(At, 0, 0); PG8_STAGE(PG8_SA(1, 1), a1 + hstep, voffA);
            PG8_WAIT_V(8); PG8_WAIT_L(0); PG8_BAR; PG8_MMA(0, 0, At, B0); PG8_MMA(0, 1, At, B1); PG8_BAR; PG8_SCHED;
            PG8_LDA(At, 0, 1); PG8_STAGE(PG8_SB(0, 0), b2, voffB); PG8_STAGE(PG8_SB(0, 1), b2 + hstep, voffB); PG8_STAGE(PG8_SA(0, 0), a2, voffA);
            PG8_WAIT_V(8); PG8_WAIT_L(0); PG8_BAR; PG8_MMA(1, 0, At, B0); PG8_MMA(1, 1, At, B1); PG8_BAR; PG8_SCHED;
            PG8_LDB(B0, 1, 0); PG8_LDB(B1, 1, 1); PG8_SCHED; PG8_LDA(At, 1, 0); PG8_STAGE(PG8_SA(0, 1), a2 + hstep, voffA);
            PG8_WAIT_V(8); PG8_WAIT_L(0); PG8_BAR; PG8_MMA(0, 0, At, B0); PG8_MMA(0, 1, At, B1); PG8_BAR; PG8_SCHED;
            PG8_LDA(At, 1, 1); PG8_STAGE(PG8_SB(1, 0), b3, voffB); PG8_STAGE(PG8_SB(1, 1), b3 + hstep, voffB); PG8_STAGE(PG8_SA(1, 0), a3, voffA);
            PG8_WAIT_V(8); PG8_WAIT_L(0); PG8_BAR; PG8_MMA(1, 0, At, B0); PG8_MMA(1, 1, At, B1); PG8_BAR; PG8_SCHED;
            } else {
            PG8_LDB(B0, 0, 0); PG8_SCHED; PG8_LDA(At, 0, 0); PG8_STAGE(PG8_SA(1, 1), a1 + hstep, voffA);
            PG8_WAIT_L(8); PG8_BAR; PG8_WAIT_L(0); PG8_MMA(0, 0, At, B0); PG8_BAR; PG8_SCHED;
            PG8_LDB(B1, 0, 1); PG8_STAGE(PG8_SB(0, 0), b2, voffB);
            PG8_BAR; PG8_WAIT_L(0); PG8_MMA(0, 1, At, B1); PG8_BAR;
            PG8_LDA(At, 0, 1); PG8_STAGE(PG8_SA(0, 0), a2, voffA);
            PG8_BAR; PG8_WAIT_L(0); PG8_MMA(1, 0, At, B0); PG8_BAR; PG8_SCHED;
            PG8_STAGE(PG8_SB(0, 1), b2 + hstep, voffB);
            PG8_WAIT_V(6); PG8_BAR; PG8_MMA(1, 1, At, B1); PG8_BAR;
            PG8_LDB(B0, 1, 0); PG8_SCHED; PG8_LDA(At, 1, 0); PG8_STAGE(PG8_SA(0, 1), a2 + hstep, voffA);
            PG8_WAIT_L(8); PG8_BAR; PG8_WAIT_L(0); PG8_MMA(0, 0, At, B0); PG8_BAR; PG8_SCHED;
            PG8_LDB(B1, 1, 1); PG8_STAGE(PG8_SB(1, 0), b3, voffB);
            PG8_BAR; PG8_WAIT_L(0); PG8_MMA(0, 1, At, B1); PG8_BAR;
            PG8_LDA(At, 1, 1); PG8_STAGE(PG8_SA(1, 0), a3, voffA);
            PG8_BAR; PG8_WAIT_L(0); PG8_MMA(1, 0, At, B0); PG8_BAR; PG8_SCHED;
            PG8_STAGE(PG8_SB(1, 1), b3 + hstep, voffB);
            PG8_WAIT_V(6); PG8_BAR; PG8_MMA(1, 1, At, B1); PG8_BAR;
            }
        }
        if constexpr (ALIGN_EPI) { if (wr == 0) PG8_BAR; }
        if constexpr (!Epi::AFTER_DRAIN) { E(acc, cur, wr, wc, fr, fq); S.done(cur); }
        if (!has_next) break;
#pragma unroll
        for (int a = 0; a < 2; ++a)
#pragma unroll
            for (int b = 0; b < 2; ++b)
#pragma unroll
                for (int m = 0; m < 4; ++m)
#pragma unroll
                    for (int n = 0; n < 2; ++n) acc[a][b][m][n] = (f32x4){0.f, 0.f, 0.f, 0.f};
        cur = nxt; cA = nA; cB = nB; ++ui;
        if constexpr (ALIGN_EPI) { if (wr == 1) PG8_BAR; }
    }
    PG8_WAIT_V(0);
    if constexpr (!ALIGN_EPI) { if (wr == 0) PG8_BAR; }
    PG8_BAR;
    if constexpr (Epi::AFTER_DRAIN) { E.fused(acc, cur, wr, wc, fr, fq, lds, wid, lane); S.done(cur); }
#undef PG8_SA
#undef PG8_SB
#undef PG8_STAGE
#undef PG8_LDA
#undef PG8_LDB
#undef PG8_MMA
#undef PG8_WAIT_V
#undef PG8_WAIT_L
#undef PG8_BAR
#undef PG8_SCHED
}
}
#define XB_TMO      128
#define XB_XCNT(j)  (256  + 64 * (j))
#define XB_XSUB(j)  (1280 + 64 * (j))
#define XB_XGEN(j)  (2304 + 64 * (j))
#define XB_TOP      3328
#define XB_TOPGEN   3392
#define XCD_BAR_WORDS 3456
#define XB_SPIN_CAP (1u << 18)

__device__ __forceinline__ unsigned xb_ld(unsigned* p)              { return __hip_atomic_load(p, __ATOMIC_RELAXED, __HIP_MEMORY_SCOPE_AGENT); }
__device__ __forceinline__ unsigned xb_add(unsigned* p, unsigned v) { return __hip_atomic_fetch_add(p, v, __ATOMIC_RELAXED, __HIP_MEMORY_SCOPE_AGENT); }
__device__ __forceinline__ unsigned xb_xcc_id() { return (unsigned)__builtin_amdgcn_s_getreg((3 << 11) | 20) & 0xFu; }
#define XB_SPIN(cond, bar) do { unsigned _sp = 0; while (cond) { __builtin_amdgcn_s_sleep(1); \
    if ((++_sp & 255u) == 0u) { if (xb_ld(&(bar)[XB_TMO])) break; if (_sp > XB_SPIN_CAP) { atomicAdd(&(bar)[XB_TMO], 1u); break; } } } } while (0)

struct XcdBarrier {
    unsigned* bar; unsigned x;
    volatile LAS unsigned* st;
};

__device__ __forceinline__ XcdBarrier xcd_barrier_post(unsigned* bar, volatile LAS unsigned* st) {
    XcdBarrier b; b.bar = bar; b.x = xb_xcc_id(); b.st = st;
    if (threadIdx.x == 0) (void)xb_add(&bar[XB_XCNT(b.x)], 1u);
    return b;
}
__device__ __forceinline__ void xcd_barrier_complete(unsigned* bar, unsigned x, unsigned& nloc, unsigned& nx) {
    const unsigned G = gridDim.x * gridDim.y * gridDim.z;
    unsigned sum, cnt, mine, sp = 0u;
    for (;;) {
        sum = 0u; cnt = 0u; mine = 0u;
#pragma unroll
        for (unsigned j = 0; j < 16; ++j) { const unsigned c = xb_ld(&bar[XB_XCNT(j)]); sum += c; cnt += (c > 0u) ? 1u : 0u; mine = (j == x) ? c : mine; }
        if (sum == G) break;
        __builtin_amdgcn_s_sleep(1);
        if ((++sp & 255u) == 0u) { if (xb_ld(&bar[XB_TMO])) break; if (sp > XB_SPIN_CAP) { atomicAdd(&bar[XB_TMO], 1u); break; } }
    }
    nloc = mine > 0u ? mine : 1u; nx = cnt > 0u ? cnt : 1u;
}

__device__ __forceinline__ void xcd_barrier(const XcdBarrier& b) {
    asm volatile("s_waitcnt vmcnt(0)" ::: "memory");
    __syncthreads();
    if (threadIdx.x == 0) {
        unsigned* bar = b.bar;
        __builtin_amdgcn_s_waitcnt(0);
        unsigned nloc = b.st[0], nx = b.st[1];
        if (nloc == 0u) { xcd_barrier_complete(bar, b.x, nloc, nx); b.st[0] = nloc; b.st[1] = nx; }
        const unsigned old = xb_add(&bar[XB_XSUB(b.x)], 1u);
        const unsigned gen = old / nloc;
        if (old + 1u == (gen + 1u) * nloc) {
            __builtin_amdgcn_fence(__ATOMIC_RELEASE, "agent");
            asm volatile("s_waitcnt vmcnt(0)" ::: "memory");
            const unsigned og = xb_add(&bar[XB_TOP], 1u);
            const unsigned tg = og / nx;
            if (og + 1u == (tg + 1u) * nx) xb_add(&bar[XB_TOPGEN], 1u);
            else XB_SPIN(xb_ld(&bar[XB_TOPGEN]) == tg, bar);
            __builtin_amdgcn_fence(__ATOMIC_ACQUIRE, "agent");
            xb_add(&bar[XB_XGEN(b.x)], 1u);
            asm volatile("s_waitcnt vmcnt(0)" ::: "memory");
        } else {
            XB_SPIN(xb_ld(&bar[XB_XGEN(b.x)]) == gen, bar);
            __builtin_amdgcn_fence(__ATOMIC_ACQUIRE, "agent");
            asm volatile("s_waitcnt vmcnt(0)" ::: "memory");
        }
    }
    __syncthreads();
}
#ifdef MK_PROF_A
#define STAMP(id) do { if (blockIdx.x == 0 && threadIdx.x == 0) ((volatile LAS unsigned long long*)(lds + 155648 + 256))[id] = __builtin_amdgcn_s_memrealtime(); } while (0)
#else
#define STAMP(id) do {} while (0)
#endif
constexpr int NWAVES = 8;
constexpr int RING_BYTES = 131072, LDSCTL_OFF = 155648, LDS_BYTES = 163840;
struct Args {
    const float* in[22]; float* out; unsigned char* ws; int ph_lo, ph_hi; int use_bar, pad;
};
enum { I_X = 0, I_C, I_CTX, I_CCTX, I_WMOD, I_BMOD, I_NORM1, I_WIN, I_GCONV, I_ALOG, I_DTB, I_GNORM, I_WGK, I_BGK, I_LNORM, I_WOUT, I_NORM2, I_WUP, I_FCONV, I_FCB, I_WDOWN, I_FNORM };


__device__ __forceinline__ void tr_item(const float* src, int ldsrc, int k0, int c0, int ncols, bf16* dst, int lddst, int r0, int kd0, LAS float* scr, int lane) {
    const int cl = lane & 31;
#pragma unroll 8
    for (int i = 0; i < 32; ++i) { const int kk = 2 * i + (lane >> 5); scr[kk * 33 + cl] = cl < ncols ? src[(size_t)(k0 + kk) * ldsrc + c0 + cl] : 0.f; }
    LDS_WAIT(); asm volatile("" ::: "memory");
    const int c = lane & 7;
#pragma unroll
    for (int j = 0; j < 4; ++j) { const int n = (lane >> 3) + 8 * j; const LAS float* s = scr + (8 * c) * 33 + n;
        v4u o; o.x = pk2(s[0 * 33], s[1 * 33]); o.y = pk2(s[2 * 33], s[3 * 33]); o.z = pk2(s[4 * 33], s[5 * 33]); o.w = pk2(s[6 * 33], s[7 * 33]);
        if (n < ncols) *(GAS v4u*)(dst + (size_t)(r0 + n) * lddst + kd0 + 8 * c) = o; }
    LDS_WAIT(); asm volatile("" ::: "memory");
}

__device__ __forceinline__ void phase_p0a(const Args& a, LAS unsigned char* lds, int vcu, int G, int tid, int wave, int lane) {
    unsigned char* ws = a.ws;
    {
        LAS float* sc = (LAS float*)lds;
        LAS float* red = (LAS float*)(lds + 36864);
        bool have = false;
        for (int it = vcu; it < 192; it += G) {
            if (!have) {
                for (int i = tid; i < 9 * 1024; i += 512) { const int s = i >> 10, k = i & 1023; const float v = s < 8 ? a.in[I_C][s * 1024 + k] : a.in[I_CCTX][k]; sc[i] = silu_f(v); }
                __syncthreads(); have = true;
            }
            const int l = it / 96, n0 = (it % 96) * 64;
            const float* W = a.in[I_WMOD] + (size_t)l * 1024 * 6144;
            const int c4 = tid & 15, ks = tid >> 4;
            f32x4 acc[9];
#pragma unroll
            for (int s = 0; s < 9; ++s) acc[s] = (f32x4){0.f, 0.f, 0.f, 0.f};
            for (int j = 0; j < 32; ++j) {
                const int k = ks + 32 * j;
                const f32x4 w = *(const f32x4*)(W + (size_t)k * 6144 + n0 + 4 * c4);
#pragma unroll
                for (int s = 0; s < 9; ++s) acc[s] += w * sc[s * 1024 + k];
            }
#pragma unroll
            for (int s = 0; s < 9; ++s) *(LAS f32x4*)(red + (ks * 9 + s) * 64 + 4 * c4) = acc[s];
            __syncthreads();
            for (int o = tid; o < 576; o += 512) {
                const int s = o >> 6, c = o & 63; float v = 0.f;
                for (int q = 0; q < 32; ++q) v += red[(q * 9 + s) * 64 + c];
                ((float*)(ws + WS_MOD))[((size_t)l * 9 + s) * 6144 + n0 + c] = v + a.in[I_BMOD][l * 6144 + n0 + c];
            }
            __syncthreads();
        }
        __syncthreads();
    }
    {
        LAS float* scr = (LAS float*)(lds + wave * 16384);
        const int gw = vcu * NWAVES + wave, NGW = G * NWAVES;
        constexpr int I_IN = 16 * 112, I_SM = 16 * 2, I_O = 16 * 32, I_U = 16 * 176, I_D = 44 * 32, PER_L = I_IN + I_SM + I_O + I_U + I_D;
#pragma unroll 1
        for (int it = gw; it < 2 * PER_L; it += NGW) {
            const int l = it / PER_L; int r = it % PER_L;
            unsigned char* wl = ws + (l == 0 ? WS_W1 : WS_W2);
            const float* src; int ldsrc, k0, c0, ncols = 32, lddst, r0, kd0; bf16* dst;
            if (r < I_IN) { const int kb = r / 112, n0 = (r % 112) * 32; src = a.in[I_WIN] + (size_t)l * 1024 * DINP; ldsrc = DINP; k0 = kb * 64; c0 = n0 < 2048 ? n0 : n0 + 16; dst = (bf16*)(wl + W_IN); lddst = 1024; r0 = n0; kd0 = k0; }
            else if ((r -= I_IN) < I_SM) { const int kb = r / 2, part = r % 2; src = a.in[I_WIN] + (size_t)l * 1024 * DINP; ldsrc = DINP; k0 = kb * 64; c0 = part == 0 ? 2048 : 3600; ncols = part == 0 ? 16 : 32;
                dst = (bf16*)(ws + WS_WSM) + (size_t)l * 48 * 1024; lddst = 1024; r0 = part == 0 ? 0 : 16; kd0 = k0; }
            else if ((r -= I_SM) < I_O) { const int kb = r / 32, nb = r % 32; src = a.in[I_WOUT] + (size_t)l * 1024 * 1024; ldsrc = 1024; k0 = kb * 64; c0 = nb * 32; dst = (bf16*)(wl + W_OUT); lddst = 1024; r0 = nb * 32; kd0 = k0; }
            else if ((r -= I_O) < I_U) { const int kb = r / 176, rr0 = (r % 176) * 32;
                src = a.in[I_WUP] + (size_t)l * 1024 * 5632; ldsrc = 5632; k0 = kb * 64;
                c0 = rr0 < 1280 ? rr0 : (rr0 < 2560 ? 2816 + (rr0 - 1280) : (rr0 < 4096 ? 1280 + (rr0 - 2560) : 2816 + 1280 + (rr0 - 4096)));
                dst = (bf16*)(wl + W_UP); lddst = 1024; r0 = rr0; kd0 = k0; }
            else { r -= I_U; const int kb = r / 32, nb = r % 32; k0 = kb * 64; src = a.in[I_WDOWN] + (size_t)l * DFF * 1024; ldsrc = 1024; c0 = nb * 32; r0 = nb * 32;
                if (k0 < FCB) { dst = (bf16*)(wl + W_DB); lddst = FCB; kd0 = k0; } else { dst = (bf16*)(wl + W_DA); lddst = FCA; kd0 = k0 - FCB; } }
            tr_item(src, ldsrc, k0, c0, ncols, dst, lddst, r0, kd0, scr, lane);
        }
    }
}

__device__ __forceinline__ void xg_rows(const float* xlat, const float* xctx, const float* gain, const float* scl  , bf16* XG, float* rowss, int gw, int NGW, int lane, int mrows) {
    f32x4 g[4];
#pragma unroll
    for (int j = 0; j < 4; ++j) g[j] = *(const f32x4*)(gain + 4 * lane + 256 * j);
#pragma unroll 1
    for (int m0 = gw; m0 < mrows; m0 += 4 * NGW) {
        f32x4 v[4][4];
#pragma unroll
        for (int u = 0; u < 4; ++u) { const int m = m0 + u * NGW; if (m < mrows) { const float* src = m < MLAT ? xlat + (size_t)m * 1024 : xctx + (size_t)(m - MLAT) * 1024;
#pragma unroll
            for (int j = 0; j < 4; ++j) v[u][j] = *(const f32x4*)(src + 4 * lane + 256 * j); } }
#pragma unroll
        for (int u = 0; u < 4; ++u) { const int m = m0 + u * NGW; if (m < mrows) {
            const int s = row_s(m); float ss = 0.f;
#pragma unroll
            for (int j = 0; j < 4; ++j) {
                const int c = 4 * lane + 256 * j; const f32x4 x = v[u][j], sc = *(const f32x4*)(scl + (size_t)s * 6144 + c);
                ss += (x[0] * x[0] + x[1] * x[1]) + (x[2] * x[2] + x[3] * x[3]);
                const f32x4 y = x * g[j] * (sc + 1.0f);
                v2u o; o.x = pk2(y[0], y[1]); o.y = pk2(y[2], y[3]);
                *(GAS v2u*)(XG + (size_t)m * 1024 + c) = o;
            }
            ss = wave_sum(ss);
            if (lane == 0) rowss[m] = ss; } }
    }
}

__device__ __forceinline__ void phase_p0b(const Args& a, LAS unsigned char* lds, int vcu, int G, int tid, int wave, int lane) {
    unsigned char* ws = a.ws;
    const int gw = vcu * NWAVES + wave, NGW = G * NWAVES;
    const float* MOD = (const float*)(ws + WS_MOD);
    constexpr LayerBufs B0 = layer_bufs(0);
    xg_rows(a.in[I_X], a.in[I_CTX], a.in[I_NORM1], MOD + 1 * 1024, (bf16*)bufp(ws, a.out, B0.XG), (float*)(ws + WS_RS1), gw, NGW, lane, MALL);
    LAS float* sh = (LAS float*)lds;
    for (int combo = 0; combo < 4; ++combo) {
        const int l = combo >> 1, which = combo & 1;
        __syncthreads();
        for (int i = tid; i < 9 * 1024; i += 512) sh[i] = MOD[((size_t)l * 9 + (i >> 10)) * 6144 + (which ? 3 : 0) * 1024 + (i & 1023)];
        __syncthreads();
        const int nrows = which ? 5632 : (NMAIN + NSMALL);
        float* SWl = (float*)(ws + WS_SW) + (size_t)l * SW_LAYER;
        unsigned char* wl = ws + (l == 0 ? WS_W1 : WS_W2);
        for (int n = gw; n < nrows; n += NGW) {
            const bf16* wrow; float* dst; int ldd;
            if (which) { wrow = (const bf16*)(wl + W_UP) + (size_t)n * 1024; dst = SWl + 9 * (NMAIN + NSMALL) + n; ldd = 5632; }
            else if (n < NMAIN) { wrow = (const bf16*)(wl + W_IN) + (size_t)n * 1024; dst = SWl + n; ldd = NMAIN; }
            else { wrow = (const bf16*)(ws + WS_WSM) + ((size_t)l * 48 + (n - NMAIN)) * 1024; dst = SWl + 9 * NMAIN + (n - NMAIN); ldd = NSMALL; }
            const v4u w0 = *(const GAS v4u*)(wrow + 8 * lane), w1 = *(const GAS v4u*)(wrow + 512 + 8 * lane);
            float wf[16] = { bflo(w0.x), bfhi(w0.x), bflo(w0.y), bfhi(w0.y), bflo(w0.z), bfhi(w0.z), bflo(w0.w), bfhi(w0.w),
                             bflo(w1.x), bfhi(w1.x), bflo(w1.y), bfhi(w1.y), bflo(w1.z), bfhi(w1.z), bflo(w1.w), bfhi(w1.w) };
#pragma unroll
            for (int s = 0; s < 9; ++s) {
                float acc = 0.f;
#pragma unroll
                for (int j = 0; j < 8; ++j) acc += wf[j] * sh[s * 1024 + 8 * lane + j] + wf[8 + j] * sh[s * 1024 + 512 + 8 * lane + j];
                acc = wave_sum(acc);
                if (lane == 0) dst[(size_t)s * ldd] = acc;
            }
        }
    }
    __syncthreads();
}

__device__ __forceinline__ void skinny_rows(const bf16* XG, const bf16* Wsm  , const float* rowss, const float* sWsm  , float* SM, int gw, int NGW, int lane) {
    const int r = lane & 15, g = lane >> 4;
    for (int t = gw; t < MALL / 16; t += NGW) {
        const int m0 = t * 16;
        f32x4 acc[3];
#pragma unroll
        for (int n = 0; n < 3; ++n) acc[n] = (f32x4){0.f, 0.f, 0.f, 0.f};
        const bf16* ap = XG + (size_t)(m0 + r) * 1024 + 8 * g;
        const bf16* bp = Wsm + (size_t)r * 1024 + 8 * g;
        float rs4[4], sw[4][3];
#pragma unroll
        for (int j = 0; j < 4; ++j) { const int m = m0 + 4 * g + j; rs4[j] = rowss[m]; const int s = row_s(m);
#pragma unroll
            for (int n = 0; n < 3; ++n) sw[j][n] = sWsm[s * 48 + 16 * n + r]; }
#pragma unroll 1
        for (int k0 = 0; k0 < 32; k0 += 4) {
            bf16x8 af[4], bfr[4][3];
#pragma unroll
            for (int kk = 0; kk < 4; ++kk) { af[kk] = *(const GAS bf16x8*)(ap + 32 * (k0 + kk));
#pragma unroll
                for (int n = 0; n < 3; ++n) bfr[kk][n] = *(const GAS bf16x8*)(bp + (size_t)n * 16 * 1024 + 32 * (k0 + kk)); }
#pragma unroll
            for (int kk = 0; kk < 4; ++kk)
#pragma unroll
                for (int n = 0; n < 3; ++n) acc[n] = __builtin_amdgcn_mfma_f32_16x16x32_bf16(af[kk], bfr[kk][n], acc[n], 0, 0, 0);
        }
#pragma unroll
        for (int j = 0; j < 4; ++j) {
            const int m = m0 + 4 * g + j;
            const float rstd = rsqrtf(rs4[j] * (1.0f / 1024.0f) + NEPS);
#pragma unroll
            for (int n = 0; n < 3; ++n) SM[(size_t)m * 48 + 16 * n + r] = acc[n][j] * rstd + sw[j][n];
        }
    }
}
#define MFMA32(a, b, c) __builtin_amdgcn_mfma_f32_32x32x16_bf16((a), (b), (c), 0, 0, 0)
__device__ __forceinline__ int crow(int reg, int h) { return (reg & 3) + 8 * (reg >> 2) + 4 * h; }
__device__ __forceinline__ bf16x8 pack_step(const f32x16& x, int s) {
    v4u p; p.x = pk2(x[8 * s], x[8 * s + 1]); p.y = pk2(x[8 * s + 2], x[8 * s + 3]); p.z = pk2(x[8 * s + 4], x[8 * s + 5]); p.w = pk2(x[8 * s + 6], x[8 * s + 7]);
    return __builtin_bit_cast(bf16x8, p);
}
__device__ __forceinline__ bf16x8 frag_perm(const LAS unsigned char* img, int stride, int row, int col16, int h) {
    const LAS unsigned char* p = img + row * stride + (col16 + 4 * h) * 2;
    const s16x4 lo = *(const LAS s16x4*)p, hi = *(const LAS s16x4*)(p + 16);
    return __builtin_shufflevector(lo, hi, 0, 1, 2, 3, 4, 5, 6, 7);
}
__device__ __forceinline__ bf16x8 frag_nat(const LAS unsigned char* img, int stride, int row, int col16, int h) {
    const LAS unsigned char* p = img + row * stride + (col16 + 8 * h) * 2;
    const s16x4 lo = *(const LAS s16x4*)p, hi = *(const LAS s16x4*)(p + 8);
    return __builtin_shufflevector(lo, hi, 0, 1, 2, 3, 4, 5, 6, 7);
}
__device__ __forceinline__ void unpack8(const v4u w, float* f) {
    f[0] = bflo(w.x); f[1] = bfhi(w.x); f[2] = bflo(w.y); f[3] = bfhi(w.y); f[4] = bflo(w.z); f[5] = bfhi(w.z); f[6] = bflo(w.w); f[7] = bfhi(w.w);
}
__device__ __forceinline__ int chunk_first(int cid) { return cid < 256 ? ((cid & 31) == 0) : ((cid & 3) == 0); }
__device__ __forceinline__ int chunk_last(int cid) { return cid < 256 ? ((cid & 31) == 31) : ((cid & 3) == 3); }

constexpr int GP_Q = 0, GP_K = 16896, GP_RAW = 33792, GP_KK = 33792, GP_QK = 50432, GP_LP = 67584, GP_LPSZ = 8448, GP_GATE = 135168, GP_GSZ = 1536, GP_CW = 141312, GP_ST = 264;
__host__ __device__ constexpr int tri_off(int i) { return i == 0 ? 0 : (8 * ((i + 3) / 4) * (((i + 3) / 4) - 1) + 4 * ((i + 3) / 4) * ((i - 1) & 3)); }
__device__ __forceinline__ int tri_off_rt(int i) { const int q = (i + 3) >> 2; return i == 0 ? 0 : 8 * q * (q - 1) + 4 * q * ((i - 1) & 3); }
struct GdnPre { v4u rr[5]; v4u vraw[2][3]; float av, bv; };
__device__ __forceinline__ void gdn_prefetch(const Args& a, int l, int cid, int h, int tid, GdnPre& P) {
    unsigned char* ws = a.ws; const LayerBufs B = layer_bufs(l);
    const bf16* GQ = (const bf16*)bufp(ws, a.out, B.GQ); const bf16* GK = (const bf16*)bufp(ws, a.out, B.GK); const bf16* GV = (const bf16*)bufp(ws, a.out, B.GV);
    const bf16* HALO = (const bf16*)(ws + WS_HALO);
    const int m0 = cid * 64, first = chunk_first(cid), last = chunk_last(cid), grp = tid >> 4, cg = tid & 15;
#pragma unroll
    for (int j = 0; j < 5; ++j) {
        const int p = tid + 512 * j; P.rr[j] = (v4u){0u, 0u, 0u, 0u};
        if (p < 2 * 66 * 16) {
            const int t = p / (66 * 16), rem = p % (66 * 16), r = rem >> 4, c = rem & 15;
            const bf16* base = t == 0 ? GQ : GK;
            if (r == 0) { if (!first) P.rr[j] = *(const GAS v4u*)(HALO + ((size_t)(cid - 1) * 2 + 1) * 1536 + t * 512 + h * 128 + 8 * c); }
            else if (r == 65) { if (!last) P.rr[j] = *(const GAS v4u*)(HALO + ((size_t)(cid + 1) * 2 + 0) * 1536 + t * 512 + h * 128 + 8 * c); }
            else P.rr[j] = *(const GAS v4u*)(base + (size_t)(m0 + r - 1) * 512 + h * 128 + 8 * c);
        }
    }
#pragma unroll
    for (int j = 0; j < 2; ++j) {
        const int r = grp + 32 * j;
#pragma unroll
        for (int d = 0; d < 3; ++d) {
            const int rr2 = r - 1 + d; P.vraw[j][d] = (v4u){0u, 0u, 0u, 0u};
            if (rr2 < 0) { if (!first) P.vraw[j][d] = *(const GAS v4u*)(HALO + ((size_t)(cid - 1) * 2 + 1) * 1536 + 1024 + h * 128 + 8 * cg); }
            else if (rr2 > 63) { if (!last) P.vraw[j][d] = *(const GAS v4u*)(HALO + ((size_t)(cid + 1) * 2 + 0) * 1536 + 1024 + h * 128 + 8 * cg); }
            else P.vraw[j][d] = *(const GAS v4u*)(GV + (size_t)(m0 + rr2) * 512 + h * 128 + 8 * cg);
        }
    }
    P.av = 0.f; P.bv = 0.f;
    if (tid < 128) { const float* sm = (const float*)(ws + WS_SM) + (size_t)(m0 + (tid & 63)) * 48; P.av = sm[(tid >> 6) * 4 + h]; P.bv = sm[8 + (tid >> 6) * 4 + h]; }
}
__device__ __forceinline__ void gdn_front1(const Args& a, LAS unsigned char* lds, int l, int cid, int h, int slot, int tid, const GdnPre& P, float alog, float dtb) {
    unsigned char* ws = a.ws; const LayerBufs B = layer_bufs(l);
    bf16* GQ = (bf16*)bufp(ws, a.out, B.GQ); bf16* GK = (bf16*)bufp(ws, a.out, B.GK); bf16* GV = (bf16*)bufp(ws, a.out, B.GV);
    const int m0 = cid * 64, grp = tid >> 4, cg = tid & 15;
    LAS unsigned char* raw_s = lds + GP_RAW;
    LAS float* gt = (LAS float*)(lds + GP_GATE + slot * GP_GSZ);
#pragma unroll
    for (int j = 0; j < 5; ++j) { const int p = tid + 512 * j; if (p < 2 * 66 * 16) *(LAS v4u*)(raw_s + p * 16) = P.rr[j]; }
    if (tid < 128) {
        const int dir = tid >> 6, i = tid & 63;
        const float gval = -__expf(alog) * softplus_f(P.av + dtb), bval = sigmoid_f(P.bv);
        float c = gval;
        if (dir == 0) {
#pragma unroll
            for (int o = 1; o < 64; o <<= 1) { const float u = __shfl_up(c, o); if (i >= o) c += u; }
        } else {
#pragma unroll
            for (int o = 1; o < 64; o <<= 1) { const float u = __shfl_down(c, o); if (i + o < 64) c += u; }
        }
        gt[dir * 64 + i] = gval; gt[128 + dir * 64 + i] = bval; gt[256 + dir * 64 + i] = c;
    }
    __syncthreads();
    const LAS float* cw = (const LAS float*)(lds + GP_CW);
#pragma unroll 1
    for (int t = 0; t < 3; ++t)
#pragma unroll
    for (int jj = 0; jj < 2; ++jj) {
        const int r = grp + 32 * jj;
        float x0[8], x1[8], x2[8], y[8];
        if (t < 2) {
            unpack8(*(const LAS v4u*)(raw_s + ((t * 66 + r) * 128 + 8 * cg) * 2), x0);
            unpack8(*(const LAS v4u*)(raw_s + ((t * 66 + r + 1) * 128 + 8 * cg) * 2), x1);
            unpack8(*(const LAS v4u*)(raw_s + ((t * 66 + r + 2) * 128 + 8 * cg) * 2), x2);
        } else { unpack8(P.vraw[jj][0], x0); unpack8(P.vraw[jj][1], x1); unpack8(P.vraw[jj][2], x2); }
        const LAS float* w0 = cw + t * 128 + 8 * cg;
        float ss = 0.f;
#pragma unroll
        for (int e = 0; e < 8; ++e) { const float c = x0[e] * w0[e] + x1[e] * w0[384 + e] + x2[e] * w0[768 + e]; y[e] = silu_f(c); ss += y[e] * y[e]; }
        ss += __shfl_xor(ss, 1); ss += __shfl_xor(ss, 2); ss += __shfl_xor(ss, 4); ss += __shfl_xor(ss, 8);
        float sc = 1.f;
        if (t == 0) sc = rsqrtf(ss + 1e-6f) * 0.08838834764831845f; else if (t == 1) sc = rsqrtf(ss + 1e-6f);
        v4u o; o.x = pk2(y[0] * sc, y[1] * sc); o.y = pk2(y[2] * sc, y[3] * sc); o.z = pk2(y[4] * sc, y[5] * sc); o.w = pk2(y[6] * sc, y[7] * sc);
        bf16* base = t == 0 ? GQ : (t == 1 ? GK : GV);
        *(GAS v4u*)(base + (size_t)(m0 + r) * 512 + h * 128 + 8 * cg) = o;
        if (t < 2) { LAS unsigned char* d = lds + (t == 0 ? GP_Q : GP_K) + r * GP_ST + 16 * cg; *(LAS v2u*)d = (v2u){o.x, o.y}; *(LAS v2u*)(d + 8) = (v2u){o.z, o.w}; }
    }
}
__device__ __forceinline__ void gdn_front2(const Args& a, LAS unsigned char* lds, int l, int cid, int h, int slot, int tid, int wave, int lane) {
    unsigned char* ws = a.ws; const LayerBufs B = layer_bufs(l);
    LAS float* gt = (LAS float*)(lds + GP_GATE + slot * GP_GSZ);
    __syncthreads();
    {
        const int which = wave >> 2, ti = (wave >> 1) & 1, tj = wave & 1, r = lane & 31, hh = lane >> 5;
        f32x16 acc; for (int i = 0; i < 16; ++i) acc[i] = 0.f;
        const LAS unsigned char* Ai = lds + (which ? GP_Q : GP_K); const LAS unsigned char* Bi = lds + GP_K;
#pragma unroll
        for (int s2 = 0; s2 < 8; ++s2) acc = MFMA32(frag_nat(Ai, GP_ST, 32 * ti + r, 16 * s2, hh), frag_nat(Bi, GP_ST, 32 * tj + r, 16 * s2, hh), acc);
        LAS float* dst = (LAS float*)(lds + (which ? GP_QK : GP_KK));
#pragma unroll
        for (int i = 0; i < 16; ++i) dst[(32 * ti + crow(i, hh)) * 65 + 32 * tj + r] = acc[i];
    }
    __syncthreads();
    {
        const LAS float* KK = (const LAS float*)(lds + GP_KK); const LAS float* QK = (const LAS float*)(lds + GP_QK);
        bf16* GTA = (bf16*)bufp(ws, a.out, B.GTA);
#pragma unroll 2
        for (int it = 0; it < 16; ++it) {
            const int p = tid + 512 * it;
            const int dir = p >> 12, ip = (p >> 6) & 63, jp = p & 63;
            const int i = dir ? 63 - ip : ip, j = dir ? 63 - jp : jp;
            if (jp < ip) {
                const float lv = gt[128 + dir * 64 + i] * KK[i * 65 + j] * __expf(gt[256 + dir * 64 + i] - gt[256 + dir * 64 + j]);
                ((LAS float*)(lds + GP_LP + (slot * 2 + dir) * GP_LPSZ))[tri_off_rt(ip) + jp] = lv;
            }
            const bool keep = dir ? (jp >= ip) : (jp <= ip);
            const float av = keep ? QK[ip * 65 + jp] * __expf(gt[256 + dir * 64 + ip] - gt[256 + dir * 64 + jp]) : 0.f;
            GTA[(((size_t)dir * NCHUNK + cid) * 4 + h) * 8192 + ip * 128 + 64 + jp] = (bf16)(pk2(av, 0.f) & 0xffffu);
        }
        if (tid < 128) {
            const int dir = tid >> 6, i = tid & 63;
            float* E = (float*)(ws + WS_GDEC);
            const float gc = gt[256 + dir * 64 + i], gl = gt[256 + dir * 64 + (dir ? 0 : 63)];
            E[(((size_t)dir * NCHUNK + cid) * 4 + h) * 64 + i] = __expf(gc);
            E[(size_t)2 * NCHUNK * 4 * 64 + (((size_t)dir * NCHUNK + cid) * 4 + h) * 64 + i] = __expf(gl - gc);
            if (i == 0) E[(size_t)4 * NCHUNK * 4 * 64 + ((size_t)dir * NCHUNK + cid) * 4 + h] = __expf(gl);
        }
    }
    __syncthreads();
}
__device__ __forceinline__ void gdn_prep_invert(LAS unsigned char* lds, int slot, int dir, int wave, int lane_in) {
    int lane = lane_in; asm volatile("" : "+v"(lane));
    LAS float* Lp = (LAS float*)(lds + GP_LP + (slot * 2 + dir) * GP_LPSZ);
    LAS float* Td = (LAS float*)(lds + wave * 8192);
    const int blk = lane >> 5, c = lane & 31;
    float t[32];
#pragma unroll
    for (int i = 0; i < 32; ++i) {
        f32x4 bA[8];
        const LAS float* rowp = Lp + (blk ? tri_off(32 + i) + 32 : tri_off(i));
#pragma unroll
        for (int q = 0; q < (i + 3) / 4; ++q) bA[q] = *(const LAS f32x4*)(rowp + 4 * q);
        float a0 = (c == i) ? 1.f : 0.f, a1 = 0.f, a2 = 0.f, a3 = 0.f;
#pragma unroll
        for (int q = 0; q < (i + 3) / 4; ++q) {
            a0 -= bA[q][0] * t[4 * q];
            if (4 * q + 1 < i) a1 -= bA[q][1] * t[4 * q + 1];
            if (4 * q + 2 < i) a2 -= bA[q][2] * t[4 * q + 2];
            if (4 * q + 3 < i) a3 -= bA[q][3] * t[4 * q + 3];
        }
        t[i] = (a0 + a1) + (a2 + a3);
        Td[blk * 1024 + i * 32 + c] = t[i];
        if (c < i) Lp[(blk ? tri_off(32 + i) + 32 : tri_off(i)) + c] = t[i];
        asm volatile("" ::: "memory");
    }
    f32x16 X; for (int r = 0; r < 16; ++r) X[r] = 0.f;
    const LAS float* l21 = Lp + tri_off_rt(32 + c) + blk;
#pragma unroll
    for (int s2 = 0; s2 < 16; ++s2) X = __builtin_amdgcn_mfma_f32_32x32x2f32(l21[2 * s2], Td[(2 * s2 + blk) * 32 + c], X, 0, 0, 0);
    f32x16 Y; for (int r = 0; r < 16; ++r) Y[r] = 0.f;
#pragma unroll
    for (int s2 = 0; s2 < 16; ++s2) Y = __builtin_amdgcn_mfma_f32_32x32x2f32(Td[1024 + c * 32 + crow(s2, blk)], X[s2], Y, 0, 0, 0);
#pragma unroll
    for (int r = 0; r < 16; ++r) Lp[tri_off_rt(32 + crow(r, blk)) + c] = -Y[r];
}
__device__ __forceinline__ void gdn_prep_tb_store(const Args& a, LAS unsigned char* lds, int l, int vcu, int G, int j0, int nb, int tid) {
    const LayerBufs B = layer_bufs(l);
    bf16* GTA = (bf16*)bufp(a.ws, a.out, B.GTA);
#pragma unroll 2
    for (int p = tid; p < nb * 2 * 64 * 8; p += 512) {
        const int pc = p & 7, io = (p >> 3) & 63, dir = (p >> 9) & 1, slot = p >> 10;
        const int it = vcu + G * (j0 + slot), cid = it >> 2, h = it & 3;
        const LAS float* Lp = (const LAS float*)(lds + GP_LP + (slot * 2 + dir) * GP_LPSZ);
        const LAS float* gt = (const LAS float*)(lds + GP_GATE + slot * GP_GSZ);
        const int ip = dir ? 63 - io : io, off = tri_off_rt(ip);
        float v[8];
#pragma unroll
        for (int e = 0; e < 8; ++e) {
            const int jo = 8 * pc + e, jp = dir ? 63 - jo : jo;
            const float tv = jp < ip ? Lp[off + jp] : (jp == ip ? 1.f : 0.f);
            v[e] = tv * gt[128 + dir * 64 + jo];
        }
        v4u o; o.x = pk2(v[0], v[1]); o.y = pk2(v[2], v[3]); o.z = pk2(v[4], v[5]); o.w = pk2(v[6], v[7]);
        *(GAS v4u*)(GTA + (((size_t)dir * NCHUNK + cid) * 4 + h) * 8192 + io * 128 + 8 * pc) = o;
    }
}

constexpr int LP_GK = 0, LP_QG = 33280, LP_KI = 51712, LP_LR = 70144, LP_W = 78336, LP_B = 86528, LP_GL = 87040, LP_QR = 87552, LP_KR = 95744, LP_ST = 144;
struct GlaPre { float lrv[4]; v4u qv, kv; };
__device__ __forceinline__ void gla_prefetch(const Args& a, int l, int cid, int h, int tid, GlaPre& P) {
    unsigned char* ws = a.ws; const LayerBufs B = layer_bufs(l);
    const int m0 = cid * 64;
#pragma unroll
    for (int j = 0; j < 4; ++j) { const int p = tid + 512 * j; P.lrv[j] = ((const float*)(ws + WS_SM))[(size_t)(m0 + (p >> 5)) * 48 + 16 + (p & 31)]; }
    const bf16* LQ = (const bf16*)bufp(ws, a.out, B.LQ); const bf16* LK = (const bf16*)bufp(ws, a.out, B.LK);
    const int i = tid >> 3, c8 = tid & 7;
    P.qv = *(const GAS v4u*)(LQ + (size_t)(m0 + i) * 256 + h * 64 + 8 * c8); P.kv = *(const GAS v4u*)(LK + (size_t)(m0 + i) * 256 + h * 64 + 8 * c8);
}
__device__ __forceinline__ void gla_prep_unit(const Args& a, LAS unsigned char* lds, int l, int cid, int h, int tid_in, const GlaPre& P) {
    int tid = tid_in; asm volatile("" : "+v"(tid));
    const int lane = tid & 63, wave = __builtin_amdgcn_readfirstlane(tid >> 6);
    unsigned char* ws = a.ws; const LayerBufs B = layer_bufs(l);
    LAS float* gk = (LAS float*)(lds + LP_GK); LAS float* lr = (LAS float*)(lds + LP_LR); const LAS float* Wv = (const LAS float*)(lds + LP_W); const LAS float* bs = (const LAS float*)(lds + LP_B); LAS float* gl = (LAS float*)(lds + LP_GL);
    {
#pragma unroll
        for (int j = 0; j < 4; ++j) lr[tid + 512 * j] = P.lrv[j];
        const int i = tid >> 3, c8 = tid & 7;
        *(LAS v4u*)(lds + LP_QR + i * 128 + 16 * c8) = P.qv; *(LAS v4u*)(lds + LP_KR + i * 128 + 16 * c8) = P.kv;
    }
    __syncthreads();
#pragma unroll 2
    for (int it = 0; it < 16; ++it) {
        const int p = tid + 512 * it;
        const int dir = p >> 12, i = (p >> 6) & 63, c = p & 63;
        float acc = bs[dir * 64 + c];
#pragma unroll
        for (int rk = 0; rk < 16; ++rk) acc += lr[i * 32 + dir * 16 + rk] * Wv[(dir * 16 + rk) * 64 + c];
        gk[(dir * 64 + i) * 65 + c] = -softplus_f(-acc) * (1.0f / 16.0f);
    }
    __syncthreads();
    if (tid < 128) {
        const int dir = tid >> 6, c = tid & 63;
        float s = 0.f;
#pragma unroll 1
        for (int i0 = 0; i0 < 64; i0 += 8) {
            float v[8];
#pragma unroll
            for (int e = 0; e < 8; ++e) { const int i = dir ? 63 - (i0 + e) : i0 + e; v[e] = gk[(dir * 64 + i) * 65 + c]; }
#pragma unroll
            for (int e = 0; e < 8; ++e) { const int i = dir ? 63 - (i0 + e) : i0 + e; s += v[e]; gk[(dir * 64 + i) * 65 + c] = s; }
        }
        gl[dir * 64 + c] = s;
        ((float*)(ws + WS_LDEC))[(((size_t)dir * NCHUNK + cid) * 4 + h) * 64 + c] = __expf(s);
    }
    __syncthreads();
    {
#pragma unroll 1
        for (int it = 0; it < 2; ++it) {
            const int p = tid + 512 * it, dir = p >> 9, i = (p >> 3) & 63, c8 = p & 7;
            float q[8], k[8];
            unpack8(*(const LAS v4u*)(lds + LP_QR + i * 128 + 16 * c8), q); unpack8(*(const LAS v4u*)(lds + LP_KR + i * 128 + 16 * c8), k);
            float qg[8], ki[8];
#pragma unroll
            for (int e = 0; e < 8; ++e) { const float gc = gk[(dir * 64 + i) * 65 + 8 * c8 + e]; qg[e] = q[e] * 0.125f * __expf(gc); ki[e] = k[e] * __expf(-gc); }
            v4u oq, ok; oq.x = pk2(qg[0], qg[1]); oq.y = pk2(qg[2], qg[3]); oq.z = pk2(qg[4], qg[5]); oq.w = pk2(qg[6], qg[7]);
            ok.x = pk2(ki[0], ki[1]); ok.y = pk2(ki[2], ki[3]); ok.z = pk2(ki[4], ki[5]); ok.w = pk2(ki[6], ki[7]);
            *(LAS v4u*)(lds + LP_QG + dir * 9216 + i * LP_ST + 16 * c8) = oq; *(LAS v4u*)(lds + LP_KI + dir * 9216 + i * LP_ST + 16 * c8) = ok;
            bf16* blk = (bf16*)bufp(ws, a.out, dir ? B.LOP1 : B.LOP0) + ((size_t)cid * 4 + h) * 12288;
            *(GAS v4u*)(blk + i * 64 + 8 * c8) = oq;
        }
#pragma unroll 1
        for (int it = 0; it < 2; ++it) {
            const int p = tid + 512 * it, dir = p >> 9, c = (p >> 3) & 63, ig = p & 7;
            const float glc = gl[dir * 64 + c];
            float kd[8];
#pragma unroll
            for (int e = 0; e < 8; ++e) { const int i = 8 * ig + e; kd[e] = bf2f(*(const LAS bf16*)(lds + LP_KR + i * 128 + 2 * c)) * __expf(glc - gk[(dir * 64 + i) * 65 + c]); }
            v4u o; o.x = pk2(kd[0], kd[1]); o.y = pk2(kd[2], kd[3]); o.z = pk2(kd[4], kd[5]); o.w = pk2(kd[6], kd[7]);
            bf16* blk = (bf16*)bufp(ws, a.out, dir ? B.LOP1 : B.LOP0) + ((size_t)cid * 4 + h) * 12288;
            *(GAS v4u*)(blk + 4096 + c * 64 + 8 * ig) = o;
        }
    }
    __syncthreads();
    {
        const int dir = wave >> 2, ti = (wave >> 1) & 1, tj = wave & 1, r = lane & 31, hh = lane >> 5;
        f32x16 acc; for (int i = 0; i < 16; ++i) acc[i] = 0.f;
        const LAS unsigned char* Ai = lds + LP_QG + dir * 9216; const LAS unsigned char* Bi = lds + LP_KI + dir * 9216;
#pragma unroll
        for (int s2 = 0; s2 < 4; ++s2) acc = MFMA32(frag_nat(Ai, LP_ST, 32 * ti + r, 16 * s2, hh), frag_nat(Bi, LP_ST, 32 * tj + r, 16 * s2, hh), acc);
        bf16* blk = (bf16*)bufp(ws, a.out, dir ? B.LOP1 : B.LOP0) + ((size_t)cid * 4 + h) * 12288 + 8192;
#pragma unroll
        for (int i = 0; i < 16; ++i) {
            const int io = 32 * ti + crow(i, hh), jo = 32 * tj + r;
            const bool keep = dir ? (jo >= io) : (jo <= io);
            blk[io * 64 + jo] = (bf16)(pk2(keep ? acc[i] : 0.f, 0.f) & 0xffffu);
        }
    }
    __syncthreads();
}

__device__ __forceinline__ void phase_prep(const Args& a, LAS unsigned char* lds, int l, int vcu, int G, int tid_in, int wave_in, int lane_in) {
    int tid = tid_in; asm volatile("" : "+v"(tid));
    const int lane = tid & 63, wave = __builtin_amdgcn_readfirstlane(tid >> 6);
    const int NU = NCHUNK * 4;
    {
        const int h0 = vcu & 3;
        for (int p = tid; p < 9 * 128; p += 512) { const int tap = p / 384, t = (p / 128) % 3, c = p & 127; ((LAS float*)(lds + GP_CW))[p] = a.in[I_GCONV][((size_t)l * 3 + tap) * 1536 + t * 512 + h0 * 128 + c]; }
        float alog = 0.f, dtb = 0.f;
        if (tid < 128) { alog = a.in[I_ALOG][l * 8 + (tid >> 6) * 4 + h0]; dtb = a.in[I_DTB][l * 8 + (tid >> 6) * 4 + h0]; }
        GdnPre P;
        if (vcu < NU) gdn_prefetch(a, l, vcu >> 2, vcu & 3, tid, P);
        __syncthreads();
#pragma unroll 1
        for (int j0 = 0; vcu + G * j0 < NU; j0 += 4) {
            int nb = 0;
#pragma unroll 1
            for (int j = 0; j < 4; ++j) {
                const int it = vcu + G * (j0 + j);
                if (it < NU) {
                    gdn_front1(a, lds, l, it >> 2, it & 3, j, tid, P, alog, dtb);
                    if (it + G < NU) gdn_prefetch(a, l, (it + G) >> 2, (it + G) & 3, tid, P);
                    gdn_front2(a, lds, l, it >> 2, it & 3, j, tid, wave, lane);
                    nb = j + 1;
                }
            }
            const int slot = wave >> 1, dir = wave & 1;
            if (slot < nb) gdn_prep_invert(lds, slot, dir, wave, lane);
            __syncthreads();
            gdn_prep_tb_store(a, lds, l, vcu, G, j0, nb, tid);
            __syncthreads();
        }
    }
    {
        const int h0 = vcu & 3;
        for (int p = tid; p < 2 * 16 * 64; p += 512) { const int dir = p >> 10, rk = (p >> 6) & 15, c = p & 63; ((LAS float*)(lds + LP_W))[p] = a.in[I_WGK][(((size_t)l * 2 + dir) * 16 + rk) * 256 + h0 * 64 + c]; }
        if (tid < 128) ((LAS float*)(lds + LP_B))[tid] = a.in[I_BGK][((size_t)l * 2 + (tid >> 6)) * 256 + h0 * 64 + (tid & 63)];
        GlaPre P;
        if (vcu < NU) gla_prefetch(a, l, vcu >> 2, vcu & 3, tid, P);
#pragma unroll 1
        for (int it = vcu; it < NU; it += G) {
            GlaPre Pc = P;
            if (it + G < NU) gla_prefetch(a, l, (it + G) >> 2, (it + G) & 3, tid, P);
            gla_prep_unit(a, lds, l, it >> 2, it & 3, tid, Pc);
        }
    }
}

__device__ __forceinline__ int chain_cid(int b, int dir, int step) {
    if (step < 4) return 256 + 4 * b + (dir ? 3 - step : step);
    const int n = step - 4; return 32 * b + (dir ? 31 - n : n);
}
typedef short v4i16_t __attribute__((ext_vector_type(4)));
__device__ __forceinline__ s16x4 tr4(const LAS unsigned char* img, int stride, int row0, int col0, int lane) {
    const int i16 = lane & 15;
    const LAS unsigned char* p = img + (row0 + (i16 >> 2)) * stride + (col0 + 4 * (i16 & 3)) * 2;
    return __builtin_bit_cast(s16x4, __builtin_amdgcn_ds_read_tr16_b64_v4i16((LAS v4i16_t*)p));
}
__device__ __forceinline__ bf16x8 tr8(const LAS unsigned char* img, int stride, int row0, int row1, int col0, int lane) {
    const s16x4 lo = tr4(img, stride, row0, col0, lane), hi = tr4(img, stride, row1, col0, lane);
    return __builtin_shufflevector(lo, hi, 0, 1, 2, 3, 4, 5, 6, 7);
}
constexpr int GS_K = 0, GS_Q = 16896, GS_K2 = 33792, GS_V = 54272, GS_TB = 74752, GS_AT = 83456, GS_E1 = 92160, GS_E2 = 92416, GS_E3 = 92672;
struct GdnLoad { v4u q[4], k[4], v[4], t[4]; float e1, e2, e3; };
__device__ __forceinline__ void gdn_issue(const bf16* GQ, const bf16* GK, const bf16* GV, const bf16* GTA, const float* E, int cid, int h, int dir, int lt, GdnLoad& L) {
    const bf16* ta = GTA + (((size_t)dir * NCHUNK + cid) * 4 + h) * 8192;
#pragma unroll
    for (int q = 0; q < 4; ++q) {
        const int p = lt + 256 * q, row = p >> 4, cg = p & 15;
        const size_t mo = ((size_t)cid * 64 + row) * 512 + h * 128 + 8 * cg;
        L.q[q] = *(const GAS v4u*)(GQ + mo); L.k[q] = *(const GAS v4u*)(GK + mo); L.v[q] = *(const GAS v4u*)(GV + mo);
        L.t[q] = *(const GAS v4u*)(ta + p * 8);
    }
    L.e1 = 0.f; L.e2 = 0.f; L.e3 = 0.f;
    if (lt < 64) { const size_t eo = (((size_t)dir * NCHUNK + cid) * 4 + h) * 64 + lt; L.e1 = E[eo]; L.e2 = E[(size_t)2 * NCHUNK * 4 * 64 + eo];
                   L.e3 = E[(size_t)4 * NCHUNK * 4 * 64 + ((size_t)dir * NCHUNK + cid) * 4 + h]; }
}
__device__ __forceinline__ void gdn_write(LAS unsigned char* lds, int lt, const GdnLoad& L) {
#pragma unroll
    for (int q = 0; q < 4; ++q) {
        const int p = lt + 256 * q, row = p >> 4, cg = p & 15;
        LAS unsigned char* d = lds + GS_Q + row * 264 + 16 * cg; *(LAS v2u*)d = (v2u){L.q[q].x, L.q[q].y}; *(LAS v2u*)(d + 8) = (v2u){L.q[q].z, L.q[q].w};
        d = lds + GS_K + row * 264 + 16 * cg; *(LAS v2u*)d = (v2u){L.k[q].x, L.k[q].y}; *(LAS v2u*)(d + 8) = (v2u){L.k[q].z, L.k[q].w};
        *(LAS v4u*)(lds + GS_K2 + row * 320 + 16 * cg) = L.k[q];
        *(LAS v4u*)(lds + GS_V + row * 320 + 16 * cg) = L.v[q];
        d = lds + (cg < 8 ? GS_TB + row * 136 + 16 * cg : GS_AT + row * 136 + 16 * (cg - 8)); *(LAS v2u*)d = (v2u){L.t[q].x, L.t[q].y}; *(LAS v2u*)(d + 8) = (v2u){L.t[q].z, L.t[q].w};
    }
    if (lt < 64) { ((LAS float*)(lds + GS_E1))[lt] = L.e1; ((LAS float*)(lds + GS_E2))[lt] = L.e2; if (lt == 0) ((LAS float*)(lds + GS_E3))[0] = L.e3; }
}
__device__ __forceinline__ void gdn_scan_chain(const Args& a, LAS unsigned char* lds, int l, int b, int h, int dir, int tid_in, int wave_in, int lane_in) {
    int tid = tid_in; asm volatile("" : "+v"(tid));
    const int lane = tid & 63, wave = __builtin_amdgcn_readfirstlane(tid >> 6);
    unsigned char* ws = a.ws; const LayerBufs B = layer_bufs(l);
    const bf16* GQ = (const bf16*)bufp(ws, a.out, B.GQ); const bf16* GK = (const bf16*)bufp(ws, a.out, B.GK); const bf16* GV = (const bf16*)bufp(ws, a.out, B.GV);
    bf16* GTA = (bf16*)bufp(ws, a.out, B.GTA);
    const float* E = (const float*)(ws + WS_GDEC);
    __syncthreads();
    if (wave >= 4) {
        const int lt = tid - 256;
        GdnLoad LA, LB;
        gdn_issue(GQ, GK, GV, GTA, E, chain_cid(b, dir, 0), h, dir, lt, LA); gdn_write(lds, lt, LA);
        gdn_issue(GQ, GK, GV, GTA, E, chain_cid(b, dir, 1), h, dir, lt, LA);
        __syncthreads();
#pragma unroll 1
        for (int step = 0; step < 36; step += 2) {
            if (step + 2 < 36) gdn_issue(GQ, GK, GV, GTA, E, chain_cid(b, dir, step + 2), h, dir, lt, LB);
            __syncthreads();
            gdn_write(lds, lt, LA);
            __syncthreads();
            if (step + 3 < 36) gdn_issue(GQ, GK, GV, GTA, E, chain_cid(b, dir, step + 3), h, dir, lt, LA);
            __syncthreads();
            if (step + 2 < 36) gdn_write(lds, lt, LB);
            __syncthreads();
        }
    } else {
        const int r = lane & 31, hh = lane >> 5, w = wave, cb16 = ((lane >> 4) & 1) * 16;
        f32x16 S[4];
#pragma unroll
        for (int mt = 0; mt < 4; ++mt) for (int i = 0; i < 16; ++i) S[mt][i] = 0.f;
        __syncthreads();
#pragma unroll 1
        for (int step = 0; step < 36; ++step) {
            const int cid = chain_cid(b, dir, step);
            const LAS float* e1s = (const LAS float*)(lds + GS_E1); const LAS float* e2s = (const LAS float*)(lds + GS_E2);
            const float e3 = ((const LAS float*)(lds + GS_E3))[0];
            f32x16 Z[2], Q[2];
#pragma unroll
            for (int it = 0; it < 2; ++it) for (int i = 0; i < 16; ++i) { Z[it][i] = 0.f; Q[it][i] = 0.f; }
#pragma unroll
            for (int mt = 0; mt < 4; ++mt)
#pragma unroll
                for (int s = 0; s < 2; ++s) {
                    const bf16x8 sb = pack_step(S[mt], s);
#pragma unroll
                    for (int it = 0; it < 2; ++it) {
                        Z[it] = MFMA32(frag_perm(lds + GS_K, 264, 32 * it + r, 32 * mt + 16 * s, hh), sb, Z[it]);
                        Q[it] = MFMA32(frag_perm(lds + GS_Q, 264, 32 * it + r, 32 * mt + 16 * s, hh), sb, Q[it]);
                    }
                }
#pragma unroll
            for (int it = 0; it < 2; ++it)
#pragma unroll
                for (int g = 0; g < 4; ++g) {
                    const f32x4 ev = *(const LAS f32x4*)(e1s + 32 * it + 8 * g + 4 * hh);
                    const s16x4 vv = tr4(lds + GS_V, 320, 32 * it + 8 * g + 4 * hh, 32 * w + cb16, lane);
#pragma unroll
                    for (int x = 0; x < 4; ++x) { Z[it][4 * g + x] = bf2f((bf16)vv[x]) - ev[x] * Z[it][4 * g + x]; Q[it][4 * g + x] *= ev[x]; }
                }
            f32x16 Vn[2];
#pragma unroll
            for (int it = 0; it < 2; ++it) for (int i = 0; i < 16; ++i) Vn[it][i] = 0.f;
#pragma unroll
            for (int kt = 0; kt < 2; ++kt)
#pragma unroll
                for (int s = 0; s < 2; ++s) {
                    const bf16x8 rb = pack_step(Z[kt], s);
#pragma unroll
                    for (int it = 0; it < 2; ++it) Vn[it] = MFMA32(frag_perm(lds + GS_TB, 136, 32 * it + r, 32 * kt + 16 * s, hh), rb, Vn[it]);
                }
#pragma unroll
            for (int kt = 0; kt < 2; ++kt)
#pragma unroll
                for (int s = 0; s < 2; ++s) {
                    const bf16x8 vb = pack_step(Vn[kt], s);
#pragma unroll
                    for (int it = 0; it < 2; ++it) Q[it] = MFMA32(frag_perm(lds + GS_AT, 136, 32 * it + r, 32 * kt + 16 * s, hh), vb, Q[it]);
                }
            {
                bf16* ob = GTA + (((size_t)dir * NCHUNK + cid) * 4 + h) * 8192 + 32 * w + r;
#pragma unroll
                for (int it = 0; it < 2; ++it)
#pragma unroll
                    for (int i = 0; i < 16; ++i) ob[(32 * it + crow(i, hh)) * 128] = (bf16)(pk2(Q[it][i], 0.f) & 0xffffu);
            }
#pragma unroll
            for (int it = 0; it < 2; ++it)
#pragma unroll
                for (int g = 0; g < 4; ++g) {
                    const f32x4 ev = *(const LAS f32x4*)(e2s + 32 * it + 8 * g + 4 * hh);
                    Vn[it][4 * g] *= ev[0]; Vn[it][4 * g + 1] *= ev[1]; Vn[it][4 * g + 2] *= ev[2]; Vn[it][4 * g + 3] *= ev[3];
                }
#pragma unroll
            for (int mt = 0; mt < 4; ++mt) for (int i = 0; i < 16; ++i) S[mt][i] *= e3;
#pragma unroll
            for (int kt = 0; kt < 2; ++kt)
#pragma unroll
                for (int s = 0; s < 2; ++s) {
                    const bf16x8 vb = pack_step(Vn[kt], s);
                    const int T0 = 32 * kt + 16 * s + 4 * hh;
#pragma unroll
                    for (int mt = 0; mt < 4; ++mt) S[mt] = MFMA32(tr8(lds + GS_K2, 320, T0, T0 + 8, 32 * mt + cb16, lane), vb, S[mt]);
                }
            __syncthreads();
            __syncthreads();
        }
    }
}

constexpr int LS_QG = 0, LS_KD = 8704, LS_AT = 17408, LS_V = 26112, LS_E3 = 46592;
struct GlaLoad { v4u o[6], v[4]; float e3; };
__device__ __forceinline__ void gla_issue(const bf16* LOP, const bf16* LV, const float* E, int cid, int h, int dir, int lt, GlaLoad& L) {
    const bf16* blk = LOP + ((size_t)cid * 4 + h) * 12288;
#pragma unroll
    for (int q = 0; q < 6; ++q) L.o[q] = *(const GAS v4u*)(blk + (lt + 256 * q) * 8);
#pragma unroll
    for (int q = 0; q < 4; ++q) { const int p = lt + 256 * q; L.v[q] = *(const GAS v4u*)(LV + ((size_t)cid * 64 + (p >> 4)) * 512 + h * 128 + 8 * (p & 15)); }
    L.e3 = 0.f; if (lt < 64) L.e3 = E[(((size_t)dir * NCHUNK + cid) * 4 + h) * 64 + lt];
}
__device__ __forceinline__ void gla_write(LAS unsigned char* lds, int lt, const GlaLoad& L) {
#pragma unroll
    for (int q = 0; q < 6; ++q) { const int p = lt + 256 * q, mat = p >> 9, row = (p >> 3) & 63, cg = p & 7;
        LAS unsigned char* d = lds + mat * 8704 + row * 136 + 16 * cg; *(LAS v2u*)d = (v2u){L.o[q].x, L.o[q].y}; *(LAS v2u*)(d + 8) = (v2u){L.o[q].z, L.o[q].w}; }
#pragma unroll
    for (int q = 0; q < 4; ++q) { const int p = lt + 256 * q; *(LAS v4u*)(lds + LS_V + (p >> 4) * 320 + 16 * (p & 15)) = L.v[q]; }
    if (lt < 64) ((LAS float*)(lds + LS_E3))[lt] = L.e3;
}
__device__ __forceinline__ void gla_scan_chain(const Args& a, LAS unsigned char* lds, int l, int b, int h, int dir, int tid_in, int wave_in, int lane_in) {
    int tid = tid_in; asm volatile("" : "+v"(tid));
    const int lane = tid & 63, wave = __builtin_amdgcn_readfirstlane(tid >> 6);
    unsigned char* ws = a.ws; const LayerBufs B = layer_bufs(l);
    bf16* LOP = (bf16*)bufp(ws, a.out, dir ? B.LOP1 : B.LOP0);
    const bf16* LV = (const bf16*)bufp(ws, a.out, B.LV);
    const float* E = (const float*)(ws + WS_LDEC);
    __syncthreads();
    if (wave >= 4) {
        const int lt = tid - 256;
        GlaLoad LA, LB;
        gla_issue(LOP, LV, E, chain_cid(b, dir, 0), h, dir, lt, LA); gla_write(lds, lt, LA);
        gla_issue(LOP, LV, E, chain_cid(b, dir, 1), h, dir, lt, LA);
        __syncthreads();
#pragma unroll 1
        for (int step = 0; step < 36; step += 2) {
            if (step + 2 < 36) gla_issue(LOP, LV, E, chain_cid(b, dir, step + 2), h, dir, lt, LB);
            __syncthreads();
            gla_write(lds, lt, LA);
            __syncthreads();
            if (step + 3 < 36) gla_issue(LOP, LV, E, chain_cid(b, dir, step + 3), h, dir, lt, LA);
            __syncthreads();
            if (step + 2 < 36) gla_write(lds, lt, LB);
            __syncthreads();
        }
    } else {
        const int r = lane & 31, hh = lane >> 5, w = wave, cb16 = ((lane >> 4) & 1) * 16;
        f32x16 S[2];
#pragma unroll
        for (int mt = 0; mt < 2; ++mt) for (int i = 0; i < 16; ++i) S[mt][i] = 0.f;
        __syncthreads();
#pragma unroll 1
        for (int step = 0; step < 36; ++step) {
            const int cid = chain_cid(b, dir, step);
            const LAS float* e3s = (const LAS float*)(lds + LS_E3);
            f32x16 O[2];
#pragma unroll
            for (int it = 0; it < 2; ++it) for (int i = 0; i < 16; ++i) O[it][i] = 0.f;
#pragma unroll
            for (int mt = 0; mt < 2; ++mt)
#pragma unroll
                for (int s = 0; s < 2; ++s) {
                    const bf16x8 sb = pack_step(S[mt], s);
#pragma unroll
                    for (int it = 0; it < 2; ++it) O[it] = MFMA32(frag_perm(lds + LS_QG, 136, 32 * it + r, 32 * mt + 16 * s, hh), sb, O[it]);
                }
#pragma unroll
            for (int mt = 0; mt < 2; ++mt)
#pragma unroll
                for (int g = 0; g < 4; ++g) {
                    const f32x4 ev = *(const LAS f32x4*)(e3s + 32 * mt + 8 * g + 4 * hh);
                    S[mt][4 * g] *= ev[0]; S[mt][4 * g + 1] *= ev[1]; S[mt][4 * g + 2] *= ev[2]; S[mt][4 * g + 3] *= ev[3];
                }
#pragma unroll
            for (int kt = 0; kt < 2; ++kt)
#pragma unroll
                for (int s = 0; s < 2; ++s) {
                    const int T0 = 32 * kt + 16 * s + 8 * hh;
                    const bf16x8 vb = tr8(lds + LS_V, 320, T0, T0 + 4, 32 * w + cb16, lane);
#pragma unroll
                    for (int it = 0; it < 2; ++it) O[it] = MFMA32(frag_nat(lds + LS_AT, 136, 32 * it + r, 32 * kt + 16 * s, hh), vb, O[it]);
#pragma unroll
                    for (int mt = 0; mt < 2; ++mt) S[mt] = MFMA32(frag_nat(lds + LS_KD, 136, 32 * mt + r, 32 * kt + 16 * s, hh), vb, S[mt]);
                }
            bf16* ob = LOP + ((size_t)cid * 4 + h) * 12288 + 32 * w + r;
#pragma unroll
            for (int it = 0; it < 2; ++it)
#pragma unroll
                for (int i = 0; i < 16; ++i) ob[(32 * it + crow(i, hh)) * 128] = (bf16)(pk2(O[it][i], 0.f) & 0xffffu);
            __syncthreads();
            __syncthreads();
        }
    }
}

__device__ __forceinline__ void phase_scan(const Args& a, LAS unsigned char* lds, int l, int vcu, int G, int tid, int wave, int lane) {
    for (int ch = vcu; ch < 128; ch += G) {
        const int dir = ch & 1, h = (ch >> 1) & 3, b = (ch >> 3) & 7;
        if (ch < 64) gdn_scan_chain(a, lds, l, b, h, dir, tid, wave, lane);
        else gla_scan_chain(a, lds, l, b, h, dir, tid, wave, lane);
    }
}

__device__ __forceinline__ void phase_merge(const Args& a, int l, int gw, int NGW, int lane) {
    unsigned char* ws = a.ws; const LayerBufs B = layer_bufs(l);
    const bf16* GTA = (const bf16*)bufp(ws, a.out, B.GTA); const bf16* L0 = (const bf16*)bufp(ws, a.out, B.LOP0); const bf16* L1 = (const bf16*)bufp(ws, a.out, B.LOP1);
    const bf16* ZA = (const bf16*)bufp(ws, a.out, B.ZA); const bf16* ZB = (const bf16*)bufp(ws, a.out, B.ZB);
    bf16* Y = (bf16*)bufp(ws, a.out, B.Y);
    const int mrows = l == DEPTH - 1 ? MLAT : MALL;
    const int grp = lane >> 4, cg = lane & 15;
    const float* gnA = a.in[I_GNORM] + l * 128; const float* gnB = a.in[I_LNORM] + l * 128;
    float gA[8], gB[8];
#pragma unroll
    for (int e = 0; e < 8; ++e) { gA[e] = gnA[8 * cg + e]; gB[e] = gnB[8 * cg + e]; }
    constexpr int UN = 4;
#pragma unroll 1
    for (int it0 = gw * 4 + grp; it0 < mrows * 8; it0 += NGW * 4 * UN) {
        v4u r0[UN], r1[UN], rz[UN];
#pragma unroll
        for (int u = 0; u < UN; ++u) {
            const int it = it0 + u * NGW * 4;
            r0[u] = (v4u){0u, 0u, 0u, 0u}; r1[u] = r0[u]; rz[u] = r0[u];
            if (it < mrows * 8) {
                const int m = it >> 3, hs = it & 7, cid = m >> 6, i = m & 63;
                const bf16 *o0, *o1, *zp;
                if (hs < 4) { o0 = GTA + (((size_t)0 * NCHUNK + cid) * 4 + hs) * 8192 + i * 128; o1 = GTA + (((size_t)1 * NCHUNK + cid) * 4 + hs) * 8192 + i * 128; zp = ZA + (size_t)m * 512 + hs * 128; }
                else { const int h2 = hs - 4; o0 = L0 + ((size_t)cid * 4 + h2) * 12288 + i * 128; o1 = L1 + ((size_t)cid * 4 + h2) * 12288 + i * 128; zp = ZB + (size_t)m * 512 + h2 * 128; }
                r0[u] = *(const GAS v4u*)(o0 + 8 * cg); r1[u] = *(const GAS v4u*)(o1 + 8 * cg); rz[u] = *(const GAS v4u*)(zp + 8 * cg);
            }
        }
#pragma unroll
        for (int u = 0; u < UN; ++u) {
            const int it = it0 + u * NGW * 4;
            if (it < mrows * 8) {
                const int m = it >> 3, hs = it & 7;
                float f0[8], f1[8], z[8];
                unpack8(r0[u], f0); unpack8(r1[u], f1); unpack8(rz[u], z);
                float ss = 0.f;
#pragma unroll
                for (int e = 0; e < 8; ++e) { f0[e] += f1[e]; ss += f0[e] * f0[e]; }
                ss += __shfl_xor(ss, 1); ss += __shfl_xor(ss, 2); ss += __shfl_xor(ss, 4); ss += __shfl_xor(ss, 8);
                const float rstd = rsqrtf(ss * (1.0f / 128.0f) + NEPS);
                float y[8];
#pragma unroll
                for (int e = 0; e < 8; ++e) y[e] = f0[e] * rstd * (hs < 4 ? gA[e] : gB[e]) * silu_f(z[e]);
                v4u o; o.x = pk2(y[0], y[1]); o.y = pk2(y[2], y[3]); o.z = pk2(y[4], y[5]); o.w = pk2(y[6], y[7]);
                *(GAS v4u*)(Y + (size_t)m * 1024 + hs * 128 + 8 * cg) = o;
            }
        }
    }
}
constexpr int CV_W = 0  , CV_B = 2304  , CV_T = 2560;
__device__ __forceinline__ void conv_unit(const Args& a, LAS unsigned char* lds, int l, const bf16* U, bf16* Gd, int Fc, int f0, int unit, int nslab, int tid_in) {
    int tid = tid_in; asm volatile("" : "+v"(tid));
    const int slab = unit % nslab, rest = unit / nslab;
    const bool isctx = rest >= 32;
    const int b = isctx ? rest - 32 : rest >> 2, gy0 = isctx ? 0 : (rest & 3) * 8;
    const int W = isctx ? 256 : 64, NR = isctx ? 1 : 8, HR = isctx ? 0 : 1, TR = NR + 2 * HR, TW = W + 2;
    const int mbase = isctx ? MLAT + b * 256 : b * 2048;
    const int fl = slab * 32;
    LAS float* wsm = (LAS float*)(lds + CV_W); LAS float* bsm = (LAS float*)(lds + CV_B); LAS unsigned char* tile = lds + CV_T;
    __syncthreads();
    for (int p = tid; p < 9 * 64; p += 512) { const int tap = p >> 6, av = (p >> 5) & 1, c = p & 31; wsm[p] = a.in[I_FCONV][((size_t)l * 9 + tap) * 5632 + av * DFF + f0 + fl + c]; }
    if (tid < 64) bsm[tid] = a.in[I_FCB][(size_t)l * 5632 + (tid >> 5) * DFF + f0 + fl + (tid & 31)];
    const int ncell = TR * TW;
    {
        v4u rr[11];
#pragma unroll
        for (int j = 0; j < 11; ++j) {
            const int p = tid + 512 * j; rr[j] = (v4u){0u, 0u, 0u, 0u};
            if (p < ncell * 8) {
                const int cell = p >> 3, pc = p & 7, tr = cell / TW, tc = cell - tr * TW;
                const int gy = gy0 - HR + tr, gx = tc - 1;
                if (gx >= 0 && gx < W && gy >= 0 && gy < (isctx ? 1 : 32)) {
                    const size_t m = (size_t)mbase + gy * W + gx;
                    rr[j] = *(const GAS v4u*)(U + m * (2 * Fc) + (pc >> 2) * Fc + fl + 8 * (pc & 3));
                }
            }
        }
#pragma unroll
        for (int j = 0; j < 11; ++j) { const int p = tid + 512 * j; if (p < ncell * 8) *(LAS v4u*)(tile + p * 16) = rr[j]; }
    }
    __syncthreads();
#pragma unroll 1
    for (int it = tid; it < NR * W * 4; it += 512) {
        const int cg = it & 3, tok = it >> 2, ry = tok / W, gx = tok % W;
        float sa[8], sv[8];
#pragma unroll
        for (int e = 0; e < 8; ++e) { sa[e] = bsm[8 * cg + e]; sv[e] = bsm[32 + 8 * cg + e]; }
#pragma unroll
        for (int dy = -1; dy <= 1; ++dy) {
            if (isctx && dy != 0) continue;
#pragma unroll
            for (int dx = -1; dx <= 1; ++dx) {
                const int tap = (dy + 1) * 3 + dx + 1;
                const LAS unsigned char* cp = tile + ((ry + HR + dy) * TW + gx + 1 + dx) * 128 + 16 * cg;
                float xa[8], xv[8];
                unpack8(*(const LAS v4u*)cp, xa); unpack8(*(const LAS v4u*)(cp + 64), xv);
                const LAS float* wp = wsm + tap * 64 + 8 * cg;
#pragma unroll
                for (int e = 0; e < 8; ++e) { sa[e] += xa[e] * wp[e]; sv[e] += xv[e] * wp[32 + e]; }
            }
        }
        float y[8];
#pragma unroll
        for (int e = 0; e < 8; ++e) y[e] = silu_f(sa[e]) * sv[e];
        v4u o; o.x = pk2(y[0], y[1]); o.y = pk2(y[2], y[3]); o.z = pk2(y[4], y[5]); o.w = pk2(y[6], y[7]);
        const size_t m = (size_t)mbase + (gy0 + ry) * W + gx;
        *(GAS v4u*)(Gd + m * Fc + fl + 8 * cg) = o;
    }
}
__device__ __forceinline__ void phase_conv(const Args& a, LAS unsigned char* lds, int l, int chunkA, int vcu, int G, int tid) {
    unsigned char* ws = a.ws; const LayerBufs B = layer_bufs(l);
    const int Fc = chunkA ? FCA : FCB, f0 = chunkA ? FCB : 0, nslab = Fc / 32;
    const bf16* U = (const bf16*)bufp(ws, a.out, chunkA ? B.UA : B.UB); bf16* Gd = (bf16*)bufp(ws, a.out, chunkA ? B.GA : B.GB);
    const int nunits = (l == DEPTH - 1 ? 32 : 40) * nslab;
    for (int u = vcu; u < nunits; u += G) conv_unit(a, lds, l, U, Gd, Fc, f0, u, nslab, tid);
    __syncthreads();
}
__device__ __forceinline__ void phase_final(const Args& a, int gw, int NGW, int lane) {
    const float* rs = (const float*)(a.ws + WS_RSA) + (size_t)3 * MALL; const float* fn = a.in[I_FNORM];
    f32x4 g[4];
#pragma unroll
    for (int j = 0; j < 4; ++j) g[j] = *(const f32x4*)(fn + 4 * lane + 256 * j);
#pragma unroll 1
    for (int m0 = gw; m0 < MLAT; m0 += 4 * NGW) {
        f32x4 v[4][4]; float rstd[4];
#pragma unroll
        for (int u = 0; u < 4; ++u) { const int m = m0 + u * NGW; if (m < MLAT) { rstd[u] = rs[m];
#pragma unroll
            for (int j = 0; j < 4; ++j) v[u][j] = *(const f32x4*)(a.out + (size_t)m * 1024 + 4 * lane + 256 * j); } }
#pragma unroll
        for (int u = 0; u < 4; ++u) { const int m = m0 + u * NGW; if (m < MLAT) { const float r = rsqrtf(rstd[u] * (1.0f / 1024.0f) + NEPS);
#pragma unroll
            for (int j = 0; j < 4; ++j) *(f32x4*)(a.out + (size_t)m * 1024 + 4 * lane + 256 * j) = v[u][j] * r * g[j]; } }
    }
}
constexpr int PH_P0A = 0, PH_P0B = 1, PH_L0 = 2, PH_PER_LAYER = 11, PH_FINAL = PH_L0 + 2 * PH_PER_LAYER, PH_COUNT = PH_FINAL + 1;
enum { K_INPROJ = 0, K_PREP, K_SCAN, K_MERGE, K_OUTPROJ, K_UPB, K_CONVB, K_DOWNB, K_UPA, K_CONVA, K_DOWNA };

__global__ void __launch_bounds__(NWAVES * 64, 2) mk_fwd(Args a) {
    extern __shared__ __attribute__((aligned(16))) unsigned char lds_raw[];
    LAS unsigned char* lds = (LAS unsigned char*)lds_raw;
    const int G = gridDim.x; const int bx = blockIdx.x;
    const int vcu = (G % 8 == 0) ? (bx % 8) * (G / 8) + bx / 8 : bx;
    const int NGW = G * NWAVES;
    unsigned char* ws = a.ws;
    for (int u = threadIdx.x; u < (LDS_BYTES - LDSCTL_OFF) / 4; u += NWAVES * 64) ((LAS unsigned*)(lds + LDSCTL_OFF))[u] = 0u;
    __syncthreads();
    XcdBarrier bar; bar.bar = (unsigned*)(ws + WS_CTL) + CW_BAR; bar.x = 0; bar.st = nullptr;
    if (a.use_bar) bar = xcd_barrier_post((unsigned*)(ws + WS_CTL) + CW_BAR, (volatile LAS unsigned*)(lds + LDSCTL_OFF) + 8);
    const float* MOD = (const float*)(ws + WS_MOD);
    float* RSA = (float*)(ws + WS_RSA);

    for (int ph = a.ph_lo; ph < a.ph_hi; ++ph) {
        STAMP(ph);
        int tid_o = threadIdx.x; asm volatile("" : "+v"(tid_o));
        const int tid = tid_o, lane = tid & 63, wave = __builtin_amdgcn_readfirstlane(tid >> 6);
        const int gw = vcu * NWAVES + wave;
        if (ph == PH_P0A) phase_p0a(a, lds, vcu, G, tid, wave, lane);
        else if (ph == PH_P0B) phase_p0b(a, lds, vcu, G, tid, wave, lane);
        else if (ph < PH_FINAL) {
            const int l = (ph - PH_L0) / PH_PER_LAYER, k = (ph - PH_L0) % PH_PER_LAYER;
            const LayerBufs B = layer_bufs(l);
            unsigned char* wl = ws + (l == 0 ? WS_W1 : WS_W2);
            const float* MODl = MOD + (size_t)l * 9 * 6144;
            const float* SWl = (const float*)(ws + WS_SW) + (size_t)l * SW_LAYER;
            const float* rs_n1 = l == 0 ? (const float*)(ws + WS_RS1) : RSA + (size_t)1 * MALL;
            if (k == K_INPROJ) {
                const bf16* XG = (const bf16*)bufp(ws, a.out, B.XG);
                skinny_rows(XG, (const bf16*)(ws + WS_WSM) + (size_t)l * 48 * 1024, rs_n1, SWl + 9 * NMAIN, (float*)(ws + WS_SM), gw, NGW, lane);
                pg8::Gemm g{XG, (const bf16*)(wl + W_IN), MALL, NMAIN, 1024}; pg8::StaticOrder S; S.init(MALL, NMAIN, G, bx);
                pg8::EpiInProj E{ws, a.out, l};
                pg8::gemm_phase<pg8::EpiInProj, pg8::StaticOrder, true, true>(lds, g, S, E);
            }
            else if (k == K_PREP) phase_prep(a, lds, l, vcu, G, tid, wave, lane);
            else if (k == K_SCAN) phase_scan(a, lds, l, vcu, G, tid, wave, lane);
            else if (k == K_MERGE) phase_merge(a, l, gw, NGW, lane);
            else if (k == K_OUTPROJ || k == K_DOWNB || k == K_DOWNA) {
                const int M = l == DEPTH - 1 ? MLAT : MALL;
                const bool last = l == DEPTH - 1;
                float* res_lat = a.out; float* res_ctx = (float*)(ws + WS_CXR);
                pg8::EpiResid E;
                E.rin_lat = (k == K_OUTPROJ && l == 0) ? a.in[I_X] : res_lat; E.rin_ctx = (k == K_OUTPROJ && l == 0) ? a.in[I_CTX] : res_ctx;
                E.rout_lat = res_lat; E.rout_ctx = res_ctx;
                E.gate = MODl + (k == K_OUTPROJ ? 2 : 5) * 1024; E.gn = nullptr; E.scl = nullptr; E.XGo = nullptr; E.rowss = nullptr;
                pg8::Gemm g;
                if (k == K_OUTPROJ) { g = pg8::Gemm{(const bf16*)bufp(ws, a.out, B.Y), (const bf16*)(wl + W_OUT), M, 1024, 1024};
                    E.gn = a.in[I_NORM2] + l * 1024; E.scl = MODl + 4 * 1024; E.XGo = (bf16*)bufp(ws, a.out, B.XG2); E.rowss = RSA + (size_t)(l == 0 ? 0 : 2) * MALL; }
                else if (k == K_DOWNB) g = pg8::Gemm{(const bf16*)bufp(ws, a.out, B.GB), (const bf16*)(wl + W_DB), M, 1024, FCB};
                else { g = pg8::Gemm{(const bf16*)bufp(ws, a.out, B.GA), (const bf16*)(wl + W_DA), M, 1024, FCA};
                    if (!last) { E.gn = a.in[I_NORM1] + 1024; E.scl = MOD + (size_t)9 * 6144 + 1 * 1024; E.XGo = (bf16*)bufp(ws, a.out, B.XGN); E.rowss = RSA + (size_t)1 * MALL; }
                    else E.rowss = RSA + (size_t)3 * MALL; }
                pg8::StaticOrder S; S.init(M, 1024, G, bx);
                pg8::gemm_phase<pg8::EpiResid, pg8::StaticOrder, true, true>(lds, g, S, E);
            }
            else if (k == K_UPB || k == K_UPA) {
                const int M = l == DEPTH - 1 ? MLAT : MALL;
                const int roff = k == K_UPA ? 2 * FCB : 0, N = k == K_UPA ? 2 * FCA : 2 * FCB;
                pg8::Gemm g{(const bf16*)bufp(ws, a.out, B.XG2), (const bf16*)(wl + W_UP) + (size_t)roff * 1024, M, N, 1024};
                pg8::EpiUp E{RSA + (size_t)(l == 0 ? 0 : 2) * MALL, SWl + 9 * (NMAIN + NSMALL) + roff, (bf16*)bufp(ws, a.out, k == K_UPA ? B.UA : B.UB), N};
                pg8::StaticOrder S; S.init(M, N, G, bx);
                pg8::gemm_phase<pg8::EpiUp, pg8::StaticOrder, true, true>(lds, g, S, E);
            }
            else if (k == K_CONVB || k == K_CONVA) phase_conv(a, lds, l, k == K_CONVA, vcu, G, tid);
        }
        else phase_final(a, gw, NGW, lane);
        if (ph + 1 < a.ph_hi && a.use_bar) xcd_barrier(bar);
    }
    STAMP(PH_COUNT);
#ifdef MK_PROF_A
    if (blockIdx.x == 0 && threadIdx.x == 0) {
        volatile LAS unsigned long long* st = (volatile LAS unsigned long long*)(lds + LDSCTL_OFF + 256);
        const unsigned long long d = (st[MK_PROF_B] - st[MK_PROF_A]) * (unsigned long long)(MK_PROF_K);
        const unsigned long long t0 = __builtin_amdgcn_s_memrealtime();
        while (__builtin_amdgcn_s_memrealtime() - t0 < d) __builtin_amdgcn_s_sleep(8);
    }
#endif
}
static int g_grid = 0;
static int mk_setup() {
    if (g_grid) return g_grid;
    int dev = 0, cus = 0;
    if (hipGetDevice(&dev) != hipSuccess || hipDeviceGetAttribute(&cus, hipDeviceAttributeMultiprocessorCount, dev) != hipSuccess) { g_grid = -1; return -1; }
    if (hipFuncSetAttribute((const void*)mk_fwd, hipFuncAttributeMaxDynamicSharedMemorySize, LDS_BYTES) != hipSuccess) { fprintf(stderr, "hipFuncSetAttribute failed\n"); g_grid = -1; return -1; }
    (void)hipGetLastError();
    g_grid = cus;
    return g_grid;
}
static void mk_launch(const Args& base, int lo, int hi, int use_bar, hipStream_t stream) {
    Args a = base; a.ph_lo = lo; a.ph_hi = hi; a.use_bar = use_bar;
    hipLaunchKernelGGL(mk_fwd, dim3(g_grid), dim3(NWAVES * 64), LDS_BYTES, stream, a);
}

extern "C" void kernel_launch(void* const* d_in, const int* in_sizes, int n_in, void* d_out, int out_size, void* d_ws, size_t ws_size, hipStream_t stream) {
    if (mk_setup() < 0) return;
    unsigned char* ws = (unsigned char*)d_ws;
    (void)hipMemsetAsync(ws + WS_CTL, 0, CTL_ZERO_BYTES, stream);
    Args a{};
    for (int i = 0; i < 22; ++i) a.in[i] = (const float*)d_in[i];
    a.out = (float*)d_out; a.ws = ws;
#ifndef MK_N_LAUNCHES
#define MK_N_LAUNCHES 1
#endif
    if (MK_N_LAUNCHES == 1) mk_launch(a, 0, PH_COUNT, 1, stream);
    else for (int ph = 0; ph < PH_COUNT; ++ph) mk_launch(a, ph, ph + 1, 0, stream);
#ifdef MK_PROBE_LIST
    {
        Args p = a; p.out = (float*)(ws + 64 * MiB);
#ifdef MK_PROBE_PMODE
        p.pad = MK_PROBE_PMODE;
#endif
        const int lst[] = { MK_PROBE_LIST };
        for (int r = 0; r < MK_PROBE_REPS; ++r) for (unsigned i = 0; i < sizeof(lst) / sizeof(lst[0]); ++i) mk_launch(p, lst[i], lst[i] + 1, 0, stream);
    }
#endif
}
```

```cpp
#include <hip/hip_runtime.h>
#include <cstdio>
#include <cstdint>
#include <math.h>

#define GAS __attribute__((address_space(1)))
#define LAS __attribute__((address_space(3)))
typedef unsigned short bf16;
typedef unsigned v4u __attribute__((ext_vector_type(4)));
typedef unsigned v2u __attribute__((ext_vector_type(2)));
typedef float f32x4 __attribute__((ext_vector_type(4)));
typedef float f32x16 __attribute__((ext_vector_type(16)));
typedef short bf16x8 __attribute__((ext_vector_type(8)));
typedef short s16x4 __attribute__((ext_vector_type(4)));
typedef __bf16 bf16x2_t __attribute__((ext_vector_type(2)));
typedef float f32x2_t __attribute__((ext_vector_type(2)));
typedef GAS unsigned gu32;

constexpr int DM = 1024, NBATCH = 8, LSEQ = 2048, LCTX = 256, DEPTH = 2;
constexpr int MLAT = NBATCH * LSEQ;
constexpr int MALL = MLAT + NBATCH * LCTX;
constexpr int NCHUNK = MALL / 64;
constexpr int DINP = 3632, NMAIN = 3584, NSMALL = 48;
constexpr int DFF = 2816, FCB = 1280, FCA = 1536;
constexpr float NEPS = 1e-6f;

constexpr size_t MiB = 1u << 20;
constexpr size_t WS_CTL = 0, CTL_ZERO_BYTES = 1 * MiB;
constexpr int CW_BAR = 4096;
constexpr size_t WS_RSA = 256 * 1024;
constexpr size_t WS_MOD = 1 * MiB;
constexpr size_t WS_RS1 = 1 * MiB + 512 * 1024;
constexpr size_t WS_SW = 2 * MiB;
constexpr size_t SW_LAYER = (size_t)9 * (NMAIN + NSMALL + 2 * DFF);
constexpr size_t WS_GDEC = 3 * MiB;
constexpr size_t WS_LDEC = 4 * MiB + 512 * 1024;
constexpr size_t WS_SM = 5 * MiB + 256 * 1024;
constexpr size_t WS_HALO = 9 * MiB;
constexpr size_t WS_WSM = 11 * MiB;
constexpr size_t WS_W2 = 12 * MiB, WS_W1 = 38 * MiB;
constexpr size_t W_IN = 0, W_OUT = 7 * MiB, W_UP = 9 * MiB, W_DB = 20 * MiB, W_DA = 20 * MiB + (size_t)1024 * FCB * 2;
constexpr size_t WS_CXR = 64 * MiB;
static_assert(W_DA + (size_t)1024 * FCA * 2 <= 26 * MiB, "weights");
static_assert(WS_SM + (size_t)MALL * 48 * 4 <= WS_HALO && WS_HALO + (size_t)NCHUNK * 2 * 1536 * 2 <= WS_WSM, "ws small map");
static_assert(WS_SW + 2 * SW_LAYER * 4 <= WS_GDEC && WS_RSA + (size_t)4 * MALL * 4 <= CTL_ZERO_BYTES, "ws map");

struct LayerBufs {
    long XG, GQ, GK, GV, LV, ZA, ZB, LQ, LK, GTA, LOP0, LOP1, Y, XG2, UB, GB, UA, GA, XGN;
};
#define DO_(x) (-(long)((x) * MiB) - 1)
__host__ __device__ constexpr LayerBufs layer_bufs(int l) {
    return l == 0 ? LayerBufs{ 72 * (long)MiB, 108 * (long)MiB, 126 * (long)MiB, 144 * (long)MiB, 162 * (long)MiB, DO_(0), DO_(18), DO_(36), DO_(45),
                               180 * (long)MiB, 72 * (long)MiB, 216 * (long)MiB, 108 * (long)MiB, 72 * (long)MiB, 108 * (long)MiB, 198 * (long)MiB, 126 * (long)MiB, 72 * (long)MiB, 220 * (long)MiB }
                  : LayerBufs{ 220 * (long)MiB, 38 * (long)MiB, 56 * (long)MiB, 74 * (long)MiB, 92 * (long)MiB, 110 * (long)MiB, 128 * (long)MiB, 146 * (long)MiB, 155 * (long)MiB,
                               164 * (long)MiB, 200 * (long)MiB, 227 * (long)MiB, 38 * (long)MiB, 74 * (long)MiB, 110 * (long)MiB, 190 * (long)MiB, 110 * (long)MiB, 206 * (long)MiB, 0 };
}

#define LDS_WAIT() asm volatile("s_waitcnt lgkmcnt(0)" ::: "memory")
#define VM_WAIT() asm volatile("s_waitcnt vmcnt(0)" ::: "memory")
__device__ __forceinline__ unsigned pk2(float lo, float hi) { f32x2_t v = {lo, hi}; bf16x2_t b = __builtin_convertvector(v, bf16x2_t); return __builtin_bit_cast(unsigned, b); }
__device__ __forceinline__ float bflo(unsigned u) { return __uint_as_float(u << 16); }
__device__ __forceinline__ float bfhi(unsigned u) { return __uint_as_float(u & 0xffff0000u); }
__device__ __forceinline__ float bf2f(bf16 u) { return __uint_as_float((unsigned)u << 16); }
__device__ __forceinline__ float silu_f(float x) { return x * __builtin_amdgcn_rcpf(1.f + __expf(-x)); }
__device__ __forceinline__ float softplus_f(float x) { return fmaxf(x, 0.f) + log1pf(__expf(-fabsf(x))); }
__device__ __forceinline__ float sigmoid_f(float x) { return __builtin_amdgcn_rcpf(1.f + __expf(-x)); }
__device__ __forceinline__ float wave_sum(float v) {
#pragma unroll
    for (int o = 1; o < 64; o <<= 1) v += __shfl_xor(v, o);
    return v;
}
__device__ __forceinline__ int row_s(int m) { return m < MLAT ? (m >> 11) : 8; }
__host__ __device__ __forceinline__ unsigned char* bufp(unsigned char* ws, float* out, long off) { return off >= 0 ? ws + off : (unsigned char*)out + (-off - 1); }
namespace pg8 {
#define PG8_LAS __attribute__((address_space(3)))
typedef unsigned short bf16_t;
typedef short bf16x8 __attribute__((ext_vector_type(8)));
typedef float f32x4 __attribute__((ext_vector_type(4)));
typedef unsigned u32x4 __attribute__((ext_vector_type(4)));
constexpr int BM = 256, BK = 64, HALF = 128, HTB = HALF * BK * 2  , STAGE_BYTES = 8 * HTB, NXCD = 8, WGM = 8;

__host__ __device__ __forceinline__ int lds_byte(int r, int c) { const int st = (r >> 4) * 2 + (c >> 5), rr = r & 15, cc = c & 31, ob = rr * 64 + cc * 2; return st * 1024 + (ob ^ (((ob >> 9) & 1) << 5)); }
__host__ __device__ __forceinline__ void stage_rc(int b, int& R, int& C) { const int st = b / 1024, sb = b % 1024, swz = sb ^ (((sb >> 9) & 1) << 5); R = (st >> 1) * 16 + swz / 64; C = (st & 1) * 32 + (swz % 64) / 2; }
__host__ __device__ __forceinline__ int perm32(int rho) { const int n = rho >> 4, i = rho & 15; return 8 * (i >> 2) + 4 * n + (i & 3); }

struct Unit { int pm, pn; };
struct Gemm { const bf16_t* A; const bf16_t* Bt; int M, N, K; };

struct StaticOrder {
    int nM, nN, nwg, G, c;
    __host__ __device__ void init(int M, int N, int G_, int c_) { nM = M / BM; nN = N / BM; nwg = nM * nN; G = G_; c = c_; }
    __host__ __device__ bool next(int i, Unit& u) const {
        const long L = (long)i * G + c; if (L >= nwg) return false;
        int wgid = (int)L; { const int q = nwg / NXCD, r = nwg % NXCD, xcd = wgid % NXCD, off = wgid / NXCD; wgid = (xcd < r ? xcd * (q + 1) : r * (q + 1) + (xcd - r) * q) + off; }
        const int nig = WGM * nN, gid = wgid / nig, fm = gid * WGM, gsz = (nM - fm) < WGM ? (nM - fm) : WGM;
        u.pm = fm + ((wgid % nig) % gsz); u.pn = (wgid % nig) / gsz; return true;
    }
    __device__ __forceinline__ void a_ready(const Unit&) const {}
    __device__ __forceinline__ void done(const Unit&) const {}
};
__device__ __forceinline__ unsigned pk2e(float lo, float hi) { f32x2_t v = {lo, hi}; bf16x2_t b = __builtin_convertvector(v, bf16x2_t); return __builtin_bit_cast(unsigned, b); }

struct EpiInProj {
    static constexpr bool PERM = true, AFTER_DRAIN = false;
    unsigned char* ws; float* out; int l;
    __device__ __forceinline__ void operator()(const f32x4 (&acc)[2][2][4][2], const Unit& u, int wr, int wc, int fr, int fq) const {
        const LayerBufs B = layer_bufs(l);
        const float* rowss = l == 0 ? (const float*)(ws + WS_RS1) : (const float*)(ws + WS_RSA) + MALL;
        const float* sW = (const float*)(ws + WS_SW) + (size_t)l * SW_LAYER;
        const int pn = u.pn, s = u.pm < 64 ? (u.pm >> 3) : 8;
        long boff; int ld, cb;
        if (pn < 8) { const int t = pn >> 1; boff = t == 0 ? B.GQ : (t == 1 ? B.GK : (t == 2 ? B.GV : B.ZA)); ld = 512; cb = (pn & 1) * 256; }
        else if (pn == 8) { boff = B.LQ; ld = 256; cb = 0; }
        else if (pn == 9) { boff = B.LK; ld = 256; cb = 0; }
        else { boff = pn < 12 ? B.LV : B.ZB; ld = 512; cb = (pn & 1) * 256; }
        bf16_t* base = (bf16_t*)bufp(ws, out, boff);
        bf16_t* HALO = (bf16_t*)(ws + WS_HALO);
        const int row0 = u.pm * BM + wr * 64 + fr, colw = wc * 32 + 8 * fq;
        const float* swp = sW + (size_t)s * 3584 + pn * BM + colw;
        f32x4 bv[2][2];
#pragma unroll
        for (int bj = 0; bj < 2; ++bj)
#pragma unroll
            for (int n = 0; n < 2; ++n) bv[bj][n] = *(const f32x4*)(swp + bj * HALF + 4 * n);
        float rs8[8];
#pragma unroll
        for (int q = 0; q < 8; ++q) rs8[q] = rowss[row0 + (q >> 2) * HALF + (q & 3) * 16];
#pragma unroll
        for (int ai = 0; ai < 2; ++ai)
#pragma unroll
            for (int m = 0; m < 4; ++m) {
                const int row = row0 + ai * HALF + m * 16;
                const float rstd = rsqrtf(rs8[ai * 4 + m] * (1.0f / 1024.0f) + 1e-6f);
                bf16_t* rowp = base + (size_t)row * ld + cb + colw;
                const bool halo = (pn < 6) && ((m == 0 && fr == 0) || (m == 3 && fr == 15));
                bf16_t* hp = HALO + ((size_t)(row >> 6) * 2 + (m == 3 ? 1 : 0)) * 1536 + (pn >> 1) * 512 + cb + colw;
#pragma unroll
                for (int bj = 0; bj < 2; ++bj) {
                    const f32x4 v0 = acc[ai][bj][m][0] * rstd + bv[bj][0], v1 = acc[ai][bj][m][1] * rstd + bv[bj][1];
                    u32x4 w; w.x = pk2e(v0[0], v0[1]); w.y = pk2e(v0[2], v0[3]); w.z = pk2e(v1[0], v1[1]); w.w = pk2e(v1[2], v1[3]);
                    *(u32x4*)(rowp + bj * HALF) = w;
                    if (halo) *(u32x4*)(hp + bj * HALF) = w;
                }
            }
    }
};

struct EpiResid {
    static constexpr bool PERM = true, AFTER_DRAIN = false;
    const float* rin_lat; const float* rin_ctx; float* rout_lat; float* rout_ctx;
    const float* gate;
    const float* gn;
    const float* scl;
    bf16_t* XGo; float* rowss;
    __device__ __forceinline__ void operator()(const f32x4 (&acc)[2][2][4][2], const Unit& u, int wr, int wc, int fr, int fq) const {
        const int s = u.pm < 64 ? (u.pm >> 3) : 8;
        const bool isctx = u.pm >= 64, do_xg = XGo != nullptr, do_ss = rowss != nullptr;
        const float* rin = isctx ? rin_ctx - (size_t)16384 * 1024 : rin_lat;
        float* rout = isctx ? rout_ctx - (size_t)16384 * 1024 : rout_lat;
        const int row0 = u.pm * BM + wr * 64 + fr, col0 = u.pn * BM + wc * 32 + 8 * fq;
        f32x4 gv[2][2], nv[2][2];
#pragma unroll
        for (int bj = 0; bj < 2; ++bj)
#pragma unroll
            for (int n = 0; n < 2; ++n) {
                gv[bj][n] = *(const f32x4*)(gate + (size_t)s * 6144 + col0 + bj * HALF + 4 * n);
                if (do_xg) { const f32x4 g = *(const f32x4*)(gn + col0 + bj * HALF + 4 * n), sc = *(const f32x4*)(scl + (size_t)s * 6144 + col0 + bj * HALF + 4 * n); nv[bj][n] = g * (sc + 1.0f); }
                else nv[bj][n] = (f32x4){0.f, 0.f, 0.f, 0.f};
            }
#pragma unroll
        for (int am = 0; am < 4; ++am) {
            const int ai = am >> 1, mb = (am & 1) * 2;
            f32x4 rv[2][2][2];
#pragma unroll
            for (int mm = 0; mm < 2; ++mm) { const float* rp = rin + (size_t)(row0 + ai * HALF + (mb + mm) * 16) * 1024 + col0;
#pragma unroll
                for (int bj = 0; bj < 2; ++bj) { rv[mm][bj][0] = *(const f32x4*)(rp + bj * HALF); rv[mm][bj][1] = *(const f32x4*)(rp + bj * HALF + 4); } }
#pragma unroll
            for (int mm = 0; mm < 2; ++mm) {
                const int m = mb + mm;
                const int row = row0 + ai * HALF + m * 16;
                float* op = rout + (size_t)row * 1024 + col0;
                float ss = 0.f;
#pragma unroll
                for (int bj = 0; bj < 2; ++bj) {
                    const f32x4 x0 = rv[mm][bj][0] + gv[bj][0] * acc[ai][bj][m][0];
                    const f32x4 x1 = rv[mm][bj][1] + gv[bj][1] * acc[ai][bj][m][1];
                    *(f32x4*)(op + bj * HALF) = x0; *(f32x4*)(op + bj * HALF + 4) = x1;
                    ss += (x0[0] * x0[0] + x0[1] * x0[1]) + (x0[2] * x0[2] + x0[3] * x0[3]) + (x1[0] * x1[0] + x1[1] * x1[1]) + (x1[2] * x1[2] + x1[3] * x1[3]);
                    if (do_xg) {
                        const f32x4 y0 = x0 * nv[bj][0], y1 = x1 * nv[bj][1];
                        u32x4 w; w.x = pk2e(y0[0], y0[1]); w.y = pk2e(y0[2], y0[3]); w.z = pk2e(y1[0], y1[1]); w.w = pk2e(y1[2], y1[3]);
                        *(u32x4*)(XGo + (size_t)row * 1024 + col0 + bj * HALF) = w;
                    }
                }
                if (do_ss) { ss += __shfl_xor(ss, 16); ss += __shfl_xor(ss, 32); if (fq == 0) atomicAdd(rowss + row, ss); }
            }
        }
    }
};

struct EpiUp {
    static constexpr bool PERM = true, AFTER_DRAIN = false;
    const float* rowss; const float* sW;
    bf16_t* U; int ldu;
    __device__ __forceinline__ void operator()(const f32x4 (&acc)[2][2][4][2], const Unit& u, int wr, int wc, int fr, int fq) const {
        const int s = u.pm < 64 ? (u.pm >> 3) : 8;
        const int row0 = u.pm * BM + wr * 64 + fr, col0 = u.pn * BM + wc * 32 + 8 * fq;
        const float* swp = sW + (size_t)s * 5632 + col0;
        f32x4 bv[2][2];
#pragma unroll
        for (int bj = 0; bj < 2; ++bj)
#pragma unroll
            for (int n = 0; n < 2; ++n) bv[bj][n] = *(const f32x4*)(swp + bj * HALF + 4 * n);
        float rs8[8];
#pragma unroll
        for (int q = 0; q < 8; ++q) rs8[q] = rowss[row0 + (q >> 2) * HALF + (q & 3) * 16];
#pragma unroll
        for (int ai = 0; ai < 2; ++ai)
#pragma unroll
            for (int m = 0; m < 4; ++m) {
                const int row = row0 + ai * HALF + m * 16;
                const float rstd = rsqrtf(rs8[ai * 4 + m] * (1.0f / 1024.0f) + 1e-6f);
                bf16_t* rowp = U + (size_t)row * ldu + col0;
#pragma unroll
                for (int bj = 0; bj < 2; ++bj) {
                    const f32x4 v0 = acc[ai][bj][m][0] * rstd + bv[bj][0], v1 = acc[ai][bj][m][1] * rstd + bv[bj][1];
                    u32x4 w; w.x = pk2e(v0[0], v0[1]); w.y = pk2e(v0[2], v0[3]); w.z = pk2e(v1[0], v1[1]); w.w = pk2e(v1[2], v1[3]);
                    *(u32x4*)(rowp + bj * HALF) = w;
                }
            }
    }
};
template <class Epi, class Sched, bool ALIGN_EPI = false, bool SP2 = false>
__device__ __forceinline__ void gemm_phase(PG8_LAS unsigned char* lds, const Gemm g, const Sched& S, const Epi& E) {
    int tid_o = threadIdx.x; asm volatile("" : "+v"(tid_o));
    const int tid = tid_o, wid = __builtin_amdgcn_readfirstlane(tid >> 6), lane = tid & 63, wr = wid >> 2, wc = wid & 3, fr = lane & 15, fq = lane >> 4;
    const int K = g.K, nt = K / BK;
    unsigned voffA[2], voffB[2];
#pragma unroll
    for (int i = 0; i < 2; ++i) { int R, C; stage_rc(tid * 16 + i * 8192, R, C); const int Rb = Epi::PERM ? ((R & ~31) + perm32(R & 31)) : R;
        voffA[i] = (unsigned)(R * K + C) * 2u; voffB[i] = (unsigned)(Rb * K + C) * 2u; }
    const size_t kstep = (size_t)(BK * 2);
    const size_t hstep = (size_t)HALF * K * 2;
    const size_t tstep = 2 * hstep;
    const unsigned ldsw = (unsigned)wid * 1024u;
    const int aoff = lds_byte(wr * 64 + fr, fq * 8), boff = lds_byte(wc * 32 + fr, fq * 8);
#define PG8_SA(b, h) (((b) * 2 + (h)) * HTB)
#define PG8_SB(b, h) ((4 + (b) * 2 + (h)) * HTB)
#define PG8_STAGE(bufoff, gbase, voff) do { _Pragma("unroll") for (int _i = 0; _i < 2; ++_i) \
        __builtin_amdgcn_global_load_lds((const unsigned*)((const char*)(gbase) + (voff)[_i]), (PG8_LAS unsigned*)(lds + (bufoff) + ldsw + _i * 8192), 16, 0, 0); } while (0)
#define PG8_LDA(dst, b, h) do { _Pragma("unroll") for (int m = 0; m < 4; ++m) _Pragma("unroll") for (int k = 0; k < 2; ++k) dst[m][k] = *(const PG8_LAS bf16x8*)(lds + PG8_SA(b, h) + aoff + m * 2048 + k * 1024); } while (0)
#define PG8_LDB(dst, b, h) do { _Pragma("unroll") for (int n = 0; n < 2; ++n) _Pragma("unroll") for (int k = 0; k < 2; ++k) dst[n][k] = *(const PG8_LAS bf16x8*)(lds + PG8_SB(b, h) + boff + n * 2048 + k * 1024); } while (0)
#define PG8_MMA(ai, bj, At, Bt) do { __builtin_amdgcn_s_setprio(1); _Pragma("unroll") for (int m = 0; m < 4; ++m) _Pragma("unroll") for (int n = 0; n < 2; ++n) _Pragma("unroll") for (int k = 0; k < 2; ++k) \
        acc[ai][bj][m][n] = __builtin_amdgcn_mfma_f32_16x16x32_bf16(Bt[n][k], At[m][k], acc[ai][bj][m][n], 0, 0, 0); __builtin_amdgcn_s_setprio(0); } while (0)
#define PG8_WAIT_V(n) asm volatile("s_waitcnt vmcnt(" #n ")" ::: "memory")
#define PG8_WAIT_L(n) asm volatile("s_waitcnt lgkmcnt(" #n ")" ::: "memory")
#define PG8_BAR __builtin_amdgcn_s_barrier()
#define PG8_SCHED __builtin_amdgcn_sched_barrier(0)
    Unit cur, nxt; int ui = 0;
    if (!S.next(0, cur)) return;
    f32x4 acc[2][2][4][2];
#pragma unroll
    for (int a = 0; a < 2; ++a)
#pragma unroll
        for (int b = 0; b < 2; ++b)
#pragma unroll
            for (int m = 0; m < 4; ++m)
#pragma unroll
                for (int n = 0; n < 2; ++n) acc[a][b][m][n] = (f32x4){0.f, 0.f, 0.f, 0.f};
    bf16x8 At[4][2], B0[2][2], B1[2][2];
    const char* cA = (const char*)g.A + (size_t)cur.pm * tstep; const char* cB = (const char*)g.Bt + (size_t)cur.pn * tstep;
    S.a_ready(cur);
    if constexpr (SP2) {
        PG8_STAGE(PG8_SB(0, 0), cB, voffB); PG8_STAGE(PG8_SB(0, 1), cB + hstep, voffB); PG8_STAGE(PG8_SA(0, 0), cA, voffA); PG8_STAGE(PG8_SA(0, 1), cA + hstep, voffA);
        if (wr == 1) PG8_BAR;
        PG8_WAIT_V(2); PG8_BAR;
        PG8_STAGE(PG8_SB(1, 0), cB + kstep, voffB); PG8_STAGE(PG8_SA(1, 0), cA + kstep, voffA); PG8_STAGE(PG8_SB(1, 1), cB + hstep + kstep, voffB);
        PG8_WAIT_V(6); PG8_BAR;
    } else {
        PG8_STAGE(PG8_SB(0, 0), cB, voffB); PG8_STAGE(PG8_SA(0, 0), cA, voffA); PG8_STAGE(PG8_SB(0, 1), cB + hstep, voffB); PG8_STAGE(PG8_SA(0, 1), cA + hstep, voffA);
        if (wr == 1) PG8_BAR;
        PG8_WAIT_V(4); PG8_BAR;
        PG8_STAGE(PG8_SB(1, 0), cB + kstep, voffB); PG8_STAGE(PG8_SA(1, 0), cA + kstep, voffA); PG8_STAGE(PG8_SB(1, 1), cB + hstep + kstep, voffB);
        PG8_WAIT_V(6); PG8_BAR;
    }
    for (;;) {
        const bool has_next = S.next(ui + 1, nxt);
        const char* nA = has_next ? (const char*)g.A + (size_t)nxt.pm * tstep : cA; const char* nB = has_next ? (const char*)g.Bt + (size_t)nxt.pn * tstep : cB;
        for (int t = 0; t < nt; t += 2) {
            const bool last = (t == nt - 2);
            const char* a1 = cA + (size_t)(t + 1) * kstep;
            const char* a2 = last ? nA : cA + (size_t)(t + 2) * kstep; const char* b2 = last ? nB : cB + (size_t)(t + 2) * kstep;
            const char* a3 = a2 + kstep; const char* b3 = b2 + kstep;
            if (last && has_next) S.a_ready(nxt);
            if constexpr (SP2) {
            PG8_LDB(B0, 0, 0); PG8_LDB(B1, 0, 1); PG8_SCHED; PG8_LDA(At, 0, 0); PG8_STAGE(PG8_SA(1, 1), a1 + hstep, voffA);
            PG8_WAIT_V(8); PG8_WAIT_L(0); PG8_BAR; PG8_MMA(0, 0, At, B0); PG8_MMA(0, 1, At, B1); PG8_BAR; PG8_SCHED;
            PG8_LDA(At, 0, 1); PG8_STAGE(PG8_SB(0, 0), b2, voffB); PG8_STAGE(PG8_SB(0, 1), b2 + hstep, voffB); PG8_STAGE(PG8_SA(0, 0), a2, voffA);
            PG8_WAIT_V(8); PG8_WAIT_L(0); PG8_BAR; PG8_MMA(1, 0, At, B0); PG8_MMA(1, 1, At, B1); PG8_BAR; PG8_SCHED;
            PG8_LDB(B0, 1, 0); PG8_LDB(B1, 1, 1); PG8_SCHED; PG8_LDA(At, 1, 0); PG8_STAGE(PG8_SA(0, 1), a2 + hstep, voffA);
            PG8_WAIT_V(8); PG8_WAIT_L(0); PG8_BAR; PG8_MMA(0, 0, At, B0); PG8_MMA(0, 1, At, B1); PG8_BAR; PG8_SCHED;
            PG8_LDA(At, 1, 1); PG8_STAGE(PG8_SB(1, 0), b3, voffB); PG8_STAGE(PG8_SB(1, 1), b3 + hstep, voffB); PG8_STAGE(PG8_SA(1, 0), a3, voffA);
            PG8_WAIT_V(8); PG8_WAIT_L(0); PG8_BAR; PG8_MMA(1, 0, At, B0); PG8_MMA(1, 1, At, B1); PG8_BAR; PG8_SCHED;
            } else {
            PG8_LDB(B0, 0, 0); PG8_SCHED; PG8_LDA(At, 0, 0); PG8_STAGE(PG8_SA(1, 1), a1 + hstep, voffA);
            PG8_WAIT_L(8); PG8_BAR; PG8_WAIT_L(0); PG8_MMA(0, 0, At, B0); PG8_BAR; PG8_SCHED;
            PG8_LDB(B1, 0, 1); PG8_STAGE(PG8_SB(0, 0), b2, voffB);
            PG8_BAR; PG8_WAIT_L(0); PG8_MMA(0, 1, At, B1); PG8_BAR;
            PG8_LDA(At, 0, 1); PG8_STAGE(PG8_SA(0, 0), a2, voffA);
            PG8_BAR; PG8_WAIT_L(0); PG8_MMA(1, 0, At, B0); PG8_BAR; PG8_SCHED;
            PG8_STAGE(PG8_SB(0, 1), b2 + hstep, voffB);
            PG8_WAIT_V(6); PG8_BAR; PG8_MMA(1, 1, At, B1); PG8_BAR;
            PG8_LDB(B0, 1, 0); PG8_SCHED; PG8_LDA(At, 1, 0); PG8_STAGE(PG8_SA(0, 1), a2 + hstep, voffA);
            PG8_WAIT_L(8); PG8_BAR; PG8_WAIT_L(0); PG8_MMA(0, 0, At, B0); PG8_BAR; PG8_SCHED;
            PG8_LDB(B1, 1, 1); PG8_STAGE(PG8_SB(1, 0), b3, voffB);
            PG8_BAR; PG8_WAIT_L(0); PG8_MMA(0, 1, At, B1); PG8_BAR;
            PG8_LDA(At, 1, 1); PG8_STAGE(PG8_SA(1, 0), a3, voffA);
            PG8_BAR; PG8_WAIT_L(0); PG8_MMA(1, 0, At, B0); PG8_BAR; PG8_SCHED;
            PG8_STAGE(PG8_SB(1, 1), b3 + hstep, voffB);
            PG8_WAIT_V(6); PG8_BAR; PG8_MMA(1, 1, At, B1); PG8_BAR;
            }
        }
        if constexpr (ALIGN_EPI) { if (wr == 0) PG8_BAR; }
        if constexpr (!Epi::AFTER_DRAIN) { E(acc, cur, wr, wc, fr, fq); S.done(cur); }
        if (!has_next) break;
#pragma unroll
        for (int a = 0; a < 2; ++a)
#pragma unroll
            for (int b = 0; b < 2; ++b)
#pragma unroll
                for (int m = 0; m < 4; ++m)
#pragma unroll
                    for (int n = 0; n < 2; ++n) acc[a][b][m][n] = (f32x4){0.f, 0.f, 0.f, 0.f};
        cur = nxt; cA = nA; cB = nB; ++ui;
        if constexpr (ALIGN_EPI) { if (wr == 1) PG8_BAR; }
    }
    PG8_WAIT_V(0);
    if constexpr (!ALIGN_EPI) { if (wr == 0) PG8_BAR; }
    PG8_BAR;
    if constexpr (Epi::AFTER_DRAIN) { E.fused(acc, cur, wr, wc, fr, fq, lds, wid, lane); S.done(cur); }
#undef PG8_SA
#undef PG8_SB
#undef PG8_STAGE
#undef PG8_LDA
#undef PG8_LDB
#undef PG8_MMA
#undef PG8_WAIT_V
#undef PG8_WAIT_L
#undef PG8_BAR
#undef PG8_SCHED
}
}
#define XB_TMO      128
#define XB_XCNT(j)  (256  + 64 * (j))
#define XB_XSUB(j)  (1280 + 64 * (j))
#define XB_XGEN(j)  (2304 + 64 * (j))
#define XB_TOP      3328
#define XB_TOPGEN   3392
#define XCD_BAR_WORDS 3456
#define XB_SPIN_CAP (1u << 18)

__device__ __forceinline__ unsigned xb_ld(unsigned* p)              { return __hip_atomic_load(p, __ATOMIC_RELAXED, __HIP_MEMORY_SCOPE_AGENT); }
__device__ __forceinline__ unsigned xb_add(unsigned* p, unsigned v) { return __hip_atomic_fetch_add(p, v, __ATOMIC_RELAXED, __HIP_MEMORY_SCOPE_AGENT); }
__device__ __forceinline__ unsigned xb_xcc_id() { return (unsigned)__builtin_amdgcn_s_getreg((3 << 11) | 20) & 0xFu; }
#define XB_SPIN(cond, bar) do { unsigned _sp = 0; while (cond) { __builtin_amdgcn_s_sleep(1); \
    if ((++_sp & 255u) == 0u) { if (xb_ld(&(bar)[XB_TMO])) break; if (_sp > XB_SPIN_CAP) { atomicAdd(&(bar)[XB_TMO], 1u); break; } } } } while (0)

struct XcdBarrier {
    unsigned* bar; unsigned x;
    volatile LAS unsigned* st;
};

__device__ __forceinline__ XcdBarrier xcd_barrier_post(unsigned* bar, volatile LAS unsigned* st) {
    XcdBarrier b; b.bar = bar; b.x = xb_xcc_id(); b.st = st;
    if (threadIdx.x == 0) (void)xb_add(&bar[XB_XCNT(b.x)], 1u);
    return b;
}
__device__ __forceinline__ void xcd_barrier_complete(unsigned* bar, unsigned x, unsigned& nloc, unsigned& nx) {
    const unsigned G = gridDim.x * gridDim.y * gridDim.z;
    unsigned sum, cnt, mine, sp = 0u;
    for (;;) {
        sum = 0u; cnt = 0u; mine = 0u;
#pragma unroll
        for (unsigned j = 0; j < 16; ++j) { const unsigned c = xb_ld(&bar[XB_XCNT(j)]); sum += c; cnt += (c > 0u) ? 1u : 0u; mine = (j == x) ? c : mine; }
        if (sum == G) break;
        __builtin_amdgcn_s_sleep(1);
        if ((++sp & 255u) == 0u) { if (xb_ld(&bar[XB_TMO])) break; if (sp > XB_SPIN_CAP) { atomicAdd(&bar[XB_TMO], 1u); break; } }
    }
    nloc = mine > 0u ? mine : 1u; nx = cnt > 0u ? cnt : 1u;
}

__device__ __forceinline__ void xcd_barrier(const XcdBarrier& b) {
    asm volatile("s_waitcnt vmcnt(0)" ::: "memory");
    __syncthreads();
    if (threadIdx.x == 0) {
        unsigned* bar = b.bar;
        __builtin_amdgcn_s_waitcnt(0);
        unsigned nloc = b.st[0], nx = b.st[1];
        if (nloc == 0u) { xcd_barrier_complete(bar, b.x, nloc, nx); b.st[0] = nloc; b.st[1] = nx; }
        const unsigned old = xb_add(&bar[XB_XSUB(b.x)], 1u);
        const unsigned gen = old / nloc;
        if (old + 1u == (gen + 1u) * nloc) {
            __builtin_amdgcn_fence(__ATOMIC_RELEASE, "agent");
            asm volatile("s_waitcnt vmcnt(0)" ::: "memory");
            const unsigned og = xb_add(&bar[XB_TOP], 1u);
            const unsigned tg = og / nx;
            if (og + 1u == (tg + 1u) * nx) xb_add(&bar[XB_TOPGEN], 1u);
            else XB_SPIN(xb_ld(&bar[XB_TOPGEN]) == tg, bar);
            __builtin_amdgcn_fence(__ATOMIC_ACQUIRE, "agent");
            xb_add(&bar[XB_XGEN(b.x)], 1u);
            asm volatile("s_waitcnt vmcnt(0)" ::: "memory");
        } else {
            XB_SPIN(xb_ld(&bar[XB_XGEN(b.x)]) == gen, bar);
            __builtin_amdgcn_fence(__ATOMIC_ACQUIRE, "agent");
            asm volatile("s_waitcnt vmcnt(0)" ::: "memory");
        }
    }
    __syncthreads();
}
#ifdef MK_PROF_A
#define STAMP(id) do { if (blockIdx.x == 0 && threadIdx.x == 0) ((volatile LAS unsigned long long*)(lds + 155648 + 256))[id] = __builtin_amdgcn_s_memrealtime(); } while (0)
#else
#define STAMP(id) do {} while (0)
#endif
constexpr int NWAVES = 8;
constexpr int RING_BYTES = 131072, LDSCTL_OFF = 155648, LDS_BYTES = 163840;
struct Args {
    const float* in[22]; float* out; unsigned char* ws; int ph_lo, ph_hi; int use_bar, pad;
};
enum { I_X = 0, I_C, I_CTX, I_CCTX, I_WMOD, I_BMOD, I_NORM1, I_WIN, I_GCONV, I_ALOG, I_DTB, I_GNORM, I_WGK, I_BGK, I_LNORM, I_WOUT, I_NORM2, I_WUP, I_FCONV, I_FCB, I_WDOWN, I_FNORM };


__device__ __forceinline__ void tr_item(const float* src, int ldsrc, int k0, int c0, int ncols, bf16* dst, int lddst, int r0, int kd0, LAS float* scr, int lane) {
    const int cl = lane & 31;
#pragma unroll 8
    for (int i = 0; i < 32; ++i) { const int kk = 2 * i + (lane >> 5); scr[kk * 33 + cl] = cl < ncols ? src[(size_t)(k0 + kk) * ldsrc + c0 + cl] : 0.f; }
    LDS_WAIT(); asm volatile("" ::: "memory");
    const int c = lane & 7;
#pragma unroll
    for (int j = 0; j < 4; ++j) { const int n = (lane >> 3) + 8 * j; const LAS float* s = scr + (8 * c) * 33 + n;
        v4u o; o.x = pk2(s[0 * 33], s[1 * 33]); o.y = pk2(s[2 * 33], s[3 * 33]); o.z = pk2(s[4 * 33], s[5 * 33]); o.w = pk2(s[6 * 33], s[7 * 33]);
        if (n < ncols) *(GAS v4u*)(dst + (size_t)(r0 + n) * lddst + kd0 + 8 * c) = o; }
    LDS_WAIT(); asm volatile("" ::: "memory");
}

__device__ __forceinline__ void phase_p0a(const Args& a, LAS unsigned char* lds, int vcu, int G, int tid, int wave, int lane) {
    unsigned char* ws = a.ws;
    {
        LAS float* sc = (LAS float*)lds;
        LAS float* red = (LAS float*)(lds + 36864);
        bool have = false;
        for (int it = vcu; it < 192; it += G) {
            if (!have) {
                for (int i = tid; i < 9 * 1024; i += 512) { const int s = i >> 10, k = i & 1023; const float v = s < 8 ? a.in[I_C][s * 1024 + k] : a.in[I_CCTX][k]; sc[i] = silu_f(v); }
                __syncthreads(); have = true;
            }
            const int l = it / 96, n0 = (it % 96) * 64;
            const float* W = a.in[I_WMOD] + (size_t)l * 1024 * 6144;
            const int c4 = tid & 15, ks = tid >> 4;
            f32x4 acc[9];
#pragma unroll
            for (int s = 0; s < 9; ++s) acc[s] = (f32x4){0.f, 0.f, 0.f, 0.f};
            for (int j = 0; j < 32; ++j) {
                const int k = ks + 32 * j;
                const f32x4 w = *(const f32x4*)(W + (size_t)k * 6144 + n0 + 4 * c4);
#pragma unroll
                for (int s = 0; s < 9; ++s) acc[s] += w * sc[s * 1024 + k];
            }
#pragma unroll
            for (int s = 0; s < 9; ++s) *(LAS f32x4*)(red + (ks * 9 + s) * 64 + 4 * c4) = acc[s];
            __syncthreads();
            for (int o = tid; o < 576; o += 512) {
                const int s = o >> 6, c = o & 63; float v = 0.f;
                for (int q = 0; q < 32; ++q) v += red[(q * 9 + s) * 64 + c];
                ((float*)(ws + WS_MOD))[((size_t)l * 9 + s) * 6144 + n0 + c] = v + a.in[I_BMOD][l * 6144 + n0 + c];
            }
            __syncthreads();
        }
        __syncthreads();
    }
    {
        LAS float* scr = (LAS float*)(lds + wave * 16384);
        const int gw = vcu * NWAVES + wave, NGW = G * NWAVES;
        constexpr int I_IN = 16 * 112, I_SM = 16 * 2, I_O = 16 * 32, I_U = 16 * 176, I_D = 44 * 32, PER_L = I_IN + I_SM + I_O + I_U + I_D;
#pragma unroll 1
        for (int it = gw; it < 2 * PER_L; it += NGW) {
            const int l = it / PER_L; int r = it % PER_L;
            unsigned char* wl = ws + (l == 0 ? WS_W1 : WS_W2);
            const float* src; int ldsrc, k0, c0, ncols = 32, lddst, r0, kd0; bf16* dst;
            if (r < I_IN) { const int kb = r / 112, n0 = (r % 112) * 32; src = a.in[I_WIN] + (size_t)l * 1024 * DINP; ldsrc = DINP; k0 = kb * 64; c0 = n0 < 2048 ? n0 : n0 + 16; dst = (bf16*)(wl + W_IN); lddst = 1024; r0 = n0; kd0 = k0; }
            else if ((r -= I_IN) < I_SM) { const int kb = r / 2, part = r % 2; src = a.in[I_WIN] + (size_t)l * 1024 * DINP; ldsrc = DINP; k0 = kb * 64; c0 = part == 0 ? 2048 : 3600; ncols = part == 0 ? 16 : 32;
                dst = (bf16*)(ws + WS_WSM) + (size_t)l * 48 * 1024; lddst = 1024; r0 = part == 0 ? 0 : 16; kd0 = k0; }
            else if ((r -= I_SM) < I_O) { const int kb = r / 32, nb = r % 32; src = a.in[I_WOUT] + (size_t)l * 1024 * 1024; ldsrc = 1024; k0 = kb * 64; c0 = nb * 32; dst = (bf16*)(wl + W_OUT); lddst = 1024; r0 = nb * 32; kd0 = k0; }
            else if ((r -= I_O) < I_U) { const int kb = r / 176, rr0 = (r % 176) * 32;
                src = a.in[I_WUP] + (size_t)l * 1024 * 5632; ldsrc = 5632; k0 = kb * 64;
                c0 = rr0 < 1280 ? rr0 : (rr0 < 2560 ? 2816 + (rr0 - 1280) : (rr0 < 4096 ? 1280 + (rr0 - 2560) : 2816 + 1280 + (rr0 - 4096)));
                dst = (bf16*)(wl + W_UP); lddst = 1024; r0 = rr0; kd0 = k0; }
            else { r -= I_U; const int kb = r / 32, nb = r % 32; k0 = kb * 64; src = a.in[I_WDOWN] + (size_t)l * DFF * 1024; ldsrc = 1024; c0 = nb * 32; r0 = nb * 32;
                if (k0 < FCB) { dst = (bf16*)(wl + W_DB); lddst = FCB; kd0 = k0; } else { dst = (bf16*)(wl + W_DA); lddst = FCA; kd0 = k0 - FCB; } }
            tr_item(src, ldsrc, k0, c0, ncols, dst, lddst, r0, kd0, scr, lane);
        }
    }
}

__device__ __forceinline__ void xg_rows(const float* xlat, const float* xctx, const float* gain, const float* scl  , bf16* XG, float* rowss, int gw, int NGW, int lane, int mrows) {
    f32x4 g[4];
#pragma unroll
    for (int j = 0; j < 4; ++j) g[j] = *(const f32x4*)(gain + 4 * lane + 256 * j);
#pragma unroll 1
    for (int m0 = gw; m0 < mrows; m0 += 4 * NGW) {
        f32x4 v[4][4];
#pragma unroll
        for (int u = 0; u < 4; ++u) { const int m = m0 + u * NGW; if (m < mrows) { const float* src = m < MLAT ? xlat + (size_t)m * 1024 : xctx + (size_t)(m - MLAT) * 1024;
#pragma unroll
            for (int j = 0; j < 4; ++j) v[u][j] = *(const f32x4*)(src + 4 * lane + 256 * j); } }
#pragma unroll
        for (int u = 0; u < 4; ++u) { const int m = m0 + u * NGW; if (m < mrows) {
            const int s = row_s(m); float ss = 0.f;
#pragma unroll
            for (int j = 0; j < 4; ++j) {
                const int c = 4 * lane + 256 * j; const f32x4 x = v[u][j], sc = *(const f32x4*)(scl + (size_t)s * 6144 + c);
                ss += (x[0] * x[0] + x[1] * x[1]) + (x[2] * x[2] + x[3] * x[3]);
                const f32x4 y = x * g[j] * (sc + 1.0f);
                v2u o; o.x = pk2(y[0], y[1]); o.y = pk2(y[2], y[3]);
                *(GAS v2u*)(XG + (size_t)m * 1024 + c) = o;
            }
            ss = wave_sum(ss);
            if (lane == 0) rowss[m] = ss; } }
    }
}

__device__ __forceinline__ void phase_p0b(const Args& a, LAS unsigned char* lds, int vcu, int G, int tid, int wave, int lane) {
    unsigned char* ws = a.ws;
    const int gw = vcu * NWAVES + wave, NGW = G * NWAVES;
    const float* MOD = (const float*)(ws + WS_MOD);
    constexpr LayerBufs B0 = layer_bufs(0);
    xg_rows(a.in[I_X], a.in[I_CTX], a.in[I_NORM1], MOD + 1 * 1024, (bf16*)bufp(ws, a.out, B0.XG), (float*)(ws + WS_RS1), gw, NGW, lane, MALL);
    LAS float* sh = (LAS float*)lds;
    for (int combo = 0; combo < 4; ++combo) {
        const int l = combo >> 1, which = combo & 1;
        __syncthreads();
        for (int i = tid; i < 9 * 1024; i += 512) sh[i] = MOD[((size_t)l * 9 + (i >> 10)) * 6144 + (which ? 3 : 0) * 1024 + (i & 1023)];
        __syncthreads();
        const int nrows = which ? 5632 : (NMAIN + NSMALL);
        float* SWl = (float*)(ws + WS_SW) + (size_t)l * SW_LAYER;
        unsigned char* wl = ws + (l == 0 ? WS_W1 : WS_W2);
        for (int n = gw; n < nrows; n += NGW) {
            const bf16* wrow; float* dst; int ldd;
            if (which) { wrow = (const bf16*)(wl + W_UP) + (size_t)n * 1024; dst = SWl + 9 * (NMAIN + NSMALL) + n; ldd = 5632; }
            else if (n < NMAIN) { wrow = (const bf16*)(wl + W_IN) + (size_t)n * 1024; dst = SWl + n; ldd = NMAIN; }
            else { wrow = (const bf16*)(ws + WS_WSM) + ((size_t)l * 48 + (n - NMAIN)) * 1024; dst = SWl + 9 * NMAIN + (n - NMAIN); ldd = NSMALL; }
            const v4u w0 = *(const GAS v4u*)(wrow + 8 * lane), w1 = *(const GAS v4u*)(wrow + 512 + 8 * lane);
            float wf[16] = { bflo(w0.x), bfhi(w0.x), bflo(w0.y), bfhi(w0.y), bflo(w0.z), bfhi(w0.z), bflo(w0.w), bfhi(w0.w),
                             bflo(w1.x), bfhi(w1.x), bflo(w1.y), bfhi(w1.y), bflo(w1.z), bfhi(w1.z), bflo(w1.w), bfhi(w1.w) };
#pragma unroll
            for (int s = 0; s < 9; ++s) {
                float acc = 0.f;
#pragma unroll
                for (int j = 0; j < 8; ++j) acc += wf[j] * sh[s * 1024 + 8 * lane + j] + wf[8 + j] * sh[s * 1024 + 512 + 8 * lane + j];
                acc = wave_sum(acc);
                if (lane == 0) dst[(size_t)s * ldd] = acc;
            }
        }
    }
    __syncthreads();
}

__device__ __forceinline__ void skinny_rows(const bf16* XG, const bf16* Wsm  , const float* rowss, const float* sWsm  , float* SM, int gw, int NGW, int lane) {
    const int r = lane & 15, g = lane >> 4;
    for (int t = gw; t < MALL / 16; t += NGW) {
        const int m0 = t * 16;
        f32x4 acc[3];
#pragma unroll
        for (int n = 0; n < 3; ++n) acc[n] = (f32x4){0.f, 0.f, 0.f, 0.f};
        const bf16* ap = XG + (size_t)(m0 + r) * 1024 + 8 * g;
        const bf16* bp = Wsm + (size_t)r * 1024 + 8 * g;
        float rs4[4], sw[4][3];
#pragma unroll
        for (int j = 0; j < 4; ++j) { const int m = m0 + 4 * g + j; rs4[j] = rowss[m]; const int s = row_s(m);
#pragma unroll
            for (int n = 0; n < 3; ++n) sw[j][n] = sWsm[s * 48 + 16 * n + r]; }
#pragma unroll 1
        for (int k0 = 0; k0 < 32; k0 += 4) {
            bf16x8 af[4], bfr[4][3];
#pragma unroll
            for (int kk = 0; kk < 4; ++kk) { af[kk] = *(const GAS bf16x8*)(ap + 32 * (k0 + kk));
#pragma unroll
                for (int n = 0; n < 3; ++n) bfr[kk][n] = *(const GAS bf16x8*)(bp + (size_t)n * 16 * 1024 + 32 * (k0 + kk)); }
#pragma unroll
            for (int kk = 0; kk < 4; ++kk)
#pragma unroll
                for (int n = 0; n < 3; ++n) acc[n] = __builtin_amdgcn_mfma_f32_16x16x32_bf16(af[kk], bfr[kk][n], acc[n], 0, 0, 0);
        }
#pragma unroll
        for (int j = 0; j < 4; ++j) {
            const int m = m0 + 4 * g + j;
            const float rstd = rsqrtf(rs4[j] * (1.0f / 1024.0f) + NEPS);
#pragma unroll
            for (int n = 0; n < 3; ++n) SM[(size_t)m * 48 + 16 * n + r] = acc[n][j] * rstd + sw[j][n];
        }
    }
}
#define MFMA32(a, b, c) __builtin_amdgcn_mfma_f32_32x32x16_bf16((a), (b), (c), 0, 0, 0)
__device__ __forceinline__ int crow(int reg, int h) { return (reg & 3) + 8 * (reg >> 2) + 4 * h; }
__device__ __forceinline__ bf16x8 pack_step(const f32x16& x, int s) {
    v4u p; p.x = pk2(x[8 * s], x[8 * s + 1]); p.y = pk2(x[8 * s + 2], x[8 * s + 3]); p.z = pk2(x[8 * s + 4], x[8 * s + 5]); p.w = pk2(x[8 * s + 6], x[8 * s + 7]);
    return __builtin_bit_cast(bf16x8, p);
}
__device__ __forceinline__ bf16x8 frag_perm(const LAS unsigned char* img, int stride, int row, int col16, int h) {
    const LAS unsigned char* p = img + row * stride + (col16 + 4 * h) * 2;
    const s16x4 lo = *(const LAS s16x4*)p, hi = *(const LAS s16x4*)(p + 16);
    return __builtin_shufflevector(lo, hi, 0, 1, 2, 3, 4, 5, 6, 7);
}
__device__ __forceinline__ bf16x8 frag_nat(const LAS unsigned char* img, int stride, int row, int col16, int h) {
    const LAS unsigned char* p = img + row * stride + (col16 + 8 * h) * 2;
    const s16x4 lo = *(const LAS s16x4*)p, hi = *(const LAS s16x4*)(p + 8);
    return __builtin_shufflevector(lo, hi, 0, 1, 2, 3, 4, 5, 6, 7);
}
__device__ __forceinline__ void unpack8(const v4u w, float* f) {
    f[0] = bflo(w.x); f[1] = bfhi(w.x); f[2] = bflo(w.y); f[3] = bfhi(w.y); f[4] = bflo(w.z); f[5] = bfhi(w.z); f[6] = bflo(w.w); f[7] = bfhi(w.w);
}
__device__ __forceinline__ int chunk_first(int cid) { return cid < 256 ? ((cid & 31) == 0) : ((cid & 3) == 0); }
__device__ __forceinline__ int chunk_last(int cid) { return cid < 256 ? ((cid & 31) == 31) : ((cid & 3) == 3); }

constexpr int GP_Q = 0, GP_K = 16896, GP_RAW = 33792, GP_KK = 33792, GP_QK = 50432, GP_LP = 67584, GP_LPSZ = 8448, GP_GATE = 135168, GP_GSZ = 1536, GP_CW = 141312, GP_ST = 264;
__host__ __device__ constexpr int tri_off(int i) { return i == 0 ? 0 : (8 * ((i + 3) / 4) * (((i + 3) / 4) - 1) + 4 * ((i + 3) / 4) * ((i - 1) & 3)); }
__device__ __forceinline__ int tri_off_rt(int i) { const int q = (i + 3) >> 2; return i == 0 ? 0 : 8 * q * (q - 1) + 4 * q * ((i - 1) & 3); }
struct GdnPre { v4u rr[5]; float av, bv; };
__device__ __forceinline__ void gdn_prefetch(const Args& a, int l, int cid, int h, int tid_in, GdnPre& P) {
    int tid = tid_in; asm volatile("" : "+v"(tid));
    unsigned char* ws = a.ws; const LayerBufs B = layer_bufs(l);
    const bf16* GQ = (const bf16*)bufp(ws, a.out, B.GQ); const bf16* GK = (const bf16*)bufp(ws, a.out, B.GK); const bf16* GV = (const bf16*)bufp(ws, a.out, B.GV);
    const bf16* HALO = (const bf16*)(ws + WS_HALO);
    const int m0 = cid * 64, first = chunk_first(cid), last = chunk_last(cid), grp = tid >> 4, cg = tid & 15;
#pragma unroll
    for (int j = 0; j < 5; ++j) {
        const int p = tid + 512 * j; P.rr[j] = (v4u){0u, 0u, 0u, 0u};
        if (p < 2 * 66 * 16) {
            const int t = p / (66 * 16), rem = p % (66 * 16), r = rem >> 4, c = rem & 15;
            const bf16* base = t == 0 ? GQ : GK;
            if (r == 0) { if (!first) P.rr[j] = *(const GAS v4u*)(HALO + ((size_t)(cid - 1) * 2 + 1) * 1536 + t * 512 + h * 128 + 8 * c); }
            else if (r == 65) { if (!last) P.rr[j] = *(const GAS v4u*)(HALO + ((size_t)(cid + 1) * 2 + 0) * 1536 + t * 512 + h * 128 + 8 * c); }
            else P.rr[j] = *(const GAS v4u*)(base + (size_t)(m0 + r - 1) * 512 + h * 128 + 8 * c);
        }
    }
    P.av = 0.f; P.bv = 0.f;
    if (tid < 128) { const float* sm = (const float*)(ws + WS_SM) + (size_t)(m0 + (tid & 63)) * 48; P.av = sm[(tid >> 6) * 4 + h]; P.bv = sm[8 + (tid >> 6) * 4 + h]; }
}
__device__ __forceinline__ void gdn_front1(const Args& a, LAS unsigned char* lds, int l, int cid, int h, int slot, int tid_in, const GdnPre& P, float alog, float dtb) {
    int tid = tid_in; asm volatile("" : "+v"(tid));
    unsigned char* ws = a.ws; const LayerBufs B = layer_bufs(l);
    bf16* GQ = (bf16*)bufp(ws, a.out, B.GQ); bf16* GK = (bf16*)bufp(ws, a.out, B.GK); bf16* GV = (bf16*)bufp(ws, a.out, B.GV);
    const int m0 = cid * 64, grp = tid >> 4, cg = tid & 15;
    LAS unsigned char* raw_s = lds + GP_RAW;
    LAS float* gt = (LAS float*)(lds + GP_GATE + slot * GP_GSZ);
    const bf16* HALO = (const bf16*)(ws + WS_HALO);
    const int first = chunk_first(cid), last = chunk_last(cid);
    v4u vraw[2][3];
#pragma unroll
    for (int j = 0; j < 2; ++j) {
        const int r = grp + 32 * j;
#pragma unroll
        for (int d = 0; d < 3; ++d) {
            const int rr2 = r - 1 + d; vraw[j][d] = (v4u){0u, 0u, 0u, 0u};
            if (rr2 < 0) { if (!first) vraw[j][d] = *(const GAS v4u*)(HALO + ((size_t)(cid - 1) * 2 + 1) * 1536 + 1024 + h * 128 + 8 * cg); }
            else if (rr2 > 63) { if (!last) vraw[j][d] = *(const GAS v4u*)(HALO + ((size_t)(cid + 1) * 2 + 0) * 1536 + 1024 + h * 128 + 8 * cg); }
            else vraw[j][d] = *(const GAS v4u*)(GV + (size_t)(m0 + rr2) * 512 + h * 128 + 8 * cg);
        }
    }
#pragma unroll
    for (int j = 0; j < 5; ++j) { const int p = tid + 512 * j; if (p < 2 * 66 * 16) *(LAS v4u*)(raw_s + p * 16) = P.rr[j]; }
    if (tid < 128) {
        const int dir = tid >> 6, i = tid & 63;
        const float gval = -__expf(alog) * softplus_f(P.av + dtb), bval = sigmoid_f(P.bv);
        float c = gval;
        if (dir == 0) {
#pragma unroll
            for (int o = 1; o < 64; o <<= 1) { const float u = __shfl_up(c, o); if (i >= o) c += u; }
        } else {
#pragma unroll
            for (int o = 1; o < 64; o <<= 1) { const float u = __shfl_down(c, o); if (i + o < 64) c += u; }
        }
        gt[dir * 64 + i] = gval; gt[128 + dir * 64 + i] = bval; gt[256 + dir * 64 + i] = c;
    }
    __syncthreads();
    const LAS float* cw = (const LAS float*)(lds + GP_CW);
#pragma unroll 1
    for (int t = 0; t < 3; ++t)
#pragma unroll
    for (int jj = 0; jj < 2; ++jj) {
        const int r = grp + 32 * jj;
        float x0[8], x1[8], x2[8], y[8];
        if (t < 2) {
            unpack8(*(const LAS v4u*)(raw_s + ((t * 66 + r) * 128 + 8 * cg) * 2), x0);
            unpack8(*(const LAS v4u*)(raw_s + ((t * 66 + r + 1) * 128 + 8 * cg) * 2), x1);
            unpack8(*(const LAS v4u*)(raw_s + ((t * 66 + r + 2) * 128 + 8 * cg) * 2), x2);
        } else { unpack8(vraw[jj][0], x0); unpack8(vraw[jj][1], x1); unpack8(vraw[jj][2], x2); }
        const LAS float* w0 = cw + t * 128 + 8 * cg;
        float ss = 0.f;
#pragma unroll
        for (int e = 0; e < 8; ++e) { const float c = x0[e] * w0[e] + x1[e] * w0[384 + e] + x2[e] * w0[768 + e]; y[e] = silu_f(c); ss += y[e] * y[e]; }
        ss += __shfl_xor(ss, 1); ss += __shfl_xor(ss, 2); ss += __shfl_xor(ss, 4); ss += __shfl_xor(ss, 8);
        float sc = 1.f;
        if (t == 0) sc = rsqrtf(ss + 1e-6f) * 0.08838834764831845f; else if (t == 1) sc = rsqrtf(ss + 1e-6f);
        v4u o; o.x = pk2(y[0] * sc, y[1] * sc); o.y = pk2(y[2] * sc, y[3] * sc); o.z = pk2(y[4] * sc, y[5] * sc); o.w = pk2(y[6] * sc, y[7] * sc);
        bf16* base = t == 0 ? GQ : (t == 1 ? GK : GV);
        *(GAS v4u*)(base + (size_t)(m0 + r) * 512 + h * 128 + 8 * cg) = o;
        if (t < 2) { LAS unsigned char* d = lds + (t == 0 ? GP_Q : GP_K) + r * GP_ST + 16 * cg; *(LAS v2u*)d = (v2u){o.x, o.y}; *(LAS v2u*)(d + 8) = (v2u){o.z, o.w}; }
    }
}
__device__ __forceinline__ void gdn_front2(const Args& a, LAS unsigned char* lds, int l, int cid, int h, int slot, int tid_in, int wave_in, int lane_in) {
    int tid = tid_in; asm volatile("" : "+v"(tid));
    const int lane = tid & 63, wave = __builtin_amdgcn_readfirstlane(tid >> 6);
    unsigned char* ws = a.ws; const LayerBufs B = layer_bufs(l);
    LAS float* gt = (LAS float*)(lds + GP_GATE + slot * GP_GSZ);
    __syncthreads();
    {
        const int which = wave >> 2, ti = (wave >> 1) & 1, tj = wave & 1, r = lane & 31, hh = lane >> 5;
        f32x16 acc; for (int i = 0; i < 16; ++i) acc[i] = 0.f;
        const LAS unsigned char* Ai = lds + (which ? GP_Q : GP_K); const LAS unsigned char* Bi = lds + GP_K;
#pragma unroll
        for (int s2 = 0; s2 < 8; ++s2) acc = MFMA32(frag_nat(Ai, GP_ST, 32 * ti + r, 16 * s2, hh), frag_nat(Bi, GP_ST, 32 * tj + r, 16 * s2, hh), acc);
        LAS float* dst = (LAS float*)(lds + (which ? GP_QK : GP_KK));
#pragma unroll
        for (int i = 0; i < 16; ++i) dst[(32 * ti + crow(i, hh)) * 65 + 32 * tj + r] = acc[i];
    }
    __syncthreads();
    {
        const LAS float* KK = (const LAS float*)(lds + GP_KK); const LAS float* QK = (const LAS float*)(lds + GP_QK);
        bf16* GTA = (bf16*)bufp(ws, a.out, B.GTA);
#pragma unroll 2
        for (int it = 0; it < 16; ++it) {
            const int p = tid + 512 * it;
            const int dir = p >> 12, ip = (p >> 6) & 63, jp = p & 63;
            const int i = dir ? 63 - ip : ip, j = dir ? 63 - jp : jp;
            if (jp < ip) {
                const float lv = gt[128 + dir * 64 + i] * KK[i * 65 + j] * __expf(gt[256 + dir * 64 + i] - gt[256 + dir * 64 + j]);
                ((LAS float*)(lds + GP_LP + (slot * 2 + dir) * GP_LPSZ))[tri_off_rt(ip) + jp] = lv;
            }
            const bool keep = dir ? (jp >= ip) : (jp <= ip);
            const float av = keep ? QK[ip * 65 + jp] * __expf(gt[256 + dir * 64 + ip] - gt[256 + dir * 64 + jp]) : 0.f;
            GTA[(((size_t)dir * NCHUNK + cid) * 4 + h) * 8192 + ip * 128 + 64 + jp] = (bf16)(pk2(av, 0.f) & 0xffffu);
        }
        if (tid < 128) {
            const int dir = tid >> 6, i = tid & 63;
            float* E = (float*)(ws + WS_GDEC);
            const float gc = gt[256 + dir * 64 + i], gl = gt[256 + dir * 64 + (dir ? 0 : 63)];
            E[(((size_t)dir * NCHUNK + cid) * 4 + h) * 64 + i] = __expf(gc);
            E[(size_t)2 * NCHUNK * 4 * 64 + (((size_t)dir * NCHUNK + cid) * 4 + h) * 64 + i] = __expf(gl - gc);
            if (i == 0) E[(size_t)4 * NCHUNK * 4 * 64 + ((size_t)dir * NCHUNK + cid) * 4 + h] = __expf(gl);
        }
    }
    __syncthreads();
}
__device__ __forceinline__ void gdn_prep_invert(LAS unsigned char* lds, int slot, int dir, int wave, int lane_in) {
    int lane = lane_in; asm volatile("" : "+v"(lane));
    LAS float* Lp = (LAS float*)(lds + GP_LP + (slot * 2 + dir) * GP_LPSZ);
    LAS float* Td = (LAS float*)(lds + wave * 8192);
    const int blk = lane >> 5, c = lane & 31;
    float t[32];
#pragma unroll
    for (int i = 0; i < 32; ++i) {
        f32x4 bA[8];
        const LAS float* rowp = Lp + (blk ? tri_off(32 + i) + 32 : tri_off(i));
#pragma unroll
        for (int q = 0; q < (i + 3) / 4; ++q) bA[q] = *(const LAS f32x4*)(rowp + 4 * q);
        float a0 = (c == i) ? 1.f : 0.f, a1 = 0.f, a2 = 0.f, a3 = 0.f;
#pragma unroll
        for (int q = 0; q < (i + 3) / 4; ++q) {
            a0 -= bA[q][0] * t[4 * q];
            if (4 * q + 1 < i) a1 -= bA[q][1] * t[4 * q + 1];
            if (4 * q + 2 < i) a2 -= bA[q][2] * t[4 * q + 2];
            if (4 * q + 3 < i) a3 -= bA[q][3] * t[4 * q + 3];
        }
        t[i] = (a0 + a1) + (a2 + a3);
        Td[blk * 1024 + i * 32 + c] = t[i];
        if (c < i) Lp[(blk ? tri_off(32 + i) + 32 : tri_off(i)) + c] = t[i];
        asm volatile("" ::: "memory");
    }
    f32x16 X; for (int r = 0; r < 16; ++r) X[r] = 0.f;
    const LAS float* l21 = Lp + tri_off_rt(32 + c) + blk;
#pragma unroll
    for (int s2 = 0; s2 < 16; ++s2) X = __builtin_amdgcn_mfma_f32_32x32x2f32(l21[2 * s2], Td[(2 * s2 + blk) * 32 + c], X, 0, 0, 0);
    f32x16 Y; for (int r = 0; r < 16; ++r) Y[r] = 0.f;
#pragma unroll
    for (int s2 = 0; s2 < 16; ++s2) Y = __builtin_amdgcn_mfma_f32_32x32x2f32(Td[1024 + c * 32 + crow(s2, blk)], X[s2], Y, 0, 0, 0);
#pragma unroll
    for (int r = 0; r < 16; ++r) Lp[tri_off_rt(32 + crow(r, blk)) + c] = -Y[r];
}
__device__ __forceinline__ void gdn_prep_tb_store(const Args& a, LAS unsigned char* lds, int l, int vcu, int G, int j0, int nb, int tid_in) {
    int tid = tid_in; asm volatile("" : "+v"(tid));
    const LayerBufs B = layer_bufs(l);
    bf16* GTA = (bf16*)bufp(a.ws, a.out, B.GTA);
#pragma unroll 2
    for (int p = tid; p < nb * 2 * 64 * 8; p += 512) {
        const int pc = p & 7, io = (p >> 3) & 63, dir = (p >> 9) & 1, slot = p >> 10;
        const int it = vcu + G * (j0 + slot), cid = it >> 2, h = it & 3;
        const LAS float* Lp = (const LAS float*)(lds + GP_LP + (slot * 2 + dir) * GP_LPSZ);
        const LAS float* gt = (const LAS float*)(lds + GP_GATE + slot * GP_GSZ);
        const int ip = dir ? 63 - io : io, off = tri_off_rt(ip);
        float v[8];
#pragma unroll
        for (int e = 0; e < 8; ++e) {
            const int jo = 8 * pc + e, jp = dir ? 63 - jo : jo;
            const float tv = jp < ip ? Lp[off + jp] : (jp == ip ? 1.f : 0.f);
            v[e] = tv * gt[128 + dir * 64 + jo];
        }
        v4u o; o.x = pk2(v[0], v[1]); o.y = pk2(v[2], v[3]); o.z = pk2(v[4], v[5]); o.w = pk2(v[6], v[7]);
        *(GAS v4u*)(GTA + (((size_t)dir * NCHUNK + cid) * 4 + h) * 8192 + io * 128 + 8 * pc) = o;
    }
}

constexpr int LP_GK = 0, LP_QG = 33280, LP_KI = 51712, LP_LR = 70144, LP_W = 78336, LP_B = 86528, LP_GL = 87040, LP_QR = 87552, LP_KR = 95744, LP_ST = 144;
struct GlaPre { float lrv[4]; v4u qv, kv; };
__device__ __forceinline__ void gla_prefetch(const Args& a, int l, int cid, int h, int tid_in, GlaPre& P) {
    int tid = tid_in; asm volatile("" : "+v"(tid));
    unsigned char* ws = a.ws; const LayerBufs B = layer_bufs(l);
    const int m0 = cid * 64;
#pragma unroll
    for (int j = 0; j < 4; ++j) { const int p = tid + 512 * j; P.lrv[j] = ((const float*)(ws + WS_SM))[(size_t)(m0 + (p >> 5)) * 48 + 16 + (p & 31)]; }
    const bf16* LQ = (const bf16*)bufp(ws, a.out, B.LQ); const bf16* LK = (const bf16*)bufp(ws, a.out, B.LK);
    const int i = tid >> 3, c8 = tid & 7;
    P.qv = *(const GAS v4u*)(LQ + (size_t)(m0 + i) * 256 + h * 64 + 8 * c8); P.kv = *(const GAS v4u*)(LK + (size_t)(m0 + i) * 256 + h * 64 + 8 * c8);
}
__device__ __forceinline__ void gla_prep_unit(const Args& a, LAS unsigned char* lds, int l, int cid, int h, int tid_in, const GlaPre& P) {
    int tid = tid_in; asm volatile("" : "+v"(tid));
    const int lane = tid & 63, wave = __builtin_amdgcn_readfirstlane(tid >> 6);
    unsigned char* ws = a.ws; const LayerBufs B = layer_bufs(l);
    LAS float* gk = (LAS float*)(lds + LP_GK); LAS float* lr = (LAS float*)(lds + LP_LR); const LAS float* Wv = (const LAS float*)(lds + LP_W); const LAS float* bs = (const LAS float*)(lds + LP_B); LAS float* gl = (LAS float*)(lds + LP_GL);
    {
#pragma unroll
        for (int j = 0; j < 4; ++j) lr[tid + 512 * j] = P.lrv[j];
        const int i = tid >> 3, c8 = tid & 7;
        *(LAS v4u*)(lds + LP_QR + i * 128 + 16 * c8) = P.qv; *(LAS v4u*)(lds + LP_KR + i * 128 + 16 * c8) = P.kv;
    }
    __syncthreads();
#pragma unroll 2
    for (int it = 0; it < 16; ++it) {
        const int p = tid + 512 * it;
        const int dir = p >> 12, i = (p >> 6) & 63, c = p & 63;
        float acc = bs[dir * 64 + c];
#pragma unroll
        for (int rk = 0; rk < 16; ++rk) acc += lr[i * 32 + dir * 16 + rk] * Wv[(dir * 16 + rk) * 64 + c];
        gk[(dir * 64 + i) * 65 + c] = -softplus_f(-acc) * (1.0f / 16.0f);
    }
    __syncthreads();
    if (tid < 128) {
        const int dir = tid >> 6, c = tid & 63;
        float s = 0.f;
#pragma unroll 1
        for (int i0 = 0; i0 < 64; i0 += 8) {
            float v[8];
#pragma unroll
            for (int e = 0; e < 8; ++e) { const int i = dir ? 63 - (i0 + e) : i0 + e; v[e] = gk[(dir * 64 + i) * 65 + c]; }
#pragma unroll
            for (int e = 0; e < 8; ++e) { const int i = dir ? 63 - (i0 + e) : i0 + e; s += v[e]; gk[(dir * 64 + i) * 65 + c] = s; }
        }
        gl[dir * 64 + c] = s;
        ((float*)(ws + WS_LDEC))[(((size_t)dir * NCHUNK + cid) * 4 + h) * 64 + c] = __expf(s);
    }
    __syncthreads();
    {
#pragma unroll 1
        for (int it = 0; it < 2; ++it) {
            const int p = tid + 512 * it, dir = p >> 9, i = (p >> 3) & 63, c8 = p & 7;
            float q[8], k[8];
            unpack8(*(const LAS v4u*)(lds + LP_QR + i * 128 + 16 * c8), q); unpack8(*(const LAS v4u*)(lds + LP_KR + i * 128 + 16 * c8), k);
            float qg[8], ki[8];
#pragma unroll
            for (int e = 0; e < 8; ++e) { const float gc = gk[(dir * 64 + i) * 65 + 8 * c8 + e]; qg[e] = q[e] * 0.125f * __expf(gc); ki[e] = k[e] * __expf(-gc); }
            v4u oq, ok; oq.x = pk2(qg[0], qg[1]); oq.y = pk2(qg[2], qg[3]); oq.z = pk2(qg[4], qg[5]); oq.w = pk2(qg[6], qg[7]);
            ok.x = pk2(ki[0], ki[1]); ok.y = pk2(ki[2], ki[3]); ok.z = pk2(ki[4], ki[5]); ok.w = pk2(ki[6], ki[7]);
            *(LAS v4u*)(lds + LP_QG + dir * 9216 + i * LP_ST + 16 * c8) = oq; *(LAS v4u*)(lds + LP_KI + dir * 9216 + i * LP_ST + 16 * c8) = ok;
            bf16* blk = (bf16*)bufp(ws, a.out, dir ? B.LOP1 : B.LOP0) + ((size_t)cid * 4 + h) * 12288;
            *(GAS v4u*)(blk + i * 64 + 8 * c8) = oq;
        }
#pragma unroll 1
        for (int it = 0; it < 2; ++it) {
            const int p = tid + 512 * it, dir = p >> 9, c = (p >> 3) & 63, ig = p & 7;
            const float glc = gl[dir * 64 + c];
            float kd[8];
#pragma unroll
            for (int e = 0; e < 8; ++e) { const int i = 8 * ig + e; kd[e] = bf2f(*(const LAS bf16*)(lds + LP_KR + i * 128 + 2 * c)) * __expf(glc - gk[(dir * 64 + i) * 65 + c]); }
            v4u o; o.x = pk2(kd[0], kd[1]); o.y = pk2(kd[2], kd[3]); o.z = pk2(kd[4], kd[5]); o.w = pk2(kd[6], kd[7]);
            bf16* blk = (bf16*)bufp(ws, a.out, dir ? B.LOP1 : B.LOP0) + ((size_t)cid * 4 + h) * 12288;
            *(GAS v4u*)(blk + 4096 + c * 64 + 8 * ig) = o;
        }
    }
    __syncthreads();
    {
        const int dir = wave >> 2, ti = (wave >> 1) & 1, tj = wave & 1, r = lane & 31, hh = lane >> 5;
        f32x16 acc; for (int i = 0; i < 16; ++i) acc[i] = 0.f;
        const LAS unsigned char* Ai = lds + LP_QG + dir * 9216; const LAS unsigned char* Bi = lds + LP_KI + dir * 9216;
#pragma unroll
        for (int s2 = 0; s2 < 4; ++s2) acc = MFMA32(frag_nat(Ai, LP_ST, 32 * ti + r, 16 * s2, hh), frag_nat(Bi, LP_ST, 32 * tj + r, 16 * s2, hh), acc);
        bf16* blk = (bf16*)bufp(ws, a.out, dir ? B.LOP1 : B.LOP0) + ((size_t)cid * 4 + h) * 12288 + 8192;
#pragma unroll
        for (int i = 0; i < 16; ++i) {
            const int io = 32 * ti + crow(i, hh), jo = 32 * tj + r;
            const bool keep = dir ? (jo >= io) : (jo <= io);
            blk[io * 64 + jo] = (bf16)(pk2(keep ? acc[i] : 0.f, 0.f) & 0xffffu);
        }
    }
    __syncthreads();
}

__device__ __forceinline__ void phase_prep(const Args& a, LAS unsigned char* lds, int l, int vcu, int G, int tid_in, int wave_in, int lane_in) {
    int tid = tid_in; asm volatile("" : "+v"(tid));
    const int lane = tid & 63, wave = __builtin_amdgcn_readfirstlane(tid >> 6);
    const int NU = NCHUNK * 4;
    {
        const int h0 = vcu & 3;
        for (int p = tid; p < 9 * 128; p += 512) { const int tap = p / 384, t = (p / 128) % 3, c = p & 127; ((LAS float*)(lds + GP_CW))[p] = a.in[I_GCONV][((size_t)l * 3 + tap) * 1536 + t * 512 + h0 * 128 + c]; }
        float alog = 0.f, dtb = 0.f;
        if (tid < 128) { alog = a.in[I_ALOG][l * 8 + (tid >> 6) * 4 + h0]; dtb = a.in[I_DTB][l * 8 + (tid >> 6) * 4 + h0]; }
        GdnPre P;
        if (vcu < NU) gdn_prefetch(a, l, vcu >> 2, vcu & 3, tid, P);
        __syncthreads();
#pragma unroll 1
        for (int j0 = 0; vcu + G * j0 < NU; j0 += 4) {
            int nb = 0;
#pragma unroll 1
            for (int j = 0; j < 4; ++j) {
                const int it = vcu + G * (j0 + j);
                if (it < NU) {
                    gdn_front1(a, lds, l, it >> 2, it & 3, j, tid, P, alog, dtb);
                    if (it + G < NU) gdn_prefetch(a, l, (it + G) >> 2, (it + G) & 3, tid, P);
                    gdn_front2(a, lds, l, it >> 2, it & 3, j, tid, wave, lane);
                    nb = j + 1;
                }
            }
            const int slot = wave >> 1, dir = wave & 1;
            if (slot < nb) gdn_prep_invert(lds, slot, dir, wave, lane);
            __syncthreads();
            gdn_prep_tb_store(a, lds, l, vcu, G, j0, nb, tid);
            __syncthreads();
        }
    }
    {
        const int h0 = vcu & 3;
        for (int p = tid; p < 2 * 16 * 64; p += 512) { const int dir = p >> 10, rk = (p >> 6) & 15, c = p & 63; ((LAS float*)(lds + LP_W))[p] = a.in[I_WGK][(((size_t)l * 2 + dir) * 16 + rk) * 256 + h0 * 64 + c]; }
        if (tid < 128) ((LAS float*)(lds + LP_B))[tid] = a.in[I_BGK][((size_t)l * 2 + (tid >> 6)) * 256 + h0 * 64 + (tid & 63)];
        GlaPre P;
        if (vcu < NU) gla_prefetch(a, l, vcu >> 2, vcu & 3, tid, P);
#pragma unroll 1
        for (int it = vcu; it < NU; it += G) {
            GlaPre Pc = P;
            if (it + G < NU) gla_prefetch(a, l, (it + G) >> 2, (it + G) & 3, tid, P);
            gla_prep_unit(a, lds, l, it >> 2, it & 3, tid, Pc);
        }
    }
}

__device__ __forceinline__ int chain_cid(int b, int dir, int step) {
    if (step < 4) return 256 + 4 * b + (dir ? 3 - step : step);
    const int n = step - 4; return 32 * b + (dir ? 31 - n : n);
}
typedef short v4i16_t __attribute__((ext_vector_type(4)));
__device__ __forceinline__ s16x4 tr4(const LAS unsigned char* img, int stride, int row0, int col0, int lane) {
    const int i16 = lane & 15;
    const LAS unsigned char* p = img + (row0 + (i16 >> 2)) * stride + (col0 + 4 * (i16 & 3)) * 2;
    return __builtin_bit_cast(s16x4, __builtin_amdgcn_ds_read_tr16_b64_v4i16((LAS v4i16_t*)p));
}
__device__ __forceinline__ bf16x8 tr8(const LAS unsigned char* img, int stride, int row0, int row1, int col0, int lane) {
    const s16x4 lo = tr4(img, stride, row0, col0, lane), hi = tr4(img, stride, row1, col0, lane);
    return __builtin_shufflevector(lo, hi, 0, 1, 2, 3, 4, 5, 6, 7);
}
constexpr int GS_K = 0, GS_Q = 16896, GS_K2 = 33792, GS_V = 54272, GS_TB = 74752, GS_AT = 83456, GS_E1 = 92160, GS_E2 = 92416, GS_E3 = 92672;
struct GdnLoad { v4u q[4], k[4], v[4], t[4]; float e1, e2, e3; };
__device__ __forceinline__ void gdn_issue(const bf16* GQ, const bf16* GK, const bf16* GV, const bf16* GTA, const float* E, int cid, int h, int dir, int lt, GdnLoad& L) {
    const bf16* ta = GTA + (((size_t)dir * NCHUNK + cid) * 4 + h) * 8192;
#pragma unroll
    for (int q = 0; q < 4; ++q) {
        const int p = lt + 256 * q, row = p >> 4, cg = p & 15;
        const size_t mo = ((size_t)cid * 64 + row) * 512 + h * 128 + 8 * cg;
        L.q[q] = *(const GAS v4u*)(GQ + mo); L.k[q] = *(const GAS v4u*)(GK + mo); L.v[q] = *(const GAS v4u*)(GV + mo);
        L.t[q] = *(const GAS v4u*)(ta + p * 8);
    }
    L.e1 = 0.f; L.e2 = 0.f; L.e3 = 0.f;
    if (lt < 64) { const size_t eo = (((size_t)dir * NCHUNK + cid) * 4 + h) * 64 + lt; L.e1 = E[eo]; L.e2 = E[(size_t)2 * NCHUNK * 4 * 64 + eo];
                   L.e3 = E[(size_t)4 * NCHUNK * 4 * 64 + ((size_t)dir * NCHUNK + cid) * 4 + h]; }
}
__device__ __forceinline__ void gdn_write(LAS unsigned char* lds, int lt, const GdnLoad& L) {
#pragma unroll
    for (int q = 0; q < 4; ++q) {
        const int p = lt + 256 * q, row = p >> 4, cg = p & 15;
        LAS unsigned char* d = lds + GS_Q + row * 264 + 16 * cg; *(LAS v2u*)d = (v2u){L.q[q].x, L.q[q].y}; *(LAS v2u*)(d + 8) = (v2u){L.q[q].z, L.q[q].w};
        d = lds + GS_K + row * 264 + 16 * cg; *(LAS v2u*)d = (v2u){L.k[q].x, L.k[q].y}; *(LAS v2u*)(d + 8) = (v2u){L.k[q].z, L.k[q].w};
        *(LAS v4u*)(lds + GS_K2 + row * 320 + 16 * cg) = L.k[q];
        *(LAS v4u*)(lds + GS_V + row * 320 + 16 * cg) = L.v[q];
        d = lds + (cg < 8 ? GS_TB + row * 136 + 16 * cg : GS_AT + row * 136 + 16 * (cg - 8)); *(LAS v2u*)d = (v2u){L.t[q].x, L.t[q].y}; *(LAS v2u*)(d + 8) = (v2u){L.t[q].z, L.t[q].w};
    }
    if (lt < 64) { ((LAS float*)(lds + GS_E1))[lt] = L.e1; ((LAS float*)(lds + GS_E2))[lt] = L.e2; if (lt == 0) ((LAS float*)(lds + GS_E3))[0] = L.e3; }
}
__device__ __forceinline__ void gdn_scan_chain(const Args& a, LAS unsigned char* lds, int l, int b, int h, int dir, int tid_in, int wave_in, int lane_in) {
    int tid = tid_in; asm volatile("" : "+v"(tid));
    const int lane = tid & 63, wave = __builtin_amdgcn_readfirstlane(tid >> 6);
    unsigned char* ws = a.ws; const LayerBufs B = layer_bufs(l);
    const bf16* GQ = (const bf16*)bufp(ws, a.out, B.GQ); const bf16* GK = (const bf16*)bufp(ws, a.out, B.GK); const bf16* GV = (const bf16*)bufp(ws, a.out, B.GV);
    bf16* GTA = (bf16*)bufp(ws, a.out, B.GTA);
    const float* E = (const float*)(ws + WS_GDEC);
    __syncthreads();
    if (wave >= 4) {
        const int lt = tid - 256;
        GdnLoad LA, LB;
        gdn_issue(GQ, GK, GV, GTA, E, chain_cid(b, dir, 0), h, dir, lt, LA); gdn_write(lds, lt, LA);
        gdn_issue(GQ, GK, GV, GTA, E, chain_cid(b, dir, 1), h, dir, lt, LA);
        __syncthreads();
#pragma unroll 1
        for (int step = 0; step < 36; step += 2) {
            if (step + 2 < 36) gdn_issue(GQ, GK, GV, GTA, E, chain_cid(b, dir, step + 2), h, dir, lt, LB);
            __syncthreads();
            gdn_write(lds, lt, LA);
            __syncthreads();
            if (step + 3 < 36) gdn_issue(GQ, GK, GV, GTA, E, chain_cid(b, dir, step + 3), h, dir, lt, LA);
            __syncthreads();
            if (step + 2 < 36) gdn_write(lds, lt, LB);
            __syncthreads();
        }
    } else {
        const int r = lane & 31, hh = lane >> 5, w = wave, cb16 = ((lane >> 4) & 1) * 16;
        f32x16 S[4];
#pragma unroll
        for (int mt = 0; mt < 4; ++mt) for (int i = 0; i < 16; ++i) S[mt][i] = 0.f;
        __syncthreads();
#pragma unroll 1
        for (int step = 0; step < 36; ++step) {
            const int cid = chain_cid(b, dir, step);
            const LAS float* e1s = (const LAS float*)(lds + GS_E1); const LAS float* e2s = (const LAS float*)(lds + GS_E2);
            const float e3 = ((const LAS float*)(lds + GS_E3))[0];
            f32x16 Z[2], Q[2];
#pragma unroll
            for (int it = 0; it < 2; ++it) for (int i = 0; i < 16; ++i) { Z[it][i] = 0.f; Q[it][i] = 0.f; }
#pragma unroll
            for (int mt = 0; mt < 4; ++mt)
#pragma unroll
                for (int s = 0; s < 2; ++s) {
                    const bf16x8 sb = pack_step(S[mt], s);
#pragma unroll
                    for (int it = 0; it < 2; ++it) {
                        Z[it] = MFMA32(frag_perm(lds + GS_K, 264, 32 * it + r, 32 * mt + 16 * s, hh), sb, Z[it]);
                        Q[it] = MFMA32(frag_perm(lds + GS_Q, 264, 32 * it + r, 32 * mt + 16 * s, hh), sb, Q[it]);
                    }
                }
#pragma unroll
            for (int it = 0; it < 2; ++it)
#pragma unroll
                for (int g = 0; g < 4; ++g) {
                    const f32x4 ev = *(const LAS f32x4*)(e1s + 32 * it + 8 * g + 4 * hh);
                    const s16x4 vv = tr4(lds + GS_V, 320, 32 * it + 8 * g + 4 * hh, 32 * w + cb16, lane);
#pragma unroll
                    for (int x = 0; x < 4; ++x) { Z[it][4 * g + x] = bf2f((bf16)vv[x]) - ev[x] * Z[it][4 * g + x]; Q[it][4 * g + x] *= ev[x]; }
                }
            f32x16 Vn[2];
#pragma unroll
            for (int it = 0; it < 2; ++it) for (int i = 0; i < 16; ++i) Vn[it][i] = 0.f;
#pragma unroll
            for (int kt = 0; kt < 2; ++kt)
#pragma unroll
                for (int s = 0; s < 2; ++s) {
                    const bf16x8 rb = pack_step(Z[kt], s);
#pragma unroll
                    for (int it = 0; it < 2; ++it) Vn[it] = MFMA32(frag_perm(lds + GS_TB, 136, 32 * it + r, 32 * kt + 16 * s, hh), rb, Vn[it]);
                }
#pragma unroll
            for (int kt = 0; kt < 2; ++kt)
#pragma unroll
                for (int s = 0; s < 2; ++s) {
                    const bf16x8 vb = pack_step(Vn[kt], s);
#pragma unroll
                    for (int it = 0; it < 2; ++it) Q[it] = MFMA32(frag_perm(lds + GS_AT, 136, 32 * it + r, 32 * kt + 16 * s, hh), vb, Q[it]);
                }
            {
                bf16* ob = GTA + (((size_t)dir * NCHUNK + cid) * 4 + h) * 8192 + 32 * w + r;
#pragma unroll
                for (int it = 0; it < 2; ++it)
#pragma unroll
                    for (int i = 0; i < 16; ++i) ob[(32 * it + crow(i, hh)) * 128] = (bf16)(pk2(Q[it][i], 0.f) & 0xffffu);
            }
#pragma unroll
            for (int it = 0; it < 2; ++it)
#pragma unroll
                for (int g = 0; g < 4; ++g) {
                    const f32x4 ev = *(const LAS f32x4*)(e2s + 32 * it + 8 * g + 4 * hh);
                    Vn[it][4 * g] *= ev[0]; Vn[it][4 * g + 1] *= ev[1]; Vn[it][4 * g + 2] *= ev[2]; Vn[it][4 * g + 3] *= ev[3];
                }
#pragma unroll
            for (int mt = 0; mt < 4; ++mt) for (int i = 0; i < 16; ++i) S[mt][i] *= e3;
#pragma unroll
            for (int kt = 0; kt < 2; ++kt)
#pragma unroll
                for (int s = 0; s < 2; ++s) {
                    const bf16x8 vb = pack_step(Vn[kt], s);
                    const int T0 = 32 * kt + 16 * s + 4 * hh;
#pragma unroll
                    for (int mt = 0; mt < 4; ++mt) S[mt] = MFMA32(tr8(lds + GS_K2, 320, T0, T0 + 8, 32 * mt + cb16, lane), vb, S[mt]);
                }
            __syncthreads();
            __syncthreads();
        }
    }
}

constexpr int LS_QG = 0, LS_KD = 8704, LS_AT = 17408, LS_V = 26112, LS_E3 = 46592;
struct GlaLoad { v4u o[6], v[4]; float e3; };
__device__ __forceinline__ void gla_issue(const bf16* LOP, const bf16* LV, const float* E, int cid, int h, int dir, int lt, GlaLoad& L) {
    const bf16* blk = LOP + ((size_t)cid * 4 + h) * 12288;
#pragma unroll
    for (int q = 0; q < 6; ++q) L.o[q] = *(const GAS v4u*)(blk + (lt + 256 * q) * 8);
#pragma unroll
    for (int q = 0; q < 4; ++q) { const int p = lt + 256 * q; L.v[q] = *(const GAS v4u*)(LV + ((size_t)cid * 64 + (p >> 4)) * 512 + h * 128 + 8 * (p & 15)); }
    L.e3 = 0.f; if (lt < 64) L.e3 = E[(((size_t)dir * NCHUNK + cid) * 4 + h) * 64 + lt];
}
__device__ __forceinline__ void gla_write(LAS unsigned char* lds, int lt, const GlaLoad& L) {
#pragma unroll
    for (int q = 0; q < 6; ++q) { const int p = lt + 256 * q, mat = p >> 9, row = (p >> 3) & 63, cg = p & 7;
        LAS unsigned char* d = lds + mat * 8704 + row * 136 + 16 * cg; *(LAS v2u*)d = (v2u){L.o[q].x, L.o[q].y}; *(LAS v2u*)(d + 8) = (v2u){L.o[q].z, L.o[q].w}; }
#pragma unroll
    for (int q = 0; q < 4; ++q) { const int p = lt + 256 * q; *(LAS v4u*)(lds + LS_V + (p >> 4) * 320 + 16 * (p & 15)) = L.v[q]; }
    if (lt < 64) ((LAS float*)(lds + LS_E3))[lt] = L.e3;
}
__device__ __forceinline__ void gla_scan_chain(const Args& a, LAS unsigned char* lds, int l, int b, int h, int dir, int tid_in, int wave_in, int lane_in) {
    int tid = tid_in; asm volatile("" : "+v"(tid));
    const int lane = tid & 63, wave = __builtin_amdgcn_readfirstlane(tid >> 6);
    unsigned char* ws = a.ws; const LayerBufs B = layer_bufs(l);
    bf16* LOP = (bf16*)bufp(ws, a.out, dir ? B.LOP1 : B.LOP0);
    const bf16* LV = (const bf16*)bufp(ws, a.out, B.LV);
    const float* E = (const float*)(ws + WS_LDEC);
    __syncthreads();
    if (wave >= 4) {
        const int lt = tid - 256;
        GlaLoad LA, LB;
        gla_issue(LOP, LV, E, chain_cid(b, dir, 0), h, dir, lt, LA); gla_write(lds, lt, LA);
        gla_issue(LOP, LV, E, chain_cid(b, dir, 1), h, dir, lt, LA);
        __syncthreads();
#pragma unroll 1
        for (int step = 0; step < 36; step += 2) {
            if (step + 2 < 36) gla_issue(LOP, LV, E, chain_cid(b, dir, step + 2), h, dir, lt, LB);
            __syncthreads();
            gla_write(lds, lt, LA);
            __syncthreads();
            if (step + 3 < 36) gla_issue(LOP, LV, E, chain_cid(b, dir, step + 3), h, dir, lt, LA);
            __syncthreads();
            if (step + 2 < 36) gla_write(lds, lt, LB);
            __syncthreads();
        }
    } else {
        const int r = lane & 31, hh = lane >> 5, w = wave, cb16 = ((lane >> 4) & 1) * 16;
        f32x16 S[2];
#pragma unroll
        for (int mt = 0; mt < 2; ++mt) for (int i = 0; i < 16; ++i) S[mt][i] = 0.f;
        __syncthreads();
#pragma unroll 1
        for (int step = 0; step < 36; ++step) {
            const int cid = chain_cid(b, dir, step);
            const LAS float* e3s = (const LAS float*)(lds + LS_E3);
            f32x16 O[2];
#pragma unroll
            for (int it = 0; it < 2; ++it) for (int i = 0; i < 16; ++i) O[it][i] = 0.f;
#pragma unroll
            for (int mt = 0; mt < 2; ++mt)
#pragma unroll
                for (int s = 0; s < 2; ++s) {
                    const bf16x8 sb = pack_step(S[mt], s);
#pragma unroll
                    for (int it = 0; it < 2; ++it) O[it] = MFMA32(frag_perm(lds + LS_QG, 136, 32 * it + r, 32 * mt + 16 * s, hh), sb, O[it]);
                }
#pragma unroll
            for (int mt = 0; mt < 2; ++mt)
#pragma unroll
                for (int g = 0; g < 4; ++g) {
                    const f32x4 ev = *(const LAS f32x4*)(e3s + 32 * mt + 8 * g + 4 * hh);
                    S[mt][4 * g] *= ev[0]; S[mt][4 * g + 1] *= ev[1]; S[mt][4 * g + 2] *= ev[2]; S[mt][4 * g + 3] *= ev[3];
                }
#pragma unroll
            for (int kt = 0; kt < 2; ++kt)
#pragma unroll
                for (int s = 0; s < 2; ++s) {
                    const int T0 = 32 * kt + 16 * s + 8 * hh;
                    const bf16x8 vb = tr8(lds + LS_V, 320, T0, T0 + 4, 32 * w + cb16, lane);
#pragma unroll
                    for (int it = 0; it < 2; ++it) O[it] = MFMA32(frag_nat(lds + LS_AT, 136, 32 * it + r, 32 * kt + 16 * s, hh), vb, O[it]);
#pragma unroll
                    for (int mt = 0; mt < 2; ++mt) S[mt] = MFMA32(frag_nat(lds + LS_KD, 136, 32 * mt + r, 32 * kt + 16 * s, hh), vb, S[mt]);
                }
            bf16* ob = LOP + ((size_t)cid * 4 + h) * 12288 + 32 * w + r;
#pragma unroll
            for (int it = 0; it < 2; ++it)
#pragma unroll
                for (int i = 0; i < 16; ++i) ob[(32 * it + crow(i, hh)) * 128] = (bf16)(pk2(O[it][i], 0.f) & 0xffffu);
            __syncthreads();
            __syncthreads();
        }
    }
}

__device__ __forceinline__ void phase_scan(const Args& a, LAS unsigned char* lds, int l, int vcu, int G, int tid, int wave, int lane) {
    for (int ch = vcu; ch < 128; ch += G) {
        const int dir = ch & 1, h = (ch >> 1) & 3, b = (ch >> 3) & 7;
        if (ch < 64) gdn_scan_chain(a, lds, l, b, h, dir, tid, wave, lane);
        else gla_scan_chain(a, lds, l, b, h, dir, tid, wave, lane);
    }
}

__device__ __forceinline__ void phase_merge(const Args& a, int l, int gw, int NGW, int lane) {
    unsigned char* ws = a.ws; const LayerBufs B = layer_bufs(l);
    const bf16* GTA = (const bf16*)bufp(ws, a.out, B.GTA); const bf16* L0 = (const bf16*)bufp(ws, a.out, B.LOP0); const bf16* L1 = (const bf16*)bufp(ws, a.out, B.LOP1);
    const bf16* ZA = (const bf16*)bufp(ws, a.out, B.ZA); const bf16* ZB = (const bf16*)bufp(ws, a.out, B.ZB);
    bf16* Y = (bf16*)bufp(ws, a.out, B.Y);
    const int mrows = l == DEPTH - 1 ? MLAT : MALL;
    const int grp = lane >> 4, cg = lane & 15;
    const float* gnA = a.in[I_GNORM] + l * 128; const float* gnB = a.in[I_LNORM] + l * 128;
    float gA[8], gB[8];
#pragma unroll
    for (int e = 0; e < 8; ++e) { gA[e] = gnA[8 * cg + e]; gB[e] = gnB[8 * cg + e]; }
    constexpr int UN = 4;
#pragma unroll 1
    for (int it0 = gw * 4 + grp; it0 < mrows * 8; it0 += NGW * 4 * UN) {
        v4u r0[UN], r1[UN], rz[UN];
#pragma unroll
        for (int u = 0; u < UN; ++u) {
            const int it = it0 + u * NGW * 4;
            r0[u] = (v4u){0u, 0u, 0u, 0u}; r1[u] = r0[u]; rz[u] = r0[u];
            if (it < mrows * 8) {
                const int m = it >> 3, hs = it & 7, cid = m >> 6, i = m & 63;
                const bf16 *o0, *o1, *zp;
                if (hs < 4) { o0 = GTA + (((size_t)0 * NCHUNK + cid) * 4 + hs) * 8192 + i * 128; o1 = GTA + (((size_t)1 * NCHUNK + cid) * 4 + hs) * 8192 + i * 128; zp = ZA + (size_t)m * 512 + hs * 128; }
                else { const int h2 = hs - 4; o0 = L0 + ((size_t)cid * 4 + h2) * 12288 + i * 128; o1 = L1 + ((size_t)cid * 4 + h2) * 12288 + i * 128; zp = ZB + (size_t)m * 512 + h2 * 128; }
                r0[u] = *(const GAS v4u*)(o0 + 8 * cg); r1[u] = *(const GAS v4u*)(o1 + 8 * cg); rz[u] = *(const GAS v4u*)(zp + 8 * cg);
            }
        }
#pragma unroll
        for (int u = 0; u < UN; ++u) {
            const int it = it0 + u * NGW * 4;
            if (it < mrows * 8) {
                const int m = it >> 3, hs = it & 7;
                float f0[8], f1[8], z[8];
                unpack8(r0[u], f0); unpack8(r1[u], f1); unpack8(rz[u], z);
                float ss = 0.f;
#pragma unroll
                for (int e = 0; e < 8; ++e) { f0[e] += f1[e]; ss += f0[e] * f0[e]; }
                ss += __shfl_xor(ss, 1); ss += __shfl_xor(ss, 2); ss += __shfl_xor(ss, 4); ss += __shfl_xor(ss, 8);
                const float rstd = rsqrtf(ss * (1.0f / 128.0f) + NEPS);
                float y[8];
#pragma unroll
                for (int e = 0; e < 8; ++e) y[e] = f0[e] * rstd * (hs < 4 ? gA[e] : gB[e]) * silu_f(z[e]);
                v4u o; o.x = pk2(y[0], y[1]); o.y = pk2(y[2], y[3]); o.z = pk2(y[4], y[5]); o.w = pk2(y[6], y[7]);
                *(GAS v4u*)(Y + (size_t)m * 1024 + hs * 128 + 8 * cg) = o;
            }
        }
    }
}
constexpr int CV_W = 0  , CV_B = 2304  , CV_T = 2560;
struct ConvPre { v4u rr[11]; float w0, w1; };
struct ConvGeo { int b, gy0, W, WS, NR, HR, TW, ncell, mbase, fl, isctx; };
__device__ __forceinline__ ConvGeo conv_geo(int unit, int nslab) {
    ConvGeo g; const int slab = unit % nslab, rest = unit / nslab;
    g.isctx = rest >= 32; g.b = g.isctx ? rest - 32 : rest >> 2; g.gy0 = g.isctx ? 0 : (rest & 3) * 8;
    g.W = g.isctx ? 256 : 64; g.WS = g.isctx ? 8 : 6; g.NR = g.isctx ? 1 : 8; g.HR = g.isctx ? 0 : 1; g.TW = g.W + 2; g.ncell = (g.NR + 2 * g.HR) * g.TW;
    g.mbase = g.isctx ? MLAT + g.b * 256 : g.b * 2048; g.fl = slab * 32; return g;
}
__device__ __forceinline__ void conv_prefetch(const Args& a, int l, const bf16* U, int Fc, int f0, int unit, int nslab, int tid, ConvPre& P) {
    const ConvGeo g = conv_geo(unit, nslab);
#pragma unroll
    for (int j = 0; j < 11; ++j) {
        const int p = tid + 512 * j; P.rr[j] = (v4u){0u, 0u, 0u, 0u};
        if (p < g.ncell * 8) {
            const int cell = p >> 3, pc = p & 7, tr = cell / g.TW, tc = cell - tr * g.TW;
            const int gy = g.gy0 - g.HR + tr, gx = tc - 1;
            if (gx >= 0 && gx < g.W && gy >= 0 && gy < (g.isctx ? 1 : 32)) {
                const size_t m = (size_t)g.mbase + gy * g.W + gx;
                P.rr[j] = *(const GAS v4u*)(U + m * (2 * Fc) + (pc >> 2) * Fc + g.fl + 8 * (pc & 3));
            }
        }
    }
    { const int p = tid, tap = p >> 6, av = (p >> 5) & 1, c = p & 31; P.w0 = a.in[I_FCONV][((size_t)l * 9 + tap) * 5632 + av * DFF + f0 + g.fl + c]; }
    P.w1 = 0.f;
    if (tid < 64) { const int p = tid + 512, tap = p >> 6, av = (p >> 5) & 1, c = p & 31; P.w1 = a.in[I_FCONV][((size_t)l * 9 + tap) * 5632 + av * DFF + f0 + g.fl + c]; }
    else if (tid < 128) { const int q = tid - 64; P.w1 = a.in[I_FCB][(size_t)l * 5632 + (q >> 5) * DFF + f0 + g.fl + (q & 31)]; }
}
__device__ __forceinline__ void conv_compute(LAS unsigned char* lds, bf16* Gd, int Fc, int unit, int nslab, int tid) {
    const ConvGeo g = conv_geo(unit, nslab);
    const LAS float* wsm = (const LAS float*)(lds + CV_W); const LAS float* bsm = (const LAS float*)(lds + CV_B); const LAS unsigned char* tile = lds + CV_T;
#pragma unroll 1
    for (int it = tid; it < g.NR * g.W * 4; it += 512) {
        const int cg = it & 3, tok = it >> 2, ry = tok >> g.WS, gx = tok & (g.W - 1);
        float sa[8], sv[8];
#pragma unroll
        for (int e = 0; e < 8; ++e) { sa[e] = bsm[8 * cg + e]; sv[e] = bsm[32 + 8 * cg + e]; }
#pragma unroll 1
        for (int dy = -1; dy <= 1; ++dy) {
            if (g.isctx && dy != 0) continue;
#pragma unroll
            for (int dx = -1; dx <= 1; ++dx) {
                const int tap = (dy + 1) * 3 + dx + 1;
                const LAS unsigned char* cp = tile + ((ry + g.HR + dy) * g.TW + gx + 1 + dx) * 192 + 16 * cg;
                float xa[8], xv[8];
                unpack8(*(const LAS v4u*)cp, xa); unpack8(*(const LAS v4u*)(cp + 64), xv);
                const LAS float* wp = wsm + tap * 64 + 8 * cg;
#pragma unroll
                for (int e = 0; e < 8; ++e) { sa[e] += xa[e] * wp[e]; sv[e] += xv[e] * wp[32 + e]; }
            }
        }
        float y[8];
#pragma unroll
        for (int e = 0; e < 8; ++e) y[e] = silu_f(sa[e]) * sv[e];
        v4u o; o.x = pk2(y[0], y[1]); o.y = pk2(y[2], y[3]); o.z = pk2(y[4], y[5]); o.w = pk2(y[6], y[7]);
        const size_t m = (size_t)g.mbase + (g.gy0 + ry) * g.W + gx;
        *(GAS v4u*)(Gd + m * Fc + g.fl + 8 * cg) = o;
    }
}
__device__ __forceinline__ void phase_conv(const Args& a, LAS unsigned char* lds, int l, int chunkA, int vcu, int G, int tid_in) {
    int tid = tid_in; asm volatile("" : "+v"(tid));
    unsigned char* ws = a.ws; const LayerBufs B = layer_bufs(l);
    const int Fc = chunkA ? FCA : FCB, f0 = chunkA ? FCB : 0, nslab = Fc / 32;
    const bf16* U = (const bf16*)bufp(ws, a.out, chunkA ? B.UA : B.UB); bf16* Gd = (bf16*)bufp(ws, a.out, chunkA ? B.GA : B.GB);
    const int nunits = (l == DEPTH - 1 ? 32 : 40) * nslab;
    ConvPre P;
    if (vcu < nunits) conv_prefetch(a, l, U, Fc, f0, vcu, nslab, tid, P);
#pragma unroll 1
    for (int u = vcu; u < nunits; u += G) {
        __syncthreads();
        {
            const ConvGeo g = conv_geo(u, nslab);
#pragma unroll
            for (int j = 0; j < 11; ++j) { const int p = tid + 512 * j; if (p < g.ncell * 8) *(LAS v4u*)(lds + CV_T + (p >> 3) * 192 + (p & 7) * 16) = P.rr[j]; }
            ((LAS float*)(lds + CV_W))[tid] = P.w0;
            if (tid < 64) ((LAS float*)(lds + CV_W))[512 + tid] = P.w1; else if (tid < 128) ((LAS float*)(lds + CV_B))[tid - 64] = P.w1;
        }
        if (u + G < nunits && !(a.pad & 32)) conv_prefetch(a, l, U, Fc, f0, u + G, nslab, tid, P);
        __syncthreads();
        if (!(a.pad & 16)) conv_compute(lds, Gd, Fc, u, nslab, tid);
    }
    __syncthreads();
}
__device__ __forceinline__ void phase_final(const Args& a, int gw, int NGW, int lane) {
    const float* rs = (const float*)(a.ws + WS_RSA) + (size_t)3 * MALL; const float* fn = a.in[I_FNORM];
    f32x4 g[4];
#pragma unroll
    for (int j = 0; j < 4; ++j) g[j] = *(const f32x4*)(fn + 4 * lane + 256 * j);
#pragma unroll 1
    for (int m0 = gw; m0 < MLAT; m0 += 4 * NGW) {
        f32x4 v[4][4]; float rstd[4];
#pragma unroll
        for (int u = 0; u < 4; ++u) { const int m = m0 + u * NGW; if (m < MLAT) { rstd[u] = rs[m];
#pragma unroll
            for (int j = 0; j < 4; ++j) v[u][j] = *(const f32x4*)(a.out + (size_t)m * 1024 + 4 * lane + 256 * j); } }
#pragma unroll
        for (int u = 0; u < 4; ++u) { const int m = m0 + u * NGW; if (m < MLAT) { const float r = rsqrtf(rstd[u] * (1.0f / 1024.0f) + NEPS);
#pragma unroll
            for (int j = 0; j < 4; ++j) *(f32x4*)(a.out + (size_t)m * 1024 + 4 * lane + 256 * j) = v[u][j] * r * g[j]; } }
    }
}
constexpr int PH_P0A = 0, PH_P0B = 1, PH_L0 = 2, PH_PER_LAYER = 11, PH_FINAL = PH_L0 + 2 * PH_PER_LAYER, PH_COUNT = PH_FINAL + 1;
enum { K_INPROJ = 0, K_PREP, K_SCAN, K_MERGE, K_OUTPROJ, K_UPB, K_CONVB, K_DOWNB, K_UPA, K_CONVA, K_DOWNA };

__global__ void __launch_bounds__(NWAVES * 64, 2) mk_fwd(Args a) {
    extern __shared__ __attribute__((aligned(16))) unsigned char lds_raw[];
    LAS unsigned char* lds = (LAS unsigned char*)lds_raw;
    const int G = gridDim.x; const int bx = blockIdx.x;
    const int vcu = (G % 8 == 0) ? (bx % 8) * (G / 8) + bx / 8 : bx;
    const int NGW = G * NWAVES;
    unsigned char* ws = a.ws;
    for (int u = threadIdx.x; u < (LDS_BYTES - LDSCTL_OFF) / 4; u += NWAVES * 64) ((LAS unsigned*)(lds + LDSCTL_OFF))[u] = 0u;
    __syncthreads();
    XcdBarrier bar; bar.bar = (unsigned*)(ws + WS_CTL) + CW_BAR; bar.x = 0; bar.st = nullptr;
    if (a.use_bar) bar = xcd_barrier_post((unsigned*)(ws + WS_CTL) + CW_BAR, (volatile LAS unsigned*)(lds + LDSCTL_OFF) + 8);
    const float* MOD = (const float*)(ws + WS_MOD);
    float* RSA = (float*)(ws + WS_RSA);

    for (int ph = a.ph_lo; ph < a.ph_hi; ++ph) {
        STAMP(ph);
        int tid_o = threadIdx.x; asm volatile("" : "+v"(tid_o));
        const int tid = tid_o, lane = tid & 63, wave = __builtin_amdgcn_readfirstlane(tid >> 6);
        const int gw = vcu * NWAVES + wave;
        if (ph == PH_P0A) phase_p0a(a, lds, vcu, G, tid, wave, lane);
        else if (ph == PH_P0B) phase_p0b(a, lds, vcu, G, tid, wave, lane);
        else if (ph < PH_FINAL) {
            const int l = (ph - PH_L0) / PH_PER_LAYER, k = (ph - PH_L0) % PH_PER_LAYER;
            const LayerBufs B = layer_bufs(l);
            unsigned char* wl = ws + (l == 0 ? WS_W1 : WS_W2);
            const float* MODl = MOD + (size_t)l * 9 * 6144;
            const float* SWl = (const float*)(ws + WS_SW) + (size_t)l * SW_LAYER;
            const float* rs_n1 = l == 0 ? (const float*)(ws + WS_RS1) : RSA + (size_t)1 * MALL;
            if (k == K_INPROJ) {
                const bf16* XG = (const bf16*)bufp(ws, a.out, B.XG);
                skinny_rows(XG, (const bf16*)(ws + WS_WSM) + (size_t)l * 48 * 1024, rs_n1, SWl + 9 * NMAIN, (float*)(ws + WS_SM), gw, NGW, lane);
                pg8::Gemm g{XG, (const bf16*)(wl + W_IN), MALL, NMAIN, 1024}; pg8::StaticOrder S; S.init(MALL, NMAIN, G, bx);
                pg8::EpiInProj E{ws, a.out, l};
                pg8::gemm_phase<pg8::EpiInProj, pg8::StaticOrder, true, true>(lds, g, S, E);
            }
            else if (k == K_PREP) phase_prep(a, lds, l, vcu, G, tid, wave, lane);
            else if (k == K_SCAN) phase_scan(a, lds, l, vcu, G, tid, wave, lane);
            else if (k == K_MERGE) phase_merge(a, l, gw, NGW, lane);
            else if (k == K_OUTPROJ || k == K_DOWNB || k == K_DOWNA) {
                const int M = l == DEPTH - 1 ? MLAT : MALL;
                const bool last = l == DEPTH - 1;
                float* res_lat = a.out; float* res_ctx = (float*)(ws + WS_CXR);
                pg8::EpiResid E;
                E.rin_lat = (k == K_OUTPROJ && l == 0) ? a.in[I_X] : res_lat; E.rin_ctx = (k == K_OUTPROJ && l == 0) ? a.in[I_CTX] : res_ctx;
                E.rout_lat = res_lat; E.rout_ctx = res_ctx;
                E.gate = MODl + (k == K_OUTPROJ ? 2 : 5) * 1024; E.gn = nullptr; E.scl = nullptr; E.XGo = nullptr; E.rowss = nullptr;
                pg8::Gemm g;
                if (k == K_OUTPROJ) { g = pg8::Gemm{(const bf16*)bufp(ws, a.out, B.Y), (const bf16*)(wl + W_OUT), M, 1024, 1024};
                    E.gn = a.in[I_NORM2] + l * 1024; E.scl = MODl + 4 * 1024; E.XGo = (bf16*)bufp(ws, a.out, B.XG2); E.rowss = RSA + (size_t)(l == 0 ? 0 : 2) * MALL; }
                else if (k == K_DOWNB) g = pg8::Gemm{(const bf16*)bufp(ws, a.out, B.GB), (const bf16*)(wl + W_DB), M, 1024, FCB};
                else { g = pg8::Gemm{(const bf16*)bufp(ws, a.out, B.GA), (const bf16*)(wl + W_DA), M, 1024, FCA};
                    if (!last) { E.gn = a.in[I_NORM1] + 1024; E.scl = MOD + (size_t)9 * 6144 + 1 * 1024; E.XGo = (bf16*)bufp(ws, a.out, B.XGN); E.rowss = RSA + (size_t)1 * MALL; }
                    else E.rowss = RSA + (size_t)3 * MALL; }
                pg8::StaticOrder S; S.init(M, 1024, G, bx);
                pg8::gemm_phase<pg8::EpiResid, pg8::StaticOrder, true, true>(lds, g, S, E);
            }
            else if (k == K_UPB || k == K_UPA) {
                const int M = l == DEPTH - 1 ? MLAT : MALL;
                const int roff = k == K_UPA ? 2 * FCB : 0, N = k == K_UPA ? 2 * FCA : 2 * FCB;
                pg8::Gemm g{(const bf16*)bufp(ws, a.out, B.XG2), (const bf16*)(wl + W_UP) + (size_t)roff * 1024, M, N, 1024};
                pg8::EpiUp E{RSA + (size_t)(l == 0 ? 0 : 2) * MALL, SWl + 9 * (NMAIN + NSMALL) + roff, (bf16*)bufp(ws, a.out, k == K_UPA ? B.UA : B.UB), N};
                pg8::StaticOrder S; S.init(M, N, G, bx);
                pg8::gemm_phase<pg8::EpiUp, pg8::StaticOrder, true, true>(lds, g, S, E);
            }
            else if (k == K_CONVB || k == K_CONVA) phase_conv(a, lds, l, k == K_CONVA, vcu, G, tid);
        }
        else phase_final(a, gw, NGW, lane);
        if (ph + 1 < a.ph_hi && a.use_bar) xcd_barrier(bar);
    }
    STAMP(PH_COUNT);
#ifdef MK_PROF_A
    if (blockIdx.x == 0 && threadIdx.x == 0) {
        volatile LAS unsigned long long* st = (volatile LAS unsigned long long*)(lds + LDSCTL_OFF + 256);
        const unsigned long long d = (st[MK_PROF_B] - st[MK_PROF_A]) * (unsigned long long)(MK_PROF_K);
        const unsigned long long t0 = __builtin_amdgcn_s_memrealtime();
        while (__builtin_amdgcn_s_memrealtime() - t0 < d) __builtin_amdgcn_s_sleep(8);
    }
#endif
}
static int g_grid = 0;
static int mk_setup() {
    if (g_grid) return g_grid;
    int dev = 0, cus = 0;
    if (hipGetDevice(&dev) != hipSuccess || hipDeviceGetAttribute(&cus, hipDeviceAttributeMultiprocessorCount, dev) != hipSuccess) { g_grid = -1; return -1; }
    if (hipFuncSetAttribute((const void*)mk_fwd, hipFuncAttributeMaxDynamicSharedMemorySize, LDS_BYTES) != hipSuccess) { fprintf(stderr, "hipFuncSetAttribute failed\n"); g_grid = -1; return -1; }
    (void)hipGetLastError();
    g_grid = cus;
    return g_grid;
}
static void mk_launch(const Args& base, int lo, int hi, int use_bar, hipStream_t stream) {
    Args a = base; a.ph_lo = lo; a.ph_hi = hi; a.use_bar = use_bar;
    hipLaunchKernelGGL(mk_fwd, dim3(g_grid), dim3(NWAVES * 64), LDS_BYTES, stream, a);
}

extern "C" void kernel_launch(void* const* d_in, const int* in_sizes, int n_in, void* d_out, int out_size, void* d_ws, size_t ws_size, hipStream_t stream) {
    if (mk_setup() < 0) return;
    unsigned char* ws = (unsigned char*)d_ws;
    (void)hipMemsetAsync(ws + WS_CTL, 0, CTL_ZERO_BYTES, stream);
    Args a{};
    for (int i = 0; i < 22; ++i) a.in[i] = (const float*)d_in[i];
    a.out = (float*)d_out; a.ws = ws;
#ifndef MK_N_LAUNCHES
#define MK_N_LAUNCHES 1
#endif
    if (MK_N_LAUNCHES == 1) mk_launch(a, 0, PH_COUNT, 1, stream);
    else for (int ph = 0; ph < PH_COUNT; ++ph) mk_launch(a, ph, ph + 1, 0, stream);
#ifdef MK_PROBE_LIST
    {
        Args p = a; p.out = (float*)(ws + 64 * MiB);
#ifdef MK_PROBE_PMODE
        p.pad = MK_PROBE_PMODE;
#endif
        const int lst[] = { MK_PROBE_LIST };
        for (int r = 0; r < MK_PROBE_REPS; ++r) for (unsigned i = 0; i < sizeof(lst) / sizeof(lst[0]); ++i) mk_launch(p, lst[i], lst[i] + 1, 0, stream);
    }
#endif
}
```

```cpp
#include <hip/hip_runtime.h>
#include <cstdio>
#include <cstdint>
#include <math.h>

#define GAS __attribute__((address_space(1)))
#define LAS __attribute__((address_space(3)))
typedef unsigned short bf16;
typedef unsigned v4u __attribute__((ext_vector_type(4)));
typedef unsigned v2u __attribute__((ext_vector_type(2)));
typedef float f32x4 __attribute__((ext_vector_type(4)));
typedef float f32x16 __attribute__((ext_vector_type(16)));
typedef short bf16x8 __attribute__((ext_vector_type(8)));
typedef short s16x4 __attribute__((ext_vector_type(4)));
typedef __bf16 bf16x2_t __attribute__((ext_vector_type(2)));
typedef float f32x2_t __attribute__((ext_vector_type(2)));
typedef GAS unsigned gu32;

constexpr int DM = 1024, NBATCH = 8, LSEQ = 2048, LCTX = 256, DEPTH = 2;
constexpr int MLAT = NBATCH * LSEQ;
constexpr int MALL = MLAT + NBATCH * LCTX;
constexpr int NCHUNK = MALL / 64;
constexpr int DINP = 3632, NMAIN = 3584, NSMALL = 48;
constexpr int DFF = 2816, FCB = 1280, FCA = 1536;
constexpr float NEPS = 1e-6f;

constexpr size_t MiB = 1u << 20;
constexpr size_t WS_CTL = 0, CTL_ZERO_BYTES = 1 * MiB;
constexpr int CW_BAR = 4096;
constexpr size_t WS_RSA = 256 * 1024;
constexpr size_t WS_MOD = 1 * MiB;
constexpr size_t WS_RS1 = 1 * MiB + 512 * 1024;
constexpr size_t WS_SW = 2 * MiB;
constexpr size_t SW_LAYER = (size_t)9 * (NMAIN + NSMALL + 2 * DFF);
constexpr size_t WS_GDEC = 3 * MiB;
constexpr size_t WS_LDEC = 4 * MiB + 512 * 1024;
constexpr size_t WS_SM = 5 * MiB + 256 * 1024;
constexpr size_t WS_HALO = 9 * MiB;
constexpr size_t WS_WSM = 11 * MiB;
constexpr size_t WS_W2 = 12 * MiB, WS_W1 = 38 * MiB;
constexpr size_t W_IN = 0, W_OUT = 7 * MiB, W_UP = 9 * MiB, W_DB = 20 * MiB, W_DA = 20 * MiB + (size_t)1024 * FCB * 2;
constexpr size_t WS_CXR = 64 * MiB;
static_assert(W_DA + (size_t)1024 * FCA * 2 <= 26 * MiB, "weights");
static_assert(WS_SM + (size_t)MALL * 48 * 4 <= WS_HALO && WS_HALO + (size_t)NCHUNK * 2 * 1536 * 2 <= WS_WSM, "ws small map");
static_assert(WS_SW + 2 * SW_LAYER * 4 <= WS_GDEC && WS_RSA + (size_t)4 * MALL * 4 <= CTL_ZERO_BYTES, "ws map");

struct LayerBufs {
    long XG, GQ, GK, GV, LV, ZA, ZB, LQ, LK, GTA, LOP0, LOP1, Y, XG2, UB, GB, UA, GA, XGN;
};
#define DO_(x) (-(long)((x) * MiB) - 1)
__host__ __device__ constexpr LayerBufs layer_bufs(int l) {
    return l == 0 ? LayerBufs{ 72 * (long)MiB, 108 * (long)MiB, 126 * (long)MiB, 144 * (long)MiB, 162 * (long)MiB, DO_(0), DO_(18), DO_(36), DO_(45),
                               180 * (long)MiB, 72 * (long)MiB, 216 * (long)MiB, 108 * (long)MiB, 72 * (long)MiB, 108 * (long)MiB, 198 * (long)MiB, 126 * (long)MiB, 72 * (long)MiB, 220 * (long)MiB }
                  : LayerBufs{ 220 * (long)MiB, 38 * (long)MiB, 56 * (long)MiB, 74 * (long)MiB, 92 * (long)MiB, 110 * (long)MiB, 128 * (long)MiB, 146 * (long)MiB, 155 * (long)MiB,
                               164 * (long)MiB, 200 * (long)MiB, 227 * (long)MiB, 38 * (long)MiB, 74 * (long)MiB, 110 * (long)MiB, 190 * (long)MiB, 110 * (long)MiB, 206 * (long)MiB, 0 };
}

#define LDS_WAIT() asm volatile("s_waitcnt lgkmcnt(0)" ::: "memory")
#define VM_WAIT() asm volatile("s_waitcnt vmcnt(0)" ::: "memory")
__device__ __forceinline__ unsigned pk2(float lo, float hi) { f32x2_t v = {lo, hi}; bf16x2_t b = __builtin_convertvector(v, bf16x2_t); return __builtin_bit_cast(unsigned, b); }
__device__ __forceinline__ float bflo(unsigned u) { return __uint_as_float(u << 16); }
__device__ __forceinline__ float bfhi(unsigned u) { return __uint_as_float(u & 0xffff0000u); }
__device__ __forceinline__ float bf2f(bf16 u) { return __uint_as_float((unsigned)u << 16); }
__device__ __forceinline__ float silu_f(float x) { return x * __builtin_amdgcn_rcpf(1.f + __expf(-x)); }
__device__ __forceinline__ float softplus_f(float x) { return fmaxf(x, 0.f) + __logf(1.f + __expf(-fabsf(x))); }
__device__ __forceinline__ float sigmoid_f(float x) { return __builtin_amdgcn_rcpf(1.f + __expf(-x)); }
__device__ __forceinline__ float wave_sum(float v) {
#pragma unroll
    for (int o = 1; o < 64; o <<= 1) v += __shfl_xor(v, o);
    return v;
}
__device__ __forceinline__ int row_s(int m) { return m < MLAT ? (m >> 11) : 8; }
__host__ __device__ __forceinline__ unsigned char* bufp(unsigned char* ws, float* out, long off) { return off >= 0 ? ws + off : (unsigned char*)out + (-off - 1); }
namespace pg8 {
#define PG8_LAS __attribute__((address_space(3)))
typedef unsigned short bf16_t;
typedef short bf16x8 __attribute__((ext_vector_type(8)));
typedef float f32x4 __attribute__((ext_vector_type(4)));
typedef unsigned u32x4 __attribute__((ext_vector_type(4)));
constexpr int BM = 256, BK = 64, HALF = 128, HTB = HALF * BK * 2  , STAGE_BYTES = 8 * HTB, NXCD = 8, WGM = 8;

__host__ __device__ __forceinline__ int lds_byte(int r, int c) { const int st = (r >> 4) * 2 + (c >> 5), rr = r & 15, cc = c & 31, ob = rr * 64 + cc * 2; return st * 1024 + (ob ^ (((ob >> 9) & 1) << 5)); }
__host__ __device__ __forceinline__ void stage_rc(int b, int& R, int& C) { const int st = b / 1024, sb = b % 1024, swz = sb ^ (((sb >> 9) & 1) << 5); R = (st >> 1) * 16 + swz / 64; C = (st & 1) * 32 + (swz % 64) / 2; }
__host__ __device__ __forceinline__ int perm32(int rho) { const int n = rho >> 4, i = rho & 15; return 8 * (i >> 2) + 4 * n + (i & 3); }

struct Unit { int pm, pn; };
struct Gemm { const bf16_t* A; const bf16_t* Bt; int M, N, K; };

struct StaticOrder {
    int nM, nN, nwg, G, c;
    __host__ __device__ void init(int M, int N, int G_, int c_) { nM = M / BM; nN = N / BM; nwg = nM * nN; G = G_; c = c_; }
    __host__ __device__ bool next(int i, Unit& u) const {
        const long L = (long)i * G + c; if (L >= nwg) return false;
        int wgid = (int)L; { const int q = nwg / NXCD, r = nwg % NXCD, xcd = wgid % NXCD, off = wgid / NXCD; wgid = (xcd < r ? xcd * (q + 1) : r * (q + 1) + (xcd - r) * q) + off; }
        const int nig = WGM * nN, gid = wgid / nig, fm = gid * WGM, gsz = (nM - fm) < WGM ? (nM - fm) : WGM;
        u.pm = fm + ((wgid % nig) % gsz); u.pn = (wgid % nig) / gsz; return true;
    }
    __device__ __forceinline__ void a_ready(const Unit&) const {}
    __device__ __forceinline__ void done(const Unit&) const {}
};
__device__ __forceinline__ unsigned pk2e(float lo, float hi) { f32x2_t v = {lo, hi}; bf16x2_t b = __builtin_convertvector(v, bf16x2_t); return __builtin_bit_cast(unsigned, b); }

struct EpiInProj {
    static constexpr bool PERM = true, AFTER_DRAIN = false;
    unsigned char* ws; float* out; int l;
    __device__ __forceinline__ void operator()(const f32x4 (&acc)[2][2][4][2], const Unit& u, int wr, int wc, int fr, int fq) const {
        const LayerBufs B = layer_bufs(l);
        const float* rowss = l == 0 ? (const float*)(ws + WS_RS1) : (const float*)(ws + WS_RSA) + MALL;
        const float* sW = (const float*)(ws + WS_SW) + (size_t)l * SW_LAYER;
        const int pn = u.pn, s = u.pm < 64 ? (u.pm >> 3) : 8;
        long boff; int ld, cb;
        if (pn < 8) { const int t = pn >> 1; boff = t == 0 ? B.GQ : (t == 1 ? B.GK : (t == 2 ? B.GV : B.ZA)); ld = 512; cb = (pn & 1) * 256; }
        else if (pn == 8) { boff = B.LQ; ld = 256; cb = 0; }
        else if (pn == 9) { boff = B.LK; ld = 256; cb = 0; }
        else { boff = pn < 12 ? B.LV : B.ZB; ld = 512; cb = (pn & 1) * 256; }
        bf16_t* base = (bf16_t*)bufp(ws, out, boff);
        bf16_t* HALO = (bf16_t*)(ws + WS_HALO);
        const int row0 = u.pm * BM + wr * 64 + fr, colw = wc * 32 + 8 * fq;
        const float* swp = sW + (size_t)s * 3584 + pn * BM + colw;
        f32x4 bv[2][2];
#pragma unroll
        for (int bj = 0; bj < 2; ++bj)
#pragma unroll
            for (int n = 0; n < 2; ++n) bv[bj][n] = *(const f32x4*)(swp + bj * HALF + 4 * n);
        float rs8[8];
#pragma unroll
        for (int q = 0; q < 8; ++q) rs8[q] = rowss[row0 + (q >> 2) * HALF + (q & 3) * 16];
#pragma unroll
        for (int ai = 0; ai < 2; ++ai)
#pragma unroll
            for (int m = 0; m < 4; ++m) {
                const int row = row0 + ai * HALF + m * 16;
                const float rstd = rsqrtf(rs8[ai * 4 + m] * (1.0f / 1024.0f) + 1e-6f);
                bf16_t* rowp = base + (size_t)row * ld + cb + colw;
                const bool halo = (pn < 6) && ((m == 0 && fr == 0) || (m == 3 && fr == 15));
                bf16_t* hp = HALO + ((size_t)(row >> 6) * 2 + (m == 3 ? 1 : 0)) * 1536 + (pn >> 1) * 512 + cb + colw;
#pragma unroll
                for (int bj = 0; bj < 2; ++bj) {
                    const f32x4 v0 = acc[ai][bj][m][0] * rstd + bv[bj][0], v1 = acc[ai][bj][m][1] * rstd + bv[bj][1];
                    u32x4 w; w.x = pk2e(v0[0], v0[1]); w.y = pk2e(v0[2], v0[3]); w.z = pk2e(v1[0], v1[1]); w.w = pk2e(v1[2], v1[3]);
                    *(u32x4*)(rowp + bj * HALF) = w;
                    if (halo) *(u32x4*)(hp + bj * HALF) = w;
                }
            }
    }
};

struct EpiResid {
    static constexpr bool PERM = true, AFTER_DRAIN = false;
    const float* rin_lat; const float* rin_ctx; float* rout_lat; float* rout_ctx;
    const float* gate;
    const float* gn;
    const float* scl;
    bf16_t* XGo; float* rowss;
    __device__ __forceinline__ void operator()(const f32x4 (&acc)[2][2][4][2], const Unit& u, int wr, int wc, int fr, int fq) const {
        const int s = u.pm < 64 ? (u.pm >> 3) : 8;
        const bool isctx = u.pm >= 64, do_xg = XGo != nullptr, do_ss = rowss != nullptr;
        const float* rin = isctx ? rin_ctx - (size_t)16384 * 1024 : rin_lat;
        float* rout = isctx ? rout_ctx - (size_t)16384 * 1024 : rout_lat;
        const int row0 = u.pm * BM + wr * 64 + fr, col0 = u.pn * BM + wc * 32 + 8 * fq;
        f32x4 gv[2][2], nv[2][2];
#pragma unroll
        for (int bj = 0; bj < 2; ++bj)
#pragma unroll
            for (int n = 0; n < 2; ++n) {
                gv[bj][n] = *(const f32x4*)(gate + (size_t)s * 6144 + col0 + bj * HALF + 4 * n);
                if (do_xg) { const f32x4 g = *(const f32x4*)(gn + col0 + bj * HALF + 4 * n), sc = *(const f32x4*)(scl + (size_t)s * 6144 + col0 + bj * HALF + 4 * n); nv[bj][n] = g * (sc + 1.0f); }
                else nv[bj][n] = (f32x4){0.f, 0.f, 0.f, 0.f};
            }
#pragma unroll
        for (int am = 0; am < 4; ++am) {
            const int ai = am >> 1, mb = (am & 1) * 2;
            f32x4 rv[2][2][2];
#pragma unroll
            for (int mm = 0; mm < 2; ++mm) { const float* rp = rin + (size_t)(row0 + ai * HALF + (mb + mm) * 16) * 1024 + col0;
#pragma unroll
                for (int bj = 0; bj < 2; ++bj) { rv[mm][bj][0] = *(const f32x4*)(rp + bj * HALF); rv[mm][bj][1] = *(const f32x4*)(rp + bj * HALF + 4); } }
#pragma unroll
            for (int mm = 0; mm < 2; ++mm) {
                const int m = mb + mm;
                const int row = row0 + ai * HALF + m * 16;
                float* op = rout + (size_t)row * 1024 + col0;
                float ss = 0.f;
#pragma unroll
                for (int bj = 0; bj < 2; ++bj) {
                    const f32x4 x0 = rv[mm][bj][0] + gv[bj][0] * acc[ai][bj][m][0];
                    const f32x4 x1 = rv[mm][bj][1] + gv[bj][1] * acc[ai][bj][m][1];
                    *(f32x4*)(op + bj * HALF) = x0; *(f32x4*)(op + bj * HALF + 4) = x1;
                    ss += (x0[0] * x0[0] + x0[1] * x0[1]) + (x0[2] * x0[2] + x0[3] * x0[3]) + (x1[0] * x1[0] + x1[1] * x1[1]) + (x1[2] * x1[2] + x1[3] * x1[3]);
                    if (do_xg) {
                        const f32x4 y0 = x0 * nv[bj][0], y1 = x1 * nv[bj][1];
                        u32x4 w; w.x = pk2e(y0[0], y0[1]); w.y = pk2e(y0[2], y0[3]); w.z = pk2e(y1[0], y1[1]); w.w = pk2e(y1[2], y1[3]);
                        *(u32x4*)(XGo + (size_t)row * 1024 + col0 + bj * HALF) = w;
                    }
                }
                if (do_ss) { ss += __shfl_xor(ss, 16); ss += __shfl_xor(ss, 32); if (fq == 0) atomicAdd(rowss + row, ss); }
            }
        }
    }
};

struct EpiUp {
    static constexpr bool PERM = true, AFTER_DRAIN = false;
    const float* rowss; const float* sW;
    bf16_t* U; int ldu;
    __device__ __forceinline__ void operator()(const f32x4 (&acc)[2][2][4][2], const Unit& u, int wr, int wc, int fr, int fq) const {
        const int s = u.pm < 64 ? (u.pm >> 3) : 8;
        const int row0 = u.pm * BM + wr * 64 + fr, col0 = u.pn * BM + wc * 32 + 8 * fq;
        const float* swp = sW + (size_t)s * 5632 + col0;
        f32x4 bv[2][2];
#pragma unroll
        for (int bj = 0; bj < 2; ++bj)
#pragma unroll
            for (int n = 0; n < 2; ++n) bv[bj][n] = *(const f32x4*)(swp + bj * HALF + 4 * n);
        float rs8[8];
#pragma unroll
        for (int q = 0; q < 8; ++q) rs8[q] = rowss[row0 + (q >> 2) * HALF + (q & 3) * 16];
#pragma unroll
        for (int ai = 0; ai < 2; ++ai)
#pragma unroll
            for (int m = 0; m < 4; ++m) {
                const int row = row0 + ai * HALF + m * 16;
                const float rstd = rsqrtf(rs8[ai * 4 + m] * (1.0f / 1024.0f) + 1e-6f);
                bf16_t* rowp = U + (size_t)row * ldu + col0;
#pragma unroll
                for (int bj = 0; bj < 2; ++bj) {
                    const f32x4 v0 = acc[ai][bj][m][0] * rstd + bv[bj][0], v1 = acc[ai][bj][m][1] * rstd + bv[bj][1];
                    u32x4 w; w.x = pk2e(v0[0], v0[1]); w.y = pk2e(v0[2], v0[3]); w.z = pk2e(v1[0], v1[1]); w.w = pk2e(v1[2], v1[3]);
                    *(u32x4*)(rowp + bj * HALF) = w;
                }
            }
    }
};

struct EpiAny {
    static constexpr bool PERM = true, AFTER_DRAIN = false;
    unsigned char* ws; float* out; const float* xin; const float* ctxin; const float* norm1; const float* norm2; int l, k;
    __device__ __forceinline__ void operator()(const f32x4 (&acc)[2][2][4][2], const Unit& u, int wr, int wc, int fr, int fq) const {
        const LayerBufs B = layer_bufs(l);
        const float* MOD = (const float*)(ws + WS_MOD); const float* MODl = MOD + (size_t)l * 9 * 6144;
        float* RSA = (float*)(ws + WS_RSA);
        if (k == 0) { EpiInProj e{ws, out, l}; e(acc, u, wr, wc, fr, fq); }
        else if (k == 5 || k == 8) {
            const float* SWl = (const float*)(ws + WS_SW) + (size_t)l * SW_LAYER;
            EpiUp e{RSA + (size_t)(l == 0 ? 0 : 2) * MALL, SWl + 9 * (NMAIN + NSMALL) + (k == 8 ? 2 * FCB : 0), (bf16_t*)bufp(ws, out, k == 8 ? B.UA : B.UB), k == 8 ? 2 * FCA : 2 * FCB};
            e(acc, u, wr, wc, fr, fq);
        } else {
            EpiResid e;
            e.rin_lat = (k == 4 && l == 0) ? xin : out; e.rin_ctx = (k == 4 && l == 0) ? ctxin : (const float*)(ws + WS_CXR);
            e.rout_lat = out; e.rout_ctx = (float*)(ws + WS_CXR);
            e.gate = MODl + (k == 4 ? 2 : 5) * 1024; e.gn = nullptr; e.scl = nullptr; e.XGo = nullptr; e.rowss = nullptr;
            if (k == 4) { e.gn = norm2 + l * 1024; e.scl = MODl + 4 * 1024; e.XGo = (bf16_t*)bufp(ws, out, B.XG2); e.rowss = RSA + (size_t)(l == 0 ? 0 : 2) * MALL; }
            else if (k == 10) { if (l != DEPTH - 1) { e.gn = norm1 + 1024; e.scl = MOD + (size_t)9 * 6144 + 1 * 1024; e.XGo = (bf16_t*)bufp(ws, out, B.XGN); e.rowss = RSA + (size_t)1 * MALL; }
                                else e.rowss = RSA + (size_t)3 * MALL; }
            e(acc, u, wr, wc, fr, fq);
        }
    }
};
template <class Epi, class Sched, bool ALIGN_EPI = false, bool SP2 = false>
__device__ __forceinline__ void gemm_phase(PG8_LAS unsigned char* lds, const Gemm g, const Sched& S, const Epi& E) {
    int tid_o = threadIdx.x; asm volatile("" : "+v"(tid_o));
    const int tid = tid_o, wid = __builtin_amdgcn_readfirstlane(tid >> 6), lane = tid & 63, wr = wid >> 2, wc = wid & 3, fr = lane & 15, fq = lane >> 4;
    const int K = g.K, nt = K / BK;
    unsigned voffA[2], voffB[2];
#pragma unroll
    for (int i = 0; i < 2; ++i) { int R, C; stage_rc(tid * 16 + i * 8192, R, C); const int Rb = Epi::PERM ? ((R & ~31) + perm32(R & 31)) : R;
        voffA[i] = (unsigned)(R * K + C) * 2u; voffB[i] = (unsigned)(Rb * K + C) * 2u; }
    const size_t kstep = (size_t)(BK * 2);
    const size_t hstep = (size_t)HALF * K * 2;
    const size_t tstep = 2 * hstep;
    const unsigned ldsw = (unsigned)wid * 1024u;
    const int aoff = lds_byte(wr * 64 + fr, fq * 8), boff = lds_byte(wc * 32 + fr, fq * 8);
#define PG8_SA(b, h) (((b) * 2 + (h)) * HTB)
#define PG8_SB(b, h) ((4 + (b) * 2 + (h)) * HTB)
#define PG8_STAGE(bufoff, gbase, voff) do { _Pragma("unroll") for (int _i = 0; _i < 2; ++_i) \
        __builtin_amdgcn_global_load_lds((const unsigned*)((const char*)(gbase) + (voff)[_i]), (PG8_LAS unsigned*)(lds + (bufoff) + ldsw + _i * 8192), 16, 0, 0); } while (0)
#define PG8_LDA(dst, b, h) do { _Pragma("unroll") for (int m = 0; m < 4; ++m) _Pragma("unroll") for (int k = 0; k < 2; ++k) dst[m][k] = *(const PG8_LAS bf16x8*)(lds + PG8_SA(b, h) + aoff + m * 2048 + k * 1024); } while (0)
#define PG8_LDB(dst, b, h) do { _Pragma("unroll") for (int n = 0; n < 2; ++n) _Pragma("unroll") for (int k = 0; k < 2; ++k) dst[n][k] = *(const PG8_LAS bf16x8*)(lds + PG8_SB(b, h) + boff + n * 2048 + k * 1024); } while (0)
#define PG8_MMA(ai, bj, At, Bt) do { __builtin_amdgcn_s_setprio(1); _Pragma("unroll") for (int m = 0; m < 4; ++m) _Pragma("unroll") for (int n = 0; n < 2; ++n) _Pragma("unroll") for (int k = 0; k < 2; ++k) \
        acc[ai][bj][m][n] = __builtin_amdgcn_mfma_f32_16x16x32_bf16(Bt[n][k], At[m][k], acc[ai][bj][m][n], 0, 0, 0); __builtin_amdgcn_s_setprio(0); } while (0)
#define PG8_WAIT_V(n) asm volatile("s_waitcnt vmcnt(" #n ")" ::: "memory")
#define PG8_WAIT_L(n) asm volatile("s_waitcnt lgkmcnt(" #n ")" ::: "memory")
#define PG8_BAR __builtin_amdgcn_s_barrier()
#define PG8_SCHED __builtin_amdgcn_sched_barrier(0)
    Unit cur, nxt; int ui = 0;
    if (!S.next(0, cur)) return;
    f32x4 acc[2][2][4][2];
#pragma unroll
    for (int a = 0; a < 2; ++a)
#pragma unroll
        for (int b = 0; b < 2; ++b)
#pragma unroll
            for (int m = 0; m < 4; ++m)
#pragma unroll
                for (int n = 0; n < 2; ++n) acc[a][b][m][n] = (f32x4){0.f, 0.f, 0.f, 0.f};
    bf16x8 At[4][2], B0[2][2], B1[2][2];
    const char* cA = (const char*)g.A + (size_t)cur.pm * tstep; const char* cB = (const char*)g.Bt + (size_t)cur.pn * tstep;
    S.a_ready(cur);
    if constexpr (SP2) {
        PG8_STAGE(PG8_SB(0, 0), cB, voffB); PG8_STAGE(PG8_SB(0, 1), cB + hstep, voffB); PG8_STAGE(PG8_SA(0, 0), cA, voffA); PG8_STAGE(PG8_SA(0, 1), cA + hstep, voffA);
        if (wr == 1) PG8_BAR;
        PG8_WAIT_V(2); PG8_BAR;
        PG8_STAGE(PG8_SB(1, 0), cB + kstep, voffB); PG8_STAGE(PG8_SA(1, 0), cA + kstep, voffA); PG8_STAGE(PG8_SB(1, 1), cB + hstep + kstep, voffB);
        PG8_WAIT_V(6); PG8_BAR;
    } else {
        PG8_STAGE(PG8_SB(0, 0), cB, voffB); PG8_STAGE(PG8_SA(0, 0), cA, voffA); PG8_STAGE(PG8_SB(0, 1), cB + hstep, voffB); PG8_STAGE(PG8_SA(0, 1), cA + hstep, voffA);
        if (wr == 1) PG8_BAR;
        PG8_WAIT_V(4); PG8_BAR;
        PG8_STAGE(PG8_SB(1, 0), cB + kstep, voffB); PG8_STAGE(PG8_SA(1, 0), cA + kstep, voffA); PG8_STAGE(PG8_SB(1, 1), cB + hstep + kstep, voffB);
        PG8_WAIT_V(6); PG8_BAR;
    }
    for (;;) {
        const bool has_next = S.next(ui + 1, nxt);
        const char* nA = has_next ? (const char*)g.A + (size_t)nxt.pm * tstep : cA; const char* nB = has_next ? (const char*)g.Bt + (size_t)nxt.pn * tstep : cB;
        for (int t = 0; t < nt; t += 2) {
            const bool last = (t == nt - 2);
            const char* a1 = cA + (size_t)(t + 1) * kstep;
            const char* a2 = last ? nA : cA + (size_t)(t + 2) * kstep; const char* b2 = last ? nB : cB + (size_t)(t + 2) * kstep;
            const char* a3 = a2 + kstep; const char* b3 = b2 + kstep;
            if (last && has_next) S.a_ready(nxt);
            if constexpr (SP2) {
            PG8_LDB(B0, 0, 0); PG8_LDB(B1, 0, 1); PG8_SCHED; PG8_LDA(At, 0, 0); PG8_STAGE(PG8_SA(1, 1), a1 + hstep, voffA);
            PG8_WAIT_V(8); PG8_WAIT_L(0); PG8_BAR; PG8_MMA(0, 0, At, B0); PG8_MMA(0, 1, At, B1); PG8_BAR; PG8_SCHED;
            PG8_LDA(At, 0, 1); PG8_STAGE(PG8_SB(0, 0), b2, voffB); PG8_STAGE(PG8_SB(0, 1), b2 + hstep, voffB); PG8_STAGE(PG8_SA(0, 0), a2, voffA);
            PG8_WAIT_V(8); PG8_WAIT_L(0); PG8_BAR; PG8_MMA(1, 0, At, B0); PG8_MMA(1, 1, At, B1); PG8_BAR; PG8_SCHED;
            PG8_LDB(B0, 1, 0); PG8_LDB(B1, 1, 1); PG8_SCHED; PG8_LDA(At, 1, 0); PG8_STAGE(PG8_SA(0, 1), a2 + hstep, voffA);
            PG8_WAIT_V(8); PG8_WAIT_L(0); PG8_BAR; PG8_MMA(0, 0, At, B0); PG8_MMA(0, 1, At, B1); PG8_BAR; PG8_SCHED;
            PG8_LDA(At, 1, 1); PG8_STAGE(PG8_SB(1, 0), b3, voffB); PG8_STAGE(PG8_SB(1, 1), b3 + hstep, voffB); PG8_STAGE(PG8_SA(1, 0), a3, voffA);
            PG8_WAIT_V(8); PG8_WAIT_L(0); PG8_BAR; PG8_MMA(1, 0, At, B0); PG8_MMA(1, 1, At, B1); PG8_BAR; PG8_SCHED;
            } else {
            PG8_LDB(B0, 0, 0); PG8_SCHED; PG8_LDA(At, 0, 0); PG8_STAGE(PG8_SA(1, 1), a1 + hstep, voffA);
            PG8_WAIT_L(8); PG8_BAR; PG8_WAIT_L(0); PG8_MMA(0, 0, At, B0); PG8_BAR; PG8_SCHED;
            PG8_LDB(B1, 0, 1); PG8_STAGE(PG8_SB(0, 0), b2, voffB);
            PG8_BAR; PG8_WAIT_L(0); PG8_MMA(0, 1, At, B1); PG8_BAR;
            PG8_LDA(At, 0, 1); PG8_STAGE(PG8_SA(0, 0), a2, voffA);
            PG8_BAR; PG8_WAIT_L(0); PG8_MMA(1, 0, At, B0); PG8_BAR; PG8_SCHED;
            PG8_STAGE(PG8_SB(0, 1), b2 + hstep, voffB);
            PG8_WAIT_V(6); PG8_BAR; PG8_MMA(1, 1, At, B1); PG8_BAR;
            PG8_LDB(B0, 1, 0); PG8_SCHED; PG8_LDA(At, 1, 0); PG8_STAGE(PG8_SA(0, 1), a2 + hstep, voffA);
            PG8_WAIT_L(8); PG8_BAR; PG8_WAIT_L(0); PG8_MMA(0, 0, At, B0); PG8_BAR; PG8_SCHED;
            PG8_LDB(B1, 1, 1); PG8_STAGE(PG8_SB(1, 0), b3, voffB);
            PG8_BAR; PG8_WAIT_L(0); PG8_MMA(0, 1, At, B1); PG8_BAR;
            PG8_LDA(At, 1, 1); PG8_STAGE(PG8_SA(1, 0), a3, voffA);
            PG8_BAR; PG8_WAIT_L(0); PG8_MMA(1, 0, At, B0); PG8_BAR; PG8_SCHED;
            PG8_STAGE(PG8_SB(1, 1), b3 + hstep, voffB);
            PG8_WAIT_V(6); PG8_BAR; PG8_MMA(1, 1, At, B1); PG8_BAR;
            }
        }
        if constexpr (ALIGN_EPI) { if (wr == 0) PG8_BAR; }
        if constexpr (!Epi::AFTER_DRAIN) { E(acc, cur, wr, wc, fr, fq); S.done(cur); }
        if (!has_next) break;
#pragma unroll
        for (int a = 0; a < 2; ++a)
#pragma unroll
            for (int b = 0; b < 2; ++b)
#pragma unroll
                for (int m = 0; m < 4; ++m)
#pragma unroll
                    for (int n = 0; n < 2; ++n) acc[a][b][m][n] = (f32x4){0.f, 0.f, 0.f, 0.f};
        cur = nxt; cA = nA; cB = nB; ++ui;
        if constexpr (ALIGN_EPI) { if (wr == 1) PG8_BAR; }
    }
    PG8_WAIT_V(0);
    if constexpr (!ALIGN_EPI) { if (wr == 0) PG8_BAR; }
    PG8_BAR;
    if constexpr (Epi::AFTER_DRAIN) { E.fused(acc, cur, wr, wc, fr, fq, lds, wid, lane); S.done(cur); }
#undef PG8_SA
#undef PG8_SB
#undef PG8_STAGE
#undef PG8_LDA
#undef PG8_LDB
#undef PG8_MMA
#undef PG8_WAIT_V
#undef PG8_WAIT_L
#undef PG8_BAR
#undef PG8_SCHED
}
}
#define XB_TMO      128
#define XB_XCNT(j)  (256  + 64 * (j))
#define XB_XSUB(j)  (1280 + 64 * (j))
#define XB_XGEN(j)  (2304 + 64 * (j))
#define XB_TOP      3328
#define XB_TOPGEN   3392
#define XCD_BAR_WORDS 3456
#define XB_SPIN_CAP (1u << 18)

__device__ __forceinline__ unsigned xb_ld(unsigned* p)              { return __hip_atomic_load(p, __ATOMIC_RELAXED, __HIP_MEMORY_SCOPE_AGENT); }
__device__ __forceinline__ unsigned xb_add(unsigned* p, unsigned v) { return __hip_atomic_fetch_add(p, v, __ATOMIC_RELAXED, __HIP_MEMORY_SCOPE_AGENT); }
__device__ __forceinline__ unsigned xb_xcc_id() { return (unsigned)__builtin_amdgcn_s_getreg((3 << 11) | 20) & 0xFu; }
#define XB_SPIN(cond, bar) do { unsigned _sp = 0; while (cond) { __builtin_amdgcn_s_sleep(1); \
    if ((++_sp & 255u) == 0u) { if (xb_ld(&(bar)[XB_TMO])) break; if (_sp > XB_SPIN_CAP) { atomicAdd(&(bar)[XB_TMO], 1u); break; } } } } while (0)

struct XcdBarrier {
    unsigned* bar; unsigned x;
    volatile LAS unsigned* st;
};

__device__ __forceinline__ XcdBarrier xcd_barrier_post(unsigned* bar, volatile LAS unsigned* st) {
    XcdBarrier b; b.bar = bar; b.x = xb_xcc_id(); b.st = st;
    if (threadIdx.x == 0) (void)xb_add(&bar[XB_XCNT(b.x)], 1u);
    return b;
}
__device__ __forceinline__ void xcd_barrier_complete(unsigned* bar, unsigned x, unsigned& nloc, unsigned& nx) {
    const unsigned G = gridDim.x * gridDim.y * gridDim.z;
    unsigned sum, cnt, mine, sp = 0u;
    for (;;) {
        sum = 0u; cnt = 0u; mine = 0u;
#pragma unroll
        for (unsigned j = 0; j < 16; ++j) { const unsigned c = xb_ld(&bar[XB_XCNT(j)]); sum += c; cnt += (c > 0u) ? 1u : 0u; mine = (j == x) ? c : mine; }
        if (sum == G) break;
        __builtin_amdgcn_s_sleep(1);
        if ((++sp & 255u) == 0u) { if (xb_ld(&bar[XB_TMO])) break; if (sp > XB_SPIN_CAP) { atomicAdd(&bar[XB_TMO], 1u); break; } }
    }
    nloc = mine > 0u ? mine : 1u; nx = cnt > 0u ? cnt : 1u;
}

__device__ __forceinline__ void xcd_barrier(const XcdBarrier& b) {
    asm volatile("s_waitcnt vmcnt(0)" ::: "memory");
    __syncthreads();
    if (threadIdx.x == 0) {
        unsigned* bar = b.bar;
        __builtin_amdgcn_s_waitcnt(0);
        unsigned nloc = b.st[0], nx = b.st[1];
        if (nloc == 0u) { xcd_barrier_complete(bar, b.x, nloc, nx); b.st[0] = nloc; b.st[1] = nx; }
        const unsigned old = xb_add(&bar[XB_XSUB(b.x)], 1u);
        const unsigned gen = old / nloc;
        if (old + 1u == (gen + 1u) * nloc) {
            __builtin_amdgcn_fence(__ATOMIC_RELEASE, "agent");
            asm volatile("s_waitcnt vmcnt(0)" ::: "memory");
            const unsigned og = xb_add(&bar[XB_TOP], 1u);
            const unsigned tg = og / nx;
            if (og + 1u == (tg + 1u) * nx) xb_add(&bar[XB_TOPGEN], 1u);
            else XB_SPIN(xb_ld(&bar[XB_TOPGEN]) == tg, bar);
            __builtin_amdgcn_fence(__ATOMIC_ACQUIRE, "agent");
            xb_add(&bar[XB_XGEN(b.x)], 1u);
            asm volatile("s_waitcnt vmcnt(0)" ::: "memory");
        } else {
            XB_SPIN(xb_ld(&bar[XB_XGEN(b.x)]) == gen, bar);
            __builtin_amdgcn_fence(__ATOMIC_ACQUIRE, "agent");
            asm volatile("s_waitcnt vmcnt(0)" ::: "memory");
        }
    }
    __syncthreads();
}
#ifdef MK_PROF_A
#define STAMP(id) do { int t_ = threadIdx.x; asm volatile("" : "+v"(t_)); if (blockIdx.x == 0 && t_ == 0) ((volatile LAS unsigned long long*)(lds + 155648 + 256))[id] = __builtin_amdgcn_s_memrealtime(); } while (0)
#else
#define STAMP(id) do {} while (0)
#endif
constexpr int NWAVES = 8;
constexpr int RING_BYTES = 131072, LDSCTL_OFF = 155648, LDS_BYTES = 163840;
struct Args {
    const float* in[22]; float* out; unsigned char* ws; int ph_lo, ph_hi; int use_bar, pad;
};
enum { I_X = 0, I_C, I_CTX, I_CCTX, I_WMOD, I_BMOD, I_NORM1, I_WIN, I_GCONV, I_ALOG, I_DTB, I_GNORM, I_WGK, I_BGK, I_LNORM, I_WOUT, I_NORM2, I_WUP, I_FCONV, I_FCB, I_WDOWN, I_FNORM };


__device__ __forceinline__ void tr_item(const float* src, int ldsrc, int k0, int c0, int ncols, bf16* dst, int lddst, int r0, int kd0, LAS float* scr, int lane) {
    const int cl = lane & 31;
    const int cle = cl < ncols ? cl : ncols - 1;
#pragma unroll 8
    for (int i = 0; i < 32; ++i) { const int kk = 2 * i + (lane >> 5); scr[kk * 33 + cl] = src[(size_t)(k0 + kk) * ldsrc + c0 + cle]; }
    LDS_WAIT(); asm volatile("" ::: "memory");
    const int c = lane & 7;
#pragma unroll
    for (int j = 0; j < 4; ++j) { const int n = (lane >> 3) + 8 * j; const LAS float* s = scr + (8 * c) * 33 + n;
        v4u o; o.x = pk2(s[0 * 33], s[1 * 33]); o.y = pk2(s[2 * 33], s[3 * 33]); o.z = pk2(s[4 * 33], s[5 * 33]); o.w = pk2(s[6 * 33], s[7 * 33]);
        if (n < ncols) *(GAS v4u*)(dst + (size_t)(r0 + n) * lddst + kd0 + 8 * c) = o; }
    LDS_WAIT(); asm volatile("" ::: "memory");
}

__device__ __forceinline__ void phase_p0a(const Args& a, LAS unsigned char* lds, int vcu, int G, int tid, int wave, int lane) {
    unsigned char* ws = a.ws;
    {
        LAS float* sc = (LAS float*)lds;
        LAS float* red = (LAS float*)(lds + 36864);
        bool have = false;
        for (int it = vcu; it < 192; it += G) {
            if (!have) {
                {
                    f32x4 v[5];
#pragma unroll
                    for (int j = 0; j < 5; ++j) { const int p = tid + 512 * j; v[j] = (f32x4){0.f, 0.f, 0.f, 0.f};
                        if (p < 9 * 256) { const int s = p >> 8, k4 = p & 255; v[j] = *(const f32x4*)((s < 8 ? a.in[I_C] + s * 1024 : a.in[I_CCTX]) + 4 * k4); } }
#pragma unroll
                    for (int j = 0; j < 5; ++j) { const int p = tid + 512 * j;
                        if (p < 9 * 256) *(LAS f32x4*)(sc + 4 * p) = (f32x4){silu_f(v[j][0]), silu_f(v[j][1]), silu_f(v[j][2]), silu_f(v[j][3])}; }
                }
                __syncthreads(); have = true;
            }
            const int l = it / 96, n0 = (it % 96) * 64;
            const float* W = a.in[I_WMOD] + (size_t)l * 1024 * 6144;
            const int c4 = tid & 15, ks = tid >> 4;
            f32x4 acc[9];
#pragma unroll
            for (int s = 0; s < 9; ++s) acc[s] = (f32x4){0.f, 0.f, 0.f, 0.f};
#pragma unroll 1
            for (int j0 = 0; j0 < 32; j0 += 8) {
                f32x4 w[8];
#pragma unroll
                for (int jj = 0; jj < 8; ++jj) w[jj] = *(const f32x4*)(W + (size_t)(ks + 32 * (j0 + jj)) * 6144 + n0 + 4 * c4);
#pragma unroll
                for (int jj = 0; jj < 8; ++jj) {
                    const int k = ks + 32 * (j0 + jj);
#pragma unroll
                    for (int s = 0; s < 9; ++s) acc[s] += w[jj] * sc[s * 1024 + k];
                }
            }
#pragma unroll
            for (int s = 0; s < 9; ++s) *(LAS f32x4*)(red + (ks * 9 + s) * 64 + 4 * c4) = acc[s];
            __syncthreads();
            for (int o = tid; o < 576; o += 512) {
                const int s = o >> 6, c = o & 63; float v = 0.f;
                for (int q = 0; q < 32; ++q) v += red[(q * 9 + s) * 64 + c];
                ((float*)(ws + WS_MOD))[((size_t)l * 9 + s) * 6144 + n0 + c] = v + a.in[I_BMOD][l * 6144 + n0 + c];
            }
            __syncthreads();
        }
        __syncthreads();
    }
    {
        LAS float* scr = (LAS float*)(lds + wave * 16384);
        const int gw = vcu * NWAVES + wave, NGW = G * NWAVES;
        constexpr int I_IN = 16 * 112, I_SM = 16 * 2, I_O = 16 * 32, I_U = 16 * 176, I_D = 44 * 32, PER_L = I_IN + I_SM + I_O + I_U + I_D;
#pragma unroll 1
        for (int it = gw; it < 2 * PER_L; it += NGW) {
            const int l = it / PER_L; int r = it % PER_L;
            unsigned char* wl = ws + (l == 0 ? WS_W1 : WS_W2);
            const float* src; int ldsrc, k0, c0, ncols = 32, lddst, r0, kd0; bf16* dst;
            if (r < I_IN) { const int kb = r / 112, n0 = (r % 112) * 32; src = a.in[I_WIN] + (size_t)l * 1024 * DINP; ldsrc = DINP; k0 = kb * 64; c0 = n0 < 2048 ? n0 : n0 + 16; dst = (bf16*)(wl + W_IN); lddst = 1024; r0 = n0; kd0 = k0; }
            else if ((r -= I_IN) < I_SM) { const int kb = r / 2, part = r % 2; src = a.in[I_WIN] + (size_t)l * 1024 * DINP; ldsrc = DINP; k0 = kb * 64; c0 = part == 0 ? 2048 : 3600; ncols = part == 0 ? 16 : 32;
                dst = (bf16*)(ws + WS_WSM) + (size_t)l * 48 * 1024; lddst = 1024; r0 = part == 0 ? 0 : 16; kd0 = k0; }
            else if ((r -= I_SM) < I_O) { const int kb = r / 32, nb = r % 32; src = a.in[I_WOUT] + (size_t)l * 1024 * 1024; ldsrc = 1024; k0 = kb * 64; c0 = nb * 32; dst = (bf16*)(wl + W_OUT); lddst = 1024; r0 = nb * 32; kd0 = k0; }
            else if ((r -= I_O) < I_U) { const int kb = r / 176, rr0 = (r % 176) * 32;
                src = a.in[I_WUP] + (size_t)l * 1024 * 5632; ldsrc = 5632; k0 = kb * 64;
                c0 = rr0 < 1280 ? rr0 : (rr0 < 2560 ? 2816 + (rr0 - 1280) : (rr0 < 4096 ? 1280 + (rr0 - 2560) : 2816 + 1280 + (rr0 - 4096)));
                dst = (bf16*)(wl + W_UP); lddst = 1024; r0 = rr0; kd0 = k0; }
            else { r -= I_U; const int kb = r / 32, nb = r % 32; k0 = kb * 64; src = a.in[I_WDOWN] + (size_t)l * DFF * 1024; ldsrc = 1024; c0 = nb * 32; r0 = nb * 32;
                if (k0 < FCB) { dst = (bf16*)(wl + W_DB); lddst = FCB; kd0 = k0; } else { dst = (bf16*)(wl + W_DA); lddst = FCA; kd0 = k0 - FCB; } }
            tr_item(src, ldsrc, k0, c0, ncols, dst, lddst, r0, kd0, scr, lane);
        }
    }
}

__device__ __forceinline__ void xg_rows(const float* xlat, const float* xctx, const float* gain, const float* scl  , bf16* XG, float* rowss, int gw, int NGW, int lane, int mrows) {
    f32x4 g[4];
#pragma unroll
    for (int j = 0; j < 4; ++j) g[j] = *(const f32x4*)(gain + 4 * lane + 256 * j);
#pragma unroll 1
    for (int m0 = gw; m0 < mrows; m0 += 4 * NGW) {
        f32x4 v[4][4];
#pragma unroll
        for (int u = 0; u < 4; ++u) { const int m1 = m0 + u * NGW, m = m1 < mrows ? m1 : mrows - 1; const float* src = m < MLAT ? xlat + (size_t)m * 1024 : xctx + (size_t)(m - MLAT) * 1024;
#pragma unroll
            for (int j = 0; j < 4; ++j) v[u][j] = *(const f32x4*)(src + 4 * lane + 256 * j); }
#pragma unroll
        for (int u = 0; u < 4; ++u) { const int m = m0 + u * NGW; if (m < mrows) {
            const int s = row_s(m); float ss = 0.f;
#pragma unroll
            for (int j = 0; j < 4; ++j) {
                const int c = 4 * lane + 256 * j; const f32x4 x = v[u][j], sc = *(const f32x4*)(scl + (size_t)s * 6144 + c);
                ss += (x[0] * x[0] + x[1] * x[1]) + (x[2] * x[2] + x[3] * x[3]);
                const f32x4 y = x * g[j] * (sc + 1.0f);
                v2u o; o.x = pk2(y[0], y[1]); o.y = pk2(y[2], y[3]);
                *(GAS v2u*)(XG + (size_t)m * 1024 + c) = o;
            }
            ss = wave_sum(ss);
            if (lane == 0) rowss[m] = ss; } }
    }
}

__device__ __forceinline__ void phase_p0b(const Args& a, LAS unsigned char* lds, int vcu, int G, int tid, int wave, int lane) {
    unsigned char* ws = a.ws;
    const int gw = vcu * NWAVES + wave, NGW = G * NWAVES;
    const float* MOD = (const float*)(ws + WS_MOD);
    constexpr LayerBufs B0 = layer_bufs(0);
    xg_rows(a.in[I_X], a.in[I_CTX], a.in[I_NORM1], MOD + 1 * 1024, (bf16*)bufp(ws, a.out, B0.XG), (float*)(ws + WS_RS1), gw, NGW, lane, MALL);
    __syncthreads();
    {
#pragma unroll 1
        for (int b0 = 0; b0 < 18; b0 += 6) {
            f32x4 v[6];
#pragma unroll
            for (int j = 0; j < 6; ++j) { const int p = tid + 512 * (b0 + j), combo = p / 2304, rem = p % 2304, s = rem >> 8, k4 = rem & 255, l = combo >> 1, which = combo & 1;
                v[j] = *(const f32x4*)(MOD + ((size_t)l * 9 + s) * 6144 + (which ? 3 : 0) * 1024 + 4 * k4); }
#pragma unroll
            for (int j = 0; j < 6; ++j) { const int p = tid + 512 * (b0 + j), combo = p / 2304, rem = p % 2304, s = rem >> 8, k4 = rem & 255;
                *(LAS v2u*)(lds + (combo * 16 + s) * 2064 + 8 * k4) = (v2u){pk2(v[j][0], v[j][1]), pk2(v[j][2], v[j][3])}; }
        }
        for (int i = tid; i < 4 * 7 * 258; i += 512) { const int combo = i / (7 * 258), rem = i % (7 * 258), s = 9 + rem / 258, q = rem % 258;
            *(LAS v2u*)(lds + (combo * 16 + s) * 2064 + 8 * q) = (v2u){0u, 0u}; }
    }
    __syncthreads();
    {
        const int r = lane & 15, g = lane >> 4;
        constexpr int T0 = (NMAIN + NSMALL) / 16, T1 = 5632 / 16, TPL = T0 + T1;
#pragma unroll 1
        for (int t = gw; t < 2 * TPL; t += NGW) {
            const int l = t / TPL, tt = t % TPL, which = tt >= T0, n0 = (which ? tt - T0 : tt) * 16;
            unsigned char* wl = ws + (l == 0 ? WS_W1 : WS_W2);
            float* SWl = (float*)(ws + WS_SW) + (size_t)l * SW_LAYER;
            const bf16* wrow; float* dst; int ldd;
            if (which) { wrow = (const bf16*)(wl + W_UP) + (size_t)(n0 + r) * 1024; dst = SWl + 9 * (NMAIN + NSMALL) + n0; ldd = 5632; }
            else if (n0 < NMAIN) { wrow = (const bf16*)(wl + W_IN) + (size_t)(n0 + r) * 1024; dst = SWl + n0; ldd = NMAIN; }
            else { wrow = (const bf16*)(ws + WS_WSM) + ((size_t)l * 48 + (n0 - NMAIN) + r) * 1024; dst = SWl + 9 * NMAIN + (n0 - NMAIN); ldd = NSMALL; }
            const LAS unsigned char* sb = lds + ((l * 2 + which) * 16 + r) * 2064 + 16 * g;
            f32x4 acc = (f32x4){0.f, 0.f, 0.f, 0.f};
#pragma unroll 1
            for (int k0 = 0; k0 < 32; k0 += 8) {
                bf16x8 af[8];
#pragma unroll
                for (int kk = 0; kk < 8; ++kk) af[kk] = *(const GAS bf16x8*)(wrow + 32 * (k0 + kk) + 8 * g);
#pragma unroll
                for (int kk = 0; kk < 8; ++kk) { const s16x4 lo = *(const LAS s16x4*)(sb + 64 * (k0 + kk)), hi = *(const LAS s16x4*)(sb + 64 * (k0 + kk) + 8);
                    acc = __builtin_amdgcn_mfma_f32_16x16x32_bf16(af[kk], __builtin_shufflevector(lo, hi, 0, 1, 2, 3, 4, 5, 6, 7), acc, 0, 0, 0); }
            }
            if (r < 9) {
#pragma unroll
                for (int j = 0; j < 4; ++j) dst[(size_t)r * ldd + 4 * g + j] = acc[j];
            }
        }
    }
    __syncthreads();
}

__device__ __forceinline__ void skinny_rows(const bf16* XG, const bf16* Wsm  , const float* rowss, const float* sWsm  , float* SM, int gw, int NGW, int lane) {
    const int r = lane & 15, g = lane >> 4;
    for (int t = gw; t < MALL / 16; t += NGW) {
        const int m0 = t * 16;
        f32x4 acc[3];
#pragma unroll
        for (int n = 0; n < 3; ++n) acc[n] = (f32x4){0.f, 0.f, 0.f, 0.f};
        const bf16* ap = XG + (size_t)(m0 + r) * 1024 + 8 * g;
        const bf16* bp = Wsm + (size_t)r * 1024 + 8 * g;
        float rs4[4], sw[4][3];
#pragma unroll
        for (int j = 0; j < 4; ++j) { const int m = m0 + 4 * g + j; rs4[j] = rowss[m]; const int s = row_s(m);
#pragma unroll
            for (int n = 0; n < 3; ++n) sw[j][n] = sWsm[s * 48 + 16 * n + r]; }
#pragma unroll 1
        for (int k0 = 0; k0 < 32; k0 += 4) {
            bf16x8 af[4], bfr[4][3];
#pragma unroll
            for (int kk = 0; kk < 4; ++kk) { af[kk] = *(const GAS bf16x8*)(ap + 32 * (k0 + kk));
#pragma unroll
                for (int n = 0; n < 3; ++n) bfr[kk][n] = *(const GAS bf16x8*)(bp + (size_t)n * 16 * 1024 + 32 * (k0 + kk)); }
#pragma unroll
            for (int kk = 0; kk < 4; ++kk)
#pragma unroll
                for (int n = 0; n < 3; ++n) acc[n] = __builtin_amdgcn_mfma_f32_16x16x32_bf16(af[kk], bfr[kk][n], acc[n], 0, 0, 0);
        }
#pragma unroll
        for (int j = 0; j < 4; ++j) {
            const int m = m0 + 4 * g + j;
            const float rstd = rsqrtf(rs4[j] * (1.0f / 1024.0f) + NEPS);
#pragma unroll
            for (int n = 0; n < 3; ++n) SM[(size_t)m * 48 + 16 * n + r] = acc[n][j] * rstd + sw[j][n];
        }
    }
}
#define MFMA32(a, b, c) __builtin_amdgcn_mfma_f32_32x32x16_bf16((a), (b), (c), 0, 0, 0)
__device__ __forceinline__ int crow(int reg, int h) { return (reg & 3) + 8 * (reg >> 2) + 4 * h; }
__device__ __forceinline__ bf16x8 pack_step(const f32x16& x, int s) {
    v4u p; p.x = pk2(x[8 * s], x[8 * s + 1]); p.y = pk2(x[8 * s + 2], x[8 * s + 3]); p.z = pk2(x[8 * s + 4], x[8 * s + 5]); p.w = pk2(x[8 * s + 6], x[8 * s + 7]);
    return __builtin_bit_cast(bf16x8, p);
}
__device__ __forceinline__ bf16x8 frag_perm(const LAS unsigned char* img, int stride, int row, int col16, int h) {
    const LAS unsigned char* p = img + row * stride + (col16 + 4 * h) * 2;
    const s16x4 lo = *(const LAS s16x4*)p, hi = *(const LAS s16x4*)(p + 16);
    return __builtin_shufflevector(lo, hi, 0, 1, 2, 3, 4, 5, 6, 7);
}
__device__ __forceinline__ bf16x8 frag_nat(const LAS unsigned char* img, int stride, int row, int col16, int h) {
    const LAS unsigned char* p = img + row * stride + (col16 + 8 * h) * 2;
    const s16x4 lo = *(const LAS s16x4*)p, hi = *(const LAS s16x4*)(p + 8);
    return __builtin_shufflevector(lo, hi, 0, 1, 2, 3, 4, 5, 6, 7);
}
__device__ __forceinline__ void unpack8(const v4u w, float* f) {
    f[0] = bflo(w.x); f[1] = bfhi(w.x); f[2] = bflo(w.y); f[3] = bfhi(w.y); f[4] = bflo(w.z); f[5] = bfhi(w.z); f[6] = bflo(w.w); f[7] = bfhi(w.w);
}
__device__ __forceinline__ int chunk_first(int cid) { return cid < 256 ? ((cid & 31) == 0) : ((cid & 3) == 0); }
__device__ __forceinline__ int chunk_last(int cid) { return cid < 256 ? ((cid & 31) == 31) : ((cid & 3) == 3); }

constexpr int GP_Q = 0, GP_K = 16896, GP_RAW = 33792, GP_KK = 33792, GP_QK = 50432, GP_LP = 67584, GP_LPSZ = 8448, GP_GATE = 135168, GP_GSZ = 1536, GP_CW = 141312, GP_ST = 264;
__host__ __device__ constexpr int tri_off(int i) { return i == 0 ? 0 : (8 * ((i + 3) / 4) * (((i + 3) / 4) - 1) + 4 * ((i + 3) / 4) * ((i - 1) & 3)); }
__device__ __forceinline__ int tri_off_rt(int i) { const int q = (i + 3) >> 2; return i == 0 ? 0 : 8 * q * (q - 1) + 4 * q * ((i - 1) & 3); }
struct GdnPre { v4u rr[5]; float av, bv; };
__device__ __forceinline__ void gdn_prefetch(const Args& a, int l, int cid, int h, int tid_in, GdnPre& P) {
    int tid = tid_in; asm volatile("" : "+v"(tid));
    unsigned char* ws = a.ws; const LayerBufs B = layer_bufs(l);
    const bf16* GQ = (const bf16*)bufp(ws, a.out, B.GQ); const bf16* GK = (const bf16*)bufp(ws, a.out, B.GK); const bf16* GV = (const bf16*)bufp(ws, a.out, B.GV);
    const bf16* HALO = (const bf16*)(ws + WS_HALO);
    const int m0 = cid * 64, first = chunk_first(cid), last = chunk_last(cid), grp = tid >> 4, cg = tid & 15;
#pragma unroll
    for (int j = 0; j < 5; ++j) {
        const int p0 = tid + 512 * j, p = p0 < 2 * 66 * 16 ? p0 : 2 * 66 * 16 - 1;
        const int t = p / (66 * 16), rem = p % (66 * 16), r = rem >> 4, c = rem & 15;
        const bool zero = (r == 0 && first) || (r == 65 && last);
        const bf16* src = (r == 0 && !first) ? HALO + ((size_t)(cid - 1) * 2 + 1) * 1536 + t * 512 + h * 128 + 8 * c
                        : (r == 65 && !last) ? HALO + ((size_t)(cid + 1) * 2 + 0) * 1536 + t * 512 + h * 128 + 8 * c
                        : (t == 0 ? GQ : GK) + (size_t)(m0 + (r == 0 ? 0 : (r == 65 ? 63 : r - 1))) * 512 + h * 128 + 8 * c;
        const v4u v = *(const GAS v4u*)src;
        P.rr[j] = zero ? (v4u){0u, 0u, 0u, 0u} : v;
    }
    { const float* sm = (const float*)(ws + WS_SM) + (size_t)(m0 + (tid & 63)) * 48; P.av = sm[((tid >> 6) & 1) * 4 + h]; P.bv = sm[8 + ((tid >> 6) & 1) * 4 + h]; }
}
__device__ __forceinline__ void gdn_front1(const Args& a, LAS unsigned char* lds, int l, int cid, int h, int slot, int tid_in, const GdnPre& P, float alog, float dtb) {
    int tid = tid_in; asm volatile("" : "+v"(tid));
    unsigned char* ws = a.ws; const LayerBufs B = layer_bufs(l);
    bf16* GQ = (bf16*)bufp(ws, a.out, B.GQ); bf16* GK = (bf16*)bufp(ws, a.out, B.GK); bf16* GV = (bf16*)bufp(ws, a.out, B.GV);
    const int m0 = cid * 64, grp = tid >> 4, cg = tid & 15;
    LAS unsigned char* raw_s = lds + GP_RAW;
    LAS float* gt = (LAS float*)(lds + GP_GATE + slot * GP_GSZ);
    const bf16* HALO = (const bf16*)(ws + WS_HALO);
    const int first = chunk_first(cid), last = chunk_last(cid);
    v4u vraw[2][3];
#pragma unroll
    for (int j = 0; j < 2; ++j) {
        const int r = grp + 32 * j;
#pragma unroll
        for (int d = 0; d < 3; ++d) {
            const int rr2 = r - 1 + d;
            const bool zero = (rr2 < 0 && first) || (rr2 > 63 && last);
            const bf16* src = (rr2 < 0 && !first) ? HALO + ((size_t)(cid - 1) * 2 + 1) * 1536 + 1024 + h * 128 + 8 * cg
                            : (rr2 > 63 && !last) ? HALO + ((size_t)(cid + 1) * 2 + 0) * 1536 + 1024 + h * 128 + 8 * cg
                            : GV + (size_t)(m0 + (rr2 < 0 ? 0 : (rr2 > 63 ? 63 : rr2))) * 512 + h * 128 + 8 * cg;
            const v4u v = *(const GAS v4u*)src;
            vraw[j][d] = zero ? (v4u){0u, 0u, 0u, 0u} : v;
        }
    }
#pragma unroll
    for (int j = 0; j < 5; ++j) { const int p = tid + 512 * j; if (p < 2 * 66 * 16) *(LAS v4u*)(raw_s + p * 16) = P.rr[j]; }
    if (tid < 128) {
        const int dir = tid >> 6, i = tid & 63;
        const float gval = -__expf(alog) * softplus_f(P.av + dtb), bval = sigmoid_f(P.bv);
        float c = gval;
        if (dir == 0) {
#pragma unroll
            for (int o = 1; o < 64; o <<= 1) { const float u = __shfl_up(c, o); if (i >= o) c += u; }
        } else {
#pragma unroll
            for (int o = 1; o < 64; o <<= 1) { const float u = __shfl_down(c, o); if (i + o < 64) c += u; }
        }
        gt[dir * 64 + i] = gval; gt[128 + dir * 64 + i] = bval; gt[256 + dir * 64 + i] = c;
    }
    __syncthreads();
    const LAS float* cw = (const LAS float*)(lds + GP_CW);
#pragma unroll 1
    for (int t = 0; t < 3; ++t)
#pragma unroll
    for (int jj = 0; jj < 2; ++jj) {
        const int r = grp + 32 * jj;
        float x0[8], x1[8], x2[8], y[8];
        if (t < 2) {
            unpack8(*(const LAS v4u*)(raw_s + ((t * 66 + r) * 128 + 8 * cg) * 2), x0);
            unpack8(*(const LAS v4u*)(raw_s + ((t * 66 + r + 1) * 128 + 8 * cg) * 2), x1);
            unpack8(*(const LAS v4u*)(raw_s + ((t * 66 + r + 2) * 128 + 8 * cg) * 2), x2);
        } else { unpack8(vraw[jj][0], x0); unpack8(vraw[jj][1], x1); unpack8(vraw[jj][2], x2); }
        const LAS float* w0 = cw + t * 128 + 8 * cg;
        float ss = 0.f;
#pragma unroll
        for (int e = 0; e < 8; ++e) { const float c = x0[e] * w0[e] + x1[e] * w0[384 + e] + x2[e] * w0[768 + e]; y[e] = silu_f(c); ss += y[e] * y[e]; }
        ss += __shfl_xor(ss, 1); ss += __shfl_xor(ss, 2); ss += __shfl_xor(ss, 4); ss += __shfl_xor(ss, 8);
        float sc = 1.f;
        if (t == 0) sc = rsqrtf(ss + 1e-6f) * 0.08838834764831845f; else if (t == 1) sc = rsqrtf(ss + 1e-6f);
        v4u o; o.x = pk2(y[0] * sc, y[1] * sc); o.y = pk2(y[2] * sc, y[3] * sc); o.z = pk2(y[4] * sc, y[5] * sc); o.w = pk2(y[6] * sc, y[7] * sc);
        bf16* base = t == 0 ? GQ : (t == 1 ? GK : GV);
        *(GAS v4u*)(base + (size_t)(m0 + r) * 512 + h * 128 + 8 * cg) = o;
        if (t < 2) { LAS unsigned char* d = lds + (t == 0 ? GP_Q : GP_K) + r * GP_ST + 16 * cg; *(LAS v2u*)d = (v2u){o.x, o.y}; *(LAS v2u*)(d + 8) = (v2u){o.z, o.w}; }
    }
}
__device__ __forceinline__ void gdn_front2(const Args& a, LAS unsigned char* lds, int l, int cid, int h, int slot, int tid_in, int wave_in, int lane_in) {
    int tid = tid_in; asm volatile("" : "+v"(tid));
    const int lane = tid & 63, wave = __builtin_amdgcn_readfirstlane(tid >> 6);
    unsigned char* ws = a.ws; const LayerBufs B = layer_bufs(l);
    LAS float* gt = (LAS float*)(lds + GP_GATE + slot * GP_GSZ);
    __syncthreads();
    {
        const int which = wave >> 2, ti = (wave >> 1) & 1, tj = wave & 1, r = lane & 31, hh = lane >> 5;
        f32x16 acc; for (int i = 0; i < 16; ++i) acc[i] = 0.f;
        const LAS unsigned char* Ai = lds + (which ? GP_Q : GP_K); const LAS unsigned char* Bi = lds + GP_K;
#pragma unroll
        for (int s2 = 0; s2 < 8; ++s2) acc = MFMA32(frag_nat(Ai, GP_ST, 32 * ti + r, 16 * s2, hh), frag_nat(Bi, GP_ST, 32 * tj + r, 16 * s2, hh), acc);
        LAS float* dst = (LAS float*)(lds + (which ? GP_QK : GP_KK));
#pragma unroll
        for (int i = 0; i < 16; ++i) dst[(32 * ti + crow(i, hh)) * 65 + 32 * tj + r] = acc[i];
    }
    __syncthreads();
    {
        const LAS float* KK = (const LAS float*)(lds + GP_KK); const LAS float* QK = (const LAS float*)(lds + GP_QK);
        bf16* GTA = (bf16*)bufp(ws, a.out, B.GTA);
#pragma unroll 2
        for (int it = 0; it < 16; ++it) {
            const int p = tid + 512 * it;
            const int dir = p >> 12, ip = (p >> 6) & 63, jp = p & 63;
            const int i = dir ? 63 - ip : ip, j = dir ? 63 - jp : jp;
            if (jp < ip) {
                const float lv = gt[128 + dir * 64 + i] * KK[i * 65 + j] * __expf(gt[256 + dir * 64 + i] - gt[256 + dir * 64 + j]);
                ((LAS float*)(lds + GP_LP + (slot * 2 + dir) * GP_LPSZ))[tri_off_rt(ip) + jp] = lv;
            }
            const bool keep = dir ? (jp >= ip) : (jp <= ip);
            const float av = keep ? QK[ip * 65 + jp] * __expf(gt[256 + dir * 64 + ip] - gt[256 + dir * 64 + jp]) : 0.f;
            GTA[(((size_t)dir * NCHUNK + cid) * 4 + h) * 8192 + ip * 128 + 64 + jp] = (bf16)(pk2(av, 0.f) & 0xffffu);
        }
        if (tid < 128) {
            const int dir = tid >> 6, i = tid & 63;
            float* E = (float*)(ws + WS_GDEC);
            const float gc = gt[256 + dir * 64 + i], gl = gt[256 + dir * 64 + (dir ? 0 : 63)];
            E[(((size_t)dir * NCHUNK + cid) * 4 + h) * 64 + i] = __expf(gc);
            E[(size_t)2 * NCHUNK * 4 * 64 + (((size_t)dir * NCHUNK + cid) * 4 + h) * 64 + i] = __expf(gl - gc);
            if (i == 0) E[(size_t)4 * NCHUNK * 4 * 64 + ((size_t)dir * NCHUNK + cid) * 4 + h] = __expf(gl);
        }
    }
    __syncthreads();
}
__device__ __forceinline__ void gdn_prep_invert(LAS unsigned char* lds, int slot, int dir, int wave, int lane_in) {
    int lane = lane_in; asm volatile("" : "+v"(lane));
    LAS float* Lp = (LAS float*)(lds + GP_LP + (slot * 2 + dir) * GP_LPSZ);
    LAS float* Td = (LAS float*)(lds + wave * 8192);
    const int blk = lane >> 5, c = lane & 31;
    float t[32];
#pragma unroll
    for (int i = 0; i < 32; ++i) {
        f32x4 bA[8];
        const LAS float* rowp = Lp + (blk ? tri_off(32 + i) + 32 : tri_off(i));
#pragma unroll
        for (int q = 0; q < (i + 3) / 4; ++q) bA[q] = *(const LAS f32x4*)(rowp + 4 * q);
        float a0 = (c == i) ? 1.f : 0.f, a1 = 0.f, a2 = 0.f, a3 = 0.f;
#pragma unroll
        for (int q = 0; q < (i + 3) / 4; ++q) {
            a0 -= bA[q][0] * t[4 * q];
            if (4 * q + 1 < i) a1 -= bA[q][1] * t[4 * q + 1];
            if (4 * q + 2 < i) a2 -= bA[q][2] * t[4 * q + 2];
            if (4 * q + 3 < i) a3 -= bA[q][3] * t[4 * q + 3];
        }
        t[i] = (a0 + a1) + (a2 + a3);
        Td[blk * 1024 + i * 32 + c] = t[i];
        if (c < i) Lp[(blk ? tri_off(32 + i) + 32 : tri_off(i)) + c] = t[i];
        asm volatile("" ::: "memory");
    }
    f32x16 X; for (int r = 0; r < 16; ++r) X[r] = 0.f;
    const LAS float* l21 = Lp + tri_off_rt(32 + c) + blk;
#pragma unroll
    for (int s2 = 0; s2 < 16; ++s2) X = __builtin_amdgcn_mfma_f32_32x32x2f32(l21[2 * s2], Td[(2 * s2 + blk) * 32 + c], X, 0, 0, 0);
    f32x16 Y; for (int r = 0; r < 16; ++r) Y[r] = 0.f;
#pragma unroll
    for (int s2 = 0; s2 < 16; ++s2) Y = __builtin_amdgcn_mfma_f32_32x32x2f32(Td[1024 + c * 32 + crow(s2, blk)], X[s2], Y, 0, 0, 0);
#pragma unroll
    for (int r = 0; r < 16; ++r) Lp[tri_off_rt(32 + crow(r, blk)) + c] = -Y[r];
}
__device__ __forceinline__ void gdn_prep_tb_store(const Args& a, LAS unsigned char* lds, int l, int vcu, int G, int j0, int nb, int tid_in) {
    int tid = tid_in; asm volatile("" : "+v"(tid));
    const LayerBufs B = layer_bufs(l);
    bf16* GTA = (bf16*)bufp(a.ws, a.out, B.GTA);
#pragma unroll 2
    for (int p = tid; p < nb * 2 * 64 * 8; p += 512) {
        const int pc = p & 7, io = (p >> 3) & 63, dir = (p >> 9) & 1, slot = p >> 10;
        const int it = vcu + G * (j0 + slot), cid = it >> 2, h = it & 3;
        const LAS float* Lp = (const LAS float*)(lds + GP_LP + (slot * 2 + dir) * GP_LPSZ);
        const LAS float* gt = (const LAS float*)(lds + GP_GATE + slot * GP_GSZ);
        const int ip = dir ? 63 - io : io, off = tri_off_rt(ip);
        float v[8];
#pragma unroll
        for (int e = 0; e < 8; ++e) {
            const int jo = 8 * pc + e, jp = dir ? 63 - jo : jo;
            const float tv = jp < ip ? Lp[off + jp] : (jp == ip ? 1.f : 0.f);
            v[e] = tv * gt[128 + dir * 64 + jo];
        }
        v4u o; o.x = pk2(v[0], v[1]); o.y = pk2(v[2], v[3]); o.z = pk2(v[4], v[5]); o.w = pk2(v[6], v[7]);
        *(GAS v4u*)(GTA + (((size_t)dir * NCHUNK + cid) * 4 + h) * 8192 + io * 128 + 8 * pc) = o;
    }
}

constexpr int LP_GK = 0, LP_QG = 33280, LP_KI = 51712, LP_LR = 70144, LP_W = 78336, LP_B = 86528, LP_GL = 87040, LP_QR = 87552, LP_KR = 95744, LP_ST = 144;
struct GlaPre { float lrv[4]; v4u qv, kv; };
__device__ __forceinline__ void gla_prefetch(const Args& a, int l, int cid, int h, int tid_in, GlaPre& P) {
    int tid = tid_in; asm volatile("" : "+v"(tid));
    unsigned char* ws = a.ws; const LayerBufs B = layer_bufs(l);
    const int m0 = cid * 64;
#pragma unroll
    for (int j = 0; j < 4; ++j) { const int p = tid + 512 * j; P.lrv[j] = ((const float*)(ws + WS_SM))[(size_t)(m0 + (p >> 5)) * 48 + 16 + (p & 31)]; }
    const bf16* LQ = (const bf16*)bufp(ws, a.out, B.LQ); const bf16* LK = (const bf16*)bufp(ws, a.out, B.LK);
    const int i = tid >> 3, c8 = tid & 7;
    P.qv = *(const GAS v4u*)(LQ + (size_t)(m0 + i) * 256 + h * 64 + 8 * c8); P.kv = *(const GAS v4u*)(LK + (size_t)(m0 + i) * 256 + h * 64 + 8 * c8);
}
__device__ __forceinline__ void gla_prep_unit(const Args& a, LAS unsigned char* lds, int l, int cid, int h, int tid_in, const GlaPre& P) {
    int tid = tid_in; asm volatile("" : "+v"(tid));
    const int lane = tid & 63, wave = __builtin_amdgcn_readfirstlane(tid >> 6);
    unsigned char* ws = a.ws; const LayerBufs B = layer_bufs(l);
    LAS float* gk = (LAS float*)(lds + LP_GK); LAS float* lr = (LAS float*)(lds + LP_LR); const LAS float* Wv = (const LAS float*)(lds + LP_W); const LAS float* bs = (const LAS float*)(lds + LP_B); LAS float* gl = (LAS float*)(lds + LP_GL);
    {
#pragma unroll
        for (int j = 0; j < 4; ++j) lr[tid + 512 * j] = P.lrv[j];
        const int i = tid >> 3, c8 = tid & 7;
        *(LAS v4u*)(lds + LP_QR + i * 128 + 16 * c8) = P.qv; *(LAS v4u*)(lds + LP_KR + i * 128 + 16 * c8) = P.kv;
    }
    __syncthreads();
    {
        const int dir = wave >> 2, ti = (wave >> 1) & 1, tj = wave & 1, r = lane & 31, hh = lane >> 5;
        f32x16 acc; for (int i = 0; i < 16; ++i) acc[i] = 0.f;
#pragma unroll
        for (int s2 = 0; s2 < 8; ++s2) acc = __builtin_amdgcn_mfma_f32_32x32x2f32(lr[(32 * ti + r) * 32 + dir * 16 + 2 * s2 + hh], Wv[(dir * 16 + 2 * s2 + hh) * 64 + 32 * tj + r], acc, 0, 0, 0);
        const float bc = bs[dir * 64 + 32 * tj + r];
#pragma unroll
        for (int i = 0; i < 16; ++i) gk[(dir * 64 + 32 * ti + crow(i, hh)) * 65 + 32 * tj + r] = -softplus_f(-(acc[i] + bc)) * (1.0f / 16.0f);
    }
    __syncthreads();
    if (tid < 128) {
        const int dir = tid >> 6, c = tid & 63;
        float s = 0.f;
#pragma unroll 1
        for (int i0 = 0; i0 < 64; i0 += 8) {
            float v[8];
#pragma unroll
            for (int e = 0; e < 8; ++e) { const int i = dir ? 63 - (i0 + e) : i0 + e; v[e] = gk[(dir * 64 + i) * 65 + c]; }
#pragma unroll
            for (int e = 0; e < 8; ++e) { const int i = dir ? 63 - (i0 + e) : i0 + e; s += v[e]; gk[(dir * 64 + i) * 65 + c] = s; }
        }
        gl[dir * 64 + c] = s;
        ((float*)(ws + WS_LDEC))[(((size_t)dir * NCHUNK + cid) * 4 + h) * 64 + c] = __expf(s);
    }
    __syncthreads();
    {
#pragma unroll 1
        for (int it = 0; it < 2; ++it) {
            const int p = tid + 512 * it, dir = p >> 9, i = (p >> 3) & 63, c8 = p & 7;
            float q[8], k[8];
            unpack8(*(const LAS v4u*)(lds + LP_QR + i * 128 + 16 * c8), q); unpack8(*(const LAS v4u*)(lds + LP_KR + i * 128 + 16 * c8), k);
            float qg[8], ki[8];
#pragma unroll
            for (int e = 0; e < 8; ++e) { const float gc = gk[(dir * 64 + i) * 65 + 8 * c8 + e]; qg[e] = q[e] * 0.125f * __expf(gc); ki[e] = k[e] * __expf(-gc); }
            v4u oq, ok; oq.x = pk2(qg[0], qg[1]); oq.y = pk2(qg[2], qg[3]); oq.z = pk2(qg[4], qg[5]); oq.w = pk2(qg[6], qg[7]);
            ok.x = pk2(ki[0], ki[1]); ok.y = pk2(ki[2], ki[3]); ok.z = pk2(ki[4], ki[5]); ok.w = pk2(ki[6], ki[7]);
            *(LAS v4u*)(lds + LP_QG + dir * 9216 + i * LP_ST + 16 * c8) = oq; *(LAS v4u*)(lds + LP_KI + dir * 9216 + i * LP_ST + 16 * c8) = ok;
            bf16* blk = (bf16*)bufp(ws, a.out, dir ? B.LOP1 : B.LOP0) + ((size_t)cid * 4 + h) * 12288;
            *(GAS v4u*)(blk + i * 64 + 8 * c8) = oq;
        }
#pragma unroll 1
        for (int it = 0; it < 2; ++it) {
            const int p = tid + 512 * it, dir = p >> 9, c = (p >> 3) & 63, ig = p & 7;
            const float glc = gl[dir * 64 + c];
            float kd[8];
#pragma unroll
            for (int e = 0; e < 8; ++e) { const int i = 8 * ig + e; kd[e] = bf2f(*(const LAS bf16*)(lds + LP_KR + i * 128 + 2 * c)) * __expf(glc - gk[(dir * 64 + i) * 65 + c]); }
            v4u o; o.x = pk2(kd[0], kd[1]); o.y = pk2(kd[2], kd[3]); o.z = pk2(kd[4], kd[5]); o.w = pk2(kd[6], kd[7]);
            bf16* blk = (bf16*)bufp(ws, a.out, dir ? B.LOP1 : B.LOP0) + ((size_t)cid * 4 + h) * 12288;
            *(GAS v4u*)(blk + 4096 + c * 64 + 8 * ig) = o;
        }
    }
    __syncthreads();
    {
        const int dir = wave >> 2, ti = (wave >> 1) & 1, tj = wave & 1, r = lane & 31, hh = lane >> 5;
        f32x16 acc; for (int i = 0; i < 16; ++i) acc[i] = 0.f;
        const LAS unsigned char* Ai = lds + LP_QG + dir * 9216; const LAS unsigned char* Bi = lds + LP_KI + dir * 9216;
#pragma unroll
        for (int s2 = 0; s2 < 4; ++s2) acc = MFMA32(frag_nat(Ai, LP_ST, 32 * ti + r, 16 * s2, hh), frag_nat(Bi, LP_ST, 32 * tj + r, 16 * s2, hh), acc);
        bf16* blk = (bf16*)bufp(ws, a.out, dir ? B.LOP1 : B.LOP0) + ((size_t)cid * 4 + h) * 12288 + 8192;
#pragma unroll
        for (int i = 0; i < 16; ++i) {
            const int io = 32 * ti + crow(i, hh), jo = 32 * tj + r;
            const bool keep = dir ? (jo >= io) : (jo <= io);
            blk[io * 64 + jo] = (bf16)(pk2(keep ? acc[i] : 0.f, 0.f) & 0xffffu);
        }
    }
    __syncthreads();
}

__device__ __forceinline__ void phase_prep(const Args& a, LAS unsigned char* lds, int l, int vcu, int G, int tid_in, int wave_in, int lane_in) {
    int tid = tid_in; asm volatile("" : "+v"(tid));
    const int lane = tid & 63, wave = __builtin_amdgcn_readfirstlane(tid >> 6);
    const int NU = NCHUNK * 4;
    {
        const int h0 = vcu & 3;
        for (int p = tid; p < 9 * 128; p += 512) { const int tap = p / 384, t = (p / 128) % 3, c = p & 127; ((LAS float*)(lds + GP_CW))[p] = a.in[I_GCONV][((size_t)l * 3 + tap) * 1536 + t * 512 + h0 * 128 + c]; }
        float alog = 0.f, dtb = 0.f;
        if (tid < 128) { alog = a.in[I_ALOG][l * 8 + (tid >> 6) * 4 + h0]; dtb = a.in[I_DTB][l * 8 + (tid >> 6) * 4 + h0]; }
        GdnPre P;
        if (vcu < NU) gdn_prefetch(a, l, vcu >> 2, vcu & 3, tid, P);
        __syncthreads();
#pragma unroll 1
        for (int j0 = 0; vcu + G * j0 < NU; j0 += 4) {
            int nb = 0;
#pragma unroll 1
            for (int j = 0; j < 4; ++j) {
                const int it = vcu + G * (j0 + j);
                if (it < NU) {
                    gdn_front1(a, lds, l, it >> 2, it & 3, j, tid, P, alog, dtb);
                    if (it + G < NU) gdn_prefetch(a, l, (it + G) >> 2, (it + G) & 3, tid, P);
                    gdn_front2(a, lds, l, it >> 2, it & 3, j, tid, wave, lane);
                    nb = j + 1;
                }
            }
            const int slot = wave >> 1, dir = wave & 1;
            if (slot < nb) gdn_prep_invert(lds, slot, dir, wave, lane);
            __syncthreads();
            gdn_prep_tb_store(a, lds, l, vcu, G, j0, nb, tid);
            __syncthreads();
        }
    }
    {
        const int vg = (vcu + (G & ~7) / 2) % G;
        const int h0 = vg & 3;
        for (int p = tid; p < 2 * 16 * 64; p += 512) { const int dir = p >> 10, rk = (p >> 6) & 15, c = p & 63; ((LAS float*)(lds + LP_W))[p] = a.in[I_WGK][(((size_t)l * 2 + dir) * 16 + rk) * 256 + h0 * 64 + c]; }
        if (tid < 128) ((LAS float*)(lds + LP_B))[tid] = a.in[I_BGK][((size_t)l * 2 + (tid >> 6)) * 256 + h0 * 64 + (tid & 63)];
        GlaPre P;
        if (vg < NU) gla_prefetch(a, l, vg >> 2, vg & 3, tid, P);
#pragma unroll 1
        for (int it = vg; it < NU; it += G) {
            GlaPre Pc = P;
            if (it + G < NU) gla_prefetch(a, l, (it + G) >> 2, (it + G) & 3, tid, P);
            gla_prep_unit(a, lds, l, it >> 2, it & 3, tid, Pc);
        }
    }
}

__device__ __forceinline__ int chain_cid(int b, int dir, int step) {
    if (step < 4) return 256 + 4 * b + (dir ? 3 - step : step);
    const int n = step - 4; return 32 * b + (dir ? 31 - n : n);
}
typedef short v4i16_t __attribute__((ext_vector_type(4)));
__device__ __forceinline__ s16x4 tr4(const LAS unsigned char* img, int stride, int row0, int col0, int lane) {
    const int i16 = lane & 15;
    const LAS unsigned char* p = img + (row0 + (i16 >> 2)) * stride + (col0 + 4 * (i16 & 3)) * 2;
    return __builtin_bit_cast(s16x4, __builtin_amdgcn_ds_read_tr16_b64_v4i16((LAS v4i16_t*)p));
}
__device__ __forceinline__ bf16x8 tr8(const LAS unsigned char* img, int stride, int row0, int row1, int col0, int lane) {
    const s16x4 lo = tr4(img, stride, row0, col0, lane), hi = tr4(img, stride, row1, col0, lane);
    return __builtin_shufflevector(lo, hi, 0, 1, 2, 3, 4, 5, 6, 7);
}
constexpr int GS_K = 0, GS_Q = 16896, GS_K2 = 33792, GS_V = 54272, GS_TB = 74752, GS_AT = 83456, GS_E1 = 92160, GS_E2 = 92416, GS_E3 = 92672;
struct GdnLoad { v4u q[4], k[4], v[4], t[4]; float e1, e2, e3; };
__device__ __forceinline__ void gdn_issue(const bf16* GQ, const bf16* GK, const bf16* GV, const bf16* GTA, const float* E, int cid, int h, int dir, int lt, GdnLoad& L) {
    const bf16* ta = GTA + (((size_t)dir * NCHUNK + cid) * 4 + h) * 8192;
#pragma unroll
    for (int q = 0; q < 4; ++q) {
        const int p = lt + 256 * q, row = p >> 4, cg = p & 15;
        const size_t mo = ((size_t)cid * 64 + row) * 512 + h * 128 + 8 * cg;
        L.q[q] = *(const GAS v4u*)(GQ + mo); L.k[q] = *(const GAS v4u*)(GK + mo); L.v[q] = *(const GAS v4u*)(GV + mo);
        L.t[q] = *(const GAS v4u*)(ta + p * 8);
    }
    { const size_t eo = (((size_t)dir * NCHUNK + cid) * 4 + h) * 64 + (lt & 63); L.e1 = E[eo]; L.e2 = E[(size_t)2 * NCHUNK * 4 * 64 + eo];
      L.e3 = E[(size_t)4 * NCHUNK * 4 * 64 + ((size_t)dir * NCHUNK + cid) * 4 + h]; }
}
__device__ __forceinline__ void gdn_write(LAS unsigned char* lds, int lt, const GdnLoad& L) {
#pragma unroll
    for (int q = 0; q < 4; ++q) {
        const int p = lt + 256 * q, row = p >> 4, cg = p & 15;
        LAS unsigned char* d = lds + GS_Q + row * 264 + 16 * cg; *(LAS v2u*)d = (v2u){L.q[q].x, L.q[q].y}; *(LAS v2u*)(d + 8) = (v2u){L.q[q].z, L.q[q].w};
        d = lds + GS_K + row * 264 + 16 * cg; *(LAS v2u*)d = (v2u){L.k[q].x, L.k[q].y}; *(LAS v2u*)(d + 8) = (v2u){L.k[q].z, L.k[q].w};
        *(LAS v4u*)(lds + GS_K2 + row * 320 + 16 * cg) = L.k[q];
        *(LAS v4u*)(lds + GS_V + row * 320 + 16 * cg) = L.v[q];
        d = lds + (cg < 8 ? GS_TB + row * 136 + 16 * cg : GS_AT + row * 136 + 16 * (cg - 8)); *(LAS v2u*)d = (v2u){L.t[q].x, L.t[q].y}; *(LAS v2u*)(d + 8) = (v2u){L.t[q].z, L.t[q].w};
    }
    if (lt < 64) { ((LAS float*)(lds + GS_E1))[lt] = L.e1; ((LAS float*)(lds + GS_E2))[lt] = L.e2; if (lt == 0) ((LAS float*)(lds + GS_E3))[0] = L.e3; }
}
__device__ __forceinline__ void gdn_scan_chain(const Args& a, LAS unsigned char* lds, int l, int b, int h, int dir, int tid_in, int wave_in, int lane_in) {
    int tid = tid_in; asm volatile("" : "+v"(tid));
    const int lane = tid & 63, wave = __builtin_amdgcn_readfirstlane(tid >> 6);
    unsigned char* ws = a.ws; const LayerBufs B = layer_bufs(l);
    const bf16* GQ = (const bf16*)bufp(ws, a.out, B.GQ); const bf16* GK = (const bf16*)bufp(ws, a.out, B.GK); const bf16* GV = (const bf16*)bufp(ws, a.out, B.GV);
    bf16* GTA = (bf16*)bufp(ws, a.out, B.GTA);
    const float* E = (const float*)(ws + WS_GDEC);
    __syncthreads();
    if (wave >= 4) {
        const int lt = tid - 256;
        GdnLoad LA, LB;
        gdn_issue(GQ, GK, GV, GTA, E, chain_cid(b, dir, 0), h, dir, lt, LA); gdn_write(lds, lt, LA);
        gdn_issue(GQ, GK, GV, GTA, E, chain_cid(b, dir, 1), h, dir, lt, LA);
        __syncthreads();
#pragma unroll 1
        for (int step = 0; step < 36; step += 2) {
            if (step + 2 < 36) gdn_issue(GQ, GK, GV, GTA, E, chain_cid(b, dir, step + 2), h, dir, lt, LB);
            __syncthreads();
            gdn_write(lds, lt, LA);
            __syncthreads();
            if (step + 3 < 36) gdn_issue(GQ, GK, GV, GTA, E, chain_cid(b, dir, step + 3), h, dir, lt, LA);
            __syncthreads();
            if (step + 2 < 36) gdn_write(lds, lt, LB);
            __syncthreads();
        }
    } else {
        const int r = lane & 31, hh = lane >> 5, w = wave, cb16 = ((lane >> 4) & 1) * 16;
        f32x16 S[4];
#pragma unroll
        for (int mt = 0; mt < 4; ++mt) for (int i = 0; i < 16; ++i) S[mt][i] = 0.f;
        __syncthreads();
#pragma unroll 1
        for (int step = 0; step < 36; ++step) {
            const int cid = chain_cid(b, dir, step);
            const LAS float* e1s = (const LAS float*)(lds + GS_E1); const LAS float* e2s = (const LAS float*)(lds + GS_E2);
            const float e3 = ((const LAS float*)(lds + GS_E3))[0];
            f32x16 Z[2], Q[2];
#pragma unroll
            for (int it = 0; it < 2; ++it) for (int i = 0; i < 16; ++i) { Z[it][i] = 0.f; Q[it][i] = 0.f; }
#pragma unroll
            for (int mt = 0; mt < 4; ++mt)
#pragma unroll
                for (int s = 0; s < 2; ++s) {
                    const bf16x8 sb = pack_step(S[mt], s);
#pragma unroll
                    for (int it = 0; it < 2; ++it) {
                        Z[it] = MFMA32(frag_perm(lds + GS_K, 264, 32 * it + r, 32 * mt + 16 * s, hh), sb, Z[it]);
                        Q[it] = MFMA32(frag_perm(lds + GS_Q, 264, 32 * it + r, 32 * mt + 16 * s, hh), sb, Q[it]);
                    }
                }
#pragma unroll
            for (int it = 0; it < 2; ++it)
#pragma unroll
                for (int g = 0; g < 4; ++g) {
                    const f32x4 ev = *(const LAS f32x4*)(e1s + 32 * it + 8 * g + 4 * hh);
                    const s16x4 vv = tr4(lds + GS_V, 320, 32 * it + 8 * g + 4 * hh, 32 * w + cb16, lane);
#pragma unroll
                    for (int x = 0; x < 4; ++x) { Z[it][4 * g + x] = bf2f((bf16)vv[x]) - ev[x] * Z[it][4 * g + x]; Q[it][4 * g + x] *= ev[x]; }
                }
            f32x16 Vn[2];
#pragma unroll
            for (int it = 0; it < 2; ++it) for (int i = 0; i < 16; ++i) Vn[it][i] = 0.f;
#pragma unroll
            for (int kt = 0; kt < 2; ++kt)
#pragma unroll
                for (int s = 0; s < 2; ++s) {
                    const bf16x8 rb = pack_step(Z[kt], s);
#pragma unroll
                    for (int it = 0; it < 2; ++it) Vn[it] = MFMA32(frag_perm(lds + GS_TB, 136, 32 * it + r, 32 * kt + 16 * s, hh), rb, Vn[it]);
                }
#pragma unroll
            for (int kt = 0; kt < 2; ++kt)
#pragma unroll
                for (int s = 0; s < 2; ++s) {
                    const bf16x8 vb = pack_step(Vn[kt], s);
#pragma unroll
                    for (int it = 0; it < 2; ++it) Q[it] = MFMA32(frag_perm(lds + GS_AT, 136, 32 * it + r, 32 * kt + 16 * s, hh), vb, Q[it]);
                }
            {
                bf16* ob = GTA + (((size_t)dir * NCHUNK + cid) * 4 + h) * 8192 + 32 * w + r;
#pragma unroll
                for (int it = 0; it < 2; ++it)
#pragma unroll
                    for (int i = 0; i < 16; ++i) ob[(32 * it + crow(i, hh)) * 128] = (bf16)(pk2(Q[it][i], 0.f) & 0xffffu);
            }
#pragma unroll
            for (int it = 0; it < 2; ++it)
#pragma unroll
                for (int g = 0; g < 4; ++g) {
                    const f32x4 ev = *(const LAS f32x4*)(e2s + 32 * it + 8 * g + 4 * hh);
                    Vn[it][4 * g] *= ev[0]; Vn[it][4 * g + 1] *= ev[1]; Vn[it][4 * g + 2] *= ev[2]; Vn[it][4 * g + 3] *= ev[3];
                }
#pragma unroll
            for (int mt = 0; mt < 4; ++mt) for (int i = 0; i < 16; ++i) S[mt][i] *= e3;
#pragma unroll
            for (int kt = 0; kt < 2; ++kt)
#pragma unroll
                for (int s = 0; s < 2; ++s) {
                    const bf16x8 vb = pack_step(Vn[kt], s);
                    const int T0 = 32 * kt + 16 * s + 4 * hh;
#pragma unroll
                    for (int mt = 0; mt < 4; ++mt) S[mt] = MFMA32(tr8(lds + GS_K2, 320, T0, T0 + 8, 32 * mt + cb16, lane), vb, S[mt]);
                }
            __syncthreads();
            __syncthreads();
        }
    }
}

constexpr int LS_QG = 0, LS_KD = 8704, LS_AT = 17408, LS_V = 26112, LS_E3 = 46592;
struct GlaLoad { v4u o[6], v[4]; float e3; };
__device__ __forceinline__ void gla_issue(const bf16* LOP, const bf16* LV, const float* E, int cid, int h, int dir, int lt, GlaLoad& L) {
    const bf16* blk = LOP + ((size_t)cid * 4 + h) * 12288;
#pragma unroll
    for (int q = 0; q < 6; ++q) L.o[q] = *(const GAS v4u*)(blk + (lt + 256 * q) * 8);
#pragma unroll
    for (int q = 0; q < 4; ++q) { const int p = lt + 256 * q; L.v[q] = *(const GAS v4u*)(LV + ((size_t)cid * 64 + (p >> 4)) * 512 + h * 128 + 8 * (p & 15)); }
    L.e3 = E[(((size_t)dir * NCHUNK + cid) * 4 + h) * 64 + (lt & 63)];
}
__device__ __forceinline__ void gla_write(LAS unsigned char* lds, int lt, const GlaLoad& L) {
#pragma unroll
    for (int q = 0; q < 6; ++q) { const int p = lt + 256 * q, mat = p >> 9, row = (p >> 3) & 63, cg = p & 7;
        LAS unsigned char* d = lds + mat * 8704 + row * 136 + 16 * cg; *(LAS v2u*)d = (v2u){L.o[q].x, L.o[q].y}; *(LAS v2u*)(d + 8) = (v2u){L.o[q].z, L.o[q].w}; }
#pragma unroll
    for (int q = 0; q < 4; ++q) { const int p = lt + 256 * q; *(LAS v4u*)(lds + LS_V + (p >> 4) * 320 + 16 * (p & 15)) = L.v[q]; }
    if (lt < 64) ((LAS float*)(lds + LS_E3))[lt] = L.e3;
}
__device__ __forceinline__ void gla_scan_chain(const Args& a, LAS unsigned char* lds, int l, int b, int h, int dir, int tid_in, int wave_in, int lane_in) {
    int tid = tid_in; asm volatile("" : "+v"(tid));
    const int lane = tid & 63, wave = __builtin_amdgcn_readfirstlane(tid >> 6);
    unsigned char* ws = a.ws; const LayerBufs B = layer_bufs(l);
    bf16* LOP = (bf16*)bufp(ws, a.out, dir ? B.LOP1 : B.LOP0);
    const bf16* LV = (const bf16*)bufp(ws, a.out, B.LV);
    const float* E = (const float*)(ws + WS_LDEC);
    __syncthreads();
    if (wave >= 4) {
        const int lt = tid - 256;
        GlaLoad LA, LB;
        gla_issue(LOP, LV, E, chain_cid(b, dir, 0), h, dir, lt, LA); gla_write(lds, lt, LA);
        gla_issue(LOP, LV, E, chain_cid(b, dir, 1), h, dir, lt, LA);
        __syncthreads();
#pragma unroll 1
        for (int step = 0; step < 36; step += 2) {
            if (step + 2 < 36) gla_issue(LOP, LV, E, chain_cid(b, dir, step + 2), h, dir, lt, LB);
            __syncthreads();
            gla_write(lds, lt, LA);
            __syncthreads();
            if (step + 3 < 36) gla_issue(LOP, LV, E, chain_cid(b, dir, step + 3), h, dir, lt, LA);
            __syncthreads();
            if (step + 2 < 36) gla_write(lds, lt, LB);
            __syncthreads();
        }
    } else {
        const int r = lane & 31, hh = lane >> 5, w = wave, cb16 = ((lane >> 4) & 1) * 16;
        f32x16 S[2];
#pragma unroll
        for (int mt = 0; mt < 2; ++mt) for (int i = 0; i < 16; ++i) S[mt][i] = 0.f;
        __syncthreads();
#pragma unroll 1
        for (int step = 0; step < 36; ++step) {
            const int cid = chain_cid(b, dir, step);
            const LAS float* e3s = (const LAS float*)(lds + LS_E3);
            f32x16 O[2];
#pragma unroll
            for (int it = 0; it < 2; ++it) for (int i = 0; i < 16; ++i) O[it][i] = 0.f;
#pragma unroll
            for (int mt = 0; mt < 2; ++mt)
#pragma unroll
                for (int s = 0; s < 2; ++s) {
                    const bf16x8 sb = pack_step(S[mt], s);
#pragma unroll
                    for (int it = 0; it < 2; ++it) O[it] = MFMA32(frag_perm(lds + LS_QG, 136, 32 * it + r, 32 * mt + 16 * s, hh), sb, O[it]);
                }
#pragma unroll
            for (int mt = 0; mt < 2; ++mt)
#pragma unroll
                for (int g = 0; g < 4; ++g) {
                    const f32x4 ev = *(const LAS f32x4*)(e3s + 32 * mt + 8 * g + 4 * hh);
                    S[mt][4 * g] *= ev[0]; S[mt][4 * g + 1] *= ev[1]; S[mt][4 * g + 2] *= ev[2]; S[mt][4 * g + 3] *= ev[3];
                }
#pragma unroll
            for (int kt = 0; kt < 2; ++kt)
#pragma unroll
                for (int s = 0; s < 2; ++s) {
                    const int T0 = 32 * kt + 16 * s + 8 * hh;
                    const bf16x8 vb = tr8(lds + LS_V, 320, T0, T0 + 4, 32 * w + cb16, lane);
#pragma unroll
                    for (int it = 0; it < 2; ++it) O[it] = MFMA32(frag_nat(lds + LS_AT, 136, 32 * it + r, 32 * kt + 16 * s, hh), vb, O[it]);
#pragma unroll
                    for (int mt = 0; mt < 2; ++mt) S[mt] = MFMA32(frag_nat(lds + LS_KD, 136, 32 * mt + r, 32 * kt + 16 * s, hh), vb, S[mt]);
                }
            bf16* ob = LOP + ((size_t)cid * 4 + h) * 12288 + 32 * w + r;
#pragma unroll
            for (int it = 0; it < 2; ++it)
#pragma unroll
                for (int i = 0; i < 16; ++i) ob[(32 * it + crow(i, hh)) * 128] = (bf16)(pk2(O[it][i], 0.f) & 0xffffu);
            __syncthreads();
            __syncthreads();
        }
    }
}

__device__ __forceinline__ void phase_scan(const Args& a, LAS unsigned char* lds, int l, int vcu, int G, int tid, int wave, int lane) {
    for (int ch = vcu; ch < 128; ch += G) {
        const int dir = ch & 1, h = (ch >> 1) & 3, b = (ch >> 3) & 7;
        if (ch < 64) gdn_scan_chain(a, lds, l, b, h, dir, tid, wave, lane);
        else gla_scan_chain(a, lds, l, b, h, dir, tid, wave, lane);
    }
}

__device__ __forceinline__ void phase_merge(const Args& a, int l, int gw, int NGW, int lane) {
    unsigned char* ws = a.ws; const LayerBufs B = layer_bufs(l);
    const bf16* GTA = (const bf16*)bufp(ws, a.out, B.GTA); const bf16* L0 = (const bf16*)bufp(ws, a.out, B.LOP0); const bf16* L1 = (const bf16*)bufp(ws, a.out, B.LOP1);
    const bf16* ZA = (const bf16*)bufp(ws, a.out, B.ZA); const bf16* ZB = (const bf16*)bufp(ws, a.out, B.ZB);
    bf16* Y = (bf16*)bufp(ws, a.out, B.Y);
    const int mrows = l == DEPTH - 1 ? MLAT : MALL;
    const int grp = lane >> 4, cg = lane & 15;
    const float* gnA = a.in[I_GNORM] + l * 128; const float* gnB = a.in[I_LNORM] + l * 128;
    float gA[8], gB[8];
#pragma unroll
    for (int e = 0; e < 8; ++e) { gA[e] = gnA[8 * cg + e]; gB[e] = gnB[8 * cg + e]; }
    constexpr int UN = 4;
#pragma unroll 1
    for (int it0 = gw * 4 + grp; it0 < mrows * 8; it0 += NGW * 4 * UN) {
        v4u r0[UN], r1[UN], rz[UN];
#pragma unroll
        for (int u = 0; u < UN; ++u) {
            const int it1 = it0 + u * NGW * 4, it = it1 < mrows * 8 ? it1 : mrows * 8 - 1;
            {
                const int m = it >> 3, hs = it & 7, cid = m >> 6, i = m & 63;
                const bf16 *o0, *o1, *zp;
                if (hs < 4) { o0 = GTA + (((size_t)0 * NCHUNK + cid) * 4 + hs) * 8192 + i * 128; o1 = GTA + (((size_t)1 * NCHUNK + cid) * 4 + hs) * 8192 + i * 128; zp = ZA + (size_t)m * 512 + hs * 128; }
                else { const int h2 = hs - 4; o0 = L0 + ((size_t)cid * 4 + h2) * 12288 + i * 128; o1 = L1 + ((size_t)cid * 4 + h2) * 12288 + i * 128; zp = ZB + (size_t)m * 512 + h2 * 128; }
                r0[u] = *(const GAS v4u*)(o0 + 8 * cg); r1[u] = *(const GAS v4u*)(o1 + 8 * cg); rz[u] = *(const GAS v4u*)(zp + 8 * cg);
            }
        }
#pragma unroll
        for (int u = 0; u < UN; ++u) {
            const int it = it0 + u * NGW * 4;
            if (it < mrows * 8) {
                const int m = it >> 3, hs = it & 7;
                float f0[8], f1[8], z[8];
                unpack8(r0[u], f0); unpack8(r1[u], f1); unpack8(rz[u], z);
                float ss = 0.f;
#pragma unroll
                for (int e = 0; e < 8; ++e) { f0[e] += f1[e]; ss += f0[e] * f0[e]; }
                ss += __shfl_xor(ss, 1); ss += __shfl_xor(ss, 2); ss += __shfl_xor(ss, 4); ss += __shfl_xor(ss, 8);
                const float rstd = rsqrtf(ss * (1.0f / 128.0f) + NEPS);
                float y[8];
#pragma unroll
                for (int e = 0; e < 8; ++e) y[e] = f0[e] * rstd * (hs < 4 ? gA[e] : gB[e]) * silu_f(z[e]);
                v4u o; o.x = pk2(y[0], y[1]); o.y = pk2(y[2], y[3]); o.z = pk2(y[4], y[5]); o.w = pk2(y[6], y[7]);
                *(GAS v4u*)(Y + (size_t)m * 1024 + hs * 128 + 8 * cg) = o;
            }
        }
    }
}
constexpr int CV_W = 0  , CV_B = 2304  , CV_T = 2560;
struct ConvPre { v4u rr[11]; float w0, w1; };
struct ConvGeo { int b, gy0, W, WS, NR, HR, TW, ncell, mbase, fl, isctx; };
__device__ __forceinline__ ConvGeo conv_geo(int unit, int nslab) {
    ConvGeo g; const int slab = unit % nslab, rest = unit / nslab;
    g.isctx = rest >= 32; g.b = g.isctx ? rest - 32 : rest >> 2; g.gy0 = g.isctx ? 0 : (rest & 3) * 8;
    g.W = g.isctx ? 256 : 64; g.WS = g.isctx ? 8 : 6; g.NR = g.isctx ? 1 : 8; g.HR = g.isctx ? 0 : 1; g.TW = g.W + 2; g.ncell = (g.NR + 2 * g.HR) * g.TW;
    g.mbase = g.isctx ? MLAT + g.b * 256 : g.b * 2048; g.fl = slab * 32; return g;
}
__device__ __forceinline__ void conv_prefetch(const Args& a, int l, const bf16* U, int Fc, int f0, int unit, int nslab, int tid, ConvPre& P) {
    const ConvGeo g = conv_geo(unit, nslab);
#pragma unroll
    for (int j = 0; j < 11; ++j) {
        const int p0 = tid + 512 * j, p = p0 < g.ncell * 8 ? p0 : g.ncell * 8 - 1;
        const int cell = p >> 3, pc = p & 7, tr = cell / g.TW, tc = cell - tr * g.TW;
        const int gy = g.gy0 - g.HR + tr, gx = tc - 1;
        const bool ok = gx >= 0 && gx < g.W && gy >= 0 && gy < (g.isctx ? 1 : 32);
        const int gyc = gy < 0 ? 0 : (gy > (g.isctx ? 0 : 31) ? (g.isctx ? 0 : 31) : gy), gxc = gx < 0 ? 0 : (gx >= g.W ? g.W - 1 : gx);
        const size_t m = (size_t)g.mbase + gyc * g.W + gxc;
        const v4u v = *(const GAS v4u*)(U + m * (2 * Fc) + (pc >> 2) * Fc + g.fl + 8 * (pc & 3));
        P.rr[j] = ok ? v : (v4u){0u, 0u, 0u, 0u};
    }
    { const int p = tid, tap = p >> 6, av = (p >> 5) & 1, c = p & 31; P.w0 = a.in[I_FCONV][((size_t)l * 9 + tap) * 5632 + av * DFF + f0 + g.fl + c]; }
    { const int q = tid & 63, av = (q >> 5) & 1, c = q & 31;
      const float* src = (tid & 64) ? a.in[I_FCB] + (size_t)l * 5632 + av * DFF + f0 + g.fl + c : a.in[I_FCONV] + ((size_t)l * 9 + 8) * 5632 + av * DFF + f0 + g.fl + c;
      P.w1 = *src; }
}
__device__ __forceinline__ void conv_compute(LAS unsigned char* lds, bf16* Gd, int Fc, int unit, int nslab, int tid) {
    const ConvGeo g = conv_geo(unit, nslab);
    const LAS float* wsm = (const LAS float*)(lds + CV_W); const LAS float* bsm = (const LAS float*)(lds + CV_B); const LAS unsigned char* tile = lds + CV_T;
#pragma unroll 1
    for (int it = tid; it < g.NR * g.W * 4; it += 512) {
        const int cg = it & 3, tok = it >> 2, ry = tok >> g.WS, gx = tok & (g.W - 1);
        float sa[8], sv[8];
#pragma unroll
        for (int e = 0; e < 8; ++e) { sa[e] = bsm[8 * cg + e]; sv[e] = bsm[32 + 8 * cg + e]; }
#pragma unroll 1
        for (int dy = -1; dy <= 1; ++dy) {
            if (g.isctx && dy != 0) continue;
#pragma unroll
            for (int dx = -1; dx <= 1; ++dx) {
                const int tap = (dy + 1) * 3 + dx + 1;
                const LAS unsigned char* cp = tile + ((ry + g.HR + dy) * g.TW + gx + 1 + dx) * 192 + 16 * cg;
                float xa[8], xv[8];
                unpack8(*(const LAS v4u*)cp, xa); unpack8(*(const LAS v4u*)(cp + 64), xv);
                const LAS float* wp = wsm + tap * 64 + 8 * cg;
#pragma unroll
                for (int e = 0; e < 8; ++e) { sa[e] += xa[e] * wp[e]; sv[e] += xv[e] * wp[32 + e]; }
            }
        }
        float y[8];
#pragma unroll
        for (int e = 0; e < 8; ++e) y[e] = silu_f(sa[e]) * sv[e];
        v4u o; o.x = pk2(y[0], y[1]); o.y = pk2(y[2], y[3]); o.z = pk2(y[4], y[5]); o.w = pk2(y[6], y[7]);
        const size_t m = (size_t)g.mbase + (g.gy0 + ry) * g.W + gx;
        *(GAS v4u*)(Gd + m * Fc + g.fl + 8 * cg) = o;
    }
}
__device__ __forceinline__ void phase_conv(const Args& a, LAS unsigned char* lds, int l, int chunkA, int vcu, int G, int tid_in) {
    int tid = tid_in; asm volatile("" : "+v"(tid));
    unsigned char* ws = a.ws; const LayerBufs B = layer_bufs(l);
    const int Fc = chunkA ? FCA : FCB, f0 = chunkA ? FCB : 0, nslab = Fc / 32;
    const bf16* U = (const bf16*)bufp(ws, a.out, chunkA ? B.UA : B.UB); bf16* Gd = (bf16*)bufp(ws, a.out, chunkA ? B.GA : B.GB);
    const int nunits = (l == DEPTH - 1 ? 32 : 40) * nslab;
    ConvPre P;
    if (vcu < nunits) conv_prefetch(a, l, U, Fc, f0, vcu, nslab, tid, P);
#pragma unroll 1
    for (int u = vcu; u < nunits; u += G) {
        __syncthreads();
        {
            const ConvGeo g = conv_geo(u, nslab);
#pragma unroll
            for (int j = 0; j < 11; ++j) { const int p = tid + 512 * j; if (p < g.ncell * 8) *(LAS v4u*)(lds + CV_T + (p >> 3) * 192 + (p & 7) * 16) = P.rr[j]; }
            ((LAS float*)(lds + CV_W))[tid] = P.w0;
            if (tid < 64) ((LAS float*)(lds + CV_W))[512 + tid] = P.w1; else if (tid < 128) ((LAS float*)(lds + CV_B))[tid - 64] = P.w1;
        }
        if (u + G < nunits && !(a.pad & 32)) conv_prefetch(a, l, U, Fc, f0, u + G, nslab, tid, P);
        __syncthreads();
        if (!(a.pad & 16)) conv_compute(lds, Gd, Fc, u, nslab, tid);
    }
    __syncthreads();
}
__device__ __forceinline__ void phase_final(const Args& a, int gw, int NGW, int lane) {
    const float* rs = (const float*)(a.ws + WS_RSA) + (size_t)3 * MALL; const float* fn = a.in[I_FNORM];
    f32x4 g[4];
#pragma unroll
    for (int j = 0; j < 4; ++j) g[j] = *(const f32x4*)(fn + 4 * lane + 256 * j);
#pragma unroll 1
    for (int m0 = gw; m0 < MLAT; m0 += 4 * NGW) {
        f32x4 v[4][4]; float rstd[4];
#pragma unroll
        for (int u = 0; u < 4; ++u) { const int m1 = m0 + u * NGW, m = m1 < MLAT ? m1 : MLAT - 1; rstd[u] = rs[m];
#pragma unroll
            for (int j = 0; j < 4; ++j) v[u][j] = *(const f32x4*)(a.out + (size_t)m * 1024 + 4 * lane + 256 * j); }
#pragma unroll
        for (int u = 0; u < 4; ++u) { const int m = m0 + u * NGW; if (m < MLAT) { const float r = rsqrtf(rstd[u] * (1.0f / 1024.0f) + NEPS);
#pragma unroll
            for (int j = 0; j < 4; ++j) *(f32x4*)(a.out + (size_t)m * 1024 + 4 * lane + 256 * j) = v[u][j] * r * g[j]; } }
    }
}
constexpr int PH_P0A = 0, PH_P0B = 1, PH_L0 = 2, PH_PER_LAYER = 11, PH_FINAL = PH_L0 + 2 * PH_PER_LAYER, PH_COUNT = PH_FINAL + 1;
enum { K_INPROJ = 0, K_PREP, K_SCAN, K_MERGE, K_OUTPROJ, K_UPB, K_CONVB, K_DOWNB, K_UPA, K_CONVA, K_DOWNA };

template <int L, int K>
__device__ __forceinline__ void layer_phase(const Args& a, LAS unsigned char* lds, int vcu, int G, int bx, int tid, int wave, int lane, int gw, int NGW) {
    unsigned char* ws = a.ws;
    constexpr int l = L, k = K;
    constexpr LayerBufs B = layer_bufs(L);
    if constexpr (K == K_INPROJ || K == K_OUTPROJ || K == K_DOWNB || K == K_DOWNA || K == K_UPB || K == K_UPA) {
        const float* RSA = (const float*)(ws + WS_RSA);
        unsigned char* wl = ws + (l == 0 ? WS_W1 : WS_W2);
        const float* SWl = (const float*)(ws + WS_SW) + (size_t)l * SW_LAYER;
        constexpr int M = (l == DEPTH - 1 && k != K_INPROJ) ? MLAT : MALL;
        pg8::Gemm g; int N;
        if constexpr (K == K_INPROJ) {
            const float* rs_n1 = l == 0 ? (const float*)(ws + WS_RS1) : RSA + (size_t)1 * MALL;
            const bf16* XG = (const bf16*)bufp(ws, a.out, B.XG);
            skinny_rows(XG, (const bf16*)(ws + WS_WSM) + (size_t)l * 48 * 1024, rs_n1, SWl + 9 * NMAIN, (float*)(ws + WS_SM), gw, NGW, lane);
            N = NMAIN; g = pg8::Gemm{XG, (const bf16*)(wl + W_IN), M, N, 1024};
        } else if constexpr (K == K_OUTPROJ) { N = 1024; g = pg8::Gemm{(const bf16*)bufp(ws, a.out, B.Y), (const bf16*)(wl + W_OUT), M, N, 1024}; }
        else if constexpr (K == K_DOWNB) { N = 1024; g = pg8::Gemm{(const bf16*)bufp(ws, a.out, B.GB), (const bf16*)(wl + W_DB), M, N, FCB}; }
        else if constexpr (K == K_DOWNA) { N = 1024; g = pg8::Gemm{(const bf16*)bufp(ws, a.out, B.GA), (const bf16*)(wl + W_DA), M, N, FCA}; }
        else { constexpr int roff = k == K_UPA ? 2 * FCB : 0; N = k == K_UPA ? 2 * FCA : 2 * FCB;
            g = pg8::Gemm{(const bf16*)bufp(ws, a.out, B.XG2), (const bf16*)(wl + W_UP) + (size_t)roff * 1024, M, N, 1024}; }
        pg8::EpiAny E{ws, a.out, a.in[I_X], a.in[I_CTX], a.in[I_NORM1], a.in[I_NORM2], l, k};
        pg8::StaticOrder S; S.init(M, N, G, bx);
        pg8::gemm_phase<pg8::EpiAny, pg8::StaticOrder, true, true>(lds, g, S, E);
    }
    else if constexpr (K == K_PREP) phase_prep(a, lds, l, vcu, G, tid, wave, lane);
    else if constexpr (K == K_SCAN) phase_scan(a, lds, l, vcu, G, tid, wave, lane);
    else if constexpr (K == K_MERGE) phase_merge(a, l, gw, NGW, lane);
    else phase_conv(a, lds, l, k == K_CONVA, vcu, G, tid);
}

__global__ void __launch_bounds__(NWAVES * 64, 2) mk_fwd(Args a) {
    extern __shared__ __attribute__((aligned(16))) unsigned char lds_raw[];
    LAS unsigned char* lds = (LAS unsigned char*)lds_raw;
    const int G = gridDim.x; const int bx = blockIdx.x;
    const int vcu = (G % 8 == 0) ? (bx % 8) * (G / 8) + bx / 8 : bx;
    const int NGW = G * NWAVES;
    for (int u = threadIdx.x; u < (LDS_BYTES - LDSCTL_OFF) / 4; u += NWAVES * 64) ((LAS unsigned*)(lds + LDSCTL_OFF))[u] = 0u;
    __syncthreads();
    if (a.use_bar) (void)xcd_barrier_post((unsigned*)(a.ws + WS_CTL) + CW_BAR, (volatile LAS unsigned*)(lds + LDSCTL_OFF) + 8);

#define MK_PHASE(PH, BODY) \
    if (a.ph_lo <= (PH) && (PH) < a.ph_hi) { \
        STAMP(PH); \
        int tid_o = threadIdx.x; asm volatile("" : "+v"(tid_o)); \
        const int tid = tid_o, lane = tid & 63, wave = __builtin_amdgcn_readfirstlane(tid >> 6); \
        const int gw = vcu * NWAVES + wave; \
        (void)tid; (void)lane; (void)wave; (void)gw; \
        BODY; \
        if ((PH) + 1 < a.ph_hi && a.use_bar) { XcdBarrier bb; bb.bar = (unsigned*)(a.ws + WS_CTL) + CW_BAR; bb.x = xb_xcc_id(); bb.st = (volatile LAS unsigned*)(lds + LDSCTL_OFF) + 8; xcd_barrier(bb); } \
    }
#define MK_LP(L, K) MK_PHASE(PH_L0 + (L) * PH_PER_LAYER + (K), (layer_phase<L, K>(a, lds, vcu, G, bx, tid, wave, lane, gw, NGW)))
#define MK_LAYER(L) MK_LP(L, 0) MK_LP(L, 1) MK_LP(L, 2) MK_LP(L, 3) MK_LP(L, 4) MK_LP(L, 5) MK_LP(L, 6) MK_LP(L, 7) MK_LP(L, 8) MK_LP(L, 9) MK_LP(L, 10)
    MK_PHASE(PH_P0A, phase_p0a(a, lds, vcu, G, tid, wave, lane))
    MK_PHASE(PH_P0B, phase_p0b(a, lds, vcu, G, tid, wave, lane))
    MK_LAYER(0)
    MK_LAYER(1)
    MK_PHASE(PH_FINAL, phase_final(a, gw, NGW, lane))
    STAMP(PH_COUNT);
#ifdef MK_PROF_A
    int tq_ = threadIdx.x; asm volatile("" : "+v"(tq_));
    if (blockIdx.x == 0 && tq_ == 0) {
        volatile LAS unsigned long long* st = (volatile LAS unsigned long long*)(lds + LDSCTL_OFF + 256);
        const unsigned long long d = (st[MK_PROF_B] - st[MK_PROF_A]) * (unsigned long long)(MK_PROF_K);
        const unsigned long long t0 = __builtin_amdgcn_s_memrealtime();
        while (__builtin_amdgcn_s_memrealtime() - t0 < d) __builtin_amdgcn_s_sleep(8);
    }
#endif
}
static int g_grid = 0;
static int mk_setup() {
    if (g_grid) return g_grid;
    int dev = 0, cus = 0;
    if (hipGetDevice(&dev) != hipSuccess || hipDeviceGetAttribute(&cus, hipDeviceAttributeMultiprocessorCount, dev) != hipSuccess) { g_grid = -1; return -1; }
    if (hipFuncSetAttribute((const void*)mk_fwd, hipFuncAttributeMaxDynamicSharedMemorySize, LDS_BYTES) != hipSuccess) { fprintf(stderr, "hipFuncSetAttribute failed\n"); g_grid = -1; return -1; }
    (void)hipGetLastError();
    g_grid = cus;
    return g_grid;
}
static void mk_launch(const Args& base, int lo, int hi, int use_bar, hipStream_t stream) {
    Args a = base; a.ph_lo = lo; a.ph_hi = hi; a.use_bar = use_bar;
    hipLaunchKernelGGL(mk_fwd, dim3(g_grid), dim3(NWAVES * 64), LDS_BYTES, stream, a);
}

extern "C" void kernel_launch(void* const* d_in, const int* in_sizes, int n_in, void* d_out, int out_size, void* d_ws, size_t ws_size, hipStream_t stream) {
    if (mk_setup() < 0) return;
    unsigned char* ws = (unsigned char*)d_ws;
    (void)hipMemsetAsync(ws + WS_CTL, 0, CTL_ZERO_BYTES, stream);
    Args a{};
    for (int i = 0; i < 22; ++i) a.in[i] = (const float*)d_in[i];
    a.out = (float*)d_out; a.ws = ws;
#ifndef MK_N_LAUNCHES
#define MK_N_LAUNCHES 1
#endif
    if (MK_N_LAUNCHES == 1) mk_launch(a, 0, PH_COUNT, 1, stream);
    else for (int ph = 0; ph < PH_COUNT; ++ph) mk_launch(a, ph, ph + 1, 0, stream);
#ifdef MK_PROBE_LIST
    {
        Args p = a; p.out = (float*)(ws + 64 * MiB);
#ifdef MK_PROBE_PMODE
        p.pad = MK_PROBE_PMODE;
#endif
        const int lst[] = { MK_PROBE_LIST };
        for (int r = 0; r < MK_PROBE_REPS; ++r) for (unsigned i = 0; i < sizeof(lst) / sizeof(lst[0]); ++i) mk_launch(p, lst[i], lst[i] + 1, 0, stream);
    }
#endif
}
```

```cpp
#include <hip/hip_runtime.h>
#include <cstdio>
#include <cstdint>
#include <math.h>

#define GAS __attribute__((address_space(1)))
#define LAS __attribute__((address_space(3)))
typedef unsigned short bf16;
typedef unsigned v4u __attribute__((ext_vector_type(4)));
typedef unsigned v2u __attribute__((ext_vector_type(2)));
typedef float f32x4 __attribute__((ext_vector_type(4)));
typedef float f32x16 __attribute__((ext_vector_type(16)));
typedef short bf16x8 __attribute__((ext_vector_type(8)));
typedef short s16x4 __attribute__((ext_vector_type(4)));
typedef __bf16 bf16x2_t __attribute__((ext_vector_type(2)));
typedef float f32x2_t __attribute__((ext_vector_type(2)));
typedef GAS unsigned gu32;

constexpr int DM = 1024, NBATCH = 8, LSEQ = 2048, LCTX = 256, DEPTH = 2;
constexpr int MLAT = NBATCH * LSEQ;
constexpr int MALL = MLAT + NBATCH * LCTX;
constexpr int NCHUNK = MALL / 64;
constexpr int DINP = 3632, NMAIN = 3584, NSMALL = 48;
constexpr int DFF = 2816, FCB = 1280, FCA = 1536;
constexpr float NEPS = 1e-6f;

constexpr size_t MiB = 1u << 20;
constexpr size_t WS_CTL = 0, CTL_ZERO_BYTES = 1 * MiB;
constexpr int CW_BAR = 4096;
constexpr size_t WS_RSA = 256 * 1024;
constexpr size_t WS_MOD = 1 * MiB;
constexpr size_t WS_RS1 = 1 * MiB + 512 * 1024;
constexpr size_t WS_SW = 2 * MiB;
constexpr size_t SW_LAYER = (size_t)9 * (NMAIN + NSMALL + 2 * DFF);
constexpr size_t WS_GDEC = 3 * MiB;
constexpr size_t WS_LDEC = 4 * MiB + 512 * 1024;
constexpr size_t WS_SM = 5 * MiB + 256 * 1024;
constexpr size_t WS_HALO = 9 * MiB;
constexpr size_t WS_WSM = 11 * MiB;
constexpr size_t WS_W2 = 12 * MiB, WS_W1 = 38 * MiB;
constexpr size_t W_IN = 0, W_OUT = 7 * MiB, W_UP = 9 * MiB, W_DB = 20 * MiB, W_DA = 20 * MiB + (size_t)1024 * FCB * 2;
constexpr size_t WS_CXR = 64 * MiB;
static_assert(W_DA + (size_t)1024 * FCA * 2 <= 26 * MiB, "weights");
static_assert(WS_SM + (size_t)MALL * 48 * 4 <= WS_HALO && WS_HALO + (size_t)NCHUNK * 2 * 1536 * 2 <= WS_WSM, "ws small map");
static_assert(WS_SW + 2 * SW_LAYER * 4 <= WS_GDEC && WS_RSA + (size_t)4 * MALL * 4 <= CTL_ZERO_BYTES, "ws map");

struct LayerBufs {
    long XG, GQ, GK, GV, LV, ZA, ZB, LQ, LK, GTA, LOP0, LOP1, Y, XG2, UB, GB, UA, GA, XGN;
};
#define DO_(x) (-(long)((x) * MiB) - 1)
__host__ __device__ constexpr LayerBufs layer_bufs(int l) {
    return l == 0 ? LayerBufs{ 72 * (long)MiB, 108 * (long)MiB, 126 * (long)MiB, 144 * (long)MiB, 162 * (long)MiB, DO_(0), DO_(18), DO_(36), DO_(45),
                               180 * (long)MiB, 72 * (long)MiB, 216 * (long)MiB, 108 * (long)MiB, 72 * (long)MiB, 108 * (long)MiB, 198 * (long)MiB, 126 * (long)MiB, 72 * (long)MiB, 220 * (long)MiB }
                  : LayerBufs{ 220 * (long)MiB, 38 * (long)MiB, 56 * (long)MiB, 74 * (long)MiB, 92 * (long)MiB, 110 * (long)MiB, 128 * (long)MiB, 146 * (long)MiB, 155 * (long)MiB,
                               164 * (long)MiB, 200 * (long)MiB, 227 * (long)MiB, 38 * (long)MiB, 222 * (long)MiB, 38 * (long)MiB, 134 * (long)MiB, 38 * (long)MiB, 134 * (long)MiB, 0 };
}

#define LDS_WAIT() asm volatile("s_waitcnt lgkmcnt(0)" ::: "memory")
#define VM_WAIT() asm volatile("s_waitcnt vmcnt(0)" ::: "memory")
__device__ __forceinline__ unsigned pk2(float lo, float hi) { f32x2_t v = {lo, hi}; bf16x2_t b = __builtin_convertvector(v, bf16x2_t); return __builtin_bit_cast(unsigned, b); }
__device__ __forceinline__ float bflo(unsigned u) { return __uint_as_float(u << 16); }
__device__ __forceinline__ float bfhi(unsigned u) { return __uint_as_float(u & 0xffff0000u); }
__device__ __forceinline__ float bf2f(bf16 u) { return __uint_as_float((unsigned)u << 16); }
__device__ __forceinline__ float silu_f(float x) { return x * __builtin_amdgcn_rcpf(1.f + __expf(-x)); }
__device__ __forceinline__ float softplus_f(float x) { return fmaxf(x, 0.f) + __logf(1.f + __expf(-fabsf(x))); }
__device__ __forceinline__ float sigmoid_f(float x) { return __builtin_amdgcn_rcpf(1.f + __expf(-x)); }
__device__ __forceinline__ float wave_sum(float v) {
#pragma unroll
    for (int o = 1; o < 64; o <<= 1) v += __shfl_xor(v, o);
    return v;
}
__device__ __forceinline__ int row_s(int m) { return m < MLAT ? (m >> 11) : 8; }
__host__ __device__ __forceinline__ unsigned char* bufp(unsigned char* ws, float* out, long off) { return off >= 0 ? ws + off : (unsigned char*)out + (-off - 1); }
namespace pg8 {
#define PG8_LAS __attribute__((address_space(3)))
typedef unsigned short bf16_t;
typedef short bf16x8 __attribute__((ext_vector_type(8)));
typedef float f32x4 __attribute__((ext_vector_type(4)));
typedef unsigned u32x4 __attribute__((ext_vector_type(4)));
constexpr int BM = 256, BK = 64, HALF = 128, HTB = HALF * BK * 2  , STAGE_BYTES = 8 * HTB, NXCD = 8, WGM = 8;

__host__ __device__ __forceinline__ int lds_byte(int r, int c) { const int st = (r >> 4) * 2 + (c >> 5), rr = r & 15, cc = c & 31, ob = rr * 64 + cc * 2; return st * 1024 + (ob ^ (((ob >> 9) & 1) << 5)); }
__host__ __device__ __forceinline__ void stage_rc(int b, int& R, int& C) { const int st = b / 1024, sb = b % 1024, swz = sb ^ (((sb >> 9) & 1) << 5); R = (st >> 1) * 16 + swz / 64; C = (st & 1) * 32 + (swz % 64) / 2; }
__host__ __device__ __forceinline__ int perm32(int rho) { const int n = rho >> 4, i = rho & 15; return 8 * (i >> 2) + 4 * n + (i & 3); }

struct Unit { int pm, pn; };
struct Gemm { const bf16_t* A; const bf16_t* Bt; int M, N, K; };

struct StaticOrder {
    int nM, nN, nwg, G, c;
    __host__ __device__ void init(int M, int N, int G_, int c_) { nM = M / BM; nN = N / BM; nwg = nM * nN; G = G_; c = c_; }
    __host__ __device__ bool next(int i, Unit& u) const {
        const long L = (long)i * G + c; if (L >= nwg) return false;
        int wgid = (int)L; { const int q = nwg / NXCD, r = nwg % NXCD, xcd = wgid % NXCD, off = wgid / NXCD; wgid = (xcd < r ? xcd * (q + 1) : r * (q + 1) + (xcd - r) * q) + off; }
        const int nig = WGM * nN, gid = wgid / nig, fm = gid * WGM, gsz = (nM - fm) < WGM ? (nM - fm) : WGM;
        u.pm = fm + ((wgid % nig) % gsz); u.pn = (wgid % nig) / gsz; return true;
    }
    __device__ __forceinline__ void a_ready(const Unit&) const {}
    __device__ __forceinline__ void done(const Unit&) const {}
};
__device__ __forceinline__ unsigned pk2e(float lo, float hi) { f32x2_t v = {lo, hi}; bf16x2_t b = __builtin_convertvector(v, bf16x2_t); return __builtin_bit_cast(unsigned, b); }

struct EpiInProj {
    static constexpr bool PERM = true, AFTER_DRAIN = false;
    unsigned char* ws; float* out; int l;
    __device__ __forceinline__ void operator()(const f32x4 (&acc)[2][2][4][2], const Unit& u, int wr, int wc, int fr, int fq) const {
        const LayerBufs B = layer_bufs(l);
        const float* rowss = l == 0 ? (const float*)(ws + WS_RS1) : (const float*)(ws + WS_RSA) + MALL;
        const float* sW = (const float*)(ws + WS_SW) + (size_t)l * SW_LAYER;
        const int pn = u.pn, s = u.pm < 64 ? (u.pm >> 3) : 8;
        long boff; int ld, cb;
        if (pn < 8) { const int t = pn >> 1; boff = t == 0 ? B.GQ : (t == 1 ? B.GK : (t == 2 ? B.GV : B.ZA)); ld = 512; cb = (pn & 1) * 256; }
        else if (pn == 8) { boff = B.LQ; ld = 256; cb = 0; }
        else if (pn == 9) { boff = B.LK; ld = 256; cb = 0; }
        else { boff = pn < 12 ? B.LV : B.ZB; ld = 512; cb = (pn & 1) * 256; }
        bf16_t* base = (bf16_t*)bufp(ws, out, boff);
        bf16_t* HALO = (bf16_t*)(ws + WS_HALO);
        const int row0 = u.pm * BM + wr * 64 + fr, colw = wc * 32 + 8 * fq;
        const float* swp = sW + (size_t)s * 3584 + pn * BM + colw;
        f32x4 bv[2][2];
#pragma unroll
        for (int bj = 0; bj < 2; ++bj)
#pragma unroll
            for (int n = 0; n < 2; ++n) bv[bj][n] = *(const f32x4*)(swp + bj * HALF + 4 * n);
        float rs8[8];
#pragma unroll
        for (int q = 0; q < 8; ++q) rs8[q] = rowss[row0 + (q >> 2) * HALF + (q & 3) * 16];
#pragma unroll
        for (int ai = 0; ai < 2; ++ai)
#pragma unroll
            for (int m = 0; m < 4; ++m) {
                const int row = row0 + ai * HALF + m * 16;
                const float rstd = rsqrtf(rs8[ai * 4 + m] * (1.0f / 1024.0f) + 1e-6f);
                bf16_t* rowp = base + (size_t)row * ld + cb + colw;
                const bool halo = (pn < 6) && ((m == 0 && fr == 0) || (m == 3 && fr == 15));
                bf16_t* hp = HALO + ((size_t)(row >> 6) * 2 + (m == 3 ? 1 : 0)) * 1536 + (pn >> 1) * 512 + cb + colw;
#pragma unroll
                for (int bj = 0; bj < 2; ++bj) {
                    const f32x4 v0 = acc[ai][bj][m][0] * rstd + bv[bj][0], v1 = acc[ai][bj][m][1] * rstd + bv[bj][1];
                    u32x4 w; w.x = pk2e(v0[0], v0[1]); w.y = pk2e(v0[2], v0[3]); w.z = pk2e(v1[0], v1[1]); w.w = pk2e(v1[2], v1[3]);
                    *(u32x4*)(rowp + bj * HALF) = w;
                    if (halo) *(u32x4*)(hp + bj * HALF) = w;
                }
            }
    }
};

struct EpiResid {
    static constexpr bool PERM = true, AFTER_DRAIN = false;
    const float* rin_lat; const float* rin_ctx; float* rout_lat; float* rout_ctx;
    const float* gate;
    const float* gn;
    const float* scl;
    bf16_t* XGo; float* rowss;
    __device__ __forceinline__ void operator()(const f32x4 (&acc)[2][2][4][2], const Unit& u, int wr, int wc, int fr, int fq) const {
        const int s = u.pm < 64 ? (u.pm >> 3) : 8;
        const bool isctx = u.pm >= 64, do_xg = XGo != nullptr, do_ss = rowss != nullptr;
        const float* rin = isctx ? rin_ctx - (size_t)16384 * 1024 : rin_lat;
        float* rout = isctx ? rout_ctx - (size_t)16384 * 1024 : rout_lat;
        const int row0 = u.pm * BM + wr * 64 + fr, col0 = u.pn * BM + wc * 32 + 8 * fq;
        f32x4 gv[2][2], nv[2][2];
#pragma unroll
        for (int bj = 0; bj < 2; ++bj)
#pragma unroll
            for (int n = 0; n < 2; ++n) {
                gv[bj][n] = *(const f32x4*)(gate + (size_t)s * 6144 + col0 + bj * HALF + 4 * n);
                if (do_xg) { const f32x4 g = *(const f32x4*)(gn + col0 + bj * HALF + 4 * n), sc = *(const f32x4*)(scl + (size_t)s * 6144 + col0 + bj * HALF + 4 * n); nv[bj][n] = g * (sc + 1.0f); }
                else nv[bj][n] = (f32x4){0.f, 0.f, 0.f, 0.f};
            }
#pragma unroll
        for (int am = 0; am < 4; ++am) {
            const int ai = am >> 1, mb = (am & 1) * 2;
            f32x4 rv[2][2][2];
#pragma unroll
            for (int mm = 0; mm < 2; ++mm) { const float* rp = rin + (size_t)(row0 + ai * HALF + (mb + mm) * 16) * 1024 + col0;
#pragma unroll
                for (int bj = 0; bj < 2; ++bj) { rv[mm][bj][0] = *(const f32x4*)(rp + bj * HALF); rv[mm][bj][1] = *(const f32x4*)(rp + bj * HALF + 4); } }
#pragma unroll
            for (int mm = 0; mm < 2; ++mm) {
                const int m = mb + mm;
                const int row = row0 + ai * HALF + m * 16;
                float* op = rout + (size_t)row * 1024 + col0;
                float ss = 0.f;
#pragma unroll
                for (int bj = 0; bj < 2; ++bj) {
                    const f32x4 x0 = rv[mm][bj][0] + gv[bj][0] * acc[ai][bj][m][0];
                    const f32x4 x1 = rv[mm][bj][1] + gv[bj][1] * acc[ai][bj][m][1];
                    *(f32x4*)(op + bj * HALF) = x0; *(f32x4*)(op + bj * HALF + 4) = x1;
                    ss += (x0[0] * x0[0] + x0[1] * x0[1]) + (x0[2] * x0[2] + x0[3] * x0[3]) + (x1[0] * x1[0] + x1[1] * x1[1]) + (x1[2] * x1[2] + x1[3] * x1[3]);
                    if (do_xg) {
                        const f32x4 y0 = x0 * nv[bj][0], y1 = x1 * nv[bj][1];
                        u32x4 w; w.x = pk2e(y0[0], y0[1]); w.y = pk2e(y0[2], y0[3]); w.z = pk2e(y1[0], y1[1]); w.w = pk2e(y1[2], y1[3]);
                        *(u32x4*)(XGo + (size_t)row * 1024 + col0 + bj * HALF) = w;
                    }
                }
                if (do_ss) { ss += __shfl_xor(ss, 16); ss += __shfl_xor(ss, 32); if (fq == 0) atomicAdd(rowss + row, ss); }
            }
        }
    }
};

struct EpiUp {
    static constexpr bool PERM = true, AFTER_DRAIN = false;
    const float* rowss; const float* sW;
    bf16_t* U; int ldu;
    __device__ __forceinline__ void operator()(const f32x4 (&acc)[2][2][4][2], const Unit& u, int wr, int wc, int fr, int fq) const {
        const int s = u.pm < 64 ? (u.pm >> 3) : 8;
        const int row0 = u.pm * BM + wr * 64 + fr, col0 = u.pn * BM + wc * 32 + 8 * fq;
        const float* swp = sW + (size_t)s * 5632 + col0;
        f32x4 bv[2][2];
#pragma unroll
        for (int bj = 0; bj < 2; ++bj)
#pragma unroll
            for (int n = 0; n < 2; ++n) bv[bj][n] = *(const f32x4*)(swp + bj * HALF + 4 * n);
        float rs8[8];
#pragma unroll
        for (int q = 0; q < 8; ++q) rs8[q] = rowss[row0 + (q >> 2) * HALF + (q & 3) * 16];
#pragma unroll
        for (int ai = 0; ai < 2; ++ai)
#pragma unroll
            for (int m = 0; m < 4; ++m) {
                const int row = row0 + ai * HALF + m * 16;
                const float rstd = rsqrtf(rs8[ai * 4 + m] * (1.0f / 1024.0f) + 1e-6f);
                bf16_t* rowp = U + (size_t)row * ldu + col0;
#pragma unroll
                for (int bj = 0; bj < 2; ++bj) {
                    const f32x4 v0 = acc[ai][bj][m][0] * rstd + bv[bj][0], v1 = acc[ai][bj][m][1] * rstd + bv[bj][1];
                    u32x4 w; w.x = pk2e(v0[0], v0[1]); w.y = pk2e(v0[2], v0[3]); w.z = pk2e(v1[0], v1[1]); w.w = pk2e(v1[2], v1[3]);
                    *(u32x4*)(rowp + bj * HALF) = w;
                }
            }
    }
};

struct EpiAny {
    static constexpr bool PERM = true, AFTER_DRAIN = false;
    unsigned char* ws; float* out; const float* xin; const float* ctxin; const float* norm1; const float* norm2; int l, k;
    __device__ __forceinline__ void operator()(const f32x4 (&acc)[2][2][4][2], const Unit& u, int wr, int wc, int fr, int fq) const {
        const LayerBufs B = layer_bufs(l);
        const float* MOD = (const float*)(ws + WS_MOD); const float* MODl = MOD + (size_t)l * 9 * 6144;
        float* RSA = (float*)(ws + WS_RSA);
        if (k == 0) { EpiInProj e{ws, out, l}; e(acc, u, wr, wc, fr, fq); }
        else if (k == 5 || k == 8) {
            const float* SWl = (const float*)(ws + WS_SW) + (size_t)l * SW_LAYER;
            EpiUp e{RSA + (size_t)(l == 0 ? 0 : 2) * MALL, SWl + 9 * (NMAIN + NSMALL) + (k == 8 ? 2 * FCB : 0), (bf16_t*)bufp(ws, out, k == 8 ? B.UA : B.UB), k == 8 ? 2 * FCA : 2 * FCB};
            e(acc, u, wr, wc, fr, fq);
        } else {
            EpiResid e;
            e.rin_lat = (k == 4 && l == 0) ? xin : out; e.rin_ctx = (k == 4 && l == 0) ? ctxin : (const float*)(ws + WS_CXR);
            e.rout_lat = out; e.rout_ctx = (float*)(ws + WS_CXR);
            e.gate = MODl + (k == 4 ? 2 : 5) * 1024; e.gn = nullptr; e.scl = nullptr; e.XGo = nullptr; e.rowss = nullptr;
            if (k == 4) { e.gn = norm2 + l * 1024; e.scl = MODl + 4 * 1024; e.XGo = (bf16_t*)bufp(ws, out, B.XG2); e.rowss = RSA + (size_t)(l == 0 ? 0 : 2) * MALL; }
            else if (k == 10) { if (l != DEPTH - 1) { e.gn = norm1 + 1024; e.scl = MOD + (size_t)9 * 6144 + 1 * 1024; e.XGo = (bf16_t*)bufp(ws, out, B.XGN); e.rowss = RSA + (size_t)1 * MALL; }
                                else e.rowss = RSA + (size_t)3 * MALL; }
            e(acc, u, wr, wc, fr, fq);
        }
    }
};
template <class Epi, class Sched, bool ALIGN_EPI = false, bool SP2 = false>
__device__ __forceinline__ void gemm_phase(PG8_LAS unsigned char* lds, const Gemm g, const Sched& S, const Epi& E) {
    int tid_o = threadIdx.x; asm volatile("" : "+v"(tid_o));
    const int tid = tid_o, wid = __builtin_amdgcn_readfirstlane(tid >> 6), lane = tid & 63, wr = wid >> 2, wc = wid & 3, fr = lane & 15, fq = lane >> 4;
    const int K = g.K, nt = K / BK;
    unsigned voffA[2], voffB[2];
#pragma unroll
    for (int i = 0; i < 2; ++i) { int R, C; stage_rc(tid * 16 + i * 8192, R, C); const int Rb = Epi::PERM ? ((R & ~31) + perm32(R & 31)) : R;
        voffA[i] = (unsigned)(R * K + C) * 2u; voffB[i] = (unsigned)(Rb * K + C) * 2u; }
    const size_t kstep = (size_t)(BK * 2);
    const size_t hstep = (size_t)HALF * K * 2;
    const size_t tstep = 2 * hstep;
    const unsigned ldsw = (unsigned)wid * 1024u;
    const int aoff = lds_byte(wr * 64 + fr, fq * 8), boff = lds_byte(wc * 32 + fr, fq * 8);
#define PG8_SA(b, h) (((b) * 2 + (h)) * HTB)
#define PG8_SB(b, h) ((4 + (b) * 2 + (h)) * HTB)
#define PG8_STAGE(bufoff, gbase, voff) do { _Pragma("unroll") for (int _i = 0; _i < 2; ++_i) \
        __builtin_amdgcn_global_load_lds((const unsigned*)((const char*)(gbase) + (voff)[_i]), (PG8_LAS unsigned*)(lds + (bufoff) + ldsw + _i * 8192), 16, 0, 0); } while (0)
#define PG8_LDA(dst, b, h) do { _Pragma("unroll") for (int m = 0; m < 4; ++m) _Pragma("unroll") for (int k = 0; k < 2; ++k) dst[m][k] = *(const PG8_LAS bf16x8*)(lds + PG8_SA(b, h) + aoff + m * 2048 + k * 1024); } while (0)
#define PG8_LDB(dst, b, h) do { _Pragma("unroll") for (int n = 0; n < 2; ++n) _Pragma("unroll") for (int k = 0; k < 2; ++k) dst[n][k] = *(const PG8_LAS bf16x8*)(lds + PG8_SB(b, h) + boff + n * 2048 + k * 1024); } while (0)
#define PG8_MMA(ai, bj, At, Bt) do { __builtin_amdgcn_s_setprio(1); _Pragma("unroll") for (int m = 0; m < 4; ++m) _Pragma("unroll") for (int n = 0; n < 2; ++n) _Pragma("unroll") for (int k = 0; k < 2; ++k) \
        acc[ai][bj][m][n] = __builtin_amdgcn_mfma_f32_16x16x32_bf16(Bt[n][k], At[m][k], acc[ai][bj][m][n], 0, 0, 0); __builtin_amdgcn_s_setprio(0); } while (0)
#define PG8_WAIT_V(n) asm volatile("s_waitcnt vmcnt(" #n ")" ::: "memory")
#define PG8_WAIT_L(n) asm volatile("s_waitcnt lgkmcnt(" #n ")" ::: "memory")
#define PG8_BAR __builtin_amdgcn_s_barrier()
#define PG8_SCHED __builtin_amdgcn_sched_barrier(0)
    Unit cur, nxt; int ui = 0;
    if (!S.next(0, cur)) return;
    f32x4 acc[2][2][4][2];
#pragma unroll
    for (int a = 0; a < 2; ++a)
#pragma unroll
        for (int b = 0; b < 2; ++b)
#pragma unroll
            for (int m = 0; m < 4; ++m)
#pragma unroll
                for (int n = 0; n < 2; ++n) acc[a][b][m][n] = (f32x4){0.f, 0.f, 0.f, 0.f};
    bf16x8 At[4][2], B0[2][2], B1[2][2];
    const char* cA = (const char*)g.A + (size_t)cur.pm * tstep; const char* cB = (const char*)g.Bt + (size_t)cur.pn * tstep;
    S.a_ready(cur);
    if constexpr (SP2) {
        PG8_STAGE(PG8_SB(0, 0), cB, voffB); PG8_STAGE(PG8_SB(0, 1), cB + hstep, voffB); PG8_STAGE(PG8_SA(0, 0), cA, voffA); PG8_STAGE(PG8_SA(0, 1), cA + hstep, voffA);
        if (wr == 1) PG8_BAR;
        PG8_WAIT_V(2); PG8_BAR;
        PG8_STAGE(PG8_SB(1, 0), cB + kstep, voffB); PG8_STAGE(PG8_SA(1, 0), cA + kstep, voffA); PG8_STAGE(PG8_SB(1, 1), cB + hstep + kstep, voffB);
        PG8_WAIT_V(6); PG8_BAR;
    } else {
        PG8_STAGE(PG8_SB(0, 0), cB, voffB); PG8_STAGE(PG8_SA(0, 0), cA, voffA); PG8_STAGE(PG8_SB(0, 1), cB + hstep, voffB); PG8_STAGE(PG8_SA(0, 1), cA + hstep, voffA);
        if (wr == 1) PG8_BAR;
        PG8_WAIT_V(4); PG8_BAR;
        PG8_STAGE(PG8_SB(1, 0), cB + kstep, voffB); PG8_STAGE(PG8_SA(1, 0), cA + kstep, voffA); PG8_STAGE(PG8_SB(1, 1), cB + hstep + kstep, voffB);
        PG8_WAIT_V(6); PG8_BAR;
    }
    for (;;) {
        const bool has_next = S.next(ui + 1, nxt);
        const char* nA = has_next ? (const char*)g.A + (size_t)nxt.pm * tstep : cA; const char* nB = has_next ? (const char*)g.Bt + (size_t)nxt.pn * tstep : cB;
        for (int t = 0; t < nt; t += 2) {
            const bool last = (t == nt - 2);
            const char* a1 = cA + (size_t)(t + 1) * kstep;
            const char* a2 = last ? nA : cA + (size_t)(t + 2) * kstep; const char* b2 = last ? nB : cB + (size_t)(t + 2) * kstep;
            const char* a3 = a2 + kstep; const char* b3 = b2 + kstep;
            if (last && has_next) S.a_ready(nxt);
            if constexpr (SP2) {
            PG8_LDB(B0, 0, 0); PG8_LDB(B1, 0, 1); PG8_SCHED; PG8_LDA(At, 0, 0); PG8_STAGE(PG8_SA(1, 1), a1 + hstep, voffA);
            PG8_WAIT_V(8); PG8_WAIT_L(0); PG8_BAR; PG8_MMA(0, 0, At, B0); PG8_MMA(0, 1, At, B1); PG8_BAR; PG8_SCHED;
            PG8_LDA(At, 0, 1); PG8_STAGE(PG8_SB(0, 0), b2, voffB); PG8_STAGE(PG8_SB(0, 1), b2 + hstep, voffB); PG8_STAGE(PG8_SA(0, 0), a2, voffA);
            PG8_WAIT_V(8); PG8_WAIT_L(0); PG8_BAR; PG8_MMA(1, 0, At, B0); PG8_MMA(1, 1, At, B1); PG8_BAR; PG8_SCHED;
            PG8_LDB(B0, 1, 0); PG8_LDB(B1, 1, 1); PG8_SCHED; PG8_LDA(At, 1, 0); PG8_STAGE(PG8_SA(0, 1), a2 + hstep, voffA);
            PG8_WAIT_V(8); PG8_WAIT_L(0); PG8_BAR; PG8_MMA(0, 0, At, B0); PG8_MMA(0, 1, At, B1); PG8_BAR; PG8_SCHED;
            PG8_LDA(At, 1, 1); PG8_STAGE(PG8_SB(1, 0), b3, voffB); PG8_STAGE(PG8_SB(1, 1), b3 + hstep, voffB); PG8_STAGE(PG8_SA(1, 0), a3, voffA);
            PG8_WAIT_V(8); PG8_WAIT_L(0); PG8_BAR; PG8_MMA(1, 0, At, B0); PG8_MMA(1, 1, At, B1); PG8_BAR; PG8_SCHED;
            } else {
            PG8_LDB(B0, 0, 0); PG8_SCHED; PG8_LDA(At, 0, 0); PG8_STAGE(PG8_SA(1, 1), a1 + hstep, voffA);
            PG8_WAIT_L(8); PG8_BAR; PG8_WAIT_L(0); PG8_MMA(0, 0, At, B0); PG8_BAR; PG8_SCHED;
            PG8_LDB(B1, 0, 1); PG8_STAGE(PG8_SB(0, 0), b2, voffB);
            PG8_BAR; PG8_WAIT_L(0); PG8_MMA(0, 1, At, B1); PG8_BAR;
            PG8_LDA(At, 0, 1); PG8_STAGE(PG8_SA(0, 0), a2, voffA);
            PG8_BAR; PG8_WAIT_L(0); PG8_MMA(1, 0, At, B0); PG8_BAR; PG8_SCHED;
            PG8_STAGE(PG8_SB(0, 1), b2 + hstep, voffB);
            PG8_WAIT_V(6); PG8_BAR; PG8_MMA(1, 1, At, B1); PG8_BAR;
            PG8_LDB(B0, 1, 0); PG8_SCHED; PG8_LDA(At, 1, 0); PG8_STAGE(PG8_SA(0, 1), a2 + hstep, voffA);
            PG8_WAIT_L(8); PG8_BAR; PG8_WAIT_L(0); PG8_MMA(0, 0, At, B0); PG8_BAR; PG8_SCHED;
            PG8_LDB(B1, 1, 1); PG8_STAGE(PG8_SB(1, 0), b3, voffB);
            PG8_BAR; PG8_WAIT_L(0); PG8_MMA(0, 1, At, B1); PG8_BAR;
            PG8_LDA(At, 1, 1); PG8_STAGE(PG8_SA(1, 0), a3, voffA);
            PG8_BAR; PG8_WAIT_L(0); PG8_MMA(1, 0, At, B0); PG8_BAR; PG8_SCHED;
            PG8_STAGE(PG8_SB(1, 1), b3 + hstep, voffB);
            PG8_WAIT_V(6); PG8_BAR; PG8_MMA(1, 1, At, B1); PG8_BAR;
            }
        }
        if constexpr (ALIGN_EPI) { if (wr == 0) PG8_BAR; }
        if constexpr (!Epi::AFTER_DRAIN) { E(acc, cur, wr, wc, fr, fq); S.done(cur); }
        if (!has_next) break;
#pragma unroll
        for (int a = 0; a < 2; ++a)
#pragma unroll
            for (int b = 0; b < 2; ++b)
#pragma unroll
                for (int m = 0; m < 4; ++m)
#pragma unroll
                    for (int n = 0; n < 2; ++n) acc[a][b][m][n] = (f32x4){0.f, 0.f, 0.f, 0.f};
        cur = nxt; cA = nA; cB = nB; ++ui;
        if constexpr (ALIGN_EPI) { if (wr == 1) PG8_BAR; }
    }
    PG8_WAIT_V(0);
    if constexpr (!ALIGN_EPI) { if (wr == 0) PG8_BAR; }
    PG8_BAR;
    if constexpr (Epi::AFTER_DRAIN) { E.fused(acc, cur, wr, wc, fr, fq, lds, wid, lane); S.done(cur); }
#undef PG8_SA
#undef PG8_SB
#undef PG8_STAGE
#undef PG8_LDA
#undef PG8_LDB
#undef PG8_MMA
#undef PG8_WAIT_V
#undef PG8_WAIT_L
#undef PG8_BAR
#undef PG8_SCHED
}
}
#define XB_TMO      128
#define XB_XCNT(j)  (256  + 64 * (j))
#define XB_XSUB(j)  (1280 + 64 * (j))
#define XB_XGEN(j)  (2304 + 64 * (j))
#define XB_TOP      3328
#define XB_TOPGEN   3392
#define XCD_BAR_WORDS 3456
#define XB_SPIN_CAP (1u << 18)

__device__ __forceinline__ unsigned xb_ld(unsigned* p)              { return __hip_atomic_load(p, __ATOMIC_RELAXED, __HIP_MEMORY_SCOPE_AGENT); }
__device__ __forceinline__ unsigned xb_add(unsigned* p, unsigned v) { return __hip_atomic_fetch_add(p, v, __ATOMIC_RELAXED, __HIP_MEMORY_SCOPE_AGENT); }
__device__ __forceinline__ unsigned xb_xcc_id() { return (unsigned)__builtin_amdgcn_s_getreg((3 << 11) | 20) & 0xFu; }
#define XB_SPIN(cond, bar) do { unsigned _sp = 0; while (cond) { __builtin_amdgcn_s_sleep(1); \
    if ((++_sp & 255u) == 0u) { if (xb_ld(&(bar)[XB_TMO])) break; if (_sp > XB_SPIN_CAP) { atomicAdd(&(bar)[XB_TMO], 1u); break; } } } } while (0)

struct XcdBarrier {
    unsigned* bar; unsigned x;
    volatile LAS unsigned* st;
};

__device__ __forceinline__ XcdBarrier xcd_barrier_post(unsigned* bar, volatile LAS unsigned* st) {
    XcdBarrier b; b.bar = bar; b.x = xb_xcc_id(); b.st = st;
    if (threadIdx.x == 0) (void)xb_add(&bar[XB_XCNT(b.x)], 1u);
    return b;
}
__device__ __forceinline__ void xcd_barrier_complete(unsigned* bar, unsigned x, unsigned& nloc, unsigned& nx) {
    const unsigned G = gridDim.x * gridDim.y * gridDim.z;
    unsigned sum, cnt, mine, sp = 0u;
    for (;;) {
        sum = 0u; cnt = 0u; mine = 0u;
#pragma unroll
        for (unsigned j = 0; j < 16; ++j) { const unsigned c = xb_ld(&bar[XB_XCNT(j)]); sum += c; cnt += (c > 0u) ? 1u : 0u; mine = (j == x) ? c : mine; }
        if (sum == G) break;
        __builtin_amdgcn_s_sleep(1);
        if ((++sp & 255u) == 0u) { if (xb_ld(&bar[XB_TMO])) break; if (sp > XB_SPIN_CAP) { atomicAdd(&bar[XB_TMO], 1u); break; } }
    }
    nloc = mine > 0u ? mine : 1u; nx = cnt > 0u ? cnt : 1u;
}

__device__ __forceinline__ void xcd_barrier(const XcdBarrier& b) {
    asm volatile("s_waitcnt vmcnt(0)" ::: "memory");
    __syncthreads();
    if (threadIdx.x == 0) {
        unsigned* bar = b.bar;
        __builtin_amdgcn_s_waitcnt(0);
        unsigned nloc = b.st[0], nx = b.st[1];
        if (nloc == 0u) { xcd_barrier_complete(bar, b.x, nloc, nx); b.st[0] = nloc; b.st[1] = nx; }
        const unsigned old = xb_add(&bar[XB_XSUB(b.x)], 1u);
        const unsigned gen = old / nloc;
        if (old + 1u == (gen + 1u) * nloc) {
            __builtin_amdgcn_fence(__ATOMIC_RELEASE, "agent");
            asm volatile("s_waitcnt vmcnt(0)" ::: "memory");
            const unsigned og = xb_add(&bar[XB_TOP], 1u);
            const unsigned tg = og / nx;
            if (og + 1u == (tg + 1u) * nx) xb_add(&bar[XB_TOPGEN], 1u);
            else XB_SPIN(xb_ld(&bar[XB_TOPGEN]) == tg, bar);
            __builtin_amdgcn_fence(__ATOMIC_ACQUIRE, "agent");
            xb_add(&bar[XB_XGEN(b.x)], 1u);
            asm volatile("s_waitcnt vmcnt(0)" ::: "memory");
        } else {
            XB_SPIN(xb_ld(&bar[XB_XGEN(b.x)]) == gen, bar);
            __builtin_amdgcn_fence(__ATOMIC_ACQUIRE, "agent");
            asm volatile("s_waitcnt vmcnt(0)" ::: "memory");
        }
    }
    __syncthreads();
}
#ifdef MK_PROF_A
#define STAMP(id) do { int t_ = threadIdx.x; asm volatile("" : "+v"(t_)); if (blockIdx.x == 0 && t_ == 0) ((volatile LAS unsigned long long*)(lds + 155648 + 256))[id] = __builtin_amdgcn_s_memrealtime(); } while (0)
#else
#define STAMP(id) do {} while (0)
#endif
constexpr int NWAVES = 8;
constexpr int RING_BYTES = 131072, LDSCTL_OFF = 155648, LDS_BYTES = 163840;
struct Args {
    const float* in[22]; float* out; unsigned char* ws; int ph_lo, ph_hi; int use_bar, pad;
};
enum { I_X = 0, I_C, I_CTX, I_CCTX, I_WMOD, I_BMOD, I_NORM1, I_WIN, I_GCONV, I_ALOG, I_DTB, I_GNORM, I_WGK, I_BGK, I_LNORM, I_WOUT, I_NORM2, I_WUP, I_FCONV, I_FCB, I_WDOWN, I_FNORM };


__device__ __forceinline__ void tr_item(const float* src, int ldsrc, int k0, int c0, int ncols, bf16* dst, int lddst, int r0, int kd0, LAS float* scr, int lane) {
    const int cl = lane & 31;
    const int cle = cl < ncols ? cl : ncols - 1;
    float tv[32];
#pragma unroll
    for (int i = 0; i < 32; ++i) tv[i] = src[(size_t)(k0 + 2 * i + (lane >> 5)) * ldsrc + c0 + cle];
#pragma unroll
    for (int i = 0; i < 32; ++i) scr[(2 * i + (lane >> 5)) * 33 + cl] = tv[i];
    LDS_WAIT(); asm volatile("" ::: "memory");
    const int c = lane & 7;
#pragma unroll
    for (int j = 0; j < 4; ++j) { const int n = (lane >> 3) + 8 * j; const LAS float* s = scr + (8 * c) * 33 + n;
        v4u o; o.x = pk2(s[0 * 33], s[1 * 33]); o.y = pk2(s[2 * 33], s[3 * 33]); o.z = pk2(s[4 * 33], s[5 * 33]); o.w = pk2(s[6 * 33], s[7 * 33]);
        if (n < ncols) *(GAS v4u*)(dst + (size_t)(r0 + n) * lddst + kd0 + 8 * c) = o; }
    LDS_WAIT(); asm volatile("" ::: "memory");
}

__device__ __forceinline__ void phase_p0a(const Args& a, LAS unsigned char* lds, int vcu, int G, int tid, int wave, int lane) {
    unsigned char* ws = a.ws;
    {
        LAS float* sc = (LAS float*)lds;
        LAS float* red = (LAS float*)(lds + 36864);
        bool have = false;
        for (int it = vcu; it < 192; it += G) {
            if (!have) {
                {
                    f32x4 v[5];
#pragma unroll
                    for (int j = 0; j < 5; ++j) { const int p = tid + 512 * j; v[j] = (f32x4){0.f, 0.f, 0.f, 0.f};
                        if (p < 9 * 256) { const int s = p >> 8, k4 = p & 255; v[j] = *(const f32x4*)((s < 8 ? a.in[I_C] + s * 1024 : a.in[I_CCTX]) + 4 * k4); } }
#pragma unroll
                    for (int j = 0; j < 5; ++j) { const int p = tid + 512 * j;
                        if (p < 9 * 256) *(LAS f32x4*)(sc + 4 * p) = (f32x4){silu_f(v[j][0]), silu_f(v[j][1]), silu_f(v[j][2]), silu_f(v[j][3])}; }
                }
                __syncthreads(); have = true;
            }
            const int l = it / 96, n0 = (it % 96) * 64;
            const float* W = a.in[I_WMOD] + (size_t)l * 1024 * 6144;
            const int c4 = tid & 15, ks = tid >> 4;
            f32x4 acc[9];
#pragma unroll
            for (int s = 0; s < 9; ++s) acc[s] = (f32x4){0.f, 0.f, 0.f, 0.f};
#pragma unroll 1
            for (int j0 = 0; j0 < 32; j0 += 8) {
                f32x4 w[8];
#pragma unroll
                for (int jj = 0; jj < 8; ++jj) w[jj] = *(const f32x4*)(W + (size_t)(ks + 32 * (j0 + jj)) * 6144 + n0 + 4 * c4);
#pragma unroll
                for (int jj = 0; jj < 8; ++jj) {
                    const int k = ks + 32 * (j0 + jj);
#pragma unroll
                    for (int s = 0; s < 9; ++s) acc[s] += w[jj] * sc[s * 1024 + k];
                }
            }
#pragma unroll
            for (int s = 0; s < 9; ++s) *(LAS f32x4*)(red + (ks * 9 + s) * 64 + 4 * c4) = acc[s];
            __syncthreads();
            for (int o = tid; o < 576; o += 512) {
                const int s = o >> 6, c = o & 63; float v = 0.f;
                for (int q = 0; q < 32; ++q) v += red[(q * 9 + s) * 64 + c];
                ((float*)(ws + WS_MOD))[((size_t)l * 9 + s) * 6144 + n0 + c] = v + a.in[I_BMOD][l * 6144 + n0 + c];
            }
            __syncthreads();
        }
        __syncthreads();
    }
    STAMP(31);
    {
        LAS float* scr = (LAS float*)(lds + wave * 16384);
        const int gw = vcu * NWAVES + wave, NGW = G * NWAVES;
        constexpr int I_IN = 16 * 112, I_SM = 16 * 2, I_O = 16 * 32, I_U = 16 * 176, I_D = 44 * 32, PER_L = I_IN + I_SM + I_O + I_U + I_D;
#pragma unroll 1
        for (int it = gw; it < 2 * PER_L; it += NGW) {
            const int l = it / PER_L; int r = it % PER_L;
            unsigned char* wl = ws + (l == 0 ? WS_W1 : WS_W2);
            const float* src; int ldsrc, k0, c0, ncols = 32, lddst, r0, kd0; bf16* dst;
            if (r < I_IN) { const int kb = r / 112, n0 = (r % 112) * 32; src = a.in[I_WIN] + (size_t)l * 1024 * DINP; ldsrc = DINP; k0 = kb * 64; c0 = n0 < 2048 ? n0 : n0 + 16; dst = (bf16*)(wl + W_IN); lddst = 1024; r0 = n0; kd0 = k0; }
            else if ((r -= I_IN) < I_SM) { const int kb = r / 2, part = r % 2; src = a.in[I_WIN] + (size_t)l * 1024 * DINP; ldsrc = DINP; k0 = kb * 64; c0 = part == 0 ? 2048 : 3600; ncols = part == 0 ? 16 : 32;
                dst = (bf16*)(ws + WS_WSM) + (size_t)l * 48 * 1024; lddst = 1024; r0 = part == 0 ? 0 : 16; kd0 = k0; }
            else if ((r -= I_SM) < I_O) { const int kb = r / 32, nb = r % 32; src = a.in[I_WOUT] + (size_t)l * 1024 * 1024; ldsrc = 1024; k0 = kb * 64; c0 = nb * 32; dst = (bf16*)(wl + W_OUT); lddst = 1024; r0 = nb * 32; kd0 = k0; }
            else if ((r -= I_O) < I_U) { const int kb = r / 176, rr0 = (r % 176) * 32;
                src = a.in[I_WUP] + (size_t)l * 1024 * 5632; ldsrc = 5632; k0 = kb * 64;
                c0 = rr0 < 1280 ? rr0 : (rr0 < 2560 ? 2816 + (rr0 - 1280) : (rr0 < 4096 ? 1280 + (rr0 - 2560) : 2816 + 1280 + (rr0 - 4096)));
                dst = (bf16*)(wl + W_UP); lddst = 1024; r0 = rr0; kd0 = k0; }
            else { r -= I_U; const int kb = r / 32, nb = r % 32; k0 = kb * 64; src = a.in[I_WDOWN] + (size_t)l * DFF * 1024; ldsrc = 1024; c0 = nb * 32; r0 = nb * 32;
                if (l == DEPTH - 1) { dst = (bf16*)(wl + W_DB); lddst = DFF; kd0 = k0; }
                else if (k0 < FCB) { dst = (bf16*)(wl + W_DB); lddst = FCB; kd0 = k0; } else { dst = (bf16*)(wl + W_DA); lddst = FCA; kd0 = k0 - FCB; } }
            tr_item(src, ldsrc, k0, c0, ncols, dst, lddst, r0, kd0, scr, lane);
        }
    }
}

__device__ __forceinline__ void xg_rows(const float* xlat, const float* xctx, const float* gain, const float* scl  , bf16* XG, float* rowss, int gw, int NGW, int lane, int mrows) {
    f32x4 g[4];
#pragma unroll
    for (int j = 0; j < 4; ++j) g[j] = *(const f32x4*)(gain + 4 * lane + 256 * j);
#pragma unroll 1
    for (int m0 = gw; m0 < mrows; m0 += 4 * NGW) {
        f32x4 v[4][4];
#pragma unroll
        for (int u = 0; u < 4; ++u) { const int m1 = m0 + u * NGW, m = m1 < mrows ? m1 : mrows - 1; const float* src = m < MLAT ? xlat + (size_t)m * 1024 : xctx + (size_t)(m - MLAT) * 1024;
#pragma unroll
            for (int j = 0; j < 4; ++j) v[u][j] = *(const f32x4*)(src + 4 * lane + 256 * j); }
#pragma unroll
        for (int u = 0; u < 4; ++u) { const int m = m0 + u * NGW; if (m < mrows) {
            const int s = row_s(m); float ss = 0.f;
#pragma unroll
            for (int j = 0; j < 4; ++j) {
                const int c = 4 * lane + 256 * j; const f32x4 x = v[u][j], sc = *(const f32x4*)(scl + (size_t)s * 6144 + c);
                ss += (x[0] * x[0] + x[1] * x[1]) + (x[2] * x[2] + x[3] * x[3]);
                const f32x4 y = x * g[j] * (sc + 1.0f);
                v2u o; o.x = pk2(y[0], y[1]); o.y = pk2(y[2], y[3]);
                *(GAS v2u*)(XG + (size_t)m * 1024 + c) = o;
            }
            ss = wave_sum(ss);
            if (lane == 0) rowss[m] = ss; } }
    }
}

__device__ __forceinline__ void phase_p0b(const Args& a, LAS unsigned char* lds, int vcu, int G, int tid, int wave, int lane) {
    unsigned char* ws = a.ws;
    const int gw = vcu * NWAVES + wave, NGW = G * NWAVES;
    const float* MOD = (const float*)(ws + WS_MOD);
    constexpr LayerBufs B0 = layer_bufs(0);
    xg_rows(a.in[I_X], a.in[I_CTX], a.in[I_NORM1], MOD + 1 * 1024, (bf16*)bufp(ws, a.out, B0.XG), (float*)(ws + WS_RS1), gw, NGW, lane, MALL);
    __syncthreads();
    {
#pragma unroll 1
        for (int b0 = 0; b0 < 18; b0 += 6) {
            f32x4 v[6];
#pragma unroll
            for (int j = 0; j < 6; ++j) { const int p = tid + 512 * (b0 + j), combo = p / 2304, rem = p % 2304, s = rem >> 8, k4 = rem & 255, l = combo >> 1, which = combo & 1;
                v[j] = *(const f32x4*)(MOD + ((size_t)l * 9 + s) * 6144 + (which ? 3 : 0) * 1024 + 4 * k4); }
#pragma unroll
            for (int j = 0; j < 6; ++j) { const int p = tid + 512 * (b0 + j), combo = p / 2304, rem = p % 2304, s = rem >> 8, k4 = rem & 255;
                *(LAS v2u*)(lds + (combo * 16 + s) * 2064 + 8 * k4) = (v2u){pk2(v[j][0], v[j][1]), pk2(v[j][2], v[j][3])}; }
        }
        for (int i = tid; i < 4 * 7 * 258; i += 512) { const int combo = i / (7 * 258), rem = i % (7 * 258), s = 9 + rem / 258, q = rem % 258;
            *(LAS v2u*)(lds + (combo * 16 + s) * 2064 + 8 * q) = (v2u){0u, 0u}; }
    }
    __syncthreads();
    {
        const int r = lane & 15, g = lane >> 4;
        constexpr int T0 = (NMAIN + NSMALL) / 16, T1 = 5632 / 16, TPL = T0 + T1;
#pragma unroll 1
        for (int t = gw; t < 2 * TPL; t += NGW) {
            const int l = t / TPL, tt = t % TPL, which = tt >= T0, n0 = (which ? tt - T0 : tt) * 16;
            unsigned char* wl = ws + (l == 0 ? WS_W1 : WS_W2);
            float* SWl = (float*)(ws + WS_SW) + (size_t)l * SW_LAYER;
            const bf16* wrow; float* dst; int ldd;
            if (which) { wrow = (const bf16*)(wl + W_UP) + (size_t)(n0 + r) * 1024; dst = SWl + 9 * (NMAIN + NSMALL) + n0; ldd = 5632; }
            else if (n0 < NMAIN) { wrow = (const bf16*)(wl + W_IN) + (size_t)(n0 + r) * 1024; dst = SWl + n0; ldd = NMAIN; }
            else { wrow = (const bf16*)(ws + WS_WSM) + ((size_t)l * 48 + (n0 - NMAIN) + r) * 1024; dst = SWl + 9 * NMAIN + (n0 - NMAIN); ldd = NSMALL; }
            const LAS unsigned char* sb = lds + ((l * 2 + which) * 16 + r) * 2064 + 16 * g;
            f32x4 acc = (f32x4){0.f, 0.f, 0.f, 0.f};
#pragma unroll 1
            for (int k0 = 0; k0 < 32; k0 += 8) {
                bf16x8 af[8];
#pragma unroll
                for (int kk = 0; kk < 8; ++kk) af[kk] = *(const GAS bf16x8*)(wrow + 32 * (k0 + kk) + 8 * g);
#pragma unroll
                for (int kk = 0; kk < 8; ++kk) { const s16x4 lo = *(const LAS s16x4*)(sb + 64 * (k0 + kk)), hi = *(const LAS s16x4*)(sb + 64 * (k0 + kk) + 8);
                    acc = __builtin_amdgcn_mfma_f32_16x16x32_bf16(af[kk], __builtin_shufflevector(lo, hi, 0, 1, 2, 3, 4, 5, 6, 7), acc, 0, 0, 0); }
            }
            if (r < 9) {
#pragma unroll
                for (int j = 0; j < 4; ++j) dst[(size_t)r * ldd + 4 * g + j] = acc[j];
            }
        }
    }
    __syncthreads();
}

__device__ __forceinline__ void skinny_rows(LAS unsigned char* lds, const bf16* XG, const bf16* Wsm  , const float* rowss, const float* sWsm  , float* SM, int gw, int NGW, int tid, int lane) {
    {
        v4u wv[12];
#pragma unroll
        for (int j = 0; j < 12; ++j) wv[j] = *(const GAS v4u*)(Wsm + (size_t)(tid + 512 * j) * 8);
#pragma unroll
        for (int j = 0; j < 12; ++j) { const int p = tid + 512 * j; *(LAS v4u*)(lds + (p >> 7) * 2064 + (p & 127) * 16) = wv[j]; }
    }
    __syncthreads();
    const int r = lane & 15, g = lane >> 4;
    for (int t = gw; t < MALL / 16; t += NGW) {
        const int m0 = t * 16;
        f32x4 acc[3];
#pragma unroll
        for (int n = 0; n < 3; ++n) acc[n] = (f32x4){0.f, 0.f, 0.f, 0.f};
        const bf16* ap = XG + (size_t)(m0 + r) * 1024 + 8 * g;
        const LAS unsigned char* bp = lds + r * 2064 + 16 * g;
        float rs4[4], sw[4][3];
#pragma unroll
        for (int j = 0; j < 4; ++j) { const int m = m0 + 4 * g + j; rs4[j] = rowss[m]; const int s = row_s(m);
#pragma unroll
            for (int n = 0; n < 3; ++n) sw[j][n] = sWsm[s * 48 + 16 * n + r]; }
#pragma unroll 1
        for (int k0 = 0; k0 < 32; k0 += 16) {
            bf16x8 af[16];
#pragma unroll
            for (int kk = 0; kk < 16; ++kk) af[kk] = *(const GAS bf16x8*)(ap + 32 * (k0 + kk));
#pragma unroll
            for (int kk = 0; kk < 16; ++kk)
#pragma unroll
                for (int n = 0; n < 3; ++n) acc[n] = __builtin_amdgcn_mfma_f32_16x16x32_bf16(af[kk], *(const LAS bf16x8*)(bp + n * 16 * 2064 + 64 * (k0 + kk)), acc[n], 0, 0, 0);
        }
#pragma unroll
        for (int j = 0; j < 4; ++j) {
            const int m = m0 + 4 * g + j;
            const float rstd = rsqrtf(rs4[j] * (1.0f / 1024.0f) + NEPS);
#pragma unroll
            for (int n = 0; n < 3; ++n) SM[(size_t)m * 48 + 16 * n + r] = acc[n][j] * rstd + sw[j][n];
        }
    }
    __syncthreads();
}
#define MFMA32(a, b, c) __builtin_amdgcn_mfma_f32_32x32x16_bf16((a), (b), (c), 0, 0, 0)
__device__ __forceinline__ int crow(int reg, int h) { return (reg & 3) + 8 * (reg >> 2) + 4 * h; }
__device__ __forceinline__ bf16x8 pack_step(const f32x16& x, int s) {
    v4u p; p.x = pk2(x[8 * s], x[8 * s + 1]); p.y = pk2(x[8 * s + 2], x[8 * s + 3]); p.z = pk2(x[8 * s + 4], x[8 * s + 5]); p.w = pk2(x[8 * s + 6], x[8 * s + 7]);
    return __builtin_bit_cast(bf16x8, p);
}
__device__ __forceinline__ bf16x8 frag_perm(const LAS unsigned char* img, int stride, int row, int col16, int h) {
    const LAS unsigned char* p = img + row * stride + (col16 + 4 * h) * 2;
    const s16x4 lo = *(const LAS s16x4*)p, hi = *(const LAS s16x4*)(p + 16);
    return __builtin_shufflevector(lo, hi, 0, 1, 2, 3, 4, 5, 6, 7);
}
__device__ __forceinline__ bf16x8 frag_nat(const LAS unsigned char* img, int stride, int row, int col16, int h) {
    const LAS unsigned char* p = img + row * stride + (col16 + 8 * h) * 2;
    const s16x4 lo = *(const LAS s16x4*)p, hi = *(const LAS s16x4*)(p + 8);
    return __builtin_shufflevector(lo, hi, 0, 1, 2, 3, 4, 5, 6, 7);
}
__device__ __forceinline__ void unpack8(const v4u w, float* f) {
    f[0] = bflo(w.x); f[1] = bfhi(w.x); f[2] = bflo(w.y); f[3] = bfhi(w.y); f[4] = bflo(w.z); f[5] = bfhi(w.z); f[6] = bflo(w.w); f[7] = bfhi(w.w);
}
__device__ __forceinline__ int chunk_first(int cid) { return cid < 256 ? ((cid & 31) == 0) : ((cid & 3) == 0); }
__device__ __forceinline__ int chunk_last(int cid) { return cid < 256 ? ((cid & 31) == 31) : ((cid & 3) == 3); }

constexpr int GP_Q = 0, GP_K = 16896, GP_RAW = 33792, GP_KK = 33792, GP_QK = 50432, GP_LP = 67584, GP_LPSZ = 8448, GP_GATE = 135168, GP_GSZ = 1536, GP_CW = 141312, GP_ST = 264;
__host__ __device__ constexpr int tri_off(int i) { return i == 0 ? 0 : (8 * ((i + 3) / 4) * (((i + 3) / 4) - 1) + 4 * ((i + 3) / 4) * ((i - 1) & 3)); }
__device__ __forceinline__ int tri_off_rt(int i) { const int q = (i + 3) >> 2; return i == 0 ? 0 : 8 * q * (q - 1) + 4 * q * ((i - 1) & 3); }
struct GdnPre { v4u rr[5]; float av, bv; };
__device__ __forceinline__ void gdn_prefetch(const Args& a, int l, int cid, int h, int tid_in, GdnPre& P) {
    int tid = tid_in; asm volatile("" : "+v"(tid));
    unsigned char* ws = a.ws; const LayerBufs B = layer_bufs(l);
    const bf16* GQ = (const bf16*)bufp(ws, a.out, B.GQ); const bf16* GK = (const bf16*)bufp(ws, a.out, B.GK); const bf16* GV = (const bf16*)bufp(ws, a.out, B.GV);
    const bf16* HALO = (const bf16*)(ws + WS_HALO);
    const int m0 = cid * 64, first = chunk_first(cid), last = chunk_last(cid), grp = tid >> 4, cg = tid & 15;
#pragma unroll
    for (int j = 0; j < 5; ++j) {
        const int p0 = tid + 512 * j, p = p0 < 2 * 66 * 16 ? p0 : 2 * 66 * 16 - 1;
        const int t = p / (66 * 16), rem = p % (66 * 16), r = rem >> 4, c = rem & 15;
        const bool zero = (r == 0 && first) || (r == 65 && last);
        const bf16* src = (r == 0 && !first) ? HALO + ((size_t)(cid - 1) * 2 + 1) * 1536 + t * 512 + h * 128 + 8 * c
                        : (r == 65 && !last) ? HALO + ((size_t)(cid + 1) * 2 + 0) * 1536 + t * 512 + h * 128 + 8 * c
                        : (t == 0 ? GQ : GK) + (size_t)(m0 + (r == 0 ? 0 : (r == 65 ? 63 : r - 1))) * 512 + h * 128 + 8 * c;
        const v4u v = *(const GAS v4u*)src;
        P.rr[j] = zero ? (v4u){0u, 0u, 0u, 0u} : v;
    }
    { const float* sm = (const float*)(ws + WS_SM) + (size_t)(m0 + (tid & 63)) * 48; P.av = sm[((tid >> 6) & 1) * 4 + h]; P.bv = sm[8 + ((tid >> 6) & 1) * 4 + h]; }
}
__device__ __forceinline__ void gdn_front1(const Args& a, LAS unsigned char* lds, int l, int cid, int h, int slot, int tid_in, const GdnPre& P, float alog, float dtb) {
    int tid = tid_in; asm volatile("" : "+v"(tid));
    unsigned char* ws = a.ws; const LayerBufs B = layer_bufs(l);
    bf16* GQ = (bf16*)bufp(ws, a.out, B.GQ); bf16* GK = (bf16*)bufp(ws, a.out, B.GK); bf16* GV = (bf16*)bufp(ws, a.out, B.GV);
    const int m0 = cid * 64, grp = tid >> 4, cg = tid & 15;
    LAS unsigned char* raw_s = lds + GP_RAW;
    LAS float* gt = (LAS float*)(lds + GP_GATE + slot * GP_GSZ);
    const bf16* HALO = (const bf16*)(ws + WS_HALO);
    const int first = chunk_first(cid), last = chunk_last(cid);
    v4u vraw[2][3];
#pragma unroll
    for (int j = 0; j < 2; ++j) {
        const int r = grp + 32 * j;
#pragma unroll
        for (int d = 0; d < 3; ++d) {
            const int rr2 = r - 1 + d;
            const bool zero = (rr2 < 0 && first) || (rr2 > 63 && last);
            const bf16* src = (rr2 < 0 && !first) ? HALO + ((size_t)(cid - 1) * 2 + 1) * 1536 + 1024 + h * 128 + 8 * cg
                            : (rr2 > 63 && !last) ? HALO + ((size_t)(cid + 1) * 2 + 0) * 1536 + 1024 + h * 128 + 8 * cg
                            : GV + (size_t)(m0 + (rr2 < 0 ? 0 : (rr2 > 63 ? 63 : rr2))) * 512 + h * 128 + 8 * cg;
            const v4u v = *(const GAS v4u*)src;
            vraw[j][d] = zero ? (v4u){0u, 0u, 0u, 0u} : v;
        }
    }
#pragma unroll
    for (int j = 0; j < 5; ++j) { const int p = tid + 512 * j; if (p < 2 * 66 * 16) *(LAS v4u*)(raw_s + p * 16) = P.rr[j]; }
    if (tid < 128) {
        const int dir = tid >> 6, i = tid & 63;
        const float gval = -__expf(alog) * softplus_f(P.av + dtb), bval = sigmoid_f(P.bv);
        float c = gval;
        if (dir == 0) {
#pragma unroll
            for (int o = 1; o < 64; o <<= 1) { const float u = __shfl_up(c, o); if (i >= o) c += u; }
        } else {
#pragma unroll
            for (int o = 1; o < 64; o <<= 1) { const float u = __shfl_down(c, o); if (i + o < 64) c += u; }
        }
        gt[dir * 64 + i] = gval; gt[128 + dir * 64 + i] = bval; gt[256 + dir * 64 + i] = c;
    }
    __syncthreads();
    const LAS float* cw = (const LAS float*)(lds + GP_CW);
#pragma unroll 1
    for (int t = 0; t < 3; ++t)
#pragma unroll
    for (int jj = 0; jj < 2; ++jj) {
        const int r = grp + 32 * jj;
        float x0[8], x1[8], x2[8], y[8];
        if (t < 2) {
            unpack8(*(const LAS v4u*)(raw_s + ((t * 66 + r) * 128 + 8 * cg) * 2), x0);
            unpack8(*(const LAS v4u*)(raw_s + ((t * 66 + r + 1) * 128 + 8 * cg) * 2), x1);
            unpack8(*(const LAS v4u*)(raw_s + ((t * 66 + r + 2) * 128 + 8 * cg) * 2), x2);
        } else { unpack8(vraw[jj][0], x0); unpack8(vraw[jj][1], x1); unpack8(vraw[jj][2], x2); }
        const LAS float* w0 = cw + t * 128 + 8 * cg;
        float ss = 0.f;
#pragma unroll
        for (int e = 0; e < 8; ++e) { const float c = x0[e] * w0[e] + x1[e] * w0[384 + e] + x2[e] * w0[768 + e]; y[e] = silu_f(c); ss += y[e] * y[e]; }
        ss += __shfl_xor(ss, 1); ss += __shfl_xor(ss, 2); ss += __shfl_xor(ss, 4); ss += __shfl_xor(ss, 8);
        float sc = 1.f;
        if (t == 0) sc = rsqrtf(ss + 1e-6f) * 0.08838834764831845f; else if (t == 1) sc = rsqrtf(ss + 1e-6f);
        v4u o; o.x = pk2(y[0] * sc, y[1] * sc); o.y = pk2(y[2] * sc, y[3] * sc); o.z = pk2(y[4] * sc, y[5] * sc); o.w = pk2(y[6] * sc, y[7] * sc);
        bf16* base = t == 0 ? GQ : (t == 1 ? GK : GV);
        *(GAS v4u*)(base + (size_t)(m0 + r) * 512 + h * 128 + 8 * cg) = o;
        if (t < 2) { LAS unsigned char* d = lds + (t == 0 ? GP_Q : GP_K) + r * GP_ST + 16 * cg; *(LAS v2u*)d = (v2u){o.x, o.y}; *(LAS v2u*)(d + 8) = (v2u){o.z, o.w}; }
    }
}
__device__ __forceinline__ void gdn_front2(const Args& a, LAS unsigned char* lds, int l, int cid, int h, int slot, int tid_in, int wave_in, int lane_in) {
    int tid = tid_in; asm volatile("" : "+v"(tid));
    const int lane = tid & 63, wave = __builtin_amdgcn_readfirstlane(tid >> 6);
    unsigned char* ws = a.ws; const LayerBufs B = layer_bufs(l);
    LAS float* gt = (LAS float*)(lds + GP_GATE + slot * GP_GSZ);
    __syncthreads();
    {
        const int which = wave >> 2, ti = (wave >> 1) & 1, tj = wave & 1, r = lane & 31, hh = lane >> 5;
        f32x16 acc; for (int i = 0; i < 16; ++i) acc[i] = 0.f;
        const LAS unsigned char* Ai = lds + (which ? GP_Q : GP_K); const LAS unsigned char* Bi = lds + GP_K;
#pragma unroll
        for (int s2 = 0; s2 < 8; ++s2) acc = MFMA32(frag_nat(Ai, GP_ST, 32 * ti + r, 16 * s2, hh), frag_nat(Bi, GP_ST, 32 * tj + r, 16 * s2, hh), acc);
        LAS float* dst = (LAS float*)(lds + (which ? GP_QK : GP_KK));
#pragma unroll
        for (int i = 0; i < 16; ++i) dst[(32 * ti + crow(i, hh)) * 65 + 32 * tj + r] = acc[i];
    }
    __syncthreads();
    {
        const LAS float* KK = (const LAS float*)(lds + GP_KK); const LAS float* QK = (const LAS float*)(lds + GP_QK);
        bf16* GTA = (bf16*)bufp(ws, a.out, B.GTA);
#pragma unroll 2
        for (int it = 0; it < 16; ++it) {
            const int p = tid + 512 * it;
            const int dir = p >> 12, ip = (p >> 6) & 63, jp = p & 63;
            const int i = dir ? 63 - ip : ip, j = dir ? 63 - jp : jp;
            if (jp < ip) {
                const float lv = gt[128 + dir * 64 + i] * KK[i * 65 + j] * __expf(gt[256 + dir * 64 + i] - gt[256 + dir * 64 + j]);
                ((LAS float*)(lds + GP_LP + (slot * 2 + dir) * GP_LPSZ))[tri_off_rt(ip) + jp] = lv;
            }
            const bool keep = dir ? (jp >= ip) : (jp <= ip);
            const float av = keep ? QK[ip * 65 + jp] * __expf(gt[256 + dir * 64 + ip] - gt[256 + dir * 64 + jp]) : 0.f;
            GTA[(((size_t)dir * NCHUNK + cid) * 4 + h) * 8192 + ip * 128 + 64 + jp] = (bf16)(pk2(av, 0.f) & 0xffffu);
        }
        if (tid < 128) {
            const int dir = tid >> 6, i = tid & 63;
            float* E = (float*)(ws + WS_GDEC);
            const float gc = gt[256 + dir * 64 + i], gl = gt[256 + dir * 64 + (dir ? 0 : 63)];
            E[(((size_t)dir * NCHUNK + cid) * 4 + h) * 64 + i] = __expf(gc);
            E[(size_t)2 * NCHUNK * 4 * 64 + (((size_t)dir * NCHUNK + cid) * 4 + h) * 64 + i] = __expf(gl - gc);
            if (i == 0) E[(size_t)4 * NCHUNK * 4 * 64 + ((size_t)dir * NCHUNK + cid) * 4 + h] = __expf(gl);
        }
    }
    __syncthreads();
}
__device__ __forceinline__ void gdn_prep_invert(LAS unsigned char* lds, int slot, int dir, int wave, int lane_in) {
    int lane = lane_in; asm volatile("" : "+v"(lane));
    LAS float* Lp = (LAS float*)(lds + GP_LP + (slot * 2 + dir) * GP_LPSZ);
    LAS float* Td = (LAS float*)(lds + wave * 8192);
    const int blk = lane >> 5, c = lane & 31;
    float t[32];
#pragma unroll
    for (int i = 0; i < 32; ++i) {
        f32x4 bA[8];
        const LAS float* rowp = Lp + (blk ? tri_off(32 + i) + 32 : tri_off(i));
#pragma unroll
        for (int q = 0; q < (i + 3) / 4; ++q) bA[q] = *(const LAS f32x4*)(rowp + 4 * q);
        float a0 = (c == i) ? 1.f : 0.f, a1 = 0.f, a2 = 0.f, a3 = 0.f;
#pragma unroll
        for (int q = 0; q < (i + 3) / 4; ++q) {
            a0 -= bA[q][0] * t[4 * q];
            if (4 * q + 1 < i) a1 -= bA[q][1] * t[4 * q + 1];
            if (4 * q + 2 < i) a2 -= bA[q][2] * t[4 * q + 2];
            if (4 * q + 3 < i) a3 -= bA[q][3] * t[4 * q + 3];
        }
        t[i] = (a0 + a1) + (a2 + a3);
        Td[blk * 1024 + i * 32 + c] = t[i];
        if (c < i) Lp[(blk ? tri_off(32 + i) + 32 : tri_off(i)) + c] = t[i];
        asm volatile("" ::: "memory");
    }
    f32x16 X; for (int r = 0; r < 16; ++r) X[r] = 0.f;
    const LAS float* l21 = Lp + tri_off_rt(32 + c) + blk;
#pragma unroll
    for (int s2 = 0; s2 < 16; ++s2) X = __builtin_amdgcn_mfma_f32_32x32x2f32(l21[2 * s2], Td[(2 * s2 + blk) * 32 + c], X, 0, 0, 0);
    f32x16 Y; for (int r = 0; r < 16; ++r) Y[r] = 0.f;
#pragma unroll
    for (int s2 = 0; s2 < 16; ++s2) Y = __builtin_amdgcn_mfma_f32_32x32x2f32(Td[1024 + c * 32 + crow(s2, blk)], X[s2], Y, 0, 0, 0);
#pragma unroll
    for (int r = 0; r < 16; ++r) Lp[tri_off_rt(32 + crow(r, blk)) + c] = -Y[r];
}
__device__ __forceinline__ void gdn_prep_tb_store(const Args& a, LAS unsigned char* lds, int l, int vcu, int G, int j0, int nb, int tid_in) {
    int tid = tid_in; asm volatile("" : "+v"(tid));
    const LayerBufs B = layer_bufs(l);
    bf16* GTA = (bf16*)bufp(a.ws, a.out, B.GTA);
#pragma unroll 2
    for (int p = tid; p < nb * 2 * 64 * 8; p += 512) {
        const int pc = p & 7, io = (p >> 3) & 63, dir = (p >> 9) & 1, slot = p >> 10;
        const int it = vcu + G * (j0 + slot), cid = it >> 2, h = it & 3;
        const LAS float* Lp = (const LAS float*)(lds + GP_LP + (slot * 2 + dir) * GP_LPSZ);
        const LAS float* gt = (const LAS float*)(lds + GP_GATE + slot * GP_GSZ);
        const int ip = dir ? 63 - io : io, off = tri_off_rt(ip);
        float v[8];
#pragma unroll
        for (int e = 0; e < 8; ++e) {
            const int jo = 8 * pc + e, jp = dir ? 63 - jo : jo;
            const float tv = jp < ip ? Lp[off + jp] : (jp == ip ? 1.f : 0.f);
            v[e] = tv * gt[128 + dir * 64 + jo];
        }
        v4u o; o.x = pk2(v[0], v[1]); o.y = pk2(v[2], v[3]); o.z = pk2(v[4], v[5]); o.w = pk2(v[6], v[7]);
        *(GAS v4u*)(GTA + (((size_t)dir * NCHUNK + cid) * 4 + h) * 8192 + io * 128 + 8 * pc) = o;
    }
}

constexpr int LP_GK = 0, LP_QG = 33280, LP_KI = 51712, LP_LR = 70144, LP_W = 78336, LP_B = 86528, LP_GL = 87040, LP_QR = 87552, LP_KR = 95744, LP_ST = 144;
struct GlaPre { float lrv[4]; v4u qv, kv; };
__device__ __forceinline__ void gla_prefetch(const Args& a, int l, int cid, int h, int tid_in, GlaPre& P) {
    int tid = tid_in; asm volatile("" : "+v"(tid));
    unsigned char* ws = a.ws; const LayerBufs B = layer_bufs(l);
    const int m0 = cid * 64;
#pragma unroll
    for (int j = 0; j < 4; ++j) { const int p = tid + 512 * j; P.lrv[j] = ((const float*)(ws + WS_SM))[(size_t)(m0 + (p >> 5)) * 48 + 16 + (p & 31)]; }
    const bf16* LQ = (const bf16*)bufp(ws, a.out, B.LQ); const bf16* LK = (const bf16*)bufp(ws, a.out, B.LK);
    const int i = tid >> 3, c8 = tid & 7;
    P.qv = *(const GAS v4u*)(LQ + (size_t)(m0 + i) * 256 + h * 64 + 8 * c8); P.kv = *(const GAS v4u*)(LK + (size_t)(m0 + i) * 256 + h * 64 + 8 * c8);
}
__device__ __forceinline__ void gla_prep_unit(const Args& a, LAS unsigned char* lds, int l, int cid, int h, int tid_in, const GlaPre& P) {
    int tid = tid_in; asm volatile("" : "+v"(tid));
    const int lane = tid & 63, wave = __builtin_amdgcn_readfirstlane(tid >> 6);
    unsigned char* ws = a.ws; const LayerBufs B = layer_bufs(l);
    LAS float* gk = (LAS float*)(lds + LP_GK); LAS float* lr = (LAS float*)(lds + LP_LR); const LAS float* Wv = (const LAS float*)(lds + LP_W); const LAS float* bs = (const LAS float*)(lds + LP_B); LAS float* gl = (LAS float*)(lds + LP_GL);
    {
#pragma unroll
        for (int j = 0; j < 4; ++j) lr[tid + 512 * j] = P.lrv[j];
        const int i = tid >> 3, c8 = tid & 7;
        *(LAS v4u*)(lds + LP_QR + i * 128 + 16 * c8) = P.qv; *(LAS v4u*)(lds + LP_KR + i * 128 + 16 * c8) = P.kv;
    }
    __syncthreads();
    {
        const int dir = wave >> 2, ti = (wave >> 1) & 1, tj = wave & 1, r = lane & 31, hh = lane >> 5;
        f32x16 acc; for (int i = 0; i < 16; ++i) acc[i] = 0.f;
#pragma unroll
        for (int s2 = 0; s2 < 8; ++s2) acc = __builtin_amdgcn_mfma_f32_32x32x2f32(lr[(32 * ti + r) * 32 + dir * 16 + 2 * s2 + hh], Wv[(dir * 16 + 2 * s2 + hh) * 64 + 32 * tj + r], acc, 0, 0, 0);
        const float bc = bs[dir * 64 + 32 * tj + r];
#pragma unroll
        for (int i = 0; i < 16; ++i) gk[(dir * 64 + 32 * ti + crow(i, hh)) * 65 + 32 * tj + r] = -softplus_f(-(acc[i] + bc)) * (1.0f / 16.0f);
    }
    __syncthreads();
    if (tid < 128) {
        const int dir = tid >> 6, c = tid & 63;
        float s = 0.f;
#pragma unroll 1
        for (int i0 = 0; i0 < 64; i0 += 8) {
            float v[8];
#pragma unroll
            for (int e = 0; e < 8; ++e) { const int i = dir ? 63 - (i0 + e) : i0 + e; v[e] = gk[(dir * 64 + i) * 65 + c]; }
#pragma unroll
            for (int e = 0; e < 8; ++e) { const int i = dir ? 63 - (i0 + e) : i0 + e; s += v[e]; gk[(dir * 64 + i) * 65 + c] = s; }
        }
        gl[dir * 64 + c] = s;
        ((float*)(ws + WS_LDEC))[(((size_t)dir * NCHUNK + cid) * 4 + h) * 64 + c] = __expf(s);
    }
    __syncthreads();
    {
#pragma unroll 1
        for (int it = 0; it < 2; ++it) {
            const int p = tid + 512 * it, dir = p >> 9, i = (p >> 3) & 63, c8 = p & 7;
            float q[8], k[8];
            unpack8(*(const LAS v4u*)(lds + LP_QR + i * 128 + 16 * c8), q); unpack8(*(const LAS v4u*)(lds + LP_KR + i * 128 + 16 * c8), k);
            float qg[8], ki[8];
#pragma unroll
            for (int e = 0; e < 8; ++e) { const float gc = gk[(dir * 64 + i) * 65 + 8 * c8 + e]; qg[e] = q[e] * 0.125f * __expf(gc); ki[e] = k[e] * __expf(-gc); }
            v4u oq, ok; oq.x = pk2(qg[0], qg[1]); oq.y = pk2(qg[2], qg[3]); oq.z = pk2(qg[4], qg[5]); oq.w = pk2(qg[6], qg[7]);
            ok.x = pk2(ki[0], ki[1]); ok.y = pk2(ki[2], ki[3]); ok.z = pk2(ki[4], ki[5]); ok.w = pk2(ki[6], ki[7]);
            *(LAS v4u*)(lds + LP_QG + dir * 9216 + i * LP_ST + 16 * c8) = oq; *(LAS v4u*)(lds + LP_KI + dir * 9216 + i * LP_ST + 16 * c8) = ok;
            bf16* blk = (bf16*)bufp(ws, a.out, dir ? B.LOP1 : B.LOP0) + ((size_t)cid * 4 + h) * 12288;
            *(GAS v4u*)(blk + i * 64 + 8 * c8) = oq;
        }
#pragma unroll 1
        for (int it = 0; it < 2; ++it) {
            const int p = tid + 512 * it, dir = p >> 9, c = (p >> 3) & 63, ig = p & 7;
            const float glc = gl[dir * 64 + c];
            float kd[8];
#pragma unroll
            for (int e = 0; e < 8; ++e) { const int i = 8 * ig + e; kd[e] = bf2f(*(const LAS bf16*)(lds + LP_KR + i * 128 + 2 * c)) * __expf(glc - gk[(dir * 64 + i) * 65 + c]); }
            v4u o; o.x = pk2(kd[0], kd[1]); o.y = pk2(kd[2], kd[3]); o.z = pk2(kd[4], kd[5]); o.w = pk2(kd[6], kd[7]);
            bf16* blk = (bf16*)bufp(ws, a.out, dir ? B.LOP1 : B.LOP0) + ((size_t)cid * 4 + h) * 12288;
            *(GAS v4u*)(blk + 4096 + c * 64 + 8 * ig) = o;
        }
    }
    __syncthreads();
    {
        const int dir = wave >> 2, ti = (wave >> 1) & 1, tj = wave & 1, r = lane & 31, hh = lane >> 5;
        f32x16 acc; for (int i = 0; i < 16; ++i) acc[i] = 0.f;
        const LAS unsigned char* Ai = lds + LP_QG + dir * 9216; const LAS unsigned char* Bi = lds + LP_KI + dir * 9216;
#pragma unroll
        for (int s2 = 0; s2 < 4; ++s2) acc = MFMA32(frag_nat(Ai, LP_ST, 32 * ti + r, 16 * s2, hh), frag_nat(Bi, LP_ST, 32 * tj + r, 16 * s2, hh), acc);
        bf16* blk = (bf16*)bufp(ws, a.out, dir ? B.LOP1 : B.LOP0) + ((size_t)cid * 4 + h) * 12288 + 8192;
#pragma unroll
        for (int i = 0; i < 16; ++i) {
            const int io = 32 * ti + crow(i, hh), jo = 32 * tj + r;
            const bool keep = dir ? (jo >= io) : (jo <= io);
            blk[io * 64 + jo] = (bf16)(pk2(keep ? acc[i] : 0.f, 0.f) & 0xffffu);
        }
    }
    __syncthreads();
}

__device__ __forceinline__ void phase_prep(const Args& a, LAS unsigned char* lds, int l, int vcu, int G, int tid_in, int wave_in, int lane_in) {
    int tid = tid_in; asm volatile("" : "+v"(tid));
    const int lane = tid & 63, wave = __builtin_amdgcn_readfirstlane(tid >> 6);
    const int NU = NCHUNK * 4;
    {
        const int h0 = vcu & 3;
        for (int p = tid; p < 9 * 128; p += 512) { const int tap = p / 384, t = (p / 128) % 3, c = p & 127; ((LAS float*)(lds + GP_CW))[p] = a.in[I_GCONV][((size_t)l * 3 + tap) * 1536 + t * 512 + h0 * 128 + c]; }
        float alog = 0.f, dtb = 0.f;
        if (tid < 128) { alog = a.in[I_ALOG][l * 8 + (tid >> 6) * 4 + h0]; dtb = a.in[I_DTB][l * 8 + (tid >> 6) * 4 + h0]; }
        GdnPre P;
        if (vcu < NU) gdn_prefetch(a, l, vcu >> 2, vcu & 3, tid, P);
        __syncthreads();
#pragma unroll 1
        for (int j0 = 0; vcu + G * j0 < NU; j0 += 4) {
            int nb = 0;
#pragma unroll 1
            for (int j = 0; j < 4; ++j) {
                const int it = vcu + G * (j0 + j);
                if (it < NU) {
                    gdn_front1(a, lds, l, it >> 2, it & 3, j, tid, P, alog, dtb);
                    if (it + G < NU) gdn_prefetch(a, l, (it + G) >> 2, (it + G) & 3, tid, P);
                    gdn_front2(a, lds, l, it >> 2, it & 3, j, tid, wave, lane);
                    nb = j + 1;
                }
            }
            const int slot = wave >> 1, dir = wave & 1;
            if (slot < nb) gdn_prep_invert(lds, slot, dir, wave, lane);
            __syncthreads();
            gdn_prep_tb_store(a, lds, l, vcu, G, j0, nb, tid);
            __syncthreads();
        }
    }
    {
        const int vg = (vcu + (G & ~7) / 2) % G;
        const int h0 = vg & 3;
        for (int p = tid; p < 2 * 16 * 64; p += 512) { const int dir = p >> 10, rk = (p >> 6) & 15, c = p & 63; ((LAS float*)(lds + LP_W))[p] = a.in[I_WGK][(((size_t)l * 2 + dir) * 16 + rk) * 256 + h0 * 64 + c]; }
        if (tid < 128) ((LAS float*)(lds + LP_B))[tid] = a.in[I_BGK][((size_t)l * 2 + (tid >> 6)) * 256 + h0 * 64 + (tid & 63)];
        GlaPre P;
        if (vg < NU) gla_prefetch(a, l, vg >> 2, vg & 3, tid, P);
#pragma unroll 1
        for (int it = vg; it < NU; it += G) {
            GlaPre Pc = P;
            if (it + G < NU) gla_prefetch(a, l, (it + G) >> 2, (it + G) & 3, tid, P);
            gla_prep_unit(a, lds, l, it >> 2, it & 3, tid, Pc);
        }
    }
}

__device__ __forceinline__ int chain_cid(int b, int dir, int step) {
    if (step < 4) return 256 + 4 * b + (dir ? 3 - step : step);
    const int n = step - 4; return 32 * b + (dir ? 31 - n : n);
}
typedef short v4i16_t __attribute__((ext_vector_type(4)));
__device__ __forceinline__ s16x4 tr4(const LAS unsigned char* img, int stride, int row0, int col0, int lane) {
    const int i16 = lane & 15;
    const LAS unsigned char* p = img + (row0 + (i16 >> 2)) * stride + (col0 + 4 * (i16 & 3)) * 2;
    return __builtin_bit_cast(s16x4, __builtin_amdgcn_ds_read_tr16_b64_v4i16((LAS v4i16_t*)p));
}
__device__ __forceinline__ bf16x8 tr8(const LAS unsigned char* img, int stride, int row0, int row1, int col0, int lane) {
    const s16x4 lo = tr4(img, stride, row0, col0, lane), hi = tr4(img, stride, row1, col0, lane);
    return __builtin_shufflevector(lo, hi, 0, 1, 2, 3, 4, 5, 6, 7);
}
constexpr int GS_K = 0, GS_Q = 16896, GS_K2 = 33792, GS_V = 54272, GS_TB = 74752, GS_AT = 83456, GS_E1 = 92160, GS_E2 = 92416, GS_E3 = 92672;
struct GdnLoad { v4u q[4], k[4], v[4], t[4]; float e1, e2, e3; };
__device__ __forceinline__ void gdn_issue(const bf16* GQ, const bf16* GK, const bf16* GV, const bf16* GTA, const float* E, int cid, int h, int dir, int lt, GdnLoad& L) {
    const bf16* ta = GTA + (((size_t)dir * NCHUNK + cid) * 4 + h) * 8192;
#pragma unroll
    for (int q = 0; q < 4; ++q) {
        const int p = lt + 256 * q, row = p >> 4, cg = p & 15;
        const size_t mo = ((size_t)cid * 64 + row) * 512 + h * 128 + 8 * cg;
        L.q[q] = *(const GAS v4u*)(GQ + mo); L.k[q] = *(const GAS v4u*)(GK + mo); L.v[q] = *(const GAS v4u*)(GV + mo);
        L.t[q] = *(const GAS v4u*)(ta + p * 8);
    }
    { const size_t eo = (((size_t)dir * NCHUNK + cid) * 4 + h) * 64 + (lt & 63); L.e1 = E[eo]; L.e2 = E[(size_t)2 * NCHUNK * 4 * 64 + eo];
      L.e3 = E[(size_t)4 * NCHUNK * 4 * 64 + ((size_t)dir * NCHUNK + cid) * 4 + h]; }
}
__device__ __forceinline__ void gdn_write(LAS unsigned char* lds, int lt, const GdnLoad& L) {
#pragma unroll
    for (int q = 0; q < 4; ++q) {
        const int p = lt + 256 * q, row = p >> 4, cg = p & 15;
        LAS unsigned char* d = lds + GS_Q + row * 264 + 16 * cg; *(LAS v2u*)d = (v2u){L.q[q].x, L.q[q].y}; *(LAS v2u*)(d + 8) = (v2u){L.q[q].z, L.q[q].w};
        d = lds + GS_K + row * 264 + 16 * cg; *(LAS v2u*)d = (v2u){L.k[q].x, L.k[q].y}; *(LAS v2u*)(d + 8) = (v2u){L.k[q].z, L.k[q].w};
        *(LAS v4u*)(lds + GS_K2 + row * 320 + 16 * cg) = L.k[q];
        *(LAS v4u*)(lds + GS_V + row * 320 + 16 * cg) = L.v[q];
        d = lds + (cg < 8 ? GS_TB + row * 136 + 16 * cg : GS_AT + row * 136 + 16 * (cg - 8)); *(LAS v2u*)d = (v2u){L.t[q].x, L.t[q].y}; *(LAS v2u*)(d + 8) = (v2u){L.t[q].z, L.t[q].w};
    }
    if (lt < 64) { ((LAS float*)(lds + GS_E1))[lt] = L.e1; ((LAS float*)(lds + GS_E2))[lt] = L.e2; if (lt == 0) ((LAS float*)(lds + GS_E3))[0] = L.e3; }
}
__device__ __forceinline__ void gdn_scan_chain(const Args& a, LAS unsigned char* lds, int l, int b, int h, int dir, int tid_in, int wave_in, int lane_in) {
    int tid = tid_in; asm volatile("" : "+v"(tid));
    const int lane = tid & 63, wave = __builtin_amdgcn_readfirstlane(tid >> 6);
    unsigned char* ws = a.ws; const LayerBufs B = layer_bufs(l);
    const bf16* GQ = (const bf16*)bufp(ws, a.out, B.GQ); const bf16* GK = (const bf16*)bufp(ws, a.out, B.GK); const bf16* GV = (const bf16*)bufp(ws, a.out, B.GV);
    bf16* GTA = (bf16*)bufp(ws, a.out, B.GTA);
    const float* E = (const float*)(ws + WS_GDEC);
    __syncthreads();
    if (wave >= 4) {
        const int lt = tid - 256;
        GdnLoad LA, LB;
        gdn_issue(GQ, GK, GV, GTA, E, chain_cid(b, dir, 0), h, dir, lt, LA); gdn_write(lds, lt, LA);
        gdn_issue(GQ, GK, GV, GTA, E, chain_cid(b, dir, 1), h, dir, lt, LA);
        __syncthreads();
#pragma unroll 1
        for (int step = 0; step < 36; step += 2) {
            if (step + 2 < 36) gdn_issue(GQ, GK, GV, GTA, E, chain_cid(b, dir, step + 2), h, dir, lt, LB);
            __syncthreads();
            gdn_write(lds, lt, LA);
            __syncthreads();
            if (step + 3 < 36) gdn_issue(GQ, GK, GV, GTA, E, chain_cid(b, dir, step + 3), h, dir, lt, LA);
            __syncthreads();
            if (step + 2 < 36) gdn_write(lds, lt, LB);
            __syncthreads();
        }
    } else {
        const int r = lane & 31, hh = lane >> 5, w = wave, cb16 = ((lane >> 4) & 1) * 16;
        f32x16 S[4];
#pragma unroll
        for (int mt = 0; mt < 4; ++mt) for (int i = 0; i < 16; ++i) S[mt][i] = 0.f;
        __syncthreads();
#pragma unroll 1
        for (int step = 0; step < 36; ++step) {
            const int cid = chain_cid(b, dir, step);
            const LAS float* e1s = (const LAS float*)(lds + GS_E1); const LAS float* e2s = (const LAS float*)(lds + GS_E2);
            const float e3 = ((const LAS float*)(lds + GS_E3))[0];
            f32x16 Z[2], Q[2];
#pragma unroll
            for (int it = 0; it < 2; ++it) for (int i = 0; i < 16; ++i) { Z[it][i] = 0.f; Q[it][i] = 0.f; }
#pragma unroll
            for (int mt = 0; mt < 4; ++mt)
#pragma unroll
                for (int s = 0; s < 2; ++s) {
                    const bf16x8 sb = pack_step(S[mt], s);
#pragma unroll
                    for (int it = 0; it < 2; ++it) {
                        Z[it] = MFMA32(frag_perm(lds + GS_K, 264, 32 * it + r, 32 * mt + 16 * s, hh), sb, Z[it]);
                        Q[it] = MFMA32(frag_perm(lds + GS_Q, 264, 32 * it + r, 32 * mt + 16 * s, hh), sb, Q[it]);
                    }
                }
#pragma unroll
            for (int it = 0; it < 2; ++it)
#pragma unroll
                for (int g = 0; g < 4; ++g) {
                    const f32x4 ev = *(const LAS f32x4*)(e1s + 32 * it + 8 * g + 4 * hh);
                    const s16x4 vv = tr4(lds + GS_V, 320, 32 * it + 8 * g + 4 * hh, 32 * w + cb16, lane);
#pragma unroll
                    for (int x = 0; x < 4; ++x) { Z[it][4 * g + x] = bf2f((bf16)vv[x]) - ev[x] * Z[it][4 * g + x]; Q[it][4 * g + x] *= ev[x]; }
                }
            f32x16 Vn[2];
#pragma unroll
            for (int it = 0; it < 2; ++it) for (int i = 0; i < 16; ++i) Vn[it][i] = 0.f;
#pragma unroll
            for (int kt = 0; kt < 2; ++kt)
#pragma unroll
                for (int s = 0; s < 2; ++s) {
                    const bf16x8 rb = pack_step(Z[kt], s);
#pragma unroll
                    for (int it = 0; it < 2; ++it) Vn[it] = MFMA32(frag_perm(lds + GS_TB, 136, 32 * it + r, 32 * kt + 16 * s, hh), rb, Vn[it]);
                }
#pragma unroll
            for (int kt = 0; kt < 2; ++kt)
#pragma unroll
                for (int s = 0; s < 2; ++s) {
                    const bf16x8 vb = pack_step(Vn[kt], s);
#pragma unroll
                    for (int it = 0; it < 2; ++it) Q[it] = MFMA32(frag_perm(lds + GS_AT, 136, 32 * it + r, 32 * kt + 16 * s, hh), vb, Q[it]);
                }
            {
                bf16* ob = GTA + (((size_t)dir * NCHUNK + cid) * 4 + h) * 8192 + 32 * w + r;
#pragma unroll
                for (int it = 0; it < 2; ++it)
#pragma unroll
                    for (int i = 0; i < 16; ++i) ob[(32 * it + crow(i, hh)) * 128] = (bf16)(pk2(Q[it][i], 0.f) & 0xffffu);
            }
#pragma unroll
            for (int it = 0; it < 2; ++it)
#pragma unroll
                for (int g = 0; g < 4; ++g) {
                    const f32x4 ev = *(const LAS f32x4*)(e2s + 32 * it + 8 * g + 4 * hh);
                    Vn[it][4 * g] *= ev[0]; Vn[it][4 * g + 1] *= ev[1]; Vn[it][4 * g + 2] *= ev[2]; Vn[it][4 * g + 3] *= ev[3];
                }
#pragma unroll
            for (int mt = 0; mt < 4; ++mt) for (int i = 0; i < 16; ++i) S[mt][i] *= e3;
#pragma unroll
            for (int kt = 0; kt < 2; ++kt)
#pragma unroll
                for (int s = 0; s < 2; ++s) {
                    const bf16x8 vb = pack_step(Vn[kt], s);
                    const int T0 = 32 * kt + 16 * s + 4 * hh;
#pragma unroll
                    for (int mt = 0; mt < 4; ++mt) S[mt] = MFMA32(tr8(lds + GS_K2, 320, T0, T0 + 8, 32 * mt + cb16, lane), vb, S[mt]);
                }
            __syncthreads();
            __syncthreads();
        }
    }
}

constexpr int LS_QG = 0, LS_KD = 8704, LS_AT = 17408, LS_V = 26112, LS_E3 = 46592;
struct GlaLoad { v4u o[6], v[4]; float e3; };
__device__ __forceinline__ void gla_issue(const bf16* LOP, const bf16* LV, const float* E, int cid, int h, int dir, int lt, GlaLoad& L) {
    const bf16* blk = LOP + ((size_t)cid * 4 + h) * 12288;
#pragma unroll
    for (int q = 0; q < 6; ++q) L.o[q] = *(const GAS v4u*)(blk + (lt + 256 * q) * 8);
#pragma unroll
    for (int q = 0; q < 4; ++q) { const int p = lt + 256 * q; L.v[q] = *(const GAS v4u*)(LV + ((size_t)cid * 64 + (p >> 4)) * 512 + h * 128 + 8 * (p & 15)); }
    L.e3 = E[(((size_t)dir * NCHUNK + cid) * 4 + h) * 64 + (lt & 63)];
}
__device__ __forceinline__ void gla_write(LAS unsigned char* lds, int lt, const GlaLoad& L) {
#pragma unroll
    for (int q = 0; q < 6; ++q) { const int p = lt + 256 * q, mat = p >> 9, row = (p >> 3) & 63, cg = p & 7;
        LAS unsigned char* d = lds + mat * 8704 + row * 136 + 16 * cg; *(LAS v2u*)d = (v2u){L.o[q].x, L.o[q].y}; *(LAS v2u*)(d + 8) = (v2u){L.o[q].z, L.o[q].w}; }
#pragma unroll
    for (int q = 0; q < 4; ++q) { const int p = lt + 256 * q; *(LAS v4u*)(lds + LS_V + (p >> 4) * 320 + 16 * (p & 15)) = L.v[q]; }
    if (lt < 64) ((LAS float*)(lds + LS_E3))[lt] = L.e3;
}
__device__ __forceinline__ void gla_scan_chain(const Args& a, LAS unsigned char* lds, int l, int b, int h, int dir, int tid_in, int wave_in, int lane_in) {
    int tid = tid_in; asm volatile("" : "+v"(tid));
    const int lane = tid & 63, wave = __builtin_amdgcn_readfirstlane(tid >> 6);
    unsigned char* ws = a.ws; const LayerBufs B = layer_bufs(l);
    bf16* LOP = (bf16*)bufp(ws, a.out, dir ? B.LOP1 : B.LOP0);
    const bf16* LV = (const bf16*)bufp(ws, a.out, B.LV);
    const float* E = (const float*)(ws + WS_LDEC);
    __syncthreads();
    if (wave >= 4) {
        const int lt = tid - 256;
        GlaLoad LA, LB;
        gla_issue(LOP, LV, E, chain_cid(b, dir, 0), h, dir, lt, LA); gla_write(lds, lt, LA);
        gla_issue(LOP, LV, E, chain_cid(b, dir, 1), h, dir, lt, LA);
        __syncthreads();
#pragma unroll 1
        for (int step = 0; step < 36; step += 2) {
            if (step + 2 < 36) gla_issue(LOP, LV, E, chain_cid(b, dir, step + 2), h, dir, lt, LB);
            __syncthreads();
            gla_write(lds, lt, LA);
            __syncthreads();
            if (step + 3 < 36) gla_issue(LOP, LV, E, chain_cid(b, dir, step + 3), h, dir, lt, LA);
            __syncthreads();
            if (step + 2 < 36) gla_write(lds, lt, LB);
            __syncthreads();
        }
    } else {
        const int r = lane & 31, hh = lane >> 5, w = wave, cb16 = ((lane >> 4) & 1) * 16;
        f32x16 S[2];
#pragma unroll
        for (int mt = 0; mt < 2; ++mt) for (int i = 0; i < 16; ++i) S[mt][i] = 0.f;
        __syncthreads();
#pragma unroll 1
        for (int step = 0; step < 36; ++step) {
            const int cid = chain_cid(b, dir, step);
            const LAS float* e3s = (const LAS float*)(lds + LS_E3);
            f32x16 O[2];
#pragma unroll
            for (int it = 0; it < 2; ++it) for (int i = 0; i < 16; ++i) O[it][i] = 0.f;
#pragma unroll
            for (int mt = 0; mt < 2; ++mt)
#pragma unroll
                for (int s = 0; s < 2; ++s) {
                    const bf16x8 sb = pack_step(S[mt], s);
#pragma unroll
                    for (int it = 0; it < 2; ++it) O[it] = MFMA32(frag_perm(lds + LS_QG, 136, 32 * it + r, 32 * mt + 16 * s, hh), sb, O[it]);
                }
#pragma unroll
            for (int mt = 0; mt < 2; ++mt)
#pragma unroll
                for (int g = 0; g < 4; ++g) {
                    const f32x4 ev = *(const LAS f32x4*)(e3s + 32 * mt + 8 * g + 4 * hh);
                    S[mt][4 * g] *= ev[0]; S[mt][4 * g + 1] *= ev[1]; S[mt][4 * g + 2] *= ev[2]; S[mt][4 * g + 3] *= ev[3];
                }
#pragma unroll
            for (int kt = 0; kt < 2; ++kt)
#pragma unroll
                for (int s = 0; s < 2; ++s) {
                    const int T0 = 32 * kt + 16 * s + 8 * hh;
                    const bf16x8 vb = tr8(lds + LS_V, 320, T0, T0 + 4, 32 * w + cb16, lane);
#pragma unroll
                    for (int it = 0; it < 2; ++it) O[it] = MFMA32(frag_nat(lds + LS_AT, 136, 32 * it + r, 32 * kt + 16 * s, hh), vb, O[it]);
#pragma unroll
                    for (int mt = 0; mt < 2; ++mt) S[mt] = MFMA32(frag_nat(lds + LS_KD, 136, 32 * mt + r, 32 * kt + 16 * s, hh), vb, S[mt]);
                }
            bf16* ob = LOP + ((size_t)cid * 4 + h) * 12288 + 32 * w + r;
#pragma unroll
            for (int it = 0; it < 2; ++it)
#pragma unroll
                for (int i = 0; i < 16; ++i) ob[(32 * it + crow(i, hh)) * 128] = (bf16)(pk2(O[it][i], 0.f) & 0xffffu);
            __syncthreads();
            __syncthreads();
        }
    }
}

__device__ __forceinline__ void phase_scan(const Args& a, LAS unsigned char* lds, int l, int vcu, int G, int tid, int wave, int lane) {
    for (int ch = vcu; ch < 128; ch += G) {
        const int dir = ch & 1, h = (ch >> 1) & 3, b = (ch >> 3) & 7;
        if (ch < 64) gdn_scan_chain(a, lds, l, b, h, dir, tid, wave, lane);
        else gla_scan_chain(a, lds, l, b, h, dir, tid, wave, lane);
    }
}

__device__ __forceinline__ void merge_rows(const Args& a, int l, int m_lo, int m_hi, int gw, int NGW, int lane_in) {
    int lane = lane_in; asm volatile("" : "+v"(lane));
    unsigned char* ws = a.ws; const LayerBufs B = layer_bufs(l);
    const bf16* GTA = (const bf16*)bufp(ws, a.out, B.GTA); const bf16* L0 = (const bf16*)bufp(ws, a.out, B.LOP0); const bf16* L1 = (const bf16*)bufp(ws, a.out, B.LOP1);
    const bf16* ZA = (const bf16*)bufp(ws, a.out, B.ZA); const bf16* ZB = (const bf16*)bufp(ws, a.out, B.ZB);
    bf16* Y = (bf16*)bufp(ws, a.out, B.Y);
    const int grp = lane >> 4, cg = lane & 15;
    const float* gnA = a.in[I_GNORM] + l * 128; const float* gnB = a.in[I_LNORM] + l * 128;
    float gA[8], gB[8];
#pragma unroll
    for (int e = 0; e < 8; ++e) { gA[e] = gnA[8 * cg + e]; gB[e] = gnB[8 * cg + e]; }
    constexpr int UN = 4;
#pragma unroll 1
    for (int it0 = m_lo * 8 + gw * 4 + grp; it0 < m_hi * 8; it0 += NGW * 4 * UN) {
        v4u r0[UN], r1[UN], rz[UN];
#pragma unroll
        for (int u = 0; u < UN; ++u) {
            const int it1 = it0 + u * NGW * 4, it = it1 < m_hi * 8 ? it1 : m_hi * 8 - 1;
            {
                const int m = it >> 3, hs = it & 7, cid = m >> 6, i = m & 63;
                const bf16 *o0, *o1, *zp;
                if (hs < 4) { o0 = GTA + (((size_t)0 * NCHUNK + cid) * 4 + hs) * 8192 + i * 128; o1 = GTA + (((size_t)1 * NCHUNK + cid) * 4 + hs) * 8192 + i * 128; zp = ZA + (size_t)m * 512 + hs * 128; }
                else { const int h2 = hs - 4; o0 = L0 + ((size_t)cid * 4 + h2) * 12288 + i * 128; o1 = L1 + ((size_t)cid * 4 + h2) * 12288 + i * 128; zp = ZB + (size_t)m * 512 + h2 * 128; }
                r0[u] = *(const GAS v4u*)(o0 + 8 * cg); r1[u] = *(const GAS v4u*)(o1 + 8 * cg); rz[u] = *(const GAS v4u*)(zp + 8 * cg);
            }
        }
#pragma unroll
        for (int u = 0; u < UN; ++u) {
            const int it = it0 + u * NGW * 4;
            if (it < m_hi * 8) {
                const int m = it >> 3, hs = it & 7;
                float f0[8], f1[8], z[8];
                unpack8(r0[u], f0); unpack8(r1[u], f1); unpack8(rz[u], z);
                float ss = 0.f;
#pragma unroll
                for (int e = 0; e < 8; ++e) { f0[e] += f1[e]; ss += f0[e] * f0[e]; }
                ss += __shfl_xor(ss, 1); ss += __shfl_xor(ss, 2); ss += __shfl_xor(ss, 4); ss += __shfl_xor(ss, 8);
                const float rstd = rsqrtf(ss * (1.0f / 128.0f) + NEPS);
                float y[8];
#pragma unroll
                for (int e = 0; e < 8; ++e) y[e] = f0[e] * rstd * (hs < 4 ? gA[e] : gB[e]) * silu_f(z[e]);
                v4u o; o.x = pk2(y[0], y[1]); o.y = pk2(y[2], y[3]); o.z = pk2(y[4], y[5]); o.w = pk2(y[6], y[7]);
                *(GAS v4u*)(Y + (size_t)m * 1024 + hs * 128 + 8 * cg) = o;
            }
        }
    }
}
constexpr int CV_W = 0  , CV_B = 2304  , CV_T = 2560;
struct ConvPre { v4u rr[11]; float w0, w1; };
struct ConvGeo { int b, gy0, W, WS, NR, HR, TW, ncell, mbase, fl, isctx; };
__device__ __forceinline__ ConvGeo conv_geo(int unit, int nslab) {
    ConvGeo g; const int slab = unit % nslab, rest = unit / nslab;
    g.isctx = rest >= 32; g.b = g.isctx ? rest - 32 : rest >> 2; g.gy0 = g.isctx ? 0 : (rest & 3) * 8;
    g.W = g.isctx ? 256 : 64; g.WS = g.isctx ? 8 : 6; g.NR = g.isctx ? 1 : 8; g.HR = g.isctx ? 0 : 1; g.TW = g.W + 2; g.ncell = (g.NR + 2 * g.HR) * g.TW;
    g.mbase = g.isctx ? MLAT + g.b * 256 : g.b * 2048; g.fl = slab * 32; return g;
}
__device__ __forceinline__ void conv_prefetch(const Args& a, int l, const bf16* U, int Fc, int f0, int unit, int nslab, int tid, ConvPre& P) {
    const ConvGeo g = conv_geo(unit, nslab);
#pragma unroll
    for (int j = 0; j < 11; ++j) {
        const int p0 = tid + 512 * j, p = p0 < g.ncell * 8 ? p0 : g.ncell * 8 - 1;
        const int cell = p >> 3, pc = p & 7, tr = cell / g.TW, tc = cell - tr * g.TW;
        const int gy = g.gy0 - g.HR + tr, gx = tc - 1;
        const bool ok = gx >= 0 && gx < g.W && gy >= 0 && gy < (g.isctx ? 1 : 32);
        const int gyc = gy < 0 ? 0 : (gy > (g.isctx ? 0 : 31) ? (g.isctx ? 0 : 31) : gy), gxc = gx < 0 ? 0 : (gx >= g.W ? g.W - 1 : gx);
        const size_t m = (size_t)g.mbase + gyc * g.W + gxc;
        const v4u v = *(const GAS v4u*)(U + m * (2 * Fc) + (pc >> 2) * Fc + g.fl + 8 * (pc & 3));
        P.rr[j] = ok ? v : (v4u){0u, 0u, 0u, 0u};
    }
    { const int p = tid, tap = p >> 6, av = (p >> 5) & 1, c = p & 31; P.w0 = a.in[I_FCONV][((size_t)l * 9 + tap) * 5632 + av * DFF + f0 + g.fl + c]; }
    { const int q = tid & 63, av = (q >> 5) & 1, c = q & 31;
      const float* src = (tid & 64) ? a.in[I_FCB] + (size_t)l * 5632 + av * DFF + f0 + g.fl + c : a.in[I_FCONV] + ((size_t)l * 9 + 8) * 5632 + av * DFF + f0 + g.fl + c;
      P.w1 = *src; }
}
__device__ __forceinline__ void conv_compute(LAS unsigned char* lds, bf16* Gd, int ldg, int unit, int nslab, int tid) {
    const ConvGeo g = conv_geo(unit, nslab);
    const LAS unsigned* wsm = (const LAS unsigned*)(lds + CV_W); const LAS float* bsm = (const LAS float*)(lds + CV_B); const LAS unsigned char* tile = lds + CV_T;
    typedef __bf16 bf16x2v __attribute__((ext_vector_type(2)));
    const int cg = tid & 3, nit = g.NR * g.W * 4;
#pragma unroll 1
    for (int kp = 0; kp < 4; kp += 2) {
        float sa[2][8], sv[2][8];
#pragma unroll
        for (int k = 0; k < 2; ++k)
#pragma unroll
            for (int e = 0; e < 8; ++e) { sa[k][e] = bsm[8 * cg + e]; sv[k][e] = bsm[32 + 8 * cg + e]; }
#pragma unroll 1
        for (int dy = -1; dy <= 1; ++dy) {
            if (g.isctx && dy != 0) continue;
            unsigned wa[3][8], wv[3][8];
#pragma unroll
            for (int dx = 0; dx < 3; ++dx) {
                const LAS unsigned* wp = wsm + ((dy + 1) * 3 + dx) * 64 + 8 * cg;
                const v4u a0 = *(const LAS v4u*)wp, a1 = *(const LAS v4u*)(wp + 4), v0 = *(const LAS v4u*)(wp + 32), v1 = *(const LAS v4u*)(wp + 36);
#pragma unroll
                for (int e = 0; e < 4; ++e) { wa[dx][e] = a0[e]; wa[dx][4 + e] = a1[e]; wv[dx][e] = v0[e]; wv[dx][4 + e] = v1[e]; }
            }
#pragma unroll
            for (int k = 0; k < 2; ++k) {
                const int it = tid + 512 * (kp + k);
                if (it < nit) {
                    const int tok = it >> 2, ry = tok >> g.WS, gx = tok & (g.W - 1);
#pragma unroll
                    for (int dx = 0; dx < 3; ++dx) {
                        const LAS unsigned char* cp = tile + ((ry + g.HR + dy) * g.TW + gx + dx) * 192 + 16 * cg;
                        const v4u xa4 = *(const LAS v4u*)cp, xv4 = *(const LAS v4u*)(cp + 64);
                        const unsigned xa[4] = {xa4[0], xa4[1], xa4[2], xa4[3]}, xv[4] = {xv4[0], xv4[1], xv4[2], xv4[3]};
#pragma unroll
                        for (int e = 0; e < 8; ++e) {
                            const unsigned xq = xa[e >> 1], wq = wa[dx][e], yq = xv[e >> 1], vq = wv[dx][e];
                            sa[k][e] = __builtin_amdgcn_fdot2_f32_bf16(__builtin_bit_cast(bf16x2v, xq), __builtin_bit_cast(bf16x2v, wq), sa[k][e], false);
                            sv[k][e] = __builtin_amdgcn_fdot2_f32_bf16(__builtin_bit_cast(bf16x2v, yq), __builtin_bit_cast(bf16x2v, vq), sv[k][e], false);
                        }
                    }
                }
            }
        }
#pragma unroll
        for (int k = 0; k < 2; ++k) {
            const int it = tid + 512 * (kp + k);
            if (it < nit) {
                const int tok = it >> 2, ry = tok >> g.WS, gx = tok & (g.W - 1);
                float y[8];
#pragma unroll
                for (int e = 0; e < 8; ++e) y[e] = silu_f(sa[k][e]) * sv[k][e];
                v4u o; o.x = pk2(y[0], y[1]); o.y = pk2(y[2], y[3]); o.z = pk2(y[4], y[5]); o.w = pk2(y[6], y[7]);
                const size_t m = (size_t)g.mbase + (g.gy0 + ry) * g.W + gx;
                *(GAS v4u*)(Gd + m * ldg + g.fl + 8 * cg) = o;
            }
        }
    }
}
__device__ __forceinline__ void phase_conv(const Args& a, LAS unsigned char* lds, int l, int chunkA, int vcu, int G, int tid_in) {
    int tid = tid_in; asm volatile("" : "+v"(tid));
    unsigned char* ws = a.ws; const LayerBufs B = layer_bufs(l);
    const int Fc = chunkA ? FCA : FCB, f0 = chunkA ? FCB : 0, nslab = Fc / 32;
    const bf16* U = (const bf16*)bufp(ws, a.out, chunkA ? B.UA : B.UB);
    const int ldg = l == DEPTH - 1 ? DFF : Fc;
    bf16* Gd = (bf16*)bufp(ws, a.out, chunkA ? B.GA : B.GB) + (l == DEPTH - 1 ? f0 : 0);
    const int nunits = (l == DEPTH - 1 ? 32 : 40) * nslab;
    ConvPre P;
    if (vcu < nunits) conv_prefetch(a, l, U, Fc, f0, vcu, nslab, tid, P);
#pragma unroll 1
    for (int u = vcu; u < nunits; u += G) {
        __syncthreads();
        {
            const ConvGeo g = conv_geo(u, nslab);
#pragma unroll
            for (int j = 0; j < 11; ++j) { const int p = tid + 512 * j; if (p < g.ncell * 8) *(LAS v4u*)(lds + CV_T + (p >> 3) * 192 + (p & 7) * 16) = P.rr[j]; }
            ((LAS unsigned*)(lds + CV_W))[tid] = (tid & 1) ? (pk2(P.w0, 0.f) << 16) : (pk2(P.w0, 0.f) & 0xffffu);
            if (tid < 64) ((LAS unsigned*)(lds + CV_W))[512 + tid] = (tid & 1) ? (pk2(P.w1, 0.f) << 16) : (pk2(P.w1, 0.f) & 0xffffu); else if (tid < 128) ((LAS float*)(lds + CV_B))[tid - 64] = P.w1;
        }
        if (u + G < nunits && !(a.pad & 32)) conv_prefetch(a, l, U, Fc, f0, u + G, nslab, tid, P);
        __syncthreads();
        if (!(a.pad & 16)) conv_compute(lds, Gd, ldg, u, nslab, tid);
    }
    __syncthreads();
}
__device__ __forceinline__ void phase_final(const Args& a, int gw, int NGW, int lane) {
    const float* rs = (const float*)(a.ws + WS_RSA) + (size_t)3 * MALL; const float* fn = a.in[I_FNORM];
    f32x4 g[4];
#pragma unroll
    for (int j = 0; j < 4; ++j) g[j] = *(const f32x4*)(fn + 4 * lane + 256 * j);
#pragma unroll 1
    for (int m0 = gw; m0 < MLAT; m0 += 4 * NGW) {
        f32x4 v[4][4]; float rstd[4];
#pragma unroll
        for (int u = 0; u < 4; ++u) { const int m1 = m0 + u * NGW, m = m1 < MLAT ? m1 : MLAT - 1; rstd[u] = rs[m];
#pragma unroll
            for (int j = 0; j < 4; ++j) v[u][j] = *(const f32x4*)(a.out + (size_t)m * 1024 + 4 * lane + 256 * j); }
#pragma unroll
        for (int u = 0; u < 4; ++u) { const int m = m0 + u * NGW; if (m < MLAT) { const float r = rsqrtf(rstd[u] * (1.0f / 1024.0f) + NEPS);
#pragma unroll
            for (int j = 0; j < 4; ++j) *(f32x4*)(a.out + (size_t)m * 1024 + 4 * lane + 256 * j) = v[u][j] * r * g[j]; } }
    }
}
constexpr int PH_P0A = 0, PH_P0B = 1, PH_L0 = 2, PH_PER_LAYER = 11, PH_FINAL = PH_L0 + 2 * PH_PER_LAYER, PH_COUNT = PH_FINAL + 1;
enum { K_INPROJ = 0, K_PREP, K_SCAN, K_MERGE, K_OUTPROJ, K_UPB, K_CONVB, K_DOWNB, K_UPA, K_CONVA, K_DOWNA };

template <int L, int K>
__device__ __forceinline__ void layer_phase(const Args& a, LAS unsigned char* lds, int vcu, int G, int bx, int tid, int wave, int lane, int gw, int NGW) {
    unsigned char* ws = a.ws;
    constexpr int l = L, k = K;
    constexpr LayerBufs B = layer_bufs(L);
    if constexpr (K == K_INPROJ || K == K_OUTPROJ || K == K_DOWNB || K == K_DOWNA || K == K_UPB || K == K_UPA) {
        const float* RSA = (const float*)(ws + WS_RSA);
        unsigned char* wl = ws + (l == 0 ? WS_W1 : WS_W2);
        const float* SWl = (const float*)(ws + WS_SW) + (size_t)l * SW_LAYER;
        constexpr int M = (l == DEPTH - 1 && k != K_INPROJ) ? MLAT : MALL;
        pg8::Gemm g; int N;
        if constexpr (K == K_INPROJ) {
            const float* rs_n1 = l == 0 ? (const float*)(ws + WS_RS1) : RSA + (size_t)1 * MALL;
            const bf16* XG = (const bf16*)bufp(ws, a.out, B.XG);
            skinny_rows(lds, XG, (const bf16*)(ws + WS_WSM) + (size_t)l * 48 * 1024, rs_n1, SWl + 9 * NMAIN, (float*)(ws + WS_SM), gw, NGW, tid, lane);
            if (L == 0) STAMP(30);
            N = NMAIN; g = pg8::Gemm{XG, (const bf16*)(wl + W_IN), M, N, 1024};
        } else if constexpr (K == K_OUTPROJ) { N = 1024; g = pg8::Gemm{(const bf16*)bufp(ws, a.out, B.Y), (const bf16*)(wl + W_OUT), M, N, 1024};
        }
        else if constexpr (K == K_DOWNB) { N = 1024; g = pg8::Gemm{(const bf16*)bufp(ws, a.out, B.GB), (const bf16*)(wl + W_DB), M, N, FCB}; }
        else if constexpr (K == K_DOWNA) { N = 1024;
            if constexpr (L == DEPTH - 1) g = pg8::Gemm{(const bf16*)bufp(ws, a.out, B.GB), (const bf16*)(wl + W_DB), M, N, DFF};
            else g = pg8::Gemm{(const bf16*)bufp(ws, a.out, B.GA), (const bf16*)(wl + W_DA), M, N, FCA}; }
        else { constexpr int roff = k == K_UPA ? 2 * FCB : 0; N = k == K_UPA ? 2 * FCA : 2 * FCB;
            g = pg8::Gemm{(const bf16*)bufp(ws, a.out, B.XG2), (const bf16*)(wl + W_UP) + (size_t)roff * 1024, M, N, 1024}; }
        pg8::EpiAny E{ws, a.out, a.in[I_X], a.in[I_CTX], a.in[I_NORM1], a.in[I_NORM2], l, k};
        pg8::StaticOrder S; S.init(M, N, G, bx);
        pg8::gemm_phase<pg8::EpiAny, pg8::StaticOrder, true, true>(lds, g, S, E);
    }
    else if constexpr (K == K_PREP) phase_prep(a, lds, l, vcu, G, tid, wave, lane);
    else if constexpr (K == K_SCAN) phase_scan(a, lds, l, vcu, G, tid, wave, lane);
    else if constexpr (K == K_MERGE) merge_rows(a, l, 0, l == DEPTH - 1 ? MLAT : MALL, gw, NGW, lane);
    else phase_conv(a, lds, l, k == K_CONVA, vcu, G, tid);
}

__global__ void __launch_bounds__(NWAVES * 64, 2) mk_fwd(Args a) {
    extern __shared__ __attribute__((aligned(16))) unsigned char lds_raw[];
    LAS unsigned char* lds = (LAS unsigned char*)lds_raw;
    const int G = gridDim.x; const int bx = blockIdx.x;
    const int vcu = (G % 8 == 0) ? (bx % 8) * (G / 8) + bx / 8 : bx;
    const int NGW = G * NWAVES;
    for (int u = threadIdx.x; u < (LDS_BYTES - LDSCTL_OFF) / 4; u += NWAVES * 64) ((LAS unsigned*)(lds + LDSCTL_OFF))[u] = 0u;
    __syncthreads();
    if (a.use_bar) (void)xcd_barrier_post((unsigned*)(a.ws + WS_CTL) + CW_BAR, (volatile LAS unsigned*)(lds + LDSCTL_OFF) + 8);

#define MK_PHASE(PH, BODY) \
    if (a.ph_lo <= (PH) && (PH) < a.ph_hi) { \
        STAMP(PH); \
        int tid_o = threadIdx.x; asm volatile("" : "+v"(tid_o)); \
        const int tid = tid_o, lane = tid & 63, wave = __builtin_amdgcn_readfirstlane(tid >> 6); \
        const int gw = vcu * NWAVES + wave; \
        (void)tid; (void)lane; (void)wave; (void)gw; \
        BODY; \
        if ((PH) + 1 < a.ph_hi && a.use_bar) { XcdBarrier bb; bb.bar = (unsigned*)(a.ws + WS_CTL) + CW_BAR; bb.x = xb_xcc_id(); bb.st = (volatile LAS unsigned*)(lds + LDSCTL_OFF) + 8; xcd_barrier(bb); } \
    }
#define MK_LP(L, K) if constexpr (!((L) == DEPTH - 1 && (K) == K_DOWNB)) { MK_PHASE(PH_L0 + (L) * PH_PER_LAYER + (K), (layer_phase<L, K>(a, lds, vcu, G, bx, tid, wave, lane, gw, NGW))) }
#define MK_LAYER(L) MK_LP(L, 0) MK_LP(L, 1) MK_LP(L, 2) MK_LP(L, 3) MK_LP(L, 4) MK_LP(L, 5) MK_LP(L, 6) MK_LP(L, 7) MK_LP(L, 8) MK_LP(L, 9) MK_LP(L, 10)
    MK_PHASE(PH_P0A, phase_p0a(a, lds, vcu, G, tid, wave, lane))
    MK_PHASE(PH_P0B, phase_p0b(a, lds, vcu, G, tid, wave, lane))
    MK_LAYER(0)
    MK_LAYER(1)
    MK_PHASE(PH_FINAL, phase_final(a, gw, NGW, lane))
    STAMP(PH_COUNT);
#ifdef MK_PROF_A
    int tq_ = threadIdx.x; asm volatile("" : "+v"(tq_));
    if (blockIdx.x == 0 && tq_ == 0) {
        volatile LAS unsigned long long* st = (volatile LAS unsigned long long*)(lds + LDSCTL_OFF + 256);
        const unsigned long long d = (st[MK_PROF_B] - st[MK_PROF_A]) * (unsigned long long)(MK_PROF_K);
        const unsigned long long t0 = __builtin_amdgcn_s_memrealtime();
        while (__builtin_amdgcn_s_memrealtime() - t0 < d) __builtin_amdgcn_s_sleep(8);
    }
#endif
}
static int g_grid = 0;
static int mk_setup() {
    if (g_grid) return g_grid;
    int dev = 0, cus = 0;
    if (hipGetDevice(&dev) != hipSuccess || hipDeviceGetAttribute(&cus, hipDeviceAttributeMultiprocessorCount, dev) != hipSuccess) { g_grid = -1; return -1; }
    if (hipFuncSetAttribute((const void*)mk_fwd, hipFuncAttributeMaxDynamicSharedMemorySize, LDS_BYTES) != hipSuccess) { fprintf(stderr, "hipFuncSetAttribute failed\n"); g_grid = -1; return -1; }
    (void)hipGetLastError();
    g_grid = cus;
    return g_grid;
}
static void mk_launch(const Args& base, int lo, int hi, int use_bar, hipStream_t stream) {
    Args a = base; a.ph_lo = lo; a.ph_hi = hi; a.use_bar = use_bar;
    hipLaunchKernelGGL(mk_fwd, dim3(g_grid), dim3(NWAVES * 64), LDS_BYTES, stream, a);
}

extern "C" void kernel_launch(void* const* d_in, const int* in_sizes, int n_in, void* d_out, int out_size, void* d_ws, size_t ws_size, hipStream_t stream) {
    if (mk_setup() < 0) return;
    unsigned char* ws = (unsigned char*)d_ws;
    (void)hipMemsetAsync(ws + WS_CTL, 0, CTL_ZERO_BYTES, stream);
    Args a{};
    for (int i = 0; i < 22; ++i) a.in[i] = (const float*)d_in[i];
    a.out = (float*)d_out; a.ws = ws;
#ifndef MK_N_LAUNCHES
#define MK_N_LAUNCHES 1
#endif
    if (MK_N_LAUNCHES == 1) mk_launch(a, 0, PH_COUNT, 1, stream);
    else for (int ph = 0; ph < PH_COUNT; ++ph) mk_launch(a, ph, ph + 1, 0, stream);
#ifdef MK_PROBE_LIST
    {
        Args p = a; p.out = (float*)(ws + 64 * MiB);
#ifdef MK_PROBE_PMODE
        p.pad = MK_PROBE_PMODE;
#endif
        const int lst[] = { MK_PROBE_LIST };
        for (int r = 0; r < MK_PROBE_REPS; ++r) for (unsigned i = 0; i < sizeof(lst) / sizeof(lst[0]); ++i) mk_launch(p, lst[i], lst[i] + 1, 0, stream);
    }
#endif
}
```
